# Optimizing an MI355X kernel written in HIP

```python
import math
import jax, jax.numpy as jnp
from jax import lax
import numpy as np

D_MODEL = 1024
BATCH = 1
SEQ = 16384
DEPTH = 2

GRID_W = 64
CTX_LEN = 256

MLA_HEADS = 8
MLA_NOPE = 64
MLA_ROPE = 32
MLA_V = 64
MLA_QK = MLA_NOPE + MLA_ROPE
MLA_Q_LORA = 384
MLA_KV_LORA = 256

NA_HEADS = 8
NA_HEAD_DIM = 64
NA_WIDTH = NA_HEADS * NA_HEAD_DIM
NA_WIN_ROWS = 8
NA_WIN_COLS = 16

RW_HEADS = 8
RW_HEAD_DIM = 64
RW_WIDTH = RW_HEADS * RW_HEAD_DIM
RW_DECAY_LORA = 64
RW_ICLR_LORA = 64
RW_GATE_LORA = 128
RW_GN_EPS = 64e-5
RW_IN = 3 * RW_WIDTH + 2 * RW_DECAY_LORA + 2 * RW_ICLR_LORA + RW_GATE_LORA

N_BRANCHES = 3
IN_SIZES = (MLA_Q_LORA, MLA_KV_LORA, MLA_ROPE, NA_WIDTH, NA_WIDTH, NA_WIDTH, RW_IN, N_BRANCHES * D_MODEL)
IN_WIDTH = sum(IN_SIZES)

FFN_DENSE = 2816
N_EXPERTS = 8
TOP_K = 2
FFN_EXPERT = 3584
MOE_BLOCK = 128
N_DENSE = (DEPTH + 1) // 2
N_MOE = DEPTH // 2

Q_BLOCK = 128
ROPE_BASE = 10000.0
NORM_EPS = 1e-6

kernel_name = "hybrid_mla_natten_rwkv7_moe_dit_block"


def rms_norm(x, g, eps=NORM_EPS):
    xf = x.astype(jnp.float32)
    y = xf * lax.rsqrt(jnp.mean(xf * xf, axis=-1, keepdims=True) + eps)
    return (y * g.astype(jnp.float32)).astype(x.dtype)


def split_last(t, sizes):
    return jnp.split(t, np.cumsum(sizes)[:-1].tolist(), axis=-1)


def to_heads(t, n_heads):
    return t.reshape(t.shape[:-1] + (n_heads, t.shape[-1] // n_heads))


def rope_axis(t, pos):
    half = t.shape[-1] // 2
    freqs = jnp.exp(-math.log(ROPE_BASE) * jnp.arange(half, dtype=jnp.float32) / half)
    ang = pos.astype(jnp.float32)[:, None] * freqs[None, :]
    cos, sin = jnp.cos(ang)[:, None, :], jnp.sin(ang)[:, None, :]
    t1 = t[..., :half].astype(jnp.float32)
    t2 = t[..., half:].astype(jnp.float32)
    return jnp.concatenate([t1 * cos - t2 * sin, t1 * sin + t2 * cos], axis=-1).astype(t.dtype)


def rope_2d_tail(t, n_pass, rows, cols):
    tail = t[..., n_pass:]
    a = tail.shape[-1] // 2
    return jnp.concatenate([t[..., :n_pass], rope_axis(tail[..., :a], rows), rope_axis(tail[..., a:], cols)], axis=-1)


def block_attention(q, k, v):
    B, Lq, H, dq = q.shape
    scale = dq ** -0.5
    nb = Lq // Q_BLOCK
    qb = q.reshape(B, nb, Q_BLOCK, H, dq).swapaxes(0, 1)

    def one(q_blk):
        s = jnp.einsum('bqhd,bkhd->bhqk', q_blk, k, preferred_element_type=jnp.float32) * scale
        p = jax.nn.softmax(s, axis=-1).astype(v.dtype)
        return jnp.einsum('bhqk,bkhd->bqhd', p, v)

    o = lax.map(one, qb)
    return o.swapaxes(0, 1).reshape(B, Lq, H, v.shape[-1])


def mla_queries(cq, cq_g, wuq, qn_g):
    q = to_heads(rms_norm(cq, cq_g) @ wuq, MLA_HEADS)
    return rms_norm(q, qn_g)


def mla_keys_values(ckv, kr, ckv_g, wukv, kn_g):
    kv = to_heads(rms_norm(ckv, ckv_g) @ wukv, MLA_HEADS)
    k_nope, v = kv[..., :MLA_NOPE], kv[..., MLA_NOPE:]
    k_rope = jnp.broadcast_to(kr[:, :, None, :], k_nope.shape[:-1] + (MLA_ROPE,))
    k = rms_norm(jnp.concatenate([k_nope, k_rope], axis=-1), kn_g)
    return k, v


def neighbourhood_attention(q, k, v, k_ctx, v_ctx, rpb):
    B, L, H, dh = q.shape
    n_rows = L // GRID_W
    kr = min(NA_WIN_ROWS, n_rows)
    kw = NA_WIN_COLS
    scale = dh ** -0.5
    kg = k.reshape(B, n_rows, GRID_W, H, dh)
    vg = v.reshape(B, n_rows, GRID_W, H, dh)
    qg = q.reshape(B, n_rows, GRID_W, H, dh).swapaxes(0, 1)
    cols = jnp.arange(GRID_W)
    col_start = jnp.clip(cols - kw // 2, 0, GRID_W - kw)
    col_idx = col_start[:, None] + jnp.arange(kw)[None, :]
    dc = col_idx - cols[:, None] + (NA_WIN_COLS - 1)

    def one_row(args):
        q_row, r = args
        rs = jnp.clip(r - kr // 2, 0, n_rows - kr)
        k_nb = lax.dynamic_slice_in_dim(kg, rs, kr, axis=1)[:, :, col_idx]
        v_nb = lax.dynamic_slice_in_dim(vg, rs, kr, axis=1)[:, :, col_idx]
        dr = rs + jnp.arange(kr) - r + (NA_WIN_ROWS - 1)
        bias = rpb[:, dr[None, :, None], dc[:, None, :]].astype(jnp.float32)
        s_loc = jnp.einsum('bqhd,brqjhd->bhqrj', q_row, k_nb, preferred_element_type=jnp.float32) * scale + bias[None]
        s_ctx = jnp.einsum('bqhd,bchd->bhqc', q_row, k_ctx, preferred_element_type=jnp.float32) * scale
        s = jnp.concatenate([s_loc.reshape(B, H, GRID_W, kr * kw), s_ctx], axis=-1)
        p = jax.nn.softmax(s, axis=-1).astype(v.dtype)
        p_loc = p[..., :kr * kw].reshape(B, H, GRID_W, kr, kw)
        p_ctx = p[..., kr * kw:]
        return jnp.einsum('bhqrj,brqjhd->bqhd', p_loc, v_nb) + jnp.einsum('bhqc,bchd->bqhd', p_ctx, v_ctx)

    o = lax.map(one_row, (qg, jnp.arange(n_rows)))
    return o.swapaxes(0, 1).reshape(B, L, H * dh)


def token_shift_centred(z, mu):
    prev = jnp.pad(z, ((0, 0), (1, 0), (0, 0)))[:, :-1]
    nxt = jnp.pad(z, ((0, 0), (0, 1), (0, 0)))[:, 1:]
    return z + mu[0] * (prev - z) + mu[1] * (nxt - z)


def rwkv_prepare(z, mu, w0, w2, a0, a2, k_k, k_a):
    B, L, _ = z.shape
    z = token_shift_centred(z.astype(jnp.float32), mu)
    r, k, v, wd, ad, gd = split_last(z, (RW_WIDTH, RW_WIDTH, RW_WIDTH, 2 * RW_DECAY_LORA, 2 * RW_ICLR_LORA, RW_GATE_LORA))
    wd = wd.reshape(B, L, 2, RW_DECAY_LORA)
    ad = ad.reshape(B, L, 2, RW_ICLR_LORA)
    w_log = -jax.nn.softplus(-(w0 + jnp.einsum('bldr,drc->bldc', jnp.tanh(wd), w2))) - 0.5
    decay = jnp.exp(-jnp.exp(w_log))
    a = jax.nn.sigmoid(a0 + jnp.einsum('bldr,drc->bldc', ad, a2))
    kk = to_heads(k * k_k, RW_HEADS)
    kk = kk / jnp.maximum(jnp.sqrt(jnp.sum(kk * kk, axis=-1, keepdims=True)), 1e-12)
    k_dir = k[:, :, None, :] * (1.0 + (a - 1.0) * k_a)
    return (to_heads(r, RW_HEADS), to_heads(v, RW_HEADS), kk, to_heads(decay, RW_HEADS),
            to_heads(a, RW_HEADS), to_heads(k_dir, RW_HEADS), gd)


def rwkv_scan(r, w, k, v, kk, a, s0, reverse):
    def step(S, inp):
        r_t, w_t, k_t, v_t, kk_t, a_t = inp
        sa = jnp.einsum('bhij,bhj->bhi', S, -kk_t)
        S = S * w_t[:, :, None, :] + sa[..., None] * (kk_t * a_t)[:, :, None, :] + v_t[..., None] * k_t[:, :, None, :]
        return S, jnp.einsum('bhij,bhj->bhi', S, r_t)

    xs = tuple(t.swapaxes(0, 1) for t in (r, w, k, v, kk, a))
    S, ys = lax.scan(step, s0, xs, reverse=reverse)
    return S, ys.swapaxes(0, 1)


def rwkv_output(r, v, k_dir, gd, y, g2, r_k, ln_g, ln_b, out_dtype):
    B, L = y.shape[:2]
    mean = jnp.mean(y, axis=-1, keepdims=True)
    var = jnp.mean(jnp.square(y - mean), axis=-1, keepdims=True)
    yn = ((y - mean) * lax.rsqrt(var + RW_GN_EPS)).reshape(B, L, RW_WIDTH) * ln_g + ln_b
    bonus = (jnp.sum(r[:, :, None] * k_dir * r_k, axis=-1, keepdims=True) * v[:, :, None]).sum(axis=2)
    g = jax.nn.sigmoid(gd) @ g2
    return ((yn + bonus.reshape(B, L, RW_WIDTH)) * g).astype(out_dtype)


def merge_branches(ya, yb, yr, gates, wo_a, wo_b, wo_r, w_o):
    g_a, g_b, g_r = jnp.split(jax.nn.sigmoid(gates), N_BRANCHES, axis=-1)
    return (g_a * (ya @ wo_a) + g_b * (yb @ wo_b) + g_r * (yr @ wo_r)) @ w_o


def swiglu(h, w1, w3, w2):
    return (jax.nn.silu(h @ w1) * (h @ w3)) @ w2


def moe_swiglu(h, router_w, w1, w3, w2):
    n_tok, d = h.shape
    logits = jnp.matmul(h, router_w, preferred_element_type=jnp.float32)
    top_logit, top_idx = lax.top_k(logits, TOP_K)
    gate = jax.nn.softmax(top_logit, axis=-1)
    n_assign = n_tok * TOP_K
    expert = top_idx.reshape(-1).astype(jnp.int32)
    token = jnp.repeat(jnp.arange(n_tok, dtype=jnp.int32), TOP_K)
    weight = gate.reshape(-1)
    order = jnp.argsort(expert)
    expert_s, token_s, weight_s = expert[order], token[order], weight[order]
    counts = jnp.bincount(expert, length=N_EXPERTS).astype(jnp.int32)
    starts = jnp.cumsum(counts) - counts
    padded = (counts + MOE_BLOCK - 1) // MOE_BLOCK * MOE_BLOCK
    pad_ends = jnp.cumsum(padded)
    pad_starts = pad_ends - padded
    dest = pad_starts[expert_s] + jnp.arange(n_assign, dtype=jnp.int32) - starts[expert_s]
    n_blocks = -(-n_assign // MOE_BLOCK) + N_EXPERTS
    buf_tok = jnp.zeros((n_blocks * MOE_BLOCK,), jnp.int32).at[dest].set(token_s)
    buf_w = jnp.zeros((n_blocks * MOE_BLOCK,), jnp.float32).at[dest].set(weight_s)
    blk_start = jnp.arange(n_blocks, dtype=jnp.int32) * MOE_BLOCK
    blk_expert = jnp.minimum(jnp.searchsorted(pad_ends, blk_start, side='right'), N_EXPERTS - 1)

    def one_block(args):
        idx, wt, e = args
        xb = h[idx]
        hid = jax.nn.silu(xb @ w1[e]) * (xb @ w3[e])
        return (hid @ w2[e]) * wt[:, None].astype(h.dtype)

    y = lax.map(one_block, (buf_tok.reshape(n_blocks, MOE_BLOCK), buf_w.reshape(n_blocks, MOE_BLOCK), blk_expert))
    return jnp.zeros_like(h).at[buf_tok].add(y.reshape(-1, d))


def setup_inputs(seed: int = 0) -> dict:
    key = jax.random.key(seed)
    ks = iter(jax.random.split(key, 64))
    D = D_MODEL

    def nrm(shape, s):
        return jax.random.normal(next(ks), shape, jnp.float32) * s

    def gain(shape):
        return 1.0 + nrm(shape, 0.05)

    return {
        "x": nrm((BATCH, SEQ, D), 1.0),
        "c": nrm((BATCH, D), 1.0),
        "ctx": nrm((BATCH, CTX_LEN, D), 1.0),
        "c_ctx": nrm((D,), 1.0),
        "mod_w": nrm((DEPTH, D, 6 * D), 0.5 * D ** -0.5),
        "mod_b": nrm((DEPTH, 6 * D), 0.02),
        "norm1_g": gain((DEPTH, D)),
        "norm2_g": gain((DEPTH, D)),
        "w_in": nrm((DEPTH, D, IN_WIDTH), D ** -0.5),
        "mla_cq_g": gain((DEPTH, MLA_Q_LORA)),
        "mla_wuq": nrm((DEPTH, MLA_Q_LORA, MLA_HEADS * MLA_QK), MLA_Q_LORA ** -0.5),
        "mla_ckv_g": gain((DEPTH, MLA_KV_LORA)),
        "mla_wukv": nrm((DEPTH, MLA_KV_LORA, MLA_HEADS * (MLA_NOPE + MLA_V)), MLA_KV_LORA ** -0.5),
        "mla_qn_g": gain((DEPTH, MLA_QK)),
        "mla_kn_g": gain((DEPTH, MLA_QK)),
        "mla_wo": nrm((DEPTH, MLA_HEADS * MLA_V, D), (MLA_HEADS * MLA_V) ** -0.5),
        "na_qn_g": gain((DEPTH, NA_HEAD_DIM)),
        "na_kn_g": gain((DEPTH, NA_HEAD_DIM)),
        "na_rpb": nrm((DEPTH, NA_HEADS, 2 * NA_WIN_ROWS - 1, 2 * NA_WIN_COLS - 1), 0.1),
        "na_wo": nrm((DEPTH, NA_WIDTH, D), NA_WIDTH ** -0.5),
        "rw_mu": jax.random.uniform(next(ks), (DEPTH, 2, RW_IN), jnp.float32, 0.0, 0.5),
        "rw_w0": jax.random.uniform(next(ks), (DEPTH, 2, RW_WIDTH), jnp.float32, -6.0, 1.0),
        "rw_w2": nrm((DEPTH, 2, RW_DECAY_LORA, RW_WIDTH), RW_DECAY_LORA ** -0.5),
        "rw_a0": nrm((DEPTH, 2, RW_WIDTH), 0.5),
        "rw_a2": nrm((DEPTH, 2, RW_ICLR_LORA, RW_WIDTH), RW_ICLR_LORA ** -0.5),
        "rw_g2": nrm((DEPTH, RW_GATE_LORA, RW_WIDTH), RW_GATE_LORA ** -0.5),
        "rw_kk": 0.85 + nrm((DEPTH, RW_WIDTH), 0.05),
        "rw_ka": gain((DEPTH, RW_WIDTH)),
        "rw_rk": nrm((DEPTH, RW_HEADS, RW_HEAD_DIM), 0.1),
        "rw_ln_g": gain((DEPTH, RW_WIDTH)),
        "rw_ln_b": nrm((DEPTH, RW_WIDTH), 0.02),
        "rw_wo": nrm((DEPTH, RW_WIDTH, D), RW_WIDTH ** -0.5),
        "w_out": nrm((DEPTH, D, D), D ** -0.5),
        "ffn_w1": nrm((N_DENSE, D, FFN_DENSE), D ** -0.5),
        "ffn_w3": nrm((N_DENSE, D, FFN_DENSE), D ** -0.5),
        "ffn_w2": nrm((N_DENSE, FFN_DENSE, D), FFN_DENSE ** -0.5),
        "moe_router": nrm((N_MOE, D, N_EXPERTS), D ** -0.5),
        "moe_w1": nrm((N_MOE, N_EXPERTS, D, FFN_EXPERT), D ** -0.5),
        "moe_w3": nrm((N_MOE, N_EXPERTS, D, FFN_EXPERT), D ** -0.5),
        "moe_w2": nrm((N_MOE, N_EXPERTS, FFN_EXPERT, D), FFN_EXPERT ** -0.5),
    }


def reference(x, c, ctx, c_ctx, mod_w, mod_b, norm1_g, norm2_g, w_in,
              mla_cq_g, mla_wuq, mla_ckv_g, mla_wukv, mla_qn_g, mla_kn_g, mla_wo,
              na_qn_g, na_kn_g, na_rpb, na_wo,
              rw_mu, rw_w0, rw_w2, rw_a0, rw_a2, rw_g2, rw_kk, rw_ka, rw_rk, rw_ln_g, rw_ln_b, rw_wo,
              w_out, ffn_w1, ffn_w3, ffn_w2, moe_router, moe_w1, moe_w3, moe_w2):
    B, L, D = x.shape
    n_ctx = ctx.shape[1]
    pos = jnp.arange(L)
    rows, cols = pos // GRID_W, pos % GRID_W
    s_lat = jax.nn.silu(c)
    s_ctx = jax.nn.silu(c_ctx)
    for l in range(DEPTH):
        need_ctx = l < DEPTH - 1
        mod = (s_lat @ mod_w[l] + mod_b[l])[:, None, :]
        mod_c = s_ctx @ mod_w[l] + mod_b[l]
        sh1, sc1, gt1, sh2, sc2, gt2 = jnp.split(mod, 6, axis=-1)
        csh1, csc1, cgt1, csh2, csc2, cgt2 = jnp.split(mod_c, 6, axis=-1)

        h = rms_norm(x, norm1_g[l]) * (1.0 + sc1) + sh1
        hc = rms_norm(ctx, norm1_g[l]) * (1.0 + csc1) + csh1
        m_cq, m_ckv, m_kr, n_q, n_k, n_v, r_z, gates = split_last(h @ w_in[l], IN_SIZES)
        mc_cq, mc_ckv, mc_kr, nc_q, nc_k, nc_v, rc_z, gates_c = split_last(hc @ w_in[l], IN_SIZES)

        qa = rope_2d_tail(mla_queries(m_cq, mla_cq_g[l], mla_wuq[l], mla_qn_g[l]), MLA_NOPE, rows, cols)
        ka, va = mla_keys_values(m_ckv, m_kr, mla_ckv_g[l], mla_wukv[l], mla_kn_g[l])
        ka = rope_2d_tail(ka, MLA_NOPE, rows, cols)
        ka_c, va_c = mla_keys_values(mc_ckv, mc_kr, mla_ckv_g[l], mla_wukv[l], mla_kn_g[l])
        ya = block_attention(qa, jnp.concatenate([ka_c, ka], axis=1),
                             jnp.concatenate([va_c, va], axis=1)).reshape(B, L, -1)

        qb = rms_norm(to_heads(n_q, NA_HEADS), na_qn_g[l])
        kb = rms_norm(to_heads(n_k, NA_HEADS), na_kn_g[l])
        vb = to_heads(n_v, NA_HEADS)
        kb_c = rms_norm(to_heads(nc_k, NA_HEADS), na_kn_g[l])
        vb_c = to_heads(nc_v, NA_HEADS)
        yb = neighbourhood_attention(qb, kb, vb, kb_c, vb_c, na_rpb[l])

        rw_p = (rw_mu[l], rw_w0[l], rw_w2[l], rw_a0[l], rw_a2[l], rw_kk[l], rw_ka[l])
        r_l, v_l, kk_l, w_l, a_l, kd_l, gd_l = rwkv_prepare(r_z, *rw_p)
        r_c, v_c, kk_c, w_c, a_c, kd_c, gd_c = rwkv_prepare(rc_z, *rw_p)
        s0 = jnp.zeros((B, RW_HEADS, RW_HEAD_DIM, RW_HEAD_DIM), jnp.float32)
        s_cf, y_cf = rwkv_scan(r_c, w_c[:, :, 0], kd_c[:, :, 0], v_c, kk_c, a_c[:, :, 0], s0, False)
        s_cb, y_cb = rwkv_scan(r_c, w_c[:, :, 1], kd_c[:, :, 1], v_c, kk_c, a_c[:, :, 1], s0, True)
        _, y_f = rwkv_scan(r_l, w_l[:, :, 0], kd_l[:, :, 0], v_l, kk_l, a_l[:, :, 0], s_cf, False)
        _, y_b = rwkv_scan(r_l, w_l[:, :, 1], kd_l[:, :, 1], v_l, kk_l, a_l[:, :, 1], s_cb, True)
        rw_o = (rw_g2[l], rw_rk[l], rw_ln_g[l], rw_ln_b[l])
        yr = rwkv_output(r_l, v_l, kd_l, gd_l, y_f + y_b, *rw_o, x.dtype)

        x_mid = x + gt1 * merge_branches(ya, yb, yr, gates, mla_wo[l], na_wo[l], rw_wo[l], w_out[l])
        if need_ctx:
            qa_c = mla_queries(mc_cq, mla_cq_g[l], mla_wuq[l], mla_qn_g[l])
            ya_c = block_attention(qa_c, ka_c, va_c).reshape(B, n_ctx, -1)
            qb_c = rms_norm(to_heads(nc_q, NA_HEADS), na_qn_g[l])
            yb_c = block_attention(qb_c, kb_c, vb_c).reshape(B, n_ctx, -1)
            yr_c = rwkv_output(r_c, v_c, kd_c, gd_c, y_cf + y_cb, *rw_o, ctx.dtype)
            ctx_mid = ctx + cgt1 * merge_branches(ya_c, yb_c, yr_c, gates_c, mla_wo[l], na_wo[l], rw_wo[l], w_out[l])

        tokens = (rms_norm(x_mid, norm2_g[l]) * (1.0 + sc2) + sh2).reshape(B * L, D)
        if need_ctx:
            h2c = rms_norm(ctx_mid, norm2_g[l]) * (1.0 + csc2) + csh2
            tokens = jnp.concatenate([tokens, h2c.reshape(B * n_ctx, D)], axis=0)
        if l % 2 == 0:
            f = swiglu(tokens, ffn_w1[l // 2], ffn_w3[l // 2], ffn_w2[l // 2])
        else:
            f = moe_swiglu(tokens, moe_router[l // 2], moe_w1[l // 2], moe_w3[l // 2], moe_w2[l // 2])
        x = x_mid + gt2 * f[:B * L].reshape(B, L, D)
        if need_ctx:
            ctx = ctx_mid + cgt2 * f[B * L:].reshape(B, n_ctx, D)
    return x
```

```cpp
#include <hip/hip_runtime.h>
#include <cstdio>
#include <cstdint>

#define LAS __attribute__((address_space(3)))
#define GAS __attribute__((address_space(1)))
typedef unsigned short bf16_t;
typedef short bf16x8 __attribute__((ext_vector_type(8)));
typedef short s16x4 __attribute__((ext_vector_type(4)));
typedef float f32x4 __attribute__((ext_vector_type(4)));
typedef float f32x2 __attribute__((ext_vector_type(2)));
typedef float f32x16 __attribute__((ext_vector_type(16)));
typedef unsigned u32x4 __attribute__((ext_vector_type(4)));
typedef unsigned u32x2 __attribute__((ext_vector_type(2)));
typedef __bf16 bf16x2_t __attribute__((ext_vector_type(2)));

constexpr int L = 16384, CT = 256, R = L + CT, DM = 1024, GW = 64;
constexpr int NWAVES = 8, NTHR = 512;
constexpr int ZA_LD = 768, ZN_LD = 1536, ZR_LD = 2048, ZM_N = 4352, ZG_LD = 3072;
constexpr int LO_LD = 2560, RKV_LD = 1536;
constexpr int FF = 2816, FFE = 3584, NEXP = 8;
constexpr int MOE_ROWS = 2 * L + NEXP * 256;
constexpr float NORM_EPS = 1e-6f;
constexpr float LOG2E = 1.4426950408889634f;
constexpr int TCH = 128, NCH = 129;

constexpr size_t MiB = 1u << 20;
constexpr size_t WS_CTL = 0, CTL_ZERO_BYTES = 1 * MiB;
constexpr size_t WS_W = 1 * MiB;
constexpr size_t WB_WINM = 0;
constexpr size_t WB_WING = WB_WINM + (size_t)ZM_N * DM * 2;
constexpr size_t WB_WUQ = WB_WING + (size_t)ZG_LD * DM * 2;
constexpr size_t WB_WUKV = WB_WUQ + (size_t)768 * 384 * 2;
constexpr size_t WB_WLORA = WB_WUKV + (size_t)1024 * 256 * 2;
constexpr size_t WB_WOA = WB_WLORA + (size_t)2560 * 384 * 2;
constexpr size_t WB_WOB = WB_WOA + (size_t)1024 * 512 * 2;
constexpr size_t WB_WOR = WB_WOB + (size_t)1024 * 512 * 2;
constexpr size_t WB_WOUT = WB_WOR + (size_t)1024 * 512 * 2;
constexpr size_t WB_SIZE = WB_WOUT + (size_t)1024 * 1024 * 2;
constexpr size_t WS_W13 = WS_W + 2 * WB_SIZE;
constexpr size_t WS_W2 = WS_W13 + (size_t)2 * FF * DM * 2;
constexpr size_t WS_W_END = WS_W2 + (size_t)DM * FF * 2;
static_assert(WS_W_END <= 67 * MiB, "weights region");
constexpr size_t WS_X1 = 67 * MiB;
constexpr size_t WS_CM = 132 * MiB;
constexpr size_t WS_H = 135 * MiB;
constexpr size_t WS_MISC = 168 * MiB;
constexpr size_t WS_MODV = WS_MISC;
constexpr size_t WS_RT_IDX = WS_MISC + 128 * 1024;
constexpr size_t WS_RT_POS = WS_RT_IDX + 128 * 1024;
constexpr size_t WS_RT_GATE = WS_RT_POS + 128 * 1024;
constexpr size_t WS_RT_ROWGATE = WS_RT_GATE + 128 * 1024;
constexpr size_t WS_KN = WS_MISC + 1 * MiB;
constexpr size_t WS_BIG = 170 * MiB;
constexpr size_t WS_ZN = WS_BIG;
constexpr size_t WS_Q = 219 * MiB, WS_K = 244 * MiB, WS_V = 269 * MiB;
constexpr size_t WS_RKV = 286 * MiB;
constexpr size_t WS_LO = 335 * MiB;
constexpr size_t WS_CQN = 417 * MiB, WS_CKVN = 430 * MiB, WS_LA = 439 * MiB, WS_KR = 452 * MiB;
constexpr size_t WS_YA = 417 * MiB, WS_YB = 434 * MiB;
constexpr size_t WS_ZA = 453 * MiB, WS_ZR = 478 * MiB;
constexpr size_t WS_QRAW = 453 * MiB, WS_KVRAW = 478 * MiB;
constexpr size_t WS_PST = 453 * MiB, WS_QST = 486 * MiB, WS_YF = 519 * MiB, WS_YBK = 536 * MiB, WS_YR = 269 * MiB;
constexpr size_t WS_ZG = WS_BIG;
constexpr size_t WS_U32 = 335 * MiB;
constexpr size_t WS_U = 286 * MiB;
constexpr size_t WS_G = WS_BIG;
constexpr size_t WS_H2G = 67 * MiB;
constexpr size_t WS_W13E = 170 * MiB;
constexpr size_t WS_W2E_LO = 135 * MiB;
constexpr size_t WS_W2E_HI = 282 * MiB;
constexpr int W2E_HI_TILE_SHIFT = (int)((WS_W2E_HI - WS_W2E_LO) / ((size_t)256 * FFE * 2)) - 16;
static_assert((WS_W2E_HI - WS_W2E_LO) % ((size_t)256 * FFE * 2) == 0 && (W2E_HI_TILE_SHIFT % 4) == 0, "W2E split");
constexpr size_t WS_HID = 310 * MiB;
constexpr size_t WS_END = 553 * MiB;
static_assert((size_t)16 * NCH * 4096 * 4 <= 33 * MiB, "state slots");
static_assert(WS_ZR + (size_t)R * ZR_LD * 2 <= WS_END, "ws map");
static_assert(WS_HID + (size_t)MOE_ROWS * FFE * 2 <= 549 * MiB, "hid");
constexpr int CW_BAR = 4096;
constexpr int CW_MOECNT = 1024;

#ifndef PROBE_CVT
#define PROBE_CVT 1
#endif
#ifndef PROBE_ROW
#define PROBE_ROW 1
#endif
__device__ __forceinline__ float bf2f(unsigned b) { return __uint_as_float(b << 16); }
__device__ __forceinline__ unsigned cvtpk(float lo, float hi) { f32x2 v = {lo, hi}; bf16x2_t b = __builtin_convertvector(v, bf16x2_t); return __builtin_bit_cast(unsigned, b); }
__device__ __forceinline__ float lo_bf(unsigned w) { return __uint_as_float(w << 16); }
__device__ __forceinline__ float hi_bf(unsigned w) { return __uint_as_float(w & 0xffff0000u); }
__device__ __forceinline__ float wave_sum(float v) {
#pragma unroll
    for (int o = 1; o < 64; o <<= 1) v += __shfl_xor(v, o);
    return v;
}
__device__ __forceinline__ float sigmoidf_(float x) { return 1.f / (1.f + __expf(-x)); }
__device__ __forceinline__ float siluf_(float x) { return x / (1.f + __expf(-x)); }
#define LDS_WAIT() asm volatile("s_waitcnt lgkmcnt(0)" ::: "memory")
#define VM_WAIT() asm volatile("s_waitcnt vmcnt(0)" ::: "memory")

namespace pg8 {
constexpr int BM = 256, BK = 64, HALF = 128, HTB = HALF * BK * 2, STAGE_BYTES = 8 * HTB, NXCD = 8, WGM = 8;
__device__ __forceinline__ int lds_byte(int r, int c) { const int st = (r >> 4) * 2 + (c >> 5), rr = r & 15, cc = c & 31, ob = rr * 64 + cc * 2; return st * 1024 + (ob ^ (((ob >> 9) & 1) << 5)); }
__device__ __forceinline__ void stage_rc(int b, int& R_, int& C_) { const int st = b / 1024, sb = b % 1024, swz = sb ^ (((sb >> 9) & 1) << 5); R_ = (st >> 1) * 16 + swz / 64; C_ = (st & 1) * 32 + (swz % 64) / 2; }
__device__ __forceinline__ int perm32(int rho) { const int n = rho >> 4, i = rho & 15; return 8 * (i >> 2) + 4 * n + (i & 3); }

struct Unit { int pm, pn; };
struct Gemm { const bf16_t* A; int lda; const bf16_t* Bt; int K; };

struct StaticOrder {
    int nM, nN, nwg, G, c, rep;
    __device__ void init(int nM_, int nN_, int G_, int c_, int rep_ = 1) { nM = nM_; nN = nN_; nwg = nM * nN; G = G_; c = c_; rep = rep_; }
    __device__ bool next(int i, Unit& u) const {
        const long Lx = (long)i * G + c; if (Lx >= (long)nwg * rep) return false;
        int wgid = (int)(Lx % nwg); { const int q = nwg / NXCD, r = nwg % NXCD, xcd = wgid % NXCD, off = wgid / NXCD; wgid = (xcd < r ? xcd * (q + 1) : r * (q + 1) + (xcd - r) * q) + off; }
        const int nig = WGM * nN, gid = wgid / nig, fm = gid * WGM, gsz = (nM - fm) < WGM ? (nM - fm) : WGM;
        u.pm = fm + ((wgid % nig) % gsz); u.pn = (wgid % nig) / gsz; return true;
    }
};

template <class Epi, class Sched>
__device__ __forceinline__ void gemm_phase(LAS unsigned char* lds, const int tid, const Gemm g, const Sched& S, const Epi& E) {
    const int wid = __builtin_amdgcn_readfirstlane(tid >> 6), lane = tid & 63, wr = wid >> 2, wc = wid & 3, fr = lane & 15, fq = lane >> 4;
    const int K = g.K, nt = K / BK;
    unsigned voffA[2], voffB[2];
#pragma unroll
    for (int i = 0; i < 2; ++i) { int R_, C_; stage_rc(tid * 16 + i * 8192, R_, C_); const int Rb = (R_ & ~31) + perm32(R_ & 31);
        voffA[i] = (unsigned)(R_ * g.lda + C_) * 2u; voffB[i] = (unsigned)(Rb * K + C_) * 2u; }
    const size_t kstep = (size_t)(BK * 2);
    const size_t hstepA = (size_t)HALF * g.lda * 2, hstepB = (size_t)HALF * K * 2;
    const size_t tstepA = 2 * hstepA, tstepB = 2 * hstepB;
    const unsigned ldsw = (unsigned)wid * 1024u;
    const int aoff = lds_byte(wr * 64 + fr, fq * 8), boff = lds_byte(wc * 32 + fr, fq * 8);
#define PG8_SA(b, h) (((b) * 2 + (h)) * HTB)
#define PG8_SB(b, h) ((4 + (b) * 2 + (h)) * HTB)
#define PG8_STAGE(bufoff, gbase, voff) do { _Pragma("unroll") for (int _i = 0; _i < 2; ++_i) \
        __builtin_amdgcn_global_load_lds((const unsigned*)((const char*)(gbase) + (voff)[_i]), (LAS unsigned*)(lds + (bufoff) + ldsw + _i * 8192), 16, 0, 0); } while (0)
#define PG8_LDA(dst, b, h) do { _Pragma("unroll") for (int m = 0; m < 4; ++m) _Pragma("unroll") for (int k = 0; k < 2; ++k) dst[m][k] = *(const LAS bf16x8*)(lds + PG8_SA(b, h) + aoff + m * 2048 + k * 1024); } while (0)
#define PG8_LDB(dst, b, h) do { _Pragma("unroll") for (int n = 0; n < 2; ++n) _Pragma("unroll") for (int k = 0; k < 2; ++k) dst[n][k] = *(const LAS bf16x8*)(lds + PG8_SB(b, h) + boff + n * 2048 + k * 1024); } while (0)
#define PG8_MMA(ai, bj, At, Bt) do { __builtin_amdgcn_s_setprio(1); _Pragma("unroll") for (int m = 0; m < 4; ++m) _Pragma("unroll") for (int n = 0; n < 2; ++n) _Pragma("unroll") for (int k = 0; k < 2; ++k) \
        acc[ai][bj][m][n] = __builtin_amdgcn_mfma_f32_16x16x32_bf16(Bt[n][k], At[m][k], acc[ai][bj][m][n], 0, 0, 0); __builtin_amdgcn_s_setprio(0); } while (0)
#define PG8_WAIT_V(n) asm volatile("s_waitcnt vmcnt(" #n ")" ::: "memory")
#define PG8_WAIT_L(n) asm volatile("s_waitcnt lgkmcnt(" #n ")" ::: "memory")
#define PG8_BAR __builtin_amdgcn_s_barrier()
#define PG8_SCHED __builtin_amdgcn_sched_barrier(0)
    Unit cur, nxt; int ui = 0;
    if (!S.next(0, cur)) return;
    f32x4 acc[2][2][4][2];
#pragma unroll
    for (int a = 0; a < 2; ++a)
#pragma unroll
        for (int b = 0; b < 2; ++b)
#pragma unroll
            for (int m = 0; m < 4; ++m)
#pragma unroll
                for (int n = 0; n < 2; ++n) acc[a][b][m][n] = (f32x4){0.f, 0.f, 0.f, 0.f};
    bf16x8 At[4][2], B0[2][2], B1[2][2];
    const char* cA = (const char*)g.A + (size_t)cur.pm * tstepA; const char* cB = (const char*)g.Bt + (size_t)cur.pn * tstepB;
    PG8_STAGE(PG8_SB(0, 0), cB, voffB); PG8_STAGE(PG8_SB(0, 1), cB + hstepB, voffB); PG8_STAGE(PG8_SA(0, 0), cA, voffA); PG8_STAGE(PG8_SA(0, 1), cA + hstepA, voffA);
    if (wr == 1) PG8_BAR;
    PG8_WAIT_V(2); PG8_BAR;
    PG8_STAGE(PG8_SB(1, 0), cB + kstep, voffB); PG8_STAGE(PG8_SA(1, 0), cA + kstep, voffA); PG8_STAGE(PG8_SB(1, 1), cB + hstepB + kstep, voffB);
    PG8_WAIT_V(6); PG8_BAR;
    for (;;) {
        const bool has_next = S.next(ui + 1, nxt);
        const char* nA = has_next ? (const char*)g.A + (size_t)nxt.pm * tstepA : cA; const char* nB = has_next ? (const char*)g.Bt + (size_t)nxt.pn * tstepB : cB;
        for (int t = 0; t < nt; t += 2) {
            const bool last = (t == nt - 2);
            const char* a1 = cA + (size_t)(t + 1) * kstep;
            const char* a2 = last ? nA : cA + (size_t)(t + 2) * kstep; const char* b2 = last ? nB : cB + (size_t)(t + 2) * kstep;
            const char* a3 = a2 + kstep; const char* b3 = b2 + kstep;
            PG8_LDB(B0, 0, 0); PG8_LDB(B1, 0, 1); PG8_SCHED; PG8_LDA(At, 0, 0); PG8_STAGE(PG8_SA(1, 1), a1 + hstepA, voffA);
            PG8_WAIT_V(8); PG8_WAIT_L(0); PG8_BAR; PG8_MMA(0, 0, At, B0); PG8_MMA(0, 1, At, B1); PG8_BAR; PG8_SCHED;
            PG8_LDA(At, 0, 1); PG8_STAGE(PG8_SB(0, 0), b2, voffB); PG8_STAGE(PG8_SB(0, 1), b2 + hstepB, voffB); PG8_STAGE(PG8_SA(0, 0), a2, voffA);
            PG8_WAIT_V(8); PG8_WAIT_L(0); PG8_BAR; PG8_MMA(1, 0, At, B0); PG8_MMA(1, 1, At, B1); PG8_BAR; PG8_SCHED;
            PG8_LDB(B0, 1, 0); PG8_LDB(B1, 1, 1); PG8_SCHED; PG8_LDA(At, 1, 0); PG8_STAGE(PG8_SA(0, 1), a2 + hstepA, voffA);
            PG8_WAIT_V(8); PG8_WAIT_L(0); PG8_BAR; PG8_MMA(0, 0, At, B0); PG8_MMA(0, 1, At, B1); PG8_BAR; PG8_SCHED;
            PG8_LDA(At, 1, 1); PG8_STAGE(PG8_SB(1, 0), b3, voffB); PG8_STAGE(PG8_SB(1, 1), b3 + hstepB, voffB); PG8_STAGE(PG8_SA(1, 0), a3, voffA);
            PG8_WAIT_V(8); PG8_WAIT_L(0); PG8_BAR; PG8_MMA(1, 0, At, B0); PG8_MMA(1, 1, At, B1); PG8_BAR; PG8_SCHED;
        }
        if (wr == 0) PG8_BAR;
        E(acc, cur, wr, wc, fr, fq);
        if (!has_next) break;
#pragma unroll
        for (int a = 0; a < 2; ++a)
#pragma unroll
            for (int b = 0; b < 2; ++b)
#pragma unroll
                for (int m = 0; m < 4; ++m)
#pragma unroll
                    for (int n = 0; n < 2; ++n) acc[a][b][m][n] = (f32x4){0.f, 0.f, 0.f, 0.f};
        cur = nxt; cA = nA; cB = nB; ++ui;
        if (wr == 1) PG8_BAR;
    }
    PG8_WAIT_V(0);
    PG8_BAR;
#undef PG8_SA
#undef PG8_SB
#undef PG8_STAGE
#undef PG8_LDA
#undef PG8_LDB
#undef PG8_MMA
#undef PG8_WAIT_V
#undef PG8_WAIT_L
#undef PG8_BAR
#undef PG8_SCHED
}

template <class F> __device__ __forceinline__ void epi_each(const f32x4 (&acc)[2][2][4][2], const Unit& u, int wr, int wc, int fr, int fq, F&& f) {
    const int row0 = u.pm * BM + wr * 64 + fr, col0 = u.pn * BM + wc * 32 + 8 * fq;
#pragma unroll
    for (int ai = 0; ai < 2; ++ai)
#pragma unroll
        for (int m = 0; m < 4; ++m)
#pragma unroll
            for (int bj = 0; bj < 2; ++bj) f(row0 + ai * HALF + m * 16, col0 + bj * HALF, acc[ai][bj][m][0], acc[ai][bj][m][1]);
}
__device__ __forceinline__ void st_bf16x8(bf16_t* p, f32x4 v0, f32x4 v1) {
    u32x4 w; w.x = cvtpk(v0[0], v0[1]); w.y = cvtpk(v0[2], v0[3]); w.z = cvtpk(v1[0], v1[1]); w.w = cvtpk(v1[2], v1[3]); *(u32x4*)p = w;
}
}
#include <hip/hip_runtime.h>
#include <cstdio>
#include <cstdint>
#include <cstdlib>
#include <vector>

#define XB_TMO      128
#define XB_XCNT(j)  (256  + 64 * (j))
#define XB_XSUB(j)  (1280 + 64 * (j))
#define XB_XGEN(j)  (2304 + 64 * (j))
#define XB_TOP      3328
#define XB_TOPGEN   3392
#define XCD_BAR_WORDS 3456
#define XB_SPIN_CAP (1u << 18)

__device__ __forceinline__ unsigned xb_ld(unsigned* p)              { return __hip_atomic_load(p, __ATOMIC_RELAXED, __HIP_MEMORY_SCOPE_AGENT); }
__device__ __forceinline__ unsigned xb_add(unsigned* p, unsigned v) { return __hip_atomic_fetch_add(p, v, __ATOMIC_RELAXED, __HIP_MEMORY_SCOPE_AGENT); }
__device__ __forceinline__ unsigned xb_xcc_id() { return (unsigned)__builtin_amdgcn_s_getreg((3 << 11) | 20) & 0xFu; }
#define XB_SPIN(cond, bar) do { unsigned _sp = 0; while (cond) { __builtin_amdgcn_s_sleep(1); \
    if ((++_sp & 255u) == 0u) { if (xb_ld(&(bar)[XB_TMO])) break; if (_sp > XB_SPIN_CAP) { atomicAdd(&(bar)[XB_TMO], 1u); break; } } } } while (0)

struct XcdBarrier {
    unsigned* bar; unsigned x;
    volatile LAS unsigned* st;
};

__device__ __forceinline__ XcdBarrier xcd_barrier_post(unsigned* bar, volatile LAS unsigned* st) {
    XcdBarrier b; b.bar = bar; b.x = xb_xcc_id(); b.st = st;
    if (threadIdx.x == 0) (void)xb_add(&bar[XB_XCNT(b.x)], 1u);
    return b;
}
__device__ __forceinline__ void xcd_barrier_complete(unsigned* bar, unsigned x, unsigned& nloc, unsigned& nx) {
    const unsigned G = gridDim.x * gridDim.y * gridDim.z;
    unsigned sum, cnt, mine, sp = 0u;
    for (;;) {
        sum = 0u; cnt = 0u; mine = 0u;
#pragma unroll
        for (unsigned j = 0; j < 16; ++j) { const unsigned c = xb_ld(&bar[XB_XCNT(j)]); sum += c; cnt += (c > 0u) ? 1u : 0u; mine = (j == x) ? c : mine; }
        if (sum == G) break;
        __builtin_amdgcn_s_sleep(1);
        if ((++sp & 255u) == 0u) { if (xb_ld(&bar[XB_TMO])) break; if (sp > XB_SPIN_CAP) { atomicAdd(&bar[XB_TMO], 1u); break; } }
    }
    nloc = mine > 0u ? mine : 1u; nx = cnt > 0u ? cnt : 1u;
}

__device__ __forceinline__ void xcd_barrier(const XcdBarrier& b) {
    asm volatile("s_waitcnt vmcnt(0)" ::: "memory");
    __syncthreads();
    if (threadIdx.x == 0) {
        unsigned* bar = b.bar;
        __builtin_amdgcn_s_waitcnt(0);
        unsigned nloc = b.st[0], nx = b.st[1];
        if (nloc == 0u) { xcd_barrier_complete(bar, b.x, nloc, nx); b.st[0] = nloc; b.st[1] = nx; }
        const unsigned old = xb_add(&bar[XB_XSUB(b.x)], 1u);
        const unsigned gen = old / nloc;
        if (old + 1u == (gen + 1u) * nloc) {
            __builtin_amdgcn_fence(__ATOMIC_RELEASE, "agent");
            asm volatile("s_waitcnt vmcnt(0)" ::: "memory");
            const unsigned og = xb_add(&bar[XB_TOP], 1u);
            const unsigned tg = og / nx;
            if (og + 1u == (tg + 1u) * nx) xb_add(&bar[XB_TOPGEN], 1u);
            else XB_SPIN(xb_ld(&bar[XB_TOPGEN]) == tg, bar);
            __builtin_amdgcn_fence(__ATOMIC_ACQUIRE, "agent");
            xb_add(&bar[XB_XGEN(b.x)], 1u);
            asm volatile("s_waitcnt vmcnt(0)" ::: "memory");
        } else {
            XB_SPIN(xb_ld(&bar[XB_XGEN(b.x)]) == gen, bar);
            __builtin_amdgcn_fence(__ATOMIC_ACQUIRE, "agent");
            asm volatile("s_waitcnt vmcnt(0)" ::: "memory");
        }
    }
    __syncthreads();
}


constexpr int LDS_BYTES = 147456;
constexpr int LDS_MISC_OFF = 131072 + 8192;
struct Args { const float* in[40]; float* out; unsigned char* ws; int ph_lo, ph_hi; };
enum { I_X = 0, I_C, I_CTX, I_CCTX, I_MODW, I_MODB, I_N1G, I_N2G, I_WIN, I_CQG, I_WUQ, I_CKVG, I_WUKV, I_QNG, I_KNG, I_MLAWO,
       I_NAQG, I_NAKG, I_RPB, I_NAWO, I_MU, I_W0, I_W2, I_A0, I_A2, I_G2, I_KK, I_KA, I_RK, I_LNG, I_LNB, I_RWWO, I_WOUT,
       I_F1, I_F3, I_F2, I_ROUTER, I_M1, I_M3, I_M2 };

struct Frame {
    LAS unsigned char* lds;
    unsigned char* ws;
    int tid, lane, wave, G, vcu, bid;
};

__device__ __forceinline__ Frame launder(const Frame& F) {
    Frame P = F; int w = F.wave, v = F.vcu, b = F.bid; unsigned char* ws = F.ws;
    asm volatile("" : "+s"(w), "+s"(v), "+s"(b));
    int ln = (int)__builtin_amdgcn_mbcnt_hi(~0u, __builtin_amdgcn_mbcnt_lo(~0u, 0u));
    asm volatile("" : "+v"(ln));
    P.tid = w * 64 + ln; P.lane = ln; P.wave = w; P.vcu = v; P.bid = b; P.ws = ws; return P;
}
__device__ __forceinline__ void tr_item(const float* src, int lds_, int scol0, bf16_t* dst, int ldd, int drow0, int koff, int nblk, int ileave, int item, LAS float* scr, int lane) {
    const int kb = item / nblk, nb = item - kb * nblk, k0 = 64 * kb, n0 = 32 * nb;
#pragma unroll 8
    for (int i = 0; i < 32; ++i) { const int kk = 2 * i + (lane >> 5); scr[kk * 33 + (lane & 31)] = src[(size_t)(k0 + kk) * lds_ + scol0 + n0 + (lane & 31)]; }
    LDS_WAIT(); asm volatile("" ::: "memory");
    const int c = lane & 7;
#pragma unroll
    for (int j = 0; j < 4; ++j) { const int n = (lane >> 3) + 8 * j; const LAS float* s = scr + (8 * c) * 33 + n;
        u32x4 o; o.x = cvtpk(s[0 * 33], s[1 * 33]); o.y = cvtpk(s[2 * 33], s[3 * 33]); o.z = cvtpk(s[4 * 33], s[5 * 33]); o.w = cvtpk(s[6 * 33], s[7 * 33]);
        const int nn = n0 + n; const int drow = ileave ? drow0 + (nn >> 7) * 256 + (nn & 127) : drow0 + nn;
        *(u32x4*)(dst + (size_t)drow * ldd + koff + k0 + 8 * c) = o; }
    LDS_WAIT(); asm volatile("" ::: "memory");
}
__device__ __forceinline__ void zero_item(bf16_t* dst, int ldd, int drow0, int koff, int nblk, int item, int lane) {
    const int kb = item / nblk, nb = item - kb * nblk, k0 = 64 * kb, n0 = 32 * nb, c = lane & 7;
#pragma unroll
    for (int j = 0; j < 4; ++j) { const int n = (lane >> 3) + 8 * j; *(u32x4*)(dst + (size_t)(drow0 + n0 + n) * ldd + koff + k0 + 8 * c) = (u32x4){0u, 0u, 0u, 0u}; }
}

#define TRJOB(NITEMS, CALL) { const int _n = (NITEMS); if (r < _n) { CALL; continue; } r -= _n; }
__device__ __forceinline__ void prologue_weights(const Frame& F, const Args& a) {
    LAS float* scr = (LAS float*)(F.lds + F.wave * 16384);
    const int gw = F.vcu * NWAVES + F.wave, NGW = F.G * NWAVES;
    constexpr int PER_LAYER = 16 * 21 + 16 * 3   + 16 * 108   + 16 * 4   + 16 * 96
                              + 6 * 24   + 4 * 32   + 6 * 80   + 3 * 8 * 32   + 16 * 32  ;
    constexpr int FFN_ITEMS = 2 * 16 * 88 + 44 * 32;
    constexpr int NITEMS = 2 * PER_LAYER + FFN_ITEMS;
    for (int it0 = gw; it0 < NITEMS * PROBE_CVT; it0 += NGW) { const int it = it0 % NITEMS;
        int r = it;
        bool done = false;
        for (int l = 0; l < 2 && !done; ++l) {
            if (r >= PER_LAYER) { r -= PER_LAYER; continue; }
            done = true;
            unsigned char* wb = F.ws + WS_W + (size_t)l * WB_SIZE;
            bf16_t* WinM = (bf16_t*)(wb + WB_WINM); bf16_t* WinG = (bf16_t*)(wb + WB_WING);
            const float* win = a.in[I_WIN] + (size_t)l * DM * 7200;
            do {
                if (r < 16 * 21) { tr_item(win, 7200, 0, WinM, DM, 0, 0, 21, 0, r, scr, F.lane); break; } r -= 16 * 21;
                if (r < 16 * 3) { zero_item(WinM, DM, 672, 0, 3, r, F.lane); break; } r -= 16 * 3;
                if (r < 16 * 108) { tr_item(win, 7200, 672, WinM, DM, 768, 0, 108, 0, r, scr, F.lane); break; } r -= 16 * 108;
                if (r < 16 * 4) { zero_item(WinM, DM, 4224, 0, 4, r, F.lane); break; } r -= 16 * 4;
                if (r < 16 * 96) { tr_item(win, 7200, 4128, WinG, DM, 0, 0, 96, 0, r, scr, F.lane); break; } r -= 16 * 96;
                if (r < 6 * 24) { tr_item(a.in[I_WUQ] + (size_t)l * 384 * 768, 768, 0, (bf16_t*)(wb + WB_WUQ), 384, 0, 0, 24, 0, r, scr, F.lane); break; } r -= 6 * 24;
                if (r < 4 * 32) { tr_item(a.in[I_WUKV] + (size_t)l * 256 * 1024, 1024, 0, (bf16_t*)(wb + WB_WUKV), 256, 0, 0, 32, 0, r, scr, F.lane); break; } r -= 4 * 32;
                if (r < 6 * 80) {
                    bf16_t* Wl = (bf16_t*)(wb + WB_WLORA);
                    const int kb = r / 80, nb = r % 80, s = nb / 16;
                    const int koff = s < 4 ? 64 * s : 256, Ks = s < 4 ? 64 : 128;
                    const int k0 = 64 * kb;
                    if (k0 >= koff && k0 < koff + Ks) {
                        const float* src = s < 2 ? a.in[I_W2] + ((size_t)l * 2 + s) * 64 * 512 : s < 4 ? a.in[I_A2] + ((size_t)l * 2 + (s - 2)) * 64 * 512 : a.in[I_G2] + (size_t)l * 128 * 512;
                        const int sub = ((k0 - koff) / 64) * 16 + (nb % 16);
                        tr_item(src, 512, 0, Wl, 384, 512 * s, koff, 16, 0, sub, scr, F.lane);
                    } else zero_item(Wl, 384, 0, 0, 80, r, F.lane);
                    break; } r -= 6 * 80;
                if (r < 3 * 8 * 32) { const int b = r / 256, rr = r % 256;
                    const float* src = (b == 0 ? a.in[I_MLAWO] : b == 1 ? a.in[I_NAWO] : a.in[I_RWWO]) + (size_t)l * 512 * 1024;
                    tr_item(src, 1024, 0, (bf16_t*)(wb + (b == 0 ? WB_WOA : b == 1 ? WB_WOB : WB_WOR)), 512, 0, 0, 32, 0, rr, scr, F.lane); break; } r -= 3 * 8 * 32;
                tr_item(a.in[I_WOUT] + (size_t)l * 1024 * 1024, 1024, 0, (bf16_t*)(wb + WB_WOUT), 1024, 0, 0, 32, 0, r, scr, F.lane);
            } while (0);
        }
        if (done) continue;
        if (r < 16 * 88) { tr_item(a.in[I_F1], FF, 0, (bf16_t*)(F.ws + WS_W13), DM, 0, 0, 88, 1, r, scr, F.lane); continue; } r -= 16 * 88;
        if (r < 16 * 88) { tr_item(a.in[I_F3], FF, 0, (bf16_t*)(F.ws + WS_W13), DM, 128, 0, 88, 1, r, scr, F.lane); continue; } r -= 16 * 88;
        tr_item(a.in[I_F2], DM, 0, (bf16_t*)(F.ws + WS_W2), FF, 0, 0, 32, 0, r, scr, F.lane);
    }
}
__device__ __forceinline__ void moe_weights(const Frame& F, const Args& a, int part) {
    LAS float* scr = (LAS float*)(F.lds + F.wave * 16384);
    const int gw = F.vcu * NWAVES + F.wave, NGW = F.G * NWAVES;
    constexpr int I13 = 16 * 112, I2 = 56 * 32;
    if (part == 0) {
        constexpr int NIT = NEXP * 2 * I13 + 4 * I2;
        for (int it0 = gw; it0 < NIT * PROBE_CVT; it0 += NGW) { const int it = it0 % NIT;
            if (it < NEXP * 2 * I13) { const int e = it / (2 * I13); int r = it - e * 2 * I13;
                bf16_t* w13 = (bf16_t*)(F.ws + WS_W13E) + (size_t)e * 2 * FFE * DM;
                if (r < I13) tr_item(a.in[I_M1] + (size_t)e * DM * FFE, FFE, 0, w13, DM, 0, 0, 112, 1, r, scr, F.lane);
                else tr_item(a.in[I_M3] + (size_t)e * DM * FFE, FFE, 0, w13, DM, 128, 0, 112, 1, r - I13, scr, F.lane);
            } else { const int q = it - NEXP * 2 * I13, e = 4 + q / I2, r = q % I2;
                tr_item(a.in[I_M2] + (size_t)e * FFE * DM, DM, 0, (bf16_t*)(F.ws + WS_W2E_HI) + (size_t)(e - 4) * DM * FFE, FFE, 0, 0, 32, 0, r, scr, F.lane); }
        }
    } else {
        for (int it = gw; it < 4 * I2; it += NGW) { const int e = it / I2, r = it % I2;
            tr_item(a.in[I_M2] + (size_t)e * FFE * DM, DM, 0, (bf16_t*)(F.ws + WS_W2E_LO) + (size_t)e * DM * FFE, FFE, 0, 0, 32, 0, r, scr, F.lane); }
    }
}

__device__ __forceinline__ void prologue_mod(const Frame& F, const Args& a) {
    LAS float* sl = (LAS float*)(F.lds);
    LAS float* part = sl + 2048;
    if (F.bid >= 192) return;
    const int l = F.bid / 96, nb = F.bid % 96;
    for (int i = F.tid; i < 2048; i += NTHR) { const float v = i < 1024 ? a.in[I_C][i] : a.in[I_CCTX][i - 1024]; sl[i] = siluf_(v); }
    __syncthreads();
    const int col = F.tid & 63, kg = F.tid >> 6, n = nb * 64 + col;
    const float* W = a.in[I_MODW] + (size_t)l * DM * 6144 + n;
    float aL = 0.f, aC = 0.f;
#pragma unroll 8
    for (int k = kg * 128; k < kg * 128 + 128; ++k) { const float w = W[(size_t)k * 6144]; aL += sl[k] * w; aC += sl[1024 + k] * w; }
    part[(kg * 64 + col) * 2] = aL; part[(kg * 64 + col) * 2 + 1] = aC;
    __syncthreads();
    if (F.tid < 128) { const int c2 = F.tid & 63, which = F.tid >> 6; float s = 0.f;
#pragma unroll
        for (int k = 0; k < 8; ++k) s += part[(k * 64 + c2) * 2 + which];
        const int nn = nb * 64 + c2;
        ((float*)(F.ws + WS_MODV))[(size_t)(l * 2 + which) * 6144 + nn] = s + a.in[I_MODB][(size_t)l * 6144 + nn]; }
    __syncthreads();
}

__device__ __forceinline__ void norm_rows(const Frame& F, const float* src, int src_row0, int m0, int m1, const float* g, const float* sh, const float* sc, bf16_t* dst) {
    f32x4 ca[4], cb[4];
#pragma unroll
    for (int j = 0; j < 4; ++j) { const int d = F.lane * 4 + 256 * j; const f32x4 gg = *(const f32x4*)(g + d), s1 = *(const f32x4*)(sc + d); ca[j] = gg * (s1 + 1.0f); cb[j] = *(const f32x4*)(sh + d); }
    const int gw = F.vcu * NWAVES + F.wave, NGW = F.G * NWAVES;
    for (int mm = gw; mm < (m1 - m0) * PROBE_ROW; mm += NGW) { const int m = m0 + mm % (m1 - m0);
        const f32x4* xr = (const f32x4*)(src + (size_t)(m - src_row0) * DM) + F.lane;
        f32x4 v[4]; float s = 0.f;
#pragma unroll
        for (int j = 0; j < 4; ++j) { v[j] = xr[64 * j]; s += (v[j].x * v[j].x + v[j].y * v[j].y) + (v[j].z * v[j].z + v[j].w * v[j].w); }
        const float rstd = rsqrtf(wave_sum(s) * (1.f / DM) + NORM_EPS);
        u32x2* o8 = (u32x2*)(dst + (size_t)m * DM) + F.lane;
#pragma unroll
        for (int j = 0; j < 4; ++j) { const f32x4 y = v[j] * rstd * ca[j] + cb[j]; u32x2 w; w.x = cvtpk(y.x, y.y); w.y = cvtpk(y.z, y.w); o8[64 * j] = w; }
    }
}

using pg8::Unit;
struct EpiZ {
    bf16_t *za, *zn, *zr;
    __device__ __forceinline__ void operator()(const f32x4 (&acc)[2][2][4][2], const Unit& u, int wr, int wc, int fr, int fq) const {
        bf16_t* base; int ld, ct;
        if (u.pn < 3) { base = za; ld = ZA_LD; ct = u.pn; } else if (u.pn < 9) { base = zn; ld = ZN_LD; ct = u.pn - 3; } else { base = zr; ld = ZR_LD; ct = u.pn - 9; }
        const int cshift = (ct - u.pn) * 256;
        pg8::epi_each(acc, u, wr, wc, fr, fq, [&](int row, int col, f32x4 v0, f32x4 v1) { pg8::st_bf16x8(base + (size_t)row * ld + col + cshift, v0, v1); });
    }
};
struct EpiBf {
    bf16_t* o; int ld;
    __device__ __forceinline__ void operator()(const f32x4 (&acc)[2][2][4][2], const Unit& u, int wr, int wc, int fr, int fq) const {
        pg8::epi_each(acc, u, wr, wc, fr, fq, [&](int row, int col, f32x4 v0, f32x4 v1) { pg8::st_bf16x8(o + (size_t)row * ld + col, v0, v1); });
    }
};
__device__ __forceinline__ f32x4 lora_fn(f32x4 v, const float* bias, int seg) {
    if (seg < 4) { const f32x4 b = *(const f32x4*)bias;
#pragma unroll
        for (int e = 0; e < 4; ++e) { const float x = b[e] + v[e];
            if (seg < 2) { const float y = -x; const float sp = fmaxf(y, 0.f) + __logf(1.f + __expf(-fabsf(y))); v[e] = -__expf(-sp - 0.5f); }
            else v[e] = sigmoidf_(x); } }
    return v;
}
struct EpiLora {
    bf16_t* o; const float* w0; const float* a0;
    __device__ __forceinline__ void operator()(const f32x4 (&acc)[2][2][4][2], const Unit& u, int wr, int wc, int fr, int fq) const {
        const int seg = u.pn >> 1;
        const float* bias = seg < 2 ? w0 : a0 - 1024;
        pg8::epi_each(acc, u, wr, wc, fr, fq, [&](int row, int col, f32x4 v0, f32x4 v1) {
            const f32x4 r0 = lora_fn(v0, bias + col, seg), r1 = lora_fn(v1, bias + col + 4, seg);
            pg8::st_bf16x8(o + (size_t)row * LO_LD + col, r0, r1);
        });
    }
};
template <int MODE> struct EpiMerge {
    float* u32; bf16_t* ub; const bf16_t* zg; int goff;
    __device__ __forceinline__ void operator()(const f32x4 (&acc)[2][2][4][2], const Unit& u, int wr, int wc, int fr, int fq) const {
        pg8::epi_each(acc, u, wr, wc, fr, fq, [&](int row, int col, f32x4 v0, f32x4 v1) {
            const u32x4 gw = *(const u32x4*)(zg + (size_t)row * ZG_LD + goff + col);
            f32x4 g0 = {sigmoidf_(lo_bf(gw.x)), sigmoidf_(hi_bf(gw.x)), sigmoidf_(lo_bf(gw.y)), sigmoidf_(hi_bf(gw.y))};
            f32x4 g1 = {sigmoidf_(lo_bf(gw.z)), sigmoidf_(hi_bf(gw.z)), sigmoidf_(lo_bf(gw.w)), sigmoidf_(hi_bf(gw.w))};
            float* up = u32 + (size_t)row * DM + col;
            f32x4 r0 = g0 * v0, r1 = g1 * v1;
            if (MODE > 0) { r0 += *(const f32x4*)up; r1 += *(const f32x4*)(up + 4); }
            if (MODE < 2) { *(f32x4*)up = r0; *(f32x4*)(up + 4) = r1; }
            else pg8::st_bf16x8(ub + (size_t)row * DM + col, r0, r1);
        });
    }
};
struct EpiRes {
    const float* resL; const float* resC; float* outL; float* outC; const float* gateL; const float* gateC;
    __device__ __forceinline__ void operator()(const f32x4 (&acc)[2][2][4][2], const Unit& u, int wr, int wc, int fr, int fq) const {
        const bool isc = u.pm >= L / 256;
        const float* res = isc ? resC - (size_t)L * DM : resL; float* out = isc ? outC - (size_t)L * DM : outL; const float* gate = isc ? gateC : gateL;
        pg8::epi_each(acc, u, wr, wc, fr, fq, [&](int row, int col, f32x4 v0, f32x4 v1) {
            const size_t o = (size_t)row * DM + col;
            const f32x4 g0 = *(const f32x4*)(gate + col), g1 = *(const f32x4*)(gate + col + 4);
            *(f32x4*)(out + o) = *(const f32x4*)(res + o) + g0 * v0; *(f32x4*)(out + o + 4) = *(const f32x4*)(res + o + 4) + g1 * v1;
        });
    }
};
struct EpiSwiglu {
    bf16_t* o; int ld; int row_sub; int ct_mod;
    __device__ __forceinline__ void operator()(const f32x4 (&acc)[2][2][4][2], const Unit& u, int wr, int wc, int fr, int fq) const {
        const int row0 = u.pm * 256 + wr * 64 + fr - row_sub, col0 = (u.pn % ct_mod) * 128 + wc * 32 + 8 * fq;
#pragma unroll
        for (int ai = 0; ai < 2; ++ai)
#pragma unroll
            for (int m = 0; m < 4; ++m) {
                f32x4 r0, r1;
#pragma unroll
                for (int e = 0; e < 4; ++e) { r0[e] = siluf_(acc[ai][0][m][0][e]) * acc[ai][1][m][0][e]; r1[e] = siluf_(acc[ai][0][m][1][e]) * acc[ai][1][m][1][e]; }
                pg8::st_bf16x8(o + (size_t)(row0 + ai * 128 + m * 16) * ld + col0, r0, r1);
            }
    }
};
struct EpiMoe2 {
    bf16_t* ys; const float* rowgate;
    __device__ __forceinline__ void operator()(const f32x4 (&acc)[2][2][4][2], const Unit& u, int wr, int wc, int fr, int fq) const {
        const int cshift = ((u.pn & 3) - u.pn) * 256;
        pg8::epi_each(acc, u, wr, wc, fr, fq, [&](int row, int col, f32x4 v0, f32x4 v1) {
            const float g = rowgate[row];
            pg8::st_bf16x8(ys + (size_t)row * DM + col + cshift, v0 * g, v1 * g);
        });
    }
};
struct MoeOrder {
    int t0, t1, t2, t3, t4, t5, t6, t7, t8, nct, hi_shift, G, c, rep;
    __device__ bool next(int i, Unit& u) const {
        int idx = i * G + c; const int tot = (t8 - t0) * nct; if (idx >= tot * rep) return false; idx %= tot;
#define MOE_E(e, ta, tb_, sh) { const int w = (tb_) - (ta), n = w * nct; if (idx < n) { u.pm = (ta) + idx % w; u.pn = (e) * nct + idx / w + (sh); return true; } idx -= n; }
        MOE_E(0, t0, t1, 0) MOE_E(1, t1, t2, 0) MOE_E(2, t2, t3, 0) MOE_E(3, t3, t4, 0)
        MOE_E(4, t4, t5, hi_shift) MOE_E(5, t5, t6, hi_shift) MOE_E(6, t6, t7, hi_shift) MOE_E(7, t7, t8, hi_shift)
#undef MOE_E
        return false;
    }
};

__device__ __forceinline__ void prepare_rows(const Frame& F, const Args& a, int l) {
    const bf16_t* ZA = (const bf16_t*)(F.ws + WS_ZA); bf16_t* ZN = (bf16_t*)(F.ws + WS_ZN); const bf16_t* ZR = (const bf16_t*)(F.ws + WS_ZR);
    bf16_t* CQN = (bf16_t*)(F.ws + WS_CQN); bf16_t* CKVN = (bf16_t*)(F.ws + WS_CKVN); bf16_t* LA = (bf16_t*)(F.ws + WS_LA); bf16_t* KR = (bf16_t*)(F.ws + WS_KR);
    bf16_t* RKV = (bf16_t*)(F.ws + WS_RKV);
    const int lane = F.lane;
    float cqg[6], ckvg[4], qng[8], kng[8];
#pragma unroll
    for (int e = 0; e < 6; ++e) cqg[e] = a.in[I_CQG][l * 384 + lane * 6 + e];
#pragma unroll
    for (int e = 0; e < 4; ++e) ckvg[e] = a.in[I_CKVG][l * 256 + lane * 4 + e];
#pragma unroll
    for (int e = 0; e < 8; ++e) { qng[e] = a.in[I_NAQG][l * 64 + (lane & 7) * 8 + e] * (0.125f * LOG2E); kng[e] = a.in[I_NAKG][l * 64 + (lane & 7) * 8 + e]; }
    const float* mu0 = a.in[I_MU] + (size_t)l * 2 * 1920; const float* mu1 = mu0 + 1920;
    float kkv[8];
#pragma unroll
    for (int e = 0; e < 8; ++e) kkv[e] = a.in[I_KK][l * 512 + lane * 8 + e];
    const int gw = F.vcu * NWAVES + F.wave, NGW = F.G * NWAVES;
    for (int m = gw; m < R; m += NGW) {
        { const unsigned* p = (const unsigned*)(ZA + (size_t)m * ZA_LD) + lane * 3; const unsigned w0 = p[0], w1 = p[1], w2 = p[2];
          float v[6] = {lo_bf(w0), hi_bf(w0), lo_bf(w1), hi_bf(w1), lo_bf(w2), hi_bf(w2)}; float s = 0.f;
#pragma unroll
          for (int e = 0; e < 6; ++e) s += v[e] * v[e];
          const float rstd = rsqrtf(wave_sum(s) * (1.f / 384.f) + NORM_EPS);
          unsigned* o = (unsigned*)(CQN + (size_t)m * 384) + lane * 3;
          o[0] = cvtpk(v[0] * rstd * cqg[0], v[1] * rstd * cqg[1]); o[1] = cvtpk(v[2] * rstd * cqg[2], v[3] * rstd * cqg[3]); o[2] = cvtpk(v[4] * rstd * cqg[4], v[5] * rstd * cqg[5]); }
        { const u32x2 w = *((const u32x2*)(ZA + (size_t)m * ZA_LD + 384) + lane);
          float v[4] = {lo_bf(w.x), hi_bf(w.x), lo_bf(w.y), hi_bf(w.y)}; float s = v[0] * v[0] + v[1] * v[1] + v[2] * v[2] + v[3] * v[3];
          const float rstd = rsqrtf(wave_sum(s) * (1.f / 256.f) + NORM_EPS);
          u32x2 o; o.x = cvtpk(v[0] * rstd * ckvg[0], v[1] * rstd * ckvg[1]); o.y = cvtpk(v[2] * rstd * ckvg[2], v[3] * rstd * ckvg[3]);
          *((u32x2*)(CKVN + (size_t)m * 256) + lane) = o; }
        if (lane < 16) ((unsigned*)(KR + (size_t)m * 32))[lane] = ((const unsigned*)(ZA + (size_t)m * ZA_LD + 640))[lane];
#pragma unroll
        for (int qk = 0; qk < 2; ++qk) {
            u32x4* p = (u32x4*)(ZN + (size_t)m * ZN_LD + qk * 512) + lane; const u32x4 w = *p;
            float v[8] = {lo_bf(w.x), hi_bf(w.x), lo_bf(w.y), hi_bf(w.y), lo_bf(w.z), hi_bf(w.z), lo_bf(w.w), hi_bf(w.w)}; float s = 0.f;
#pragma unroll
            for (int e = 0; e < 8; ++e) s += v[e] * v[e];
            s += __shfl_xor(s, 1); s += __shfl_xor(s, 2); s += __shfl_xor(s, 4);
            const float rstd = rsqrtf(s * (1.f / 64.f) + NORM_EPS);
            u32x4 o;
            if (qk == 0) { o.x = cvtpk(v[0] * rstd * qng[0], v[1] * rstd * qng[1]); o.y = cvtpk(v[2] * rstd * qng[2], v[3] * rstd * qng[3]); o.z = cvtpk(v[4] * rstd * qng[4], v[5] * rstd * qng[5]); o.w = cvtpk(v[6] * rstd * qng[6], v[7] * rstd * qng[7]); }
            else { o.x = cvtpk(v[0] * rstd * kng[0], v[1] * rstd * kng[1]); o.y = cvtpk(v[2] * rstd * kng[2], v[3] * rstd * kng[3]); o.z = cvtpk(v[4] * rstd * kng[4], v[5] * rstd * kng[5]); o.w = cvtpk(v[6] * rstd * kng[6], v[7] * rstd * kng[7]); }
            *p = o;
        }
        const bool hasp = (m != 0) && (m != L), hasn = (m != L - 1) && (m != R - 1);
        const bf16_t* zc = ZR + (size_t)m * ZR_LD; const bf16_t* zp = zc - ZR_LD; const bf16_t* zn = zc + ZR_LD;
#pragma unroll
        for (int ch = 0; ch < 3; ++ch) {
            const int c0 = ch * 512 + lane * 8;
            const u32x4 wc_ = *(const u32x4*)(zc + c0); u32x4 wp = {0u, 0u, 0u, 0u}, wn = {0u, 0u, 0u, 0u};
            if (hasp) wp = *(const u32x4*)(zp + c0); if (hasn) wn = *(const u32x4*)(zn + c0);
            const float zcv[8] = {lo_bf(wc_.x), hi_bf(wc_.x), lo_bf(wc_.y), hi_bf(wc_.y), lo_bf(wc_.z), hi_bf(wc_.z), lo_bf(wc_.w), hi_bf(wc_.w)};
            const float zpv[8] = {lo_bf(wp.x), hi_bf(wp.x), lo_bf(wp.y), hi_bf(wp.y), lo_bf(wp.z), hi_bf(wp.z), lo_bf(wp.w), hi_bf(wp.w)};
            const float znv[8] = {lo_bf(wn.x), hi_bf(wn.x), lo_bf(wn.y), hi_bf(wn.y), lo_bf(wn.z), hi_bf(wn.z), lo_bf(wn.w), hi_bf(wn.w)};
            float o[8];
            const f32x4 ma = *(const f32x4*)(mu0 + c0), mb = *(const f32x4*)(mu0 + c0 + 4), na = *(const f32x4*)(mu1 + c0), nb = *(const f32x4*)(mu1 + c0 + 4);
            const float m0v[8] = {ma[0], ma[1], ma[2], ma[3], mb[0], mb[1], mb[2], mb[3]}, m1v[8] = {na[0], na[1], na[2], na[3], nb[0], nb[1], nb[2], nb[3]};
#pragma unroll
            for (int e = 0; e < 8; ++e) o[e] = zcv[e] + m0v[e] * (zpv[e] - zcv[e]) + m1v[e] * (znv[e] - zcv[e]);
            u32x4 w; w.x = cvtpk(o[0], o[1]); w.y = cvtpk(o[2], o[3]); w.z = cvtpk(o[4], o[5]); w.w = cvtpk(o[6], o[7]);
            *(u32x4*)(RKV + (size_t)m * RKV_LD + c0) = w;
            if (ch == 1) {
                const float kr_[8] = {lo_bf(w.x), hi_bf(w.x), lo_bf(w.y), hi_bf(w.y), lo_bf(w.z), hi_bf(w.z), lo_bf(w.w), hi_bf(w.w)};
                float s2 = 0.f;
#pragma unroll
                for (int e = 0; e < 8; ++e) { const float kx = kr_[e] * kkv[e]; s2 += kx * kx; }
                s2 += __shfl_xor(s2, 1); s2 += __shfl_xor(s2, 2); s2 += __shfl_xor(s2, 4);
                if ((lane & 7) == 0) ((float*)(F.ws + WS_KN))[(size_t)m * 8 + (lane >> 3)] = 1.f / fmaxf(sqrtf(s2), 1e-12f);
            }
        }
#pragma unroll
        for (int ch = 0; ch < 3; ++ch) {
            const int c0 = 1536 + ch * 128 + lane * 2;
            const unsigned wc_ = *(const unsigned*)(zc + c0); unsigned wp = 0u, wn = 0u;
            if (hasp) wp = *(const unsigned*)(zp + c0); if (hasn) wn = *(const unsigned*)(zn + c0);
            float o0 = lo_bf(wc_), o1 = hi_bf(wc_);
            o0 = o0 + mu0[c0] * (lo_bf(wp) - o0) + mu1[c0] * (lo_bf(wn) - o0);
            o1 = o1 + mu0[c0 + 1] * (hi_bf(wp) - o1) + mu1[c0 + 1] * (hi_bf(wn) - o1);
            if (ch == 0) { o0 = tanhf(o0); o1 = tanhf(o1); } else if (ch == 2) { o0 = sigmoidf_(o0); o1 = sigmoidf_(o1); }
            *(unsigned*)(LA + (size_t)m * 384 + ch * 128 + lane * 2) = cvtpk(o0, o1);
        }
    }
}

__device__ __forceinline__ void mla_fixup(const Frame& F, const Args& a, int l, bool need_ctx_q) {
    const bf16_t* QRAW = (const bf16_t*)(F.ws + WS_QRAW); const bf16_t* KVRAW = (const bf16_t*)(F.ws + WS_KVRAW); const bf16_t* KR = (const bf16_t*)(F.ws + WS_KR);
    bf16_t* Q = (bf16_t*)(F.ws + WS_Q); bf16_t* K = (bf16_t*)(F.ws + WS_K); bf16_t* V = (bf16_t*)(F.ws + WS_V);
    const int lane = F.lane, h = lane >> 3, sub = lane & 7;
    float qg[12], kg[12];
#pragma unroll
    for (int i = 0; i < 12; ++i) { qg[i] = a.in[I_QNG][l * 96 + sub + 8 * i] * (0.10206207261596575f * LOG2E); kg[i] = a.in[I_KNG][l * 96 + sub + 8 * i]; }
    const float freq = __expf(-9.210340371976184f * (float)sub * 0.125f);
    const int gw = F.vcu * NWAVES + F.wave, NGW = F.G * NWAVES;
    for (int m0 = gw; m0 < R * PROBE_ROW; m0 += NGW) { const int m = m0 % R;
        const bool lat = m < L;
        float cr = 1.f, sr = 0.f, cc = 1.f, sc = 0.f;
        if (lat) { sincosf((float)(m >> 6) * freq, &sr, &cr); sincosf((float)(m & 63) * freq, &sc, &cc); }
        if (lat || need_ctx_q) {
            float v[12]; float s = 0.f;
#pragma unroll
            for (int i = 0; i < 12; ++i) { v[i] = bf2f(QRAW[(size_t)m * 768 + h * 96 + sub + 8 * i]); s += v[i] * v[i]; }
            s += __shfl_xor(s, 1); s += __shfl_xor(s, 2); s += __shfl_xor(s, 4);
            const float rstd = rsqrtf(s * (1.f / 96.f) + NORM_EPS);
#pragma unroll
            for (int i = 0; i < 12; ++i) v[i] *= rstd * qg[i];
            { const float t1 = v[8], t2 = v[9]; v[8] = t1 * cr - t2 * sr; v[9] = t1 * sr + t2 * cr; }
            { const float t1 = v[10], t2 = v[11]; v[10] = t1 * cc - t2 * sc; v[11] = t1 * sc + t2 * cc; }
            bf16_t* qo = Q + ((size_t)h * R + m) * 96 + sub;
#pragma unroll
            for (int i = 0; i < 12; ++i) qo[8 * i] = (bf16_t)(cvtpk(v[i], 0.f) & 0xffffu);
        }
        {
            float v[12]; float s = 0.f;
#pragma unroll
            for (int i = 0; i < 8; ++i) v[i] = bf2f(KVRAW[(size_t)m * 1024 + h * 128 + sub + 8 * i]);
#pragma unroll
            for (int i = 0; i < 4; ++i) v[8 + i] = bf2f(KR[(size_t)m * 32 + sub + 8 * i]);
#pragma unroll
            for (int i = 0; i < 12; ++i) s += v[i] * v[i];
            s += __shfl_xor(s, 1); s += __shfl_xor(s, 2); s += __shfl_xor(s, 4);
            const float rstd = rsqrtf(s * (1.f / 96.f) + NORM_EPS);
#pragma unroll
            for (int i = 0; i < 12; ++i) v[i] *= rstd * kg[i];
            { const float t1 = v[8], t2 = v[9]; v[8] = t1 * cr - t2 * sr; v[9] = t1 * sr + t2 * cr; }
            { const float t1 = v[10], t2 = v[11]; v[10] = t1 * cc - t2 * sc; v[11] = t1 * sc + t2 * cc; }
            bf16_t* ko = K + ((size_t)h * R + m) * 96 + sub;
#pragma unroll
            for (int i = 0; i < 12; ++i) ko[8 * i] = (bf16_t)(cvtpk(v[i], 0.f) & 0xffffu);
            *(u32x4*)(V + ((size_t)h * R + m) * 64 + sub * 8) = *(const u32x4*)(KVRAW + (size_t)m * 1024 + h * 128 + 64 + sub * 8);
        }
    }
}

__device__ __forceinline__ void rwkv_output_rows(const Frame& F, const Args& a, int l, int m_end) {
    const bf16_t* RKV = (const bf16_t*)(F.ws + WS_RKV); const bf16_t* LO = (const bf16_t*)(F.ws + WS_LO);
    const bf16_t* YF = (const bf16_t*)(F.ws + WS_YF); const bf16_t* YBK = (const bf16_t*)(F.ws + WS_YBK); bf16_t* YR = (bf16_t*)(F.ws + WS_YR);
    const int lane = F.lane, c0 = lane * 8;
    float ka[8], rk[8], lg[8], lb[8];
#pragma unroll
    for (int e = 0; e < 8; ++e) { ka[e] = a.in[I_KA][l * 512 + c0 + e]; rk[e] = a.in[I_RK][l * 512 + c0 + e]; lg[e] = a.in[I_LNG][l * 512 + c0 + e]; lb[e] = a.in[I_LNB][l * 512 + c0 + e]; }
    const int gw = F.vcu * NWAVES + F.wave, NGW = F.G * NWAVES;
#define UNPK8(W, V) const float V[8] = {lo_bf(W.x), hi_bf(W.x), lo_bf(W.y), hi_bf(W.y), lo_bf(W.z), hi_bf(W.z), lo_bf(W.w), hi_bf(W.w)}
    for (int m0 = gw; m0 < m_end * PROBE_ROW; m0 += NGW) { const int m = m0 % m_end;
        const u32x4 wr_ = *(const u32x4*)(RKV + (size_t)m * RKV_LD + c0), wk_ = *(const u32x4*)(RKV + (size_t)m * RKV_LD + 512 + c0), wv_ = *(const u32x4*)(RKV + (size_t)m * RKV_LD + 1024 + c0);
        const u32x4 wa0 = *(const u32x4*)(LO + (size_t)m * LO_LD + 1024 + c0), wa1 = *(const u32x4*)(LO + (size_t)m * LO_LD + 1536 + c0), wg_ = *(const u32x4*)(LO + (size_t)m * LO_LD + 2048 + c0);
        const u32x4 wyf = *(const u32x4*)(YF + (size_t)m * 512 + c0), wyb = *(const u32x4*)(YBK + (size_t)m * 512 + c0);
        UNPK8(wr_, r); UNPK8(wk_, k); UNPK8(wv_, v); UNPK8(wa0, a0v); UNPK8(wa1, a1v); UNPK8(wg_, g); UNPK8(wyf, yf); UNPK8(wyb, yb);
        float y[8]; float s = 0.f, bs = 0.f;
#pragma unroll
        for (int e = 0; e < 8; ++e) { y[e] = yf[e] + yb[e]; s += y[e];
            const float kd0 = k[e] * (1.f + (a0v[e] - 1.f) * ka[e]), kd1 = k[e] * (1.f + (a1v[e] - 1.f) * ka[e]);
            bs += r[e] * rk[e] * (kd0 + kd1); }
        s += __shfl_xor(s, 1); s += __shfl_xor(s, 2); s += __shfl_xor(s, 4);
        bs += __shfl_xor(bs, 1); bs += __shfl_xor(bs, 2); bs += __shfl_xor(bs, 4);
        const float mean = s * (1.f / 64.f); float q = 0.f;
#pragma unroll
        for (int e = 0; e < 8; ++e) { const float d = y[e] - mean; q += d * d; }
        q += __shfl_xor(q, 1); q += __shfl_xor(q, 2); q += __shfl_xor(q, 4);
        const float rstd = rsqrtf(q * (1.f / 64.f) + 64e-5f);
        float o[8];
#pragma unroll
        for (int e = 0; e < 8; ++e) o[e] = ((y[e] - mean) * rstd * lg[e] + lb[e] + bs * v[e]) * g[e];
        u32x4 w; w.x = cvtpk(o[0], o[1]); w.y = cvtpk(o[2], o[3]); w.z = cvtpk(o[4], o[5]); w.w = cvtpk(o[6], o[7]);
        *(u32x4*)(YR + (size_t)m * 512 + c0) = w;
    }
#undef UNPK8
}

__device__ __forceinline__ int crow(int r, int hi) { return (r & 3) + 8 * (r >> 2) + 4 * hi; }
#define SBAR() __builtin_amdgcn_sched_barrier(0)
__device__ __forceinline__ s16x4 tr_read_at(unsigned addr) { s16x4 r; asm volatile("ds_read_b64_tr_b16 %0, %1" : "=&v"(r) : "v"(addr) : "memory"); return r; }
__device__ __forceinline__ float rowmax32(const f32x16& p0, const f32x16& p1) {
    float m = p0[0];
#pragma unroll
    for (int r = 1; r < 16; ++r) m = fmaxf(m, p0[r]);
#pragma unroll
    for (int r = 0; r < 16; ++r) m = fmaxf(m, p1[r]);
    auto rr = __builtin_amdgcn_permlane32_swap(__float_as_uint(m), __float_as_uint(m), false, false);
    return fmaxf(__uint_as_float(rr[0]), __uint_as_float(rr[1]));
}
__device__ __forceinline__ float halfsum(float s) {
    auto rr = __builtin_amdgcn_permlane32_swap(__float_as_uint(s), __float_as_uint(s), false, false);
    return __uint_as_float(rr[0]) + __uint_as_float(rr[1]);
}
__device__ __forceinline__ void pack_p(const f32x16& p0, const f32x16& p1, bf16x8 (&pa)[4]) {
#define PK8(P, B, OUT) do { u32x4 w = {cvtpk(P[B + 0], P[B + 1]), cvtpk(P[B + 2], P[B + 3]), cvtpk(P[B + 4], P[B + 5]), cvtpk(P[B + 6], P[B + 7])}; OUT = __builtin_bit_cast(bf16x8, w); } while (0)
    PK8(p0, 0, pa[0]); PK8(p0, 8, pa[1]); PK8(p1, 0, pa[2]); PK8(p1, 8, pa[3]);
#undef PK8
}

constexpr int AK_PITCH = 208, AK_BYTES = 64 * AK_PITCH, AV_BYTES = 8192;
constexpr int ALDS_K = 0, ALDS_V = 3 * AK_BYTES, ALDS_WS = ALDS_V + 3 * AV_BYTES, ALDS_Q = ALDS_WS + 8 * 256, ALDS_END = ALDS_Q + 8 * 6144;
typedef short v4i16_t __attribute__((ext_vector_type(4)));
__device__ __forceinline__ s16x4 vtr(LAS const unsigned char* p) { return __builtin_bit_cast(s16x4, __builtin_amdgcn_ds_read_tr16_b64_v4i16((LAS v4i16_t*)p)); }
__device__ __forceinline__ void mla_unit(const Frame& F, int h, int q0, int k0, int nt) {
    const bf16_t* Q = (const bf16_t*)(F.ws + WS_Q) + (size_t)h * R * 96; const bf16_t* K = (const bf16_t*)(F.ws + WS_K) + (size_t)h * R * 96 + (size_t)k0 * 96;
    const bf16_t* V = (const bf16_t*)(F.ws + WS_V) + (size_t)h * R * 64 + (size_t)k0 * 64; bf16_t* YA = (bf16_t*)(F.ws + WS_YA);
    LAS unsigned char* lds = F.lds;
    const int tid = F.tid, lane = F.lane, wid = F.wave, r32 = lane & 31, hi = lane >> 5;
    LAS float* wsf = (LAS float*)(lds + ALDS_WS) + wid * 64;
    bf16x8 qr[6];
    { const bf16_t* qp = Q + (size_t)(q0 + wid * 32 + r32) * 96 + hi * 8;
#pragma unroll
      for (int s = 0; s < 6; ++s) qr[s] = *(const bf16x8*)(qp + s * 16); }
    const int kc0 = tid, kc1 = 512 + tid; const bool k2 = tid < 256;
    const int kr0 = kc0 / 12, kq0 = kc0 % 12, kr1 = kc1 / 12, kq1 = kc1 % 12;
    const int vkey = tid >> 3, vc8 = tid & 7;
    const unsigned kdst0 = kr0 * AK_PITCH + kq0 * 16, kdst1 = kr1 * AK_PITCH + kq1 * 16;
    const unsigned vdst = (vc8 >> 2) * 4096 + vkey * 64 + (vc8 & 3) * 16;
    u32x4 sk0, sk1, sv;
#define A_LOAD(t) do { const bf16_t* kt = K + (size_t)(t) * 64 * 96; sk0 = *(const u32x4*)(kt + kr0 * 96 + kq0 * 8); if (k2) sk1 = *(const u32x4*)(kt + kr1 * 96 + kq1 * 8); \
        sv = *(const u32x4*)(V + (size_t)(t) * 64 * 64 + vkey * 64 + vc8 * 8); } while (0)
#define A_WRITE(sl) do { *(LAS u32x4*)(lds + ALDS_K + (sl) * AK_BYTES + kdst0) = sk0; if (k2) *(LAS u32x4*)(lds + ALDS_K + (sl) * AK_BYTES + kdst1) = sk1; \
        *(LAS u32x4*)(lds + ALDS_V + (sl) * AV_BYTES + vdst) = sv; } while (0)
    f32x16 o[2]; o[0] = f32x16{}; o[1] = f32x16{};
    float mref = 0.f, lsum = 0.f; f32x16 negm = f32x16{};
    LAS const unsigned char* kb_rd = lds + ALDS_K + r32 * AK_PITCH + hi * 16;
    LAS const unsigned char* vb_rd = lds + ALDS_V + ((lane >> 4) & 1) * 32 + (lane & 3) * 8 + (4 * hi + ((lane & 15) >> 2)) * 64;
#define PIN(x) asm volatile("" : "+v"(x))
#define A_QKT(C0, C1, sl) do { LAS const unsigned char* kt_ = kb_rd + (sl) * AK_BYTES; C0 = negm; C1 = negm; \
        _Pragma("unroll") for (int s = 0; s < 6; ++s) { const bf16x8 a0 = *(LAS const bf16x8*)(kt_ + s * 32); const bf16x8 a1 = *(LAS const bf16x8*)(kt_ + 32 * AK_PITCH + s * 32); \
            C0 = __builtin_amdgcn_mfma_f32_32x32x16_bf16(a0, qr[s], C0, 0, 0, 0); C1 = __builtin_amdgcn_mfma_f32_32x32x16_bf16(a1, qr[s], C1, 0, 0, 0); } } while (0)
#define A_MAX(C0, C1, al) do { const float rm_ = rowmax32(C0, C1); al = 1.f; \
        if (__builtin_expect(__any(rm_ > 8.f), 0)) { const float dl_ = fmaxf(rm_, 0.f); mref += dl_; al = __builtin_amdgcn_exp2f(-dl_); \
            _Pragma("unroll") for (int r = 0; r < 16; ++r) { C0[r] -= dl_; C1[r] -= dl_; negm[r] = -mref; } } } while (0)
#define A_RESC(al) do { if (__any((al) < 1.f)) { if (hi == 0) wsf[r32] = (al); LDS_WAIT(); \
        _Pragma("unroll") for (int r = 0; r < 16; ++r) { const float f_ = wsf[crow(r, hi)]; o[0][r] *= f_; o[1][r] *= f_; } } } while (0)
#define A_STEP(C0, C1, P0, P1, sk_, sv_, alP, alC) do { \
        LAS const unsigned char* kt_ = kb_rd + (sk_) * AK_BYTES; LAS const unsigned char* vt_ = vb_rd + (sv_) * AV_BYTES; \
        bf16x8 ka_[2], kb_[2]; u32x4 pw_[4]; float ps0_ = 0.f, ps1_ = 0.f; \
        ka_[0] = *(LAS const bf16x8*)(kt_); kb_[0] = *(LAS const bf16x8*)(kt_ + 32 * AK_PITCH); SBAR(); \
        _Pragma("unroll") for (int s = 0; s < 6; ++s) { const int c_ = s & 1, n_ = c_ ^ 1; \
            if (s + 1 < 6) { ka_[n_] = *(LAS const bf16x8*)(kt_ + (s + 1) * 32); kb_[n_] = *(LAS const bf16x8*)(kt_ + 32 * AK_PITCH + (s + 1) * 32); } \
            if (s == 0) C0 = __builtin_amdgcn_mfma_f32_32x32x16_bf16(ka_[c_], qr[s], negm, 0, 0, 0); else C0 = __builtin_amdgcn_mfma_f32_32x32x16_bf16(ka_[c_], qr[s], C0, 0, 0, 0); \
            if (s < 4) { ps0_ += P0[4 * s] + P0[4 * s + 1]; ps1_ += P0[4 * s + 2] + P0[4 * s + 3]; PIN(ps0_); PIN(ps1_); } \
            else { pw_[2 * (s - 4)][0] = cvtpk(P0[8 * (s - 4)], P0[8 * (s - 4) + 1]); pw_[2 * (s - 4)][1] = cvtpk(P0[8 * (s - 4) + 2], P0[8 * (s - 4) + 3]); pw_[2 * (s - 4)][2] = cvtpk(P0[8 * (s - 4) + 4], P0[8 * (s - 4) + 5]); pw_[2 * (s - 4)][3] = cvtpk(P0[8 * (s - 4) + 6], P0[8 * (s - 4) + 7]); PIN(pw_[2 * (s - 4)]); } \
            SBAR(); \
            if (s == 0) C1 = __builtin_amdgcn_mfma_f32_32x32x16_bf16(kb_[c_], qr[s], negm, 0, 0, 0); else C1 = __builtin_amdgcn_mfma_f32_32x32x16_bf16(kb_[c_], qr[s], C1, 0, 0, 0); \
            if (s < 4) { ps0_ += P1[4 * s] + P1[4 * s + 1]; ps1_ += P1[4 * s + 2] + P1[4 * s + 3]; PIN(ps0_); PIN(ps1_); } \
            else { pw_[2 * (s - 4) + 1][0] = cvtpk(P1[8 * (s - 4)], P1[8 * (s - 4) + 1]); pw_[2 * (s - 4) + 1][1] = cvtpk(P1[8 * (s - 4) + 2], P1[8 * (s - 4) + 3]); pw_[2 * (s - 4) + 1][2] = cvtpk(P1[8 * (s - 4) + 4], P1[8 * (s - 4) + 5]); pw_[2 * (s - 4) + 1][3] = cvtpk(P1[8 * (s - 4) + 6], P1[8 * (s - 4) + 7]); PIN(pw_[2 * (s - 4) + 1]); } \
            SBAR(); } \
        lsum = lsum * (alP) + (ps0_ + ps1_); \
        A_MAX(C0, C1, alC); SBAR(); \
          \
        s16x4 vl_[2], vh_[2]; vl_[0] = vtr(vt_); vh_[0] = vtr(vt_ + 512); SBAR(); \
        _Pragma("unroll") for (int m_ = 0; m_ < 8; ++m_) { const int dt_ = m_ >> 2, s_ = m_ & 3, c_ = m_ & 1, n_ = c_ ^ 1; \
            if (m_ + 1 < 8) { vl_[n_] = vtr(vt_ + ((m_ + 1) >> 2) * 4096 + ((m_ + 1) & 3) * 1024); vh_[n_] = vtr(vt_ + ((m_ + 1) >> 2) * 4096 + ((m_ + 1) & 3) * 1024 + 512); } \
            const bf16x8 vf_ = {vl_[c_][0], vl_[c_][1], vl_[c_][2], vl_[c_][3], vh_[c_][0], vh_[c_][1], vh_[c_][2], vh_[c_][3]}; \
            const int pi_ = (s_ == 0) ? 0 : (s_ == 1) ? 2 : (s_ == 2) ? 1 : 3; \
            o[dt_] = __builtin_amdgcn_mfma_f32_32x32x16_bf16(__builtin_bit_cast(bf16x8, pw_[pi_]), vf_, o[dt_], 0, 0, 0); \
            if (m_ < 4) { C0[4 * m_] = __builtin_amdgcn_exp2f(C0[4 * m_]); C0[4 * m_ + 1] = __builtin_amdgcn_exp2f(C0[4 * m_ + 1]); C0[4 * m_ + 2] = __builtin_amdgcn_exp2f(C0[4 * m_ + 2]); C0[4 * m_ + 3] = __builtin_amdgcn_exp2f(C0[4 * m_ + 3]); PIN(C0); } \
            else { C1[4 * (m_ - 4)] = __builtin_amdgcn_exp2f(C1[4 * (m_ - 4)]); C1[4 * (m_ - 4) + 1] = __builtin_amdgcn_exp2f(C1[4 * (m_ - 4) + 1]); C1[4 * (m_ - 4) + 2] = __builtin_amdgcn_exp2f(C1[4 * (m_ - 4) + 2]); C1[4 * (m_ - 4) + 3] = __builtin_amdgcn_exp2f(C1[4 * (m_ - 4) + 3]); PIN(C1); } \
            SBAR(); } \
    } while (0)
    f32x16 pA0, pA1, pB0, pB1; float alA = 1.f, alB = 1.f;
    A_LOAD(0); A_WRITE(0); A_LOAD(1); A_WRITE(1); A_LOAD(2); __syncthreads();
    A_QKT(pA0, pA1, 0); A_MAX(pA0, pA1, alA);
#pragma unroll
    for (int r = 0; r < 16; ++r) { pA0[r] = __builtin_amdgcn_exp2f(pA0[r]); pA1[r] = __builtin_amdgcn_exp2f(pA1[r]); }
    A_WRITE(2); __syncthreads();
    alA = 1.f;
    int sk = 1, sv_ = 0, sw = 0;
    for (int t = 1; t + 1 < nt; t += 2) {
        if (t + 2 < nt) A_LOAD(t + 2);
        A_STEP(pB0, pB1, pA0, pA1, sk, sv_, alA, alB);
        __syncthreads(); if (t + 2 < nt) A_WRITE(sw); A_RESC(alB);
        sv_ = sk; sk = (sk == 2) ? 0 : sk + 1; sw = (sw == 2) ? 0 : sw + 1;
        if (t + 3 < nt) A_LOAD(t + 3);
        A_STEP(pA0, pA1, pB0, pB1, sk, sv_, alB, alA);
        __syncthreads(); if (t + 3 < nt) A_WRITE(sw); A_RESC(alA);
        sv_ = sk; sk = (sk == 2) ? 0 : sk + 1; sw = (sw == 2) ? 0 : sw + 1;
    }
    A_STEP(pB0, pB1, pA0, pA1, sk, sv_, alA, alB);
    A_RESC(alB);
    { float ps = 0.f;
#pragma unroll
      for (int r = 0; r < 16; ++r) ps += pB0[r] + pB1[r];
      lsum = lsum * alB + ps;
      bf16x8 pa[4]; pack_p(pB0, pB1, pa);
      LAS const unsigned char* vt_ = vb_rd + sk * AV_BYTES;
#pragma unroll
      for (int dt = 0; dt < 2; ++dt)
#pragma unroll
          for (int s = 0; s < 4; ++s) { const s16x4 lo_ = vtr(vt_ + dt * 4096 + s * 1024), hh_ = vtr(vt_ + dt * 4096 + s * 1024 + 512);
              const bf16x8 vf = {lo_[0], lo_[1], lo_[2], lo_[3], hh_[0], hh_[1], hh_[2], hh_[3]};
              o[dt] = __builtin_amdgcn_mfma_f32_32x32x16_bf16(pa[s], vf, o[dt], 0, 0, 0); } }
    lsum = halfsum(lsum);
    if (hi == 0) wsf[r32] = lsum; LDS_WAIT();
#pragma unroll
    for (int r = 0; r < 16; ++r) { const float inv = 1.f / wsf[crow(r, hi)]; const int row = q0 + wid * 32 + crow(r, hi);
        bf16_t* op = YA + (size_t)row * 512 + h * 64 + r32;
        op[0] = (bf16_t)(cvtpk(o[0][r] * inv, 0.f) & 0xffffu); op[32] = (bf16_t)(cvtpk(o[1][r] * inv, 0.f) & 0xffffu); }
    __syncthreads();
#undef A_LOAD
#undef A_WRITE
#undef A_QKT
#undef A_MAX
#undef A_RESC
#undef A_STEP
#undef PIN
}

constexpr int NLDS_V = 0, NLDS_RPB = 8 * 8192, NLDS_WS = NLDS_RPB + 8 * 2048, NLDS_END = NLDS_WS + 8 * 256;
__device__ __forceinline__ void na_unit(const Frame& F, const float* rpb_l, int unit, bool ctxq, int qt) {
    const bf16_t* ZN = (const bf16_t*)(F.ws + WS_ZN); bf16_t* YB = (bf16_t*)(F.ws + WS_YB);
    LAS unsigned char* lds = F.lds;
    const int lane = F.lane, h = F.wave, r32 = lane & 31, hi = lane >> 5;
    LAS unsigned char* vlds = lds + NLDS_V + h * 8192; LAS float* rpbs = (LAS float*)(lds + NLDS_RPB + h * 2048); LAS float* wsf = (LAS float*)(lds + NLDS_WS) + h * 64;
    const int qrow0 = ctxq ? L + unit * 64 : unit * 64;
    const int rs = ctxq ? 0 : min(max(unit - 4, 0), 256 - 8);
    for (int i = lane; i < 15 * 31; i += 64) rpbs[i] = rpb_l[h * 465 + i] * LOG2E;
    bf16x8 qr[4];
#pragma unroll
    for (int s = 0; s < 4; ++s) qr[s] = *(const bf16x8*)(ZN + (size_t)(qrow0 + qt * 32 + r32) * ZN_LD + h * 64 + s * 16 + hi * 8);
    f32x16 o[2]; o[0] = f32x16{}; o[1] = f32x16{};
    float mref = -1e30f, lsum = 0.f;
    const unsigned vb_rd = (unsigned)(uintptr_t)vlds + ((lane >> 4) & 1) * 32 + (lane & 3) * 8 + (4 * hi + ((lane & 15) >> 2)) * 64;
    const int ntl = ctxq ? 0 : 8, nt = ntl + 4;
    LDS_WAIT();
    for (int t = 0; t < nt; ++t) {
        const bool local = t < ntl;
        const int krow0 = local ? (rs + t) * 64 : L + (t - ntl) * 64;
#pragma unroll
        for (int hv = 0; hv < 2; ++hv) {
            u32x4 sv[4];
#pragma unroll
            for (int i = 0; i < 4; ++i) { const int c = (hv * 4 + i) * 64 + lane; sv[i] = *(const u32x4*)(ZN + (size_t)(krow0 + (c >> 3)) * ZN_LD + 1024 + h * 64 + (c & 7) * 8); }
#pragma unroll
            for (int i = 0; i < 4; ++i) { const int c = (hv * 4 + i) * 64 + lane; const int key = c >> 3, c8 = c & 7; *(LAS u32x4*)(vlds + (c8 >> 2) * 4096 + key * 64 + (c8 & 3) * 16) = sv[i]; }
        }
        bf16x8 kf[2][4];
#pragma unroll
        for (int hf = 0; hf < 2; ++hf)
#pragma unroll
            for (int s = 0; s < 4; ++s) kf[hf][s] = *(const bf16x8*)(ZN + (size_t)(krow0 + hf * 32 + r32) * ZN_LD + 512 + h * 64 + s * 16 + hi * 8);
        LDS_WAIT();
        const int dr = rs + t - unit + 7;
        {
            f32x16 p0 = f32x16{}, p1 = f32x16{};
#pragma unroll
            for (int s = 0; s < 4; ++s) { p0 = __builtin_amdgcn_mfma_f32_32x32x16_bf16(kf[0][s], qr[s], p0, 0, 0, 0); p1 = __builtin_amdgcn_mfma_f32_32x32x16_bf16(kf[1][s], qr[s], p1, 0, 0, 0); }
            if (local) {
                const int qc = qt * 32 + r32, cs = min(max(qc - 8, 0), 48);
#pragma unroll
                for (int r = 0; r < 16; ++r) { const int kc0 = crow(r, hi), kc1 = kc0 + 32;
                    const bool v0 = (kc0 >= cs) && (kc0 < cs + 16), v1 = (kc1 >= cs) && (kc1 < cs + 16);
                    const int d0 = v0 ? kc0 - qc + 15 : 0, d1 = v1 ? kc1 - qc + 15 : 0;
                    const float b0 = rpbs[dr * 31 + d0], b1 = rpbs[dr * 31 + d1];
                    p0[r] = v0 ? p0[r] + b0 : -1e30f; p1[r] = v1 ? p1[r] + b1 : -1e30f; }
            }
            const float rm = rowmax32(p0, p1);
            if (__any(rm > mref + 8.f)) {
                const float mn = fmaxf(mref, rm); const float al = __builtin_amdgcn_exp2f(mref - mn); mref = mn; lsum *= al;
                if (hi == 0) wsf[r32] = al; LDS_WAIT();
#pragma unroll
                for (int r = 0; r < 16; ++r) { const float f = wsf[crow(r, hi)]; o[0][r] *= f; o[1][r] *= f; }
                LDS_WAIT();
            }
            float ps = 0.f;
#pragma unroll
            for (int r = 0; r < 16; ++r) { p0[r] = __builtin_amdgcn_exp2f(p0[r] - mref); p1[r] = __builtin_amdgcn_exp2f(p1[r] - mref); ps += p0[r] + p1[r]; }
            lsum += ps;
            bf16x8 pa[4]; pack_p(p0, p1, pa);
#pragma unroll
            for (int dt = 0; dt < 2; ++dt) {
                s16x4 lo[4], hh[4];
#pragma unroll
                for (int s = 0; s < 4; ++s) { lo[s] = tr_read_at(vb_rd + dt * 4096 + s * 1024); hh[s] = tr_read_at(vb_rd + dt * 4096 + s * 1024 + 512); }
                LDS_WAIT(); SBAR();
#pragma unroll
                for (int s = 0; s < 4; ++s) { const bf16x8 vf = {lo[s][0], lo[s][1], lo[s][2], lo[s][3], hh[s][0], hh[s][1], hh[s][2], hh[s][3]};
                    o[dt] = __builtin_amdgcn_mfma_f32_32x32x16_bf16(pa[s], vf, o[dt], 0, 0, 0); }
            }
        }
        LDS_WAIT(); SBAR();
    }
    {
        const float ls = halfsum(lsum);
        if (hi == 0) wsf[r32] = ls; LDS_WAIT();
#pragma unroll
        for (int r = 0; r < 16; ++r) { const float inv = 1.f / wsf[crow(r, hi)]; const int row = qrow0 + qt * 32 + crow(r, hi);
            bf16_t* op = YB + (size_t)row * 512 + h * 64 + r32;
            op[0] = (bf16_t)(cvtpk(o[0][r] * inv, 0.f) & 0xffffu); op[32] = (bf16_t)(cvtpk(o[1][r] * inv, 0.f) & 0xffffu); }
        LDS_WAIT();
    }
}

__device__ __forceinline__ int rw_row2(int d, int seq, int t) {
    if (seq == 0) return d == 0 ? L + t : L + (CT - 1) - t;
    return d == 0 ? t : (L - 1) - t;
}
constexpr int RWB = 4, RWB3 = 4;
constexpr int RW_LDS_PER_WAVE = RWB * 2 * 5 * 64 * 4;

template <bool CTX> __device__ __forceinline__ void rwkv_pass1_item(const Frame& F, const Args& a, int l, int d, int h, int ci) {
    const bf16_t* RKV = (const bf16_t*)(F.ws + WS_RKV); const bf16_t* LO = (const bf16_t*)(F.ws + WS_LO); const float* KN = (const float*)(F.ws + WS_KN);
    const int lane = F.lane, c = h * 64 + lane;
    LAS float* sl = (LAS float*)(F.lds + F.wave * RW_LDS_PER_WAVE);
    const float kkp = a.in[I_KK][l * 512 + c], kap = a.in[I_KA][l * 512 + c];
    if (CTX) __builtin_amdgcn_s_setprio(3);
    float sq[64], sp[64];
    int ln_ = lane; asm volatile("" : "+v"(ln_));
#pragma unroll
    for (int j = 0; j < 64; ++j) { sq[j] = 0.f; sp[j] = (j == ln_) ? 1.f : 0.f; }
    unsigned short rk[RWB], rv[RWB], ra[RWB], rl[RWB]; float rn[RWB];
#define RW_LOAD(bi) do { _Pragma("unroll") for (int s = 0; s < RWB; ++s) { const size_t row = (size_t)rw_row2(d, CTX ? 0 : 1, (CTX ? 0 : (ci - 1) * TCH) + (bi) * RWB + s); \
        rk[s] = RKV[row * RKV_LD + 512 + c]; rv[s] = RKV[row * RKV_LD + 1024 + c]; rl[s] = LO[row * LO_LD + d * 512 + c]; ra[s] = LO[row * LO_LD + 1024 + d * 512 + c]; rn[s] = KN[row * 8 + h]; } } while (0)
    RW_LOAD(0);
    constexpr int NB = (CTX ? CT : TCH) / RWB;
    for (int bi = 0; bi < NB; ++bi) {
        float vv[RWB];
#pragma unroll
        for (int s = 0; s < RWB; ++s) {
            const float k = bf2f(rk[s]), av = bf2f(ra[s]), lw = bf2f(rl[s]); vv[s] = bf2f(rv[s]);
            const float kk = k * kkp * rn[s];
            sl[(s * 5 + 0) * 64 + lane] = kk; sl[(s * 5 + 1) * 64 + lane] = __expf(lw); sl[(s * 5 + 2) * 64 + lane] = kk * av; sl[(s * 5 + 3) * 64 + lane] = k * (1.f + (av - 1.f) * kap);
        }
        if (bi + 1 < NB) RW_LOAD(bi + 1);
        LDS_WAIT();
#pragma unroll 1
        for (int s = 0; s < RWB; ++s) {
            const LAS f32x4* vk = (const LAS f32x4*)(sl + (s * 5 + 0) * 64); const LAS f32x4* vw = (const LAS f32x4*)(sl + (s * 5 + 1) * 64);
            const LAS f32x4* vb = (const LAS f32x4*)(sl + (s * 5 + 2) * 64); const LAS f32x4* vd = (const LAS f32x4*)(sl + (s * 5 + 3) * 64);
            float q0 = 0.f, q1 = 0.f, p0 = 0.f, p1 = 0.f;
            f32x4 kc = vk[0], kn = vk[1];
#pragma unroll
            for (int j4 = 0; j4 < 16; ++j4) {
                f32x4 kf = kn; if (j4 + 2 < 16) kf = vk[j4 + 2];
                q0 -= sq[4 * j4] * kc[0]; q1 -= sq[4 * j4 + 1] * kc[1]; q0 -= sq[4 * j4 + 2] * kc[2]; q1 -= sq[4 * j4 + 3] * kc[3];
                if (!CTX) { p0 -= sp[4 * j4] * kc[0]; p1 -= sp[4 * j4 + 1] * kc[1]; p0 -= sp[4 * j4 + 2] * kc[2]; p1 -= sp[4 * j4 + 3] * kc[3]; }
                kc = kn; kn = kf; __builtin_amdgcn_sched_barrier(0); }
            const float saq = q0 + q1, sap = p0 + p1;
            float vi = vv[0];
#pragma unroll
            for (int s2 = 1; s2 < RWB; ++s2) vi = (s == s2) ? vv[s2] : vi;
            f32x4 wc_ = vw[0], bc = vb[0], dc = vd[0];
#pragma unroll
            for (int j4 = 0; j4 < 16; ++j4) {
                f32x4 wn = wc_, bn = bc, dn = dc; if (j4 + 1 < 16) { wn = vw[j4 + 1]; bn = vb[j4 + 1]; dn = vd[j4 + 1]; }
#pragma unroll
                for (int e = 0; e < 4; ++e) { sq[4 * j4 + e] = sq[4 * j4 + e] * wc_[e] + (saq * bc[e] + vi * dc[e]); if (!CTX) sp[4 * j4 + e] = sp[4 * j4 + e] * wc_[e] + sap * bc[e]; }
                wc_ = wn; bc = bn; dc = dn; __builtin_amdgcn_sched_barrier(0); }
        }
        LDS_WAIT();
        if (CTX && bi == TCH / RWB - 1) {
            float* Qm = (float*)(F.ws + WS_QST) + ((size_t)(d * 8 + h) * NCH + (NCH - 1)) * 4096 + lane * 64;
#pragma unroll
            for (int j4 = 0; j4 < 16; ++j4) *(f32x4*)(Qm + 4 * j4) = (f32x4){sq[4 * j4], sq[4 * j4 + 1], sq[4 * j4 + 2], sq[4 * j4 + 3]};
        }
    }
#undef RW_LOAD
    float* Qo = (float*)(F.ws + WS_QST) + ((size_t)(d * 8 + h) * NCH + ci) * 4096 + lane * 64;
    bf16_t* Po = (bf16_t*)(F.ws + WS_PST) + ((size_t)(d * 8 + h) * NCH + ci) * 4096 + ((lane & 0x33) | ((lane & 4) << 1) | ((lane & 8) >> 1));
#pragma unroll
    for (int j4 = 0; j4 < 16; ++j4) { *(f32x4*)(Qo + 4 * j4) = (f32x4){sq[4 * j4], sq[4 * j4 + 1], sq[4 * j4 + 2], sq[4 * j4 + 3]}; if (!CTX) {
#pragma unroll
            for (int e = 0; e < 4; ++e) Po[(4 * j4 + e) * 64] = (bf16_t)(cvtpk(sp[4 * j4 + e], 0.f) & 0xffffu); } }
    if (CTX) __builtin_amdgcn_s_setprio(0);
}

__device__ __forceinline__ void rwkv_pass2(const Frame& F, int dh, int it) {
    const int lane = F.lane, r32 = lane & 31, hi = lane >> 5;
    float* Qb = (float*)(F.ws + WS_QST) + (size_t)dh * NCH * 4096;
    f32x16 X[2];
#pragma unroll
    for (int jt = 0; jt < 2; ++jt)
#pragma unroll
        for (int r = 0; r < 16; ++r) X[jt][r] = Qb[(size_t)(32 * it + r32) * 64 + 32 * jt + crow(r, hi)];
    bf16x8 pnx[2][2][2]; f32x4 qn[2][4];
    const bf16_t* PTb = (const bf16_t*)(F.ws + WS_PST) + (size_t)dh * NCH * 4096;
#define P2_LOAD(ci_) do { const bf16_t* P_ = PTb + (size_t)(ci_) * 4096; const float* Q_ = Qb + (size_t)(ci_) * 4096 + (size_t)(32 * it + r32) * 64 + 4 * hi; \
        _Pragma("unroll") for (int jn = 0; jn < 2; ++jn) _Pragma("unroll") for (int jt = 0; jt < 2; ++jt) _Pragma("unroll") for (int s = 0; s < 2; ++s) pnx[jn][jt][s] = *(const bf16x8*)(P_ + (size_t)(32 * jn + r32) * 64 + jt * 32 + s * 16 + hi * 8); \
        _Pragma("unroll") for (int jt = 0; jt < 2; ++jt) _Pragma("unroll") for (int g = 0; g < 4; ++g) qn[jt][g] = *(const f32x4*)(Q_ + 32 * jt + 8 * g); } while (0)
    P2_LOAD(1);
    for (int ci = 1; ci < NCH - 1; ++ci) {
        float* Qc = Qb + (size_t)ci * 4096;
        bf16x8 pa[2][2][2]; f32x16 N[2];
#pragma unroll
        for (int jn = 0; jn < 2; ++jn)
#pragma unroll
            for (int jt = 0; jt < 2; ++jt)
#pragma unroll
                for (int s = 0; s < 2; ++s) pa[jn][jt][s] = pnx[jn][jt][s];
#pragma unroll
        for (int jt = 0; jt < 2; ++jt)
#pragma unroll
            for (int r = 0; r < 16; ++r) N[jt][r] = qn[jt][r >> 2][r & 3];
        if (ci + 1 < NCH - 1) P2_LOAD(ci + 1);
        bf16x8 bh[2][2], bl[2][2];
#pragma unroll
        for (int jt = 0; jt < 2; ++jt)
#pragma unroll
            for (int s = 0; s < 2; ++s) {
                unsigned wh[4], wl[4];
#pragma unroll
                for (int e2 = 0; e2 < 4; ++e2) { const float x0 = X[jt][8 * s + 2 * e2], x1 = X[jt][8 * s + 2 * e2 + 1]; const unsigned h = cvtpk(x0, x1); wh[e2] = h; wl[e2] = cvtpk(x0 - lo_bf(h), x1 - hi_bf(h)); }
                u32x4 a = {wh[0], wh[1], wh[2], wh[3]}, b = {wl[0], wl[1], wl[2], wl[3]}; bh[jt][s] = __builtin_bit_cast(bf16x8, a); bl[jt][s] = __builtin_bit_cast(bf16x8, b);
            }
#pragma unroll
        for (int jn = 0; jn < 2; ++jn)
#pragma unroll
            for (int jt = 0; jt < 2; ++jt)
#pragma unroll
                for (int s = 0; s < 2; ++s) { N[jn] = __builtin_amdgcn_mfma_f32_32x32x16_bf16(pa[jn][jt][s], bh[jt][s], N[jn], 0, 0, 0); N[jn] = __builtin_amdgcn_mfma_f32_32x32x16_bf16(pa[jn][jt][s], bl[jt][s], N[jn], 0, 0, 0); }
        X[0] = N[0]; X[1] = N[1];
#pragma unroll
        for (int jt = 0; jt < 2; ++jt)
#pragma unroll
            for (int r = 0; r < 16; ++r) Qc[(size_t)(32 * it + r32) * 64 + 32 * jt + crow(r, hi)] = X[jt][r];
    }
#undef P2_LOAD
}

__device__ __forceinline__ void rwkv_pass3_item(const Frame& F, const Args& a, int l, int d, int hp, int pc) {
    const bf16_t* RKV = (const bf16_t*)(F.ws + WS_RKV); const bf16_t* LO = (const bf16_t*)(F.ws + WS_LO); const float* KN = (const float*)(F.ws + WS_KN);
    bf16_t* Y = (bf16_t*)(F.ws + (d == 0 ? WS_YF : WS_YBK));
    const int lane = F.lane, hs = lane >> 5, ri = lane & 31, hme = 2 * hp + hs;
    LAS float* sl = (LAS float*)(F.lds + F.wave * RW_LDS_PER_WAVE);
    float kkp[2], kap[2];
#pragma unroll
    for (int hh = 0; hh < 2; ++hh) { kkp[hh] = a.in[I_KK][l * 512 + (2 * hp + hh) * 64 + lane]; kap[hh] = a.in[I_KA][l * 512 + (2 * hp + hh) * 64 + lane]; }
    float sa[64], sb[64];
    const int seq = pc < 2 ? 0 : 1, tbase = pc < 2 ? pc * TCH : (pc - 2) * TCH;
    const int slot = pc == 1 ? NCH - 1 : pc - 2;
    if (pc == 0) {
#pragma unroll
        for (int j = 0; j < 64; ++j) { sa[j] = 0.f; sb[j] = 0.f; }
    } else {
        const float* S0 = (const float*)(F.ws + WS_QST) + ((size_t)(d * 8 + hme) * NCH + slot) * 4096 + ri * 64;
#pragma unroll
        for (int j4 = 0; j4 < 16; ++j4) { const f32x4 t = *(const f32x4*)(S0 + 4 * j4), u = *(const f32x4*)(S0 + 2048 + 4 * j4);
            sa[4 * j4] = t[0]; sa[4 * j4 + 1] = t[1]; sa[4 * j4 + 2] = t[2]; sa[4 * j4 + 3] = t[3]; sb[4 * j4] = u[0]; sb[4 * j4 + 1] = u[1]; sb[4 * j4 + 2] = u[2]; sb[4 * j4 + 3] = u[3]; }
    }
    unsigned rka[2][RWB3], rlr[2][RWB3], rvv[RWB3]; float rn[2][RWB3];
#define RW_LOAD(bi) do { _Pragma("unroll") for (int s = 0; s < RWB3; ++s) { const size_t row = (size_t)rw_row2(d, seq, tbase + (bi) * RWB3 + s); \
        _Pragma("unroll") for (int hh = 0; hh < 2; ++hh) { const int c = (2 * hp + hh) * 64 + lane; \
            rka[hh][s] = (unsigned)RKV[row * RKV_LD + 512 + c] | ((unsigned)LO[row * LO_LD + 1024 + d * 512 + c] << 16); \
            rlr[hh][s] = (unsigned)LO[row * LO_LD + d * 512 + c] | ((unsigned)RKV[row * RKV_LD + c] << 16); rn[hh][s] = KN[row * 8 + 2 * hp + hh]; } \
        rvv[s] = (unsigned)RKV[row * RKV_LD + 1024 + hme * 64 + ri] | ((unsigned)RKV[row * RKV_LD + 1024 + hme * 64 + ri + 32] << 16); } } while (0)
    RW_LOAD(0);
    for (int bi = 0; bi < TCH / RWB3; ++bi) {
        float va[RWB3], vb_[RWB3];
#pragma unroll
        for (int s = 0; s < RWB3; ++s) {
            va[s] = lo_bf(rvv[s]); vb_[s] = hi_bf(rvv[s]);
#pragma unroll
            for (int hh = 0; hh < 2; ++hh) {
                const float k = lo_bf(rka[hh][s]), av = hi_bf(rka[hh][s]), lw = lo_bf(rlr[hh][s]);
                const float kk = k * kkp[hh] * rn[hh][s];
                LAS float* o = sl + ((s * 2 + hh) * 5) * 64 + lane;
                o[0] = kk; o[64] = __expf(lw); o[128] = kk * av; o[192] = k * (1.f + (av - 1.f) * kap[hh]); o[256] = hi_bf(rlr[hh][s]);
            }
        }
        if (bi + 1 < TCH / RWB3) RW_LOAD(bi + 1);
        LDS_WAIT();
#pragma unroll 1
        for (int s = 0; s < RWB3; ++s) {
            const LAS float* base = sl + ((s * 2 + hs) * 5) * 64;
            const LAS f32x4* vk = (const LAS f32x4*)(base); const LAS f32x4* vw = (const LAS f32x4*)(base + 64);
            const LAS f32x4* vb = (const LAS f32x4*)(base + 128); const LAS f32x4* vd = (const LAS f32x4*)(base + 192); const LAS f32x4* vr = (const LAS f32x4*)(base + 256);
            float q0 = 0.f, q1 = 0.f, p0 = 0.f, p1 = 0.f;
            f32x4 kc = vk[0], kn = vk[1];
#pragma unroll
            for (int j4 = 0; j4 < 16; ++j4) {
                f32x4 kf = kn; if (j4 + 2 < 16) kf = vk[j4 + 2];
                q0 -= sa[4 * j4] * kc[0]; q1 -= sa[4 * j4 + 1] * kc[1]; q0 -= sa[4 * j4 + 2] * kc[2]; q1 -= sa[4 * j4 + 3] * kc[3];
                p0 -= sb[4 * j4] * kc[0]; p1 -= sb[4 * j4 + 1] * kc[1]; p0 -= sb[4 * j4 + 2] * kc[2]; p1 -= sb[4 * j4 + 3] * kc[3];
                kc = kn; kn = kf; __builtin_amdgcn_sched_barrier(0); }
            const float saa = q0 + q1, sab = p0 + p1;
            float via = va[0], vib = vb_[0];
#pragma unroll
            for (int s2 = 1; s2 < RWB3; ++s2) { via = (s == s2) ? va[s2] : via; vib = (s == s2) ? vb_[s2] : vib; }
            f32x2 ya2 = {0.f, 0.f}, yb2 = {0.f, 0.f};
            f32x4 wc_ = vw[0], bc = vb[0], dc = vd[0], rc = vr[0];
#pragma unroll
            for (int j4 = 0; j4 < 16; ++j4) {
                f32x4 wn = wc_, bn = bc, dn = dc, rn_ = rc; if (j4 + 1 < 16) { wn = vw[j4 + 1]; bn = vb[j4 + 1]; dn = vd[j4 + 1]; rn_ = vr[j4 + 1]; }
#pragma unroll
                for (int e2 = 0; e2 < 2; ++e2) {
                    const f32x2 w2 = {wc_[2 * e2], wc_[2 * e2 + 1]}, b2 = {bc[2 * e2], bc[2 * e2 + 1]}, d2 = {dc[2 * e2], dc[2 * e2 + 1]}, r2 = {rc[2 * e2], rc[2 * e2 + 1]};
                    const f32x2 oa = {sa[4 * j4 + 2 * e2], sa[4 * j4 + 2 * e2 + 1]}, ob = {sb[4 * j4 + 2 * e2], sb[4 * j4 + 2 * e2 + 1]};
                    const f32x2 na = oa * w2 + (b2 * saa + d2 * via), nb = ob * w2 + (b2 * sab + d2 * vib);
                    sa[4 * j4 + 2 * e2] = na[0]; sa[4 * j4 + 2 * e2 + 1] = na[1]; sb[4 * j4 + 2 * e2] = nb[0]; sb[4 * j4 + 2 * e2 + 1] = nb[1];
                    ya2 += na * r2; yb2 += nb * r2; }
                wc_ = wn; bc = bn; dc = dn; rc = rn_; __builtin_amdgcn_sched_barrier(0); }
            const int row = rw_row2(d, seq, tbase + bi * RWB3 + s);
            bf16_t* yo = Y + (size_t)row * 512 + hme * 64 + ri;
            yo[0] = (bf16_t)(cvtpk(ya2[0] + ya2[1], 0.f) & 0xffffu); yo[32] = (bf16_t)(cvtpk(yb2[0] + yb2[1], 0.f) & 0xffffu);
        }
        LDS_WAIT();
    }
#undef RW_LOAD
}

__device__ __forceinline__ void norm2_route_rows(const Frame& F, const Args& a, int l, const float* src, const float* g, const float* sh, const float* sc) {
    bf16_t* H = (bf16_t*)(F.ws + WS_H);
    int* ridx = (int*)(F.ws + WS_RT_IDX); int* rpos = (int*)(F.ws + WS_RT_POS); float* rgate = (float*)(F.ws + WS_RT_GATE);
    unsigned* cnt = (unsigned*)(F.ws + WS_CTL) + CW_MOECNT;
    const float* rw = a.in[I_ROUTER];
    f32x4 ca[4], cb[4];
#pragma unroll
    for (int j = 0; j < 4; ++j) { const int d = F.lane * 4 + 256 * j; const f32x4 gg = *(const f32x4*)(g + d), s1 = *(const f32x4*)(sc + d); ca[j] = gg * (s1 + 1.0f); cb[j] = *(const f32x4*)(sh + d); }
    const int gw = F.vcu * NWAVES + F.wave, NGW = F.G * NWAVES;
    for (int m = gw; m < L; m += NGW) {
        const f32x4* xr = (const f32x4*)(src + (size_t)m * DM) + F.lane;
        f32x4 v[4]; float s = 0.f;
#pragma unroll
        for (int j = 0; j < 4; ++j) { v[j] = xr[64 * j]; s += (v[j].x * v[j].x + v[j].y * v[j].y) + (v[j].z * v[j].z + v[j].w * v[j].w); }
        const float rstd = rsqrtf(wave_sum(s) * (1.f / DM) + NORM_EPS);
        u32x2* o8 = (u32x2*)(H + (size_t)m * DM) + F.lane;
        float lg[8] = {0.f, 0.f, 0.f, 0.f, 0.f, 0.f, 0.f, 0.f};
#pragma unroll
        for (int j = 0; j < 4; ++j) { const f32x4 y = v[j] * rstd * ca[j] + cb[j]; u32x2 w; w.x = cvtpk(y.x, y.y); w.y = cvtpk(y.z, y.w); o8[64 * j] = w;
            const float* rp = rw + (size_t)(F.lane * 4 + 256 * j) * 8;
#pragma unroll
            for (int e4 = 0; e4 < 4; ++e4) { const f32x4 w0 = *(const f32x4*)(rp + e4 * 8), w1 = *(const f32x4*)(rp + e4 * 8 + 4);
                const float yy = y[e4];
                lg[0] += yy * w0[0]; lg[1] += yy * w0[1]; lg[2] += yy * w0[2]; lg[3] += yy * w0[3]; lg[4] += yy * w1[0]; lg[5] += yy * w1[1]; lg[6] += yy * w1[2]; lg[7] += yy * w1[3]; } }
#pragma unroll
        for (int e = 0; e < 8; ++e) lg[e] = wave_sum(lg[e]);
        if (F.lane == 0) {
            int i1 = 0; float l1 = lg[0];
#pragma unroll
            for (int e = 1; e < 8; ++e) if (lg[e] > l1) { l1 = lg[e]; i1 = e; }
            int i2 = -1; float l2 = -3.0e38f;
#pragma unroll
            for (int e = 0; e < 8; ++e) if (e != i1 && lg[e] > l2) { l2 = lg[e]; i2 = e; }
            const float g2v = 1.f / (1.f + __expf(l1 - l2)), g1v = 1.f - g2v;
            const unsigned p1 = __hip_atomic_fetch_add(cnt + 64 * i1, 1u, __ATOMIC_RELAXED, __HIP_MEMORY_SCOPE_AGENT);
            const unsigned p2 = __hip_atomic_fetch_add(cnt + 64 * i2, 1u, __ATOMIC_RELAXED, __HIP_MEMORY_SCOPE_AGENT);
            ridx[2 * m] = i1; ridx[2 * m + 1] = i2; rpos[2 * m] = (int)p1; rpos[2 * m + 1] = (int)p2; rgate[2 * m] = g1v; rgate[2 * m + 1] = g2v;
        }
    }
}
__device__ __forceinline__ void moe_tile_bases(const Frame& F, int (&tb)[9]) {
    const unsigned* cnt = (const unsigned*)(F.ws + WS_CTL) + CW_MOECNT;
    int acc = 0;
#pragma unroll
    for (int e = 0; e < 8; ++e) { tb[e] = acc; const unsigned c = __hip_atomic_load(cnt + 64 * e, __ATOMIC_RELAXED, __HIP_MEMORY_SCOPE_AGENT); acc += (int)((c + 255u) >> 8); }
    tb[8] = acc;
}
__device__ __forceinline__ void moe_gather(const Frame& F) {
    const bf16_t* H = (const bf16_t*)(F.ws + WS_H); bf16_t* H2G = (bf16_t*)(F.ws + WS_H2G);
    const int* ridx = (const int*)(F.ws + WS_RT_IDX); const int* rpos = (const int*)(F.ws + WS_RT_POS); const float* rgate = (const float*)(F.ws + WS_RT_GATE);
    float* rowgate = (float*)(F.ws + WS_RT_ROWGATE);
    const unsigned* cnt = (const unsigned*)(F.ws + WS_CTL) + CW_MOECNT;
    int tb[9]; moe_tile_bases(F, tb);
    const int gw = F.vcu * NWAVES + F.wave, NGW = F.G * NWAVES;
    for (int m = gw; m < L; m += NGW) {
        const u32x4 r0 = *((const u32x4*)(H + (size_t)m * DM) + F.lane), r1 = *((const u32x4*)(H + (size_t)m * DM) + 64 + F.lane);
#pragma unroll
        for (int s = 0; s < 2; ++s) {
            const int e = ridx[2 * m + s]; int base = 0;
#pragma unroll
            for (int k = 0; k < 8; ++k) base = (e == k) ? tb[k] : base;
            const size_t row = (size_t)base * 256 + rpos[2 * m + s];
            *((u32x4*)(H2G + row * DM) + F.lane) = r0; *((u32x4*)(H2G + row * DM) + 64 + F.lane) = r1;
            if (F.lane == 0) rowgate[row] = rgate[2 * m + s];
        }
    }
#pragma unroll
    for (int e = 0; e < 8; ++e) {
        const int c = (int)__hip_atomic_load(cnt + 64 * e, __ATOMIC_RELAXED, __HIP_MEMORY_SCOPE_AGENT);
        const int lo = tb[e] * 256 + c, hi_ = tb[e + 1] * 256;
        for (int row = lo + gw; row < hi_; row += NGW) { *((u32x4*)(H2G + (size_t)row * DM) + F.lane) = (u32x4){0u, 0u, 0u, 0u}; *((u32x4*)(H2G + (size_t)row * DM) + 64 + F.lane) = (u32x4){0u, 0u, 0u, 0u}; if (F.lane == 0) rowgate[row] = 0.f; }
    }
}
__device__ __forceinline__ void moe_combine(const Frame& F, float* out, const float* gt2) {
    const bf16_t* YS = (const bf16_t*)(F.ws + WS_H2G);
    const int* ridx = (const int*)(F.ws + WS_RT_IDX); const int* rpos = (const int*)(F.ws + WS_RT_POS);
    int tb[9]; moe_tile_bases(F, tb);
    const int gw = F.vcu * NWAVES + F.wave, NGW = F.G * NWAVES;
    for (int m = gw; m < L; m += NGW) {
        size_t rows[2];
#pragma unroll
        for (int s = 0; s < 2; ++s) { const int e = ridx[2 * m + s]; int base = 0;
#pragma unroll
            for (int k = 0; k < 8; ++k) base = (e == k) ? tb[k] : base;
            rows[s] = (size_t)base * 256 + rpos[2 * m + s]; }
#pragma unroll
        for (int hf = 0; hf < 2; ++hf) {
            const int c0 = hf * 512 + F.lane * 8;
            const u32x4 a0 = *(const u32x4*)(YS + rows[0] * DM + c0), a1 = *(const u32x4*)(YS + rows[1] * DM + c0);
            float* op = out + (size_t)m * DM + c0;
            const f32x4 g0 = *(const f32x4*)(gt2 + c0), g1 = *(const f32x4*)(gt2 + c0 + 4);
            f32x4 x0 = *(const f32x4*)op, x1 = *(const f32x4*)(op + 4);
            x0 += g0 * (f32x4){lo_bf(a0.x) + lo_bf(a1.x), hi_bf(a0.x) + hi_bf(a1.x), lo_bf(a0.y) + lo_bf(a1.y), hi_bf(a0.y) + hi_bf(a1.y)};
            x1 += g1 * (f32x4){lo_bf(a0.z) + lo_bf(a1.z), hi_bf(a0.z) + hi_bf(a1.z), lo_bf(a0.w) + lo_bf(a1.w), hi_bf(a0.w) + hi_bf(a1.w)};
            *(f32x4*)op = x0; *(f32x4*)(op + 4) = x1;
        }
    }
}

#ifndef PROBE_MOE
#define PROBE_MOE 1
#endif
#ifndef PROBE_NA
#define PROBE_NA 1
#endif
#ifndef PROBE_MLA
#define PROBE_MLA 1
#endif
#ifndef PROBE_GEMM
#define PROBE_GEMM 1
#endif
#ifndef PROBE_RW1
#define PROBE_RW1 1
#endif
#ifndef REP_MLA
#define REP_MLA 1
#endif
#ifndef REP_NA
#define REP_NA 1
#endif
#ifndef REP_RW1
#define REP_RW1 1
#endif
#ifndef REP_RW3
#define REP_RW3 1
#endif
#ifndef REP_GEMM
#define REP_GEMM 1
#endif
#ifndef REP_ROW
#define REP_ROW 1
#endif
constexpr int PH_PER_LAYER = 24;
constexpr int N_PHASES = 1 + 2 * PH_PER_LAYER;
__global__ void __launch_bounds__(NTHR, 2) mega_fwd(Args args) {
    extern __shared__ __attribute__((aligned(16))) unsigned char lds_raw[];
    Frame F;
    F.lds = (LAS unsigned char*)lds_raw; F.ws = args.ws;
    F.tid = threadIdx.x; F.lane = F.tid & 63; F.wave = __builtin_amdgcn_readfirstlane((int)threadIdx.x >> 6);
    F.G = gridDim.x; F.bid = blockIdx.x; F.vcu = (F.G % 8 == 0) ? (F.bid % 8) * (F.G / 8) + F.bid / 8 : F.bid;
    volatile LAS unsigned* MISC = (volatile LAS unsigned*)(F.lds + LDS_MISC_OFF);
    if (F.tid < 64) MISC[F.tid] = 0u;
    __syncthreads();
    const int lo = args.ph_lo, hi = args.ph_hi;
    const bool multi = (hi - lo) > 1;
    XcdBarrier bar; bar.bar = (unsigned*)(F.ws + WS_CTL) + CW_BAR; bar.x = 0; bar.st = MISC + 8;
    if (multi) bar = xcd_barrier_post((unsigned*)(F.ws + WS_CTL) + CW_BAR, MISC + 8);
#define IN(k) (lo <= (k) && (k) < hi)
    const Frame F0 = F;
#define SEAM(k) do { if (multi) xcd_barrier(bar); } while (0)
    LAS unsigned char* lds = F.lds;
    float* MODV = (float*)(F.ws + WS_MODV);
    float* out = args.out;

    if (IN(0)) { const Frame F = launder(F0); prologue_mod(F, args); prologue_weights(F, args); }
    SEAM(0);

#pragma unroll
    for (int l = 0; l < 2; ++l) {
        const int pb = 1 + l * PH_PER_LAYER;
        const bool need_ctx = (l == 0);
        unsigned char* wb = F.ws + WS_W + (size_t)l * WB_SIZE;
        const float* modL = MODV + (size_t)(l * 2) * 6144; const float* modC = modL + 6144;
        float* X1 = (float*)(F.ws + WS_X1); float* CM = (float*)(F.ws + WS_CM);
        bf16_t* H = (bf16_t*)(F.ws + WS_H);
        const int nMall = R / 256, nMlat = L / 256;

        if (IN(pb + 0)) { const Frame F = launder(F0);
            if (l == 0) { norm_rows(F, args.in[I_X], 0, 0, L, args.in[I_N1G] + l * DM, modL, modL + 1024, H);
                          norm_rows(F, args.in[I_CTX], L, L, R, args.in[I_N1G] + l * DM, modC, modC + 1024, H); }
            else { norm_rows(F, X1, 0, 0, L, args.in[I_N1G] + l * DM, modL, modL + 1024, H);
                   norm_rows(F, X1, 0, L, R, args.in[I_N1G] + l * DM, modC, modC + 1024, H); }
        }
        SEAM(pb + 0);
        if (IN(pb + 1)) { const Frame F = launder(F0);
            pg8::Gemm g{H, DM, (const bf16_t*)(wb + WB_WINM), DM}; pg8::StaticOrder S; S.init(nMall, ZM_N / 256, F.G, F.bid, PROBE_GEMM);
            EpiZ E{(bf16_t*)(F.ws + WS_ZA), (bf16_t*)(F.ws + WS_ZN), (bf16_t*)(F.ws + WS_ZR)};
            pg8::gemm_phase(lds, F.tid, g, S, E);
        }
        SEAM(pb + 1);
        if (IN(pb + 2)) { const Frame F = launder(F0); prepare_rows(F, args, l); }
        SEAM(pb + 2);
        if (IN(pb + 3)) { const Frame F = launder(F0);
            { pg8::Gemm g{(const bf16_t*)(F.ws + WS_CQN), 384, (const bf16_t*)(wb + WB_WUQ), 384}; pg8::StaticOrder S; S.init(nMall, 3, F.G, F.bid, PROBE_GEMM);
              EpiBf E{(bf16_t*)(F.ws + WS_QRAW), 768}; pg8::gemm_phase(lds, F.tid, g, S, E); }
            { pg8::Gemm g{(const bf16_t*)(F.ws + WS_CKVN), 256, (const bf16_t*)(wb + WB_WUKV), 256}; pg8::StaticOrder S; S.init(nMall, 4, F.G, F.bid, PROBE_GEMM);
              EpiBf E{(bf16_t*)(F.ws + WS_KVRAW), 1024}; pg8::gemm_phase(lds, F.tid, g, S, E); }
            { pg8::Gemm g{(const bf16_t*)(F.ws + WS_LA), 384, (const bf16_t*)(wb + WB_WLORA), 384}; pg8::StaticOrder S; S.init(nMall, 10, F.G, F.bid, PROBE_GEMM);
              EpiLora E{(bf16_t*)(F.ws + WS_LO), args.in[I_W0] + (size_t)l * 1024, args.in[I_A0] + (size_t)l * 1024}; pg8::gemm_phase(lds, F.tid, g, S, E); }
        }
        SEAM(pb + 3);
        if (IN(pb + 4)) { const Frame F = launder(F0); mla_fixup(F, args, l, need_ctx); }
        SEAM(pb + 4);
        if (IN(pb + 5)) { const Frame F = launder(F0);
            const int xcd = F.bid % 8, idx = F.bid / 8, per = F.G / 8;
            for (int u0 = idx; u0 < 64 * PROBE_MLA + ((need_ctx && idx == 0) ? per : 0); u0 += per) { const int u = u0 >= 64 * PROBE_MLA ? 64 : u0 % 64;
                const bool cu = u >= 64;
                mla_unit(F, xcd, cu ? L : u * 256, cu ? L : 0, cu ? CT / 64 : R / 64);
            }
        }
        SEAM(pb + 5);
        if (IN(pb + 6)) { const Frame F = launder(F0);
            for (int it = F.wave * F.G + F.bid; it < PROBE_RW1 * 16 * 128; it += NWAVES * F.G) { const int dh = (it >> 7) & 15, ci = it & 127;
                if (ci == 0) rwkv_pass1_item<true>(F, args, l, dh >> 3, dh & 7, 0); else rwkv_pass1_item<false>(F, args, l, dh >> 3, dh & 7, ci);
            }
        }
        SEAM(pb + 6);
        if (IN(pb + 7)) { const Frame F = launder(F0);
            const int nrw = F.G > 64 ? 16 : 0;
            if (F.bid < nrw) {
                if (F.wave < 2) rwkv_pass2(F, F.bid, F.wave);
                else if (F.wave == 2 && need_ctx) rwkv_pass3_item(F, args, l, F.bid >> 3, (F.bid >> 1) & 3, F.bid & 1);
            }
            else {
                if (nrw == 0 && F.bid < 16 && F.wave < 2) rwkv_pass2(F, F.bid, F.wave);
                __syncthreads();
                const float* rpb_l = args.in[I_RPB] + (size_t)l * 8 * 465;
                for (int u0 = F.bid - nrw; u0 < PROBE_NA * 2 * (256 + (need_ctx ? 4 : 0)); u0 += F.G - nrw) { const int u = u0 % (2 * (256 + (need_ctx ? 4 : 0))); const int un = u >> 1; na_unit(F, rpb_l, un < 256 ? un : un - 256, un >= 256, u & 1); }
            }
        }
        SEAM(pb + 7);
        if (IN(pb + 8)) { const Frame F = launder(F0);
            for (int it = F.wave * F.G + F.bid; it < 8 * 128; it += NWAVES * F.G) { const int dp = it >> 7, pc = 2 + (it & 127);
                rwkv_pass3_item(F, args, l, dp >> 2, dp & 3, pc);
            }
            if (F.G <= 64 && need_ctx) for (int it = F.wave * F.G + F.bid; it < 16; it += NWAVES * F.G) rwkv_pass3_item(F, args, l, it >> 3, (it >> 1) & 3, it & 1);
        }
        SEAM(pb + 8);
        if (IN(pb + 10)) { const Frame F = launder(F0);
            rwkv_output_rows(F, args, l, need_ctx ? R : L);
            __syncthreads();
            pg8::Gemm g{H, DM, (const bf16_t*)(wb + WB_WING), DM}; pg8::StaticOrder S; S.init(need_ctx ? nMall : nMlat, 12, F.G, F.bid, PROBE_GEMM);
            EpiBf E{(bf16_t*)(F.ws + WS_ZG), ZG_LD}; pg8::gemm_phase(lds, F.tid, g, S, E);
        }
        SEAM(pb + 10);
        if (IN(pb + 11)) { const Frame F = launder(F0);
            const int nM = need_ctx ? nMall : nMlat;
            float* U32 = (float*)(F.ws + WS_U32); bf16_t* U = (bf16_t*)(F.ws + WS_U); const bf16_t* ZG = (const bf16_t*)(F.ws + WS_ZG);
            { pg8::Gemm g{(const bf16_t*)(F.ws + WS_YA), 512, (const bf16_t*)(wb + WB_WOA), 512}; pg8::StaticOrder S; S.init(nM, 4, F.G, F.bid);
              EpiMerge<0> E{U32, U, ZG, 0}; pg8::gemm_phase(lds, F.tid, g, S, E); }
            { pg8::Gemm g{(const bf16_t*)(F.ws + WS_YB), 512, (const bf16_t*)(wb + WB_WOB), 512}; pg8::StaticOrder S; S.init(nM, 4, F.G, F.bid);
              EpiMerge<1> E{U32, U, ZG, 1024}; pg8::gemm_phase(lds, F.tid, g, S, E); }
            { pg8::Gemm g{(const bf16_t*)(F.ws + WS_YR), 512, (const bf16_t*)(wb + WB_WOR), 512}; pg8::StaticOrder S; S.init(nM, 4, F.G, F.bid);
              EpiMerge<2> E{U32, U, ZG, 2048}; pg8::gemm_phase(lds, F.tid, g, S, E); }
        }
        SEAM(pb + 11);
        if (IN(pb + 12)) { const Frame F = launder(F0);
            pg8::Gemm g{(const bf16_t*)(F.ws + WS_U), DM, (const bf16_t*)(wb + WB_WOUT), DM}; pg8::StaticOrder S; S.init(need_ctx ? nMall : nMlat, 4, F.G, F.bid, PROBE_GEMM);
            EpiRes E{l == 0 ? args.in[I_X] : X1, l == 0 ? args.in[I_CTX] : X1 + (size_t)L * DM, out, CM, modL + 2048, modC + 2048};
            pg8::gemm_phase(lds, F.tid, g, S, E);
        }
        SEAM(pb + 12);
        if (l == 0) {
            if (IN(pb + 13)) { const Frame F = launder(F0); norm_rows(F, out, 0, 0, L, args.in[I_N2G] + l * DM, modL + 3072, modL + 4096, H);
                               norm_rows(F, CM, L, L, R, args.in[I_N2G] + l * DM, modC + 3072, modC + 4096, H); }
            SEAM(pb + 13);
            if (IN(pb + 14)) { const Frame F = launder(F0);
                pg8::Gemm g{H, DM, (const bf16_t*)(F.ws + WS_W13), DM}; pg8::StaticOrder S; S.init(nMall, 22, F.G, F.bid, PROBE_GEMM);
                EpiSwiglu E{(bf16_t*)(F.ws + WS_G), FF, 0, 1 << 20}; pg8::gemm_phase(lds, F.tid, g, S, E);
            }
            SEAM(pb + 14);
            if (IN(pb + 15)) { const Frame F = launder(F0);
                pg8::Gemm g{(const bf16_t*)(F.ws + WS_G), FF, (const bf16_t*)(F.ws + WS_W2), FF}; pg8::StaticOrder S; S.init(nMall, 4, F.G, F.bid, PROBE_GEMM);
                EpiRes E{out, CM, X1, X1 + (size_t)L * DM, modL + 5120, modC + 5120};
                pg8::gemm_phase(lds, F.tid, g, S, E);
            }
            SEAM(pb + 15);
        } else {
            if (IN(pb + 13)) { const Frame F = launder(F0); norm2_route_rows(F, args, l, out, args.in[I_N2G] + l * DM, modL + 3072, modL + 4096); }
            SEAM(pb + 13);
            if (IN(pb + 14)) { const Frame F = launder(F0); moe_gather(F); moe_weights(F, args, 0); }
            SEAM(pb + 14);
            int tb[9]; moe_tile_bases(F, tb);
            if (IN(pb + 15)) { const Frame F = launder(F0);
                moe_weights(F, args, 1);
                __syncthreads();
                MoeOrder S{tb[0], tb[1], tb[2], tb[3], tb[4], tb[5], tb[6], tb[7], tb[8], 28, 0, F.G, F.bid, PROBE_MOE};
                pg8::Gemm g{(const bf16_t*)(F.ws + WS_H2G), DM, (const bf16_t*)(F.ws + WS_W13E), DM};
                EpiSwiglu E{(bf16_t*)(F.ws + WS_HID), FFE, 0, 28}; pg8::gemm_phase(lds, F.tid, g, S, E);
            }
            SEAM(pb + 15);
            if (IN(pb + 17)) { const Frame F = launder(F0);
                MoeOrder S{tb[0], tb[1], tb[2], tb[3], tb[4], tb[5], tb[6], tb[7], tb[8], 4, W2E_HI_TILE_SHIFT, F.G, F.bid, PROBE_MOE};
                pg8::Gemm g{(const bf16_t*)(F.ws + WS_HID), FFE, (const bf16_t*)(F.ws + WS_W2E_LO), FFE};
                EpiMoe2 E{(bf16_t*)(F.ws + WS_H2G), (const float*)(F.ws + WS_RT_ROWGATE)}; pg8::gemm_phase(lds, F.tid, g, S, E);
            }
            SEAM(pb + 17);
            if (IN(pb + 19)) { const Frame F = launder(F0); moe_combine(F, out, modL + 5120); }
        }
    }
#undef IN
#undef SEAM
}

#ifndef MK_PER_PHASE
#define MK_PER_PHASE 0
#endif
extern "C" void kernel_launch(void* const* d_in, const int* in_sizes, int n_in, void* d_out, int out_size, void* d_ws, size_t ws_size, hipStream_t stream) {
    static int grid = 0;
    if (grid == 0) {
        if (n_in != 40 || out_size != L * DM || ws_size < 560 * MiB) { fprintf(stderr, "kernel_launch: unexpected shapes (n_in %d out %d ws %zu)\n", n_in, out_size, ws_size); grid = -1; return; }
        int dev = 0, cus = 0, per_cu = 0;
        if (hipGetDevice(&dev) != hipSuccess || hipDeviceGetAttribute(&cus, hipDeviceAttributeMultiprocessorCount, dev) != hipSuccess) { grid = -1; return; }
        if (hipFuncSetAttribute((const void*)mega_fwd, hipFuncAttributeMaxDynamicSharedMemorySize, LDS_BYTES) != hipSuccess) { fprintf(stderr, "kernel_launch: hipFuncSetAttribute failed\n"); grid = -1; return; }
        if (hipOccupancyMaxActiveBlocksPerMultiprocessor(&per_cu, (const void*)mega_fwd, NTHR, LDS_BYTES) != hipSuccess || per_cu < 1) fprintf(stderr, "kernel_launch: occupancy query says %d\n", per_cu);
        (void)hipGetLastError();
        grid = cus;
    }
    if (grid < 0) return;
    (void)hipMemsetAsync((char*)d_ws + WS_CTL, 0, CTL_ZERO_BYTES, stream);
    Args a{};
    for (int i = 0; i < 40; ++i) a.in[i] = (const float*)d_in[i];
    a.out = (float*)d_out; a.ws = (unsigned char*)d_ws;
#if MK_PER_PHASE
    for (int p = 0; p < N_PHASES; ++p) { a.ph_lo = p; a.ph_hi = p + 1; hipLaunchKernelGGL(mega_fwd, dim3(grid), dim3(NTHR), LDS_BYTES, stream, a); }
#else
    a.ph_lo = 0; a.ph_hi = N_PHASES;
    hipLaunchKernelGGL(mega_fwd, dim3(grid), dim3(NTHR), LDS_BYTES, stream, a);
#endif
    const hipError_t le = hipPeekAtLastError();
    if (le != hipSuccess) fprintf(stderr, "kernel_launch: launch failed: %s\n", hipGetErrorName(le));
}
```

```cpp
#include <hip/hip_runtime.h>
#include <cstdio>
#include <cstdint>

#define LAS __attribute__((address_space(3)))
#define GAS __attribute__((address_space(1)))
typedef unsigned short bf16_t;
typedef short bf16x8 __attribute__((ext_vector_type(8)));
typedef short s16x4 __attribute__((ext_vector_type(4)));
typedef float f32x4 __attribute__((ext_vector_type(4)));
typedef float f32x2 __attribute__((ext_vector_type(2)));
typedef float f32x16 __attribute__((ext_vector_type(16)));
typedef unsigned u32x4 __attribute__((ext_vector_type(4)));
typedef unsigned u32x2 __attribute__((ext_vector_type(2)));
typedef __bf16 bf16x2_t __attribute__((ext_vector_type(2)));

constexpr int L = 16384, CT = 256, R = L + CT, DM = 1024, GW = 64;
constexpr int NWAVES = 8, NTHR = 512;
constexpr int ZA_LD = 768, ZN_LD = 1536, ZR_LD = 2048, ZM_N = 4352, ZG_LD = 3072;
constexpr int LO_LD = 2560, RKV_LD = 1536;
constexpr int FF = 2816, FFE = 3584, NEXP = 8;
constexpr int MOE_ROWS = 2 * L + NEXP * 256;
constexpr float NORM_EPS = 1e-6f;
constexpr float LOG2E = 1.4426950408889634f;
constexpr int TCH = 128, NCH = 129;

constexpr size_t MiB = 1u << 20;
constexpr size_t WS_CTL = 0, CTL_ZERO_BYTES = 1 * MiB;
constexpr size_t WS_W = 1 * MiB;
constexpr size_t WB_WINM = 0;
constexpr size_t WB_WING = WB_WINM + (size_t)ZM_N * DM * 2;
constexpr size_t WB_WUQ = WB_WING + (size_t)ZG_LD * DM * 2;
constexpr size_t WB_WUKV = WB_WUQ + (size_t)768 * 384 * 2;
constexpr size_t WB_WLORA = WB_WUKV + (size_t)1024 * 256 * 2;
constexpr size_t WB_WOA = WB_WLORA + (size_t)2560 * 384 * 2;
constexpr size_t WB_WOB = WB_WOA + (size_t)1024 * 512 * 2;
constexpr size_t WB_WOR = WB_WOB + (size_t)1024 * 512 * 2;
constexpr size_t WB_WOUT = WB_WOR + (size_t)1024 * 512 * 2;
constexpr size_t WB_SIZE = WB_WOUT + (size_t)1024 * 1024 * 2;
constexpr size_t WS_W13 = WS_W + 2 * WB_SIZE;
constexpr size_t WS_W2 = WS_W13 + (size_t)2 * FF * DM * 2;
constexpr size_t WS_W_END = WS_W2 + (size_t)DM * FF * 2;
static_assert(WS_W_END <= 67 * MiB, "weights region");
constexpr size_t WS_X1 = 67 * MiB;
constexpr size_t WS_CM = 132 * MiB;
constexpr size_t WS_H = 135 * MiB;
constexpr size_t WS_MISC = 168 * MiB;
constexpr size_t WS_MODV = WS_MISC;
constexpr size_t WS_RT_IDX = WS_MISC + 128 * 1024;
constexpr size_t WS_RT_POS = WS_RT_IDX + 128 * 1024;
constexpr size_t WS_RT_GATE = WS_RT_POS + 128 * 1024;
constexpr size_t WS_RT_ROWGATE = WS_RT_GATE + 128 * 1024;
constexpr size_t WS_KN = WS_MISC + 1 * MiB;
constexpr size_t WS_BIG = 170 * MiB;
constexpr size_t WS_ZN = WS_BIG;
constexpr size_t WS_Q = 219 * MiB, WS_K = 244 * MiB, WS_V = 269 * MiB;
constexpr size_t WS_RKV = 286 * MiB;
constexpr size_t WS_LO = 335 * MiB;
constexpr size_t WS_CQN = 417 * MiB, WS_CKVN = 430 * MiB, WS_LA = 439 * MiB, WS_KR = 452 * MiB;
constexpr size_t WS_YA = 417 * MiB, WS_YB = 434 * MiB;
constexpr size_t WS_ZA = 453 * MiB, WS_ZR = 478 * MiB;
constexpr size_t WS_QRAW = 453 * MiB, WS_KVRAW = 478 * MiB;
constexpr size_t WS_PST = 453 * MiB, WS_QST = 486 * MiB, WS_YF = 519 * MiB, WS_YBK = 536 * MiB, WS_YR = 269 * MiB;
constexpr size_t WS_ZG = WS_BIG;
constexpr size_t WS_U32 = 335 * MiB;
constexpr size_t WS_U = 286 * MiB;
constexpr size_t WS_G = WS_BIG;
constexpr size_t WS_H2G = 67 * MiB;
constexpr size_t WS_W13E = 170 * MiB;
constexpr size_t WS_W2E_LO = 135 * MiB;
constexpr size_t WS_W2E_HI = 282 * MiB;
constexpr int W2E_HI_TILE_SHIFT = (int)((WS_W2E_HI - WS_W2E_LO) / ((size_t)256 * FFE * 2)) - 16;
static_assert((WS_W2E_HI - WS_W2E_LO) % ((size_t)256 * FFE * 2) == 0 && (W2E_HI_TILE_SHIFT % 4) == 0, "W2E split");
constexpr size_t WS_HID = 310 * MiB;
constexpr size_t WS_END = 553 * MiB;
static_assert((size_t)16 * NCH * 4096 * 4 <= 33 * MiB, "state slots");
static_assert(WS_ZR + (size_t)R * ZR_LD * 2 <= WS_END, "ws map");
static_assert(WS_HID + (size_t)MOE_ROWS * FFE * 2 <= 549 * MiB, "hid");
constexpr int CW_BAR = 4096;
constexpr int CW_MOECNT = 1024;

#ifndef PROBE_CVT
#define PROBE_CVT 1
#endif
#ifndef PROBE_ROW
#define PROBE_ROW 1
#endif
__device__ __forceinline__ float bf2f(unsigned b) { return __uint_as_float(b << 16); }
__device__ __forceinline__ unsigned cvtpk(float lo, float hi) { f32x2 v = {lo, hi}; bf16x2_t b = __builtin_convertvector(v, bf16x2_t); return __builtin_bit_cast(unsigned, b); }
__device__ __forceinline__ float lo_bf(unsigned w) { return __uint_as_float(w << 16); }
__device__ __forceinline__ float hi_bf(unsigned w) { return __uint_as_float(w & 0xffff0000u); }
__device__ __forceinline__ float wave_sum(float v) {
#pragma unroll
    for (int o = 1; o < 64; o <<= 1) v += __shfl_xor(v, o);
    return v;
}
__device__ __forceinline__ float sigmoidf_(float x) { return 1.f / (1.f + __expf(-x)); }
__device__ __forceinline__ float siluf_(float x) { return x / (1.f + __expf(-x)); }
#define LDS_WAIT() asm volatile("s_waitcnt lgkmcnt(0)" ::: "memory")
#define VM_WAIT() asm volatile("s_waitcnt vmcnt(0)" ::: "memory")

namespace pg8 {
constexpr int BM = 256, BK = 64, HALF = 128, HTB = HALF * BK * 2, STAGE_BYTES = 8 * HTB, NXCD = 8, WGM = 8;
__device__ __forceinline__ int lds_byte(int r, int c) { const int st = (r >> 4) * 2 + (c >> 5), rr = r & 15, cc = c & 31, ob = rr * 64 + cc * 2; return st * 1024 + (ob ^ (((ob >> 9) & 1) << 5)); }
__device__ __forceinline__ void stage_rc(int b, int& R_, int& C_) { const int st = b / 1024, sb = b % 1024, swz = sb ^ (((sb >> 9) & 1) << 5); R_ = (st >> 1) * 16 + swz / 64; C_ = (st & 1) * 32 + (swz % 64) / 2; }
__device__ __forceinline__ int perm32(int rho) { const int n = rho >> 4, i = rho & 15; return 8 * (i >> 2) + 4 * n + (i & 3); }

struct Unit { int pm, pn; };
struct Gemm { const bf16_t* A; int lda; const bf16_t* Bt; int K; };

struct StaticOrder {
    int nM, nN, nwg, G, c, rep;
    __device__ void init(int nM_, int nN_, int G_, int c_, int rep_ = 1) { nM = nM_; nN = nN_; nwg = nM * nN; G = G_; c = c_; rep = rep_; }
    __device__ bool next(int i, Unit& u) const {
        const long Lx = (long)i * G + c; if (Lx >= (long)nwg * rep) return false;
        int wgid = (int)(Lx % nwg); { const int q = nwg / NXCD, r = nwg % NXCD, xcd = wgid % NXCD, off = wgid / NXCD; wgid = (xcd < r ? xcd * (q + 1) : r * (q + 1) + (xcd - r) * q) + off; }
        const int nig = WGM * nN, gid = wgid / nig, fm = gid * WGM, gsz = (nM - fm) < WGM ? (nM - fm) : WGM;
        u.pm = fm + ((wgid % nig) % gsz); u.pn = (wgid % nig) / gsz; return true;
    }
};

template <class Epi, class Sched>
__device__ __forceinline__ void gemm_phase(LAS unsigned char* lds, const int tid, const Gemm g, const Sched& S, const Epi& E) {
    const int wid = __builtin_amdgcn_readfirstlane(tid >> 6), lane = tid & 63, wr = wid >> 2, wc = wid & 3, fr = lane & 15, fq = lane >> 4;
    const int K = g.K, nt = K / BK;
    unsigned voffA[2], voffB[2];
#pragma unroll
    for (int i = 0; i < 2; ++i) { int R_, C_; stage_rc(tid * 16 + i * 8192, R_, C_); const int Rb = (R_ & ~31) + perm32(R_ & 31);
        voffA[i] = (unsigned)(R_ * g.lda + C_) * 2u; voffB[i] = (unsigned)(Rb * K + C_) * 2u; }
    const size_t kstep = (size_t)(BK * 2);
    const size_t hstepA = (size_t)HALF * g.lda * 2, hstepB = (size_t)HALF * K * 2;
    const size_t tstepA = 2 * hstepA, tstepB = 2 * hstepB;
    const unsigned ldsw = (unsigned)wid * 1024u;
    const int aoff = lds_byte(wr * 64 + fr, fq * 8), boff = lds_byte(wc * 32 + fr, fq * 8);
#define PG8_SA(b, h) (((b) * 2 + (h)) * HTB)
#define PG8_SB(b, h) ((4 + (b) * 2 + (h)) * HTB)
#define PG8_STAGE(bufoff, gbase, voff) do { _Pragma("unroll") for (int _i = 0; _i < 2; ++_i) \
        __builtin_amdgcn_global_load_lds((const unsigned*)((const char*)(gbase) + (voff)[_i]), (LAS unsigned*)(lds + (bufoff) + ldsw + _i * 8192), 16, 0, 0); } while (0)
#define PG8_LDA(dst, b, h) do { _Pragma("unroll") for (int m = 0; m < 4; ++m) _Pragma("unroll") for (int k = 0; k < 2; ++k) dst[m][k] = *(const LAS bf16x8*)(lds + PG8_SA(b, h) + aoff + m * 2048 + k * 1024); } while (0)
#define PG8_LDB(dst, b, h) do { _Pragma("unroll") for (int n = 0; n < 2; ++n) _Pragma("unroll") for (int k = 0; k < 2; ++k) dst[n][k] = *(const LAS bf16x8*)(lds + PG8_SB(b, h) + boff + n * 2048 + k * 1024); } while (0)
#define PG8_MMA(ai, bj, At, Bt) do { __builtin_amdgcn_s_setprio(1); _Pragma("unroll") for (int m = 0; m < 4; ++m) _Pragma("unroll") for (int n = 0; n < 2; ++n) _Pragma("unroll") for (int k = 0; k < 2; ++k) \
        acc[ai][bj][m][n] = __builtin_amdgcn_mfma_f32_16x16x32_bf16(Bt[n][k], At[m][k], acc[ai][bj][m][n], 0, 0, 0); __builtin_amdgcn_s_setprio(0); } while (0)
#define PG8_WAIT_V(n) asm volatile("s_waitcnt vmcnt(" #n ")" ::: "memory")
#define PG8_WAIT_L(n) asm volatile("s_waitcnt lgkmcnt(" #n ")" ::: "memory")
#define PG8_BAR __builtin_amdgcn_s_barrier()
#define PG8_SCHED __builtin_amdgcn_sched_barrier(0)
    Unit cur, nxt; int ui = 0;
    if (!S.next(0, cur)) return;
    f32x4 acc[2][2][4][2];
#pragma unroll
    for (int a = 0; a < 2; ++a)
#pragma unroll
        for (int b = 0; b < 2; ++b)
#pragma unroll
            for (int m = 0; m < 4; ++m)
#pragma unroll
                for (int n = 0; n < 2; ++n) acc[a][b][m][n] = (f32x4){0.f, 0.f, 0.f, 0.f};
    bf16x8 At[4][2], B0[2][2], B1[2][2];
    const char* cA = (const char*)g.A + (size_t)cur.pm * tstepA; const char* cB = (const char*)g.Bt + (size_t)cur.pn * tstepB;
    PG8_STAGE(PG8_SB(0, 0), cB, voffB); PG8_STAGE(PG8_SB(0, 1), cB + hstepB, voffB); PG8_STAGE(PG8_SA(0, 0), cA, voffA); PG8_STAGE(PG8_SA(0, 1), cA + hstepA, voffA);
    if (wr == 1) PG8_BAR;
    PG8_WAIT_V(2); PG8_BAR;
    PG8_STAGE(PG8_SB(1, 0), cB + kstep, voffB); PG8_STAGE(PG8_SA(1, 0), cA + kstep, voffA); PG8_STAGE(PG8_SB(1, 1), cB + hstepB + kstep, voffB);
    PG8_WAIT_V(6); PG8_BAR;
    for (;;) {
        const bool has_next = S.next(ui + 1, nxt);
        const char* nA = has_next ? (const char*)g.A + (size_t)nxt.pm * tstepA : cA; const char* nB = has_next ? (const char*)g.Bt + (size_t)nxt.pn * tstepB : cB;
        for (int t = 0; t < nt; t += 2) {
            const bool last = (t == nt - 2);
            const char* a1 = cA + (size_t)(t + 1) * kstep;
            const char* a2 = last ? nA : cA + (size_t)(t + 2) * kstep; const char* b2 = last ? nB : cB + (size_t)(t + 2) * kstep;
            const char* a3 = a2 + kstep; const char* b3 = b2 + kstep;
            PG8_LDB(B0, 0, 0); PG8_LDB(B1, 0, 1); PG8_SCHED; PG8_LDA(At, 0, 0); PG8_STAGE(PG8_SA(1, 1), a1 + hstepA, voffA);
            PG8_WAIT_V(8); PG8_WAIT_L(0); PG8_BAR; PG8_MMA(0, 0, At, B0); PG8_MMA(0, 1, At, B1); PG8_BAR; PG8_SCHED;
            PG8_LDA(At, 0, 1); PG8_STAGE(PG8_SB(0, 0), b2, voffB); PG8_STAGE(PG8_SB(0, 1), b2 + hstepB, voffB); PG8_STAGE(PG8_SA(0, 0), a2, voffA);
            PG8_WAIT_V(8); PG8_WAIT_L(0); PG8_BAR; PG8_MMA(1, 0, At, B0); PG8_MMA(1, 1, At, B1); PG8_BAR; PG8_SCHED;
            PG8_LDB(B0, 1, 0); PG8_LDB(B1, 1, 1); PG8_SCHED; PG8_LDA(At, 1, 0); PG8_STAGE(PG8_SA(0, 1), a2 + hstepA, voffA);
            PG8_WAIT_V(8); PG8_WAIT_L(0); PG8_BAR; PG8_MMA(0, 0, At, B0); PG8_MMA(0, 1, At, B1); PG8_BAR; PG8_SCHED;
            PG8_LDA(At, 1, 1); PG8_STAGE(PG8_SB(1, 0), b3, voffB); PG8_STAGE(PG8_SB(1, 1), b3 + hstepB, voffB); PG8_STAGE(PG8_SA(1, 0), a3, voffA);
            PG8_WAIT_V(8); PG8_WAIT_L(0); PG8_BAR; PG8_MMA(1, 0, At, B0); PG8_MMA(1, 1, At, B1); PG8_BAR; PG8_SCHED;
        }
        if (wr == 0) PG8_BAR;
        E(acc, cur, wr, wc, fr, fq);
        if (!has_next) break;
#pragma unroll
        for (int a = 0; a < 2; ++a)
#pragma unroll
            for (int b = 0; b < 2; ++b)
#pragma unroll
                for (int m = 0; m < 4; ++m)
#pragma unroll
                    for (int n = 0; n < 2; ++n) acc[a][b][m][n] = (f32x4){0.f, 0.f, 0.f, 0.f};
        cur = nxt; cA = nA; cB = nB; ++ui;
        if (wr == 1) PG8_BAR;
    }
    PG8_WAIT_V(0);
    PG8_BAR;
#undef PG8_SA
#undef PG8_SB
#undef PG8_STAGE
#undef PG8_LDA
#undef PG8_LDB
#undef PG8_MMA
#undef PG8_WAIT_V
#undef PG8_WAIT_L
#undef PG8_BAR
#undef PG8_SCHED
}

template <class F> __device__ __forceinline__ void epi_each(const f32x4 (&acc)[2][2][4][2], const Unit& u, int wr, int wc, int fr, int fq, F&& f) {
    const int row0 = u.pm * BM + wr * 64 + fr, col0 = u.pn * BM + wc * 32 + 8 * fq;
#pragma unroll
    for (int ai = 0; ai < 2; ++ai)
#pragma unroll
        for (int m = 0; m < 4; ++m)
#pragma unroll
            for (int bj = 0; bj < 2; ++bj) f(row0 + ai * HALF + m * 16, col0 + bj * HALF, acc[ai][bj][m][0], acc[ai][bj][m][1]);
}
__device__ __forceinline__ void st_bf16x8(bf16_t* p, f32x4 v0, f32x4 v1) {
    u32x4 w; w.x = cvtpk(v0[0], v0[1]); w.y = cvtpk(v0[2], v0[3]); w.z = cvtpk(v1[0], v1[1]); w.w = cvtpk(v1[2], v1[3]); *(u32x4*)p = w;
}
}
#include <hip/hip_runtime.h>
#include <cstdio>
#include <cstdint>
#include <cstdlib>
#include <vector>

#define XB_TMO      128
#define XB_XCNT(j)  (256  + 64 * (j))
#define XB_XSUB(j)  (1280 + 64 * (j))
#define XB_XGEN(j)  (2304 + 64 * (j))
#define XB_TOP      3328
#define XB_TOPGEN   3392
#define XCD_BAR_WORDS 3456
#define XB_SPIN_CAP (1u << 18)

__device__ __forceinline__ unsigned xb_ld(unsigned* p)              { return __hip_atomic_load(p, __ATOMIC_RELAXED, __HIP_MEMORY_SCOPE_AGENT); }
__device__ __forceinline__ unsigned xb_add(unsigned* p, unsigned v) { return __hip_atomic_fetch_add(p, v, __ATOMIC_RELAXED, __HIP_MEMORY_SCOPE_AGENT); }
__device__ __forceinline__ unsigned xb_xcc_id() { return (unsigned)__builtin_amdgcn_s_getreg((3 << 11) | 20) & 0xFu; }
#define XB_SPIN(cond, bar) do { unsigned _sp = 0; while (cond) { __builtin_amdgcn_s_sleep(1); \
    if ((++_sp & 255u) == 0u) { if (xb_ld(&(bar)[XB_TMO])) break; if (_sp > XB_SPIN_CAP) { atomicAdd(&(bar)[XB_TMO], 1u); break; } } } } while (0)

struct XcdBarrier {
    unsigned* bar; unsigned x;
    volatile LAS unsigned* st;
};

__device__ __forceinline__ XcdBarrier xcd_barrier_post(unsigned* bar, volatile LAS unsigned* st) {
    XcdBarrier b; b.bar = bar; b.x = xb_xcc_id(); b.st = st;
    if (threadIdx.x == 0) (void)xb_add(&bar[XB_XCNT(b.x)], 1u);
    return b;
}
__device__ __forceinline__ void xcd_barrier_complete(unsigned* bar, unsigned x, unsigned& nloc, unsigned& nx) {
    const unsigned G = gridDim.x * gridDim.y * gridDim.z;
    unsigned sum, cnt, mine, sp = 0u;
    for (;;) {
        sum = 0u; cnt = 0u; mine = 0u;
#pragma unroll
        for (unsigned j = 0; j < 16; ++j) { const unsigned c = xb_ld(&bar[XB_XCNT(j)]); sum += c; cnt += (c > 0u) ? 1u : 0u; mine = (j == x) ? c : mine; }
        if (sum == G) break;
        __builtin_amdgcn_s_sleep(1);
        if ((++sp & 255u) == 0u) { if (xb_ld(&bar[XB_TMO])) break; if (sp > XB_SPIN_CAP) { atomicAdd(&bar[XB_TMO], 1u); break; } }
    }
    nloc = mine > 0u ? mine : 1u; nx = cnt > 0u ? cnt : 1u;
}

__device__ __forceinline__ void xcd_barrier(const XcdBarrier& b) {
    asm volatile("s_waitcnt vmcnt(0)" ::: "memory");
    __syncthreads();
    if (threadIdx.x == 0) {
        unsigned* bar = b.bar;
        __builtin_amdgcn_s_waitcnt(0);
        unsigned nloc = b.st[0], nx = b.st[1];
        if (nloc == 0u) { xcd_barrier_complete(bar, b.x, nloc, nx); b.st[0] = nloc; b.st[1] = nx; }
        const unsigned old = xb_add(&bar[XB_XSUB(b.x)], 1u);
        const unsigned gen = old / nloc;
        if (old + 1u == (gen + 1u) * nloc) {
            __builtin_amdgcn_fence(__ATOMIC_RELEASE, "agent");
            asm volatile("s_waitcnt vmcnt(0)" ::: "memory");
            const unsigned og = xb_add(&bar[XB_TOP], 1u);
            const unsigned tg = og / nx;
            if (og + 1u == (tg + 1u) * nx) xb_add(&bar[XB_TOPGEN], 1u);
            else XB_SPIN(xb_ld(&bar[XB_TOPGEN]) == tg, bar);
            __builtin_amdgcn_fence(__ATOMIC_ACQUIRE, "agent");
            xb_add(&bar[XB_XGEN(b.x)], 1u);
            asm volatile("s_waitcnt vmcnt(0)" ::: "memory");
        } else {
            XB_SPIN(xb_ld(&bar[XB_XGEN(b.x)]) == gen, bar);
            __builtin_amdgcn_fence(__ATOMIC_ACQUIRE, "agent");
            asm volatile("s_waitcnt vmcnt(0)" ::: "memory");
        }
    }
    __syncthreads();
}


constexpr int LDS_BYTES = 147456;
constexpr int LDS_MISC_OFF = 146432;
struct Args { const float* in[40]; float* out; unsigned char* ws; int ph_lo, ph_hi; };
enum { I_X = 0, I_C, I_CTX, I_CCTX, I_MODW, I_MODB, I_N1G, I_N2G, I_WIN, I_CQG, I_WUQ, I_CKVG, I_WUKV, I_QNG, I_KNG, I_MLAWO,
       I_NAQG, I_NAKG, I_RPB, I_NAWO, I_MU, I_W0, I_W2, I_A0, I_A2, I_G2, I_KK, I_KA, I_RK, I_LNG, I_LNB, I_RWWO, I_WOUT,
       I_F1, I_F3, I_F2, I_ROUTER, I_M1, I_M3, I_M2 };

struct Frame {
    LAS unsigned char* lds;
    unsigned char* ws;
    int tid, lane, wave, G, vcu, bid;
};

__device__ __forceinline__ Frame launder(const Frame& F) {
    Frame P = F; int w = F.wave, v = F.vcu, b = F.bid; unsigned long long wi = (unsigned long long)F.ws;
    asm volatile("" : "+s"(w), "+s"(v), "+s"(b), "+s"(wi));
    int ln = (int)__builtin_amdgcn_mbcnt_hi(~0u, __builtin_amdgcn_mbcnt_lo(~0u, 0u));
    asm volatile("" : "+v"(ln));
    P.tid = w * 64 + ln; P.lane = ln; P.wave = w; P.vcu = v; P.bid = b;
    P.ws = (unsigned char*)(GAS unsigned char*)wi;
    return P;
}
__device__ __forceinline__ void tr_item(const float* src, int lds_, int scol0, bf16_t* dst, int ldd, int drow0, int koff, int nblk, int ileave, int item, LAS float* scr, int lane) {
    const int kb = item / nblk, nb = item - kb * nblk, k0 = 64 * kb, n0 = 32 * nb;
#pragma unroll 8
    for (int i = 0; i < 32; ++i) { const int kk = 2 * i + (lane >> 5); scr[kk * 33 + (lane & 31)] = src[(size_t)(k0 + kk) * lds_ + scol0 + n0 + (lane & 31)]; }
    LDS_WAIT(); asm volatile("" ::: "memory");
    const int c = lane & 7;
#pragma unroll
    for (int j = 0; j < 4; ++j) { const int n = (lane >> 3) + 8 * j; const LAS float* s = scr + (8 * c) * 33 + n;
        u32x4 o; o.x = cvtpk(s[0 * 33], s[1 * 33]); o.y = cvtpk(s[2 * 33], s[3 * 33]); o.z = cvtpk(s[4 * 33], s[5 * 33]); o.w = cvtpk(s[6 * 33], s[7 * 33]);
        const int nn = n0 + n; const int drow = ileave ? drow0 + (nn >> 7) * 256 + (nn & 127) : drow0 + nn;
        *(u32x4*)(dst + (size_t)drow * ldd + koff + k0 + 8 * c) = o; }
    LDS_WAIT(); asm volatile("" ::: "memory");
}
__device__ __forceinline__ void zero_item(bf16_t* dst, int ldd, int drow0, int koff, int nblk, int item, int lane) {
    const int kb = item / nblk, nb = item - kb * nblk, k0 = 64 * kb, n0 = 32 * nb, c = lane & 7;
#pragma unroll
    for (int j = 0; j < 4; ++j) { const int n = (lane >> 3) + 8 * j; *(u32x4*)(dst + (size_t)(drow0 + n0 + n) * ldd + koff + k0 + 8 * c) = (u32x4){0u, 0u, 0u, 0u}; }
}

#define TRJOB(NITEMS, CALL) { const int _n = (NITEMS); if (r < _n) { CALL; continue; } r -= _n; }
__device__ __forceinline__ void prologue_weights(const Frame& F, const Args& a) {
    LAS float* scr = (LAS float*)(F.lds + F.wave * 16384);
    const int gw = F.vcu * NWAVES + F.wave, NGW = F.G * NWAVES;
    constexpr int PER_LAYER = 16 * 21 + 16 * 3   + 16 * 108   + 16 * 4   + 16 * 96
                              + 6 * 24   + 4 * 32   + 6 * 80   + 3 * 8 * 32   + 16 * 32  ;
    constexpr int FFN_ITEMS = 2 * 16 * 88 + 44 * 32;
    constexpr int NITEMS = 2 * PER_LAYER + FFN_ITEMS;
    for (int it0 = gw; it0 < NITEMS * PROBE_CVT; it0 += NGW) { const int it = it0 % NITEMS;
        int r = it;
        bool done = false;
        for (int l = 0; l < 2 && !done; ++l) {
            if (r >= PER_LAYER) { r -= PER_LAYER; continue; }
            done = true;
            unsigned char* wb = F.ws + WS_W + (size_t)l * WB_SIZE;
            bf16_t* WinM = (bf16_t*)(wb + WB_WINM); bf16_t* WinG = (bf16_t*)(wb + WB_WING);
            const float* win = a.in[I_WIN] + (size_t)l * DM * 7200;
            do {
                if (r < 16 * 21) { tr_item(win, 7200, 0, WinM, DM, 0, 0, 21, 0, r, scr, F.lane); break; } r -= 16 * 21;
                if (r < 16 * 3) { zero_item(WinM, DM, 672, 0, 3, r, F.lane); break; } r -= 16 * 3;
                if (r < 16 * 108) { tr_item(win, 7200, 672, WinM, DM, 768, 0, 108, 0, r, scr, F.lane); break; } r -= 16 * 108;
                if (r < 16 * 4) { zero_item(WinM, DM, 4224, 0, 4, r, F.lane); break; } r -= 16 * 4;
                if (r < 16 * 96) { tr_item(win, 7200, 4128, WinG, DM, 0, 0, 96, 0, r, scr, F.lane); break; } r -= 16 * 96;
                if (r < 6 * 24) { tr_item(a.in[I_WUQ] + (size_t)l * 384 * 768, 768, 0, (bf16_t*)(wb + WB_WUQ), 384, 0, 0, 24, 0, r, scr, F.lane); break; } r -= 6 * 24;
                if (r < 4 * 32) { tr_item(a.in[I_WUKV] + (size_t)l * 256 * 1024, 1024, 0, (bf16_t*)(wb + WB_WUKV), 256, 0, 0, 32, 0, r, scr, F.lane); break; } r -= 4 * 32;
                if (r < 6 * 80) {
                    bf16_t* Wl = (bf16_t*)(wb + WB_WLORA);
                    const int kb = r / 80, nb = r % 80, s = nb / 16;
                    const int koff = s < 4 ? 64 * s : 256, Ks = s < 4 ? 64 : 128;
                    const int k0 = 64 * kb;
                    if (k0 >= koff && k0 < koff + Ks) {
                        const float* src = s < 2 ? a.in[I_W2] + ((size_t)l * 2 + s) * 64 * 512 : s < 4 ? a.in[I_A2] + ((size_t)l * 2 + (s - 2)) * 64 * 512 : a.in[I_G2] + (size_t)l * 128 * 512;
                        const int sub = ((k0 - koff) / 64) * 16 + (nb % 16);
                        tr_item(src, 512, 0, Wl, 384, 512 * s, koff, 16, 0, sub, scr, F.lane);
                    } else zero_item(Wl, 384, 0, 0, 80, r, F.lane);
                    break; } r -= 6 * 80;
                if (r < 3 * 8 * 32) { const int b = r / 256, rr = r % 256;
                    const float* src = (b == 0 ? a.in[I_MLAWO] : b == 1 ? a.in[I_NAWO] : a.in[I_RWWO]) + (size_t)l * 512 * 1024;
                    tr_item(src, 1024, 0, (bf16_t*)(wb + (b == 0 ? WB_WOA : b == 1 ? WB_WOB : WB_WOR)), 512, 0, 0, 32, 0, rr, scr, F.lane); break; } r -= 3 * 8 * 32;
                tr_item(a.in[I_WOUT] + (size_t)l * 1024 * 1024, 1024, 0, (bf16_t*)(wb + WB_WOUT), 1024, 0, 0, 32, 0, r, scr, F.lane);
            } while (0);
        }
        if (done) continue;
        if (r < 16 * 88) { tr_item(a.in[I_F1], FF, 0, (bf16_t*)(F.ws + WS_W13), DM, 0, 0, 88, 1, r, scr, F.lane); continue; } r -= 16 * 88;
        if (r < 16 * 88) { tr_item(a.in[I_F3], FF, 0, (bf16_t*)(F.ws + WS_W13), DM, 128, 0, 88, 1, r, scr, F.lane); continue; } r -= 16 * 88;
        tr_item(a.in[I_F2], DM, 0, (bf16_t*)(F.ws + WS_W2), FF, 0, 0, 32, 0, r, scr, F.lane);
    }
}
__device__ __forceinline__ void moe_weights(const Frame& F, const Args& a, int part) {
    LAS float* scr = (LAS float*)(F.lds + F.wave * 16384);
    const int gw = F.vcu * NWAVES + F.wave, NGW = F.G * NWAVES;
    constexpr int I13 = 16 * 112, I2 = 56 * 32;
    if (part == 0) {
        constexpr int NIT = NEXP * 2 * I13 + 4 * I2;
        for (int it0 = gw; it0 < NIT * PROBE_CVT; it0 += NGW) { const int it = it0 % NIT;
            if (it < NEXP * 2 * I13) { const int e = it / (2 * I13); int r = it - e * 2 * I13;
                bf16_t* w13 = (bf16_t*)(F.ws + WS_W13E) + (size_t)e * 2 * FFE * DM;
                if (r < I13) tr_item(a.in[I_M1] + (size_t)e * DM * FFE, FFE, 0, w13, DM, 0, 0, 112, 1, r, scr, F.lane);
                else tr_item(a.in[I_M3] + (size_t)e * DM * FFE, FFE, 0, w13, DM, 128, 0, 112, 1, r - I13, scr, F.lane);
            } else { const int q = it - NEXP * 2 * I13, e = 4 + q / I2, r = q % I2;
                tr_item(a.in[I_M2] + (size_t)e * FFE * DM, DM, 0, (bf16_t*)(F.ws + WS_W2E_HI) + (size_t)(e - 4) * DM * FFE, FFE, 0, 0, 32, 0, r, scr, F.lane); }
        }
    } else {
        for (int it = gw; it < 4 * I2; it += NGW) { const int e = it / I2, r = it % I2;
            tr_item(a.in[I_M2] + (size_t)e * FFE * DM, DM, 0, (bf16_t*)(F.ws + WS_W2E_LO) + (size_t)e * DM * FFE, FFE, 0, 0, 32, 0, r, scr, F.lane); }
    }
}

__device__ __forceinline__ void prologue_mod(const Frame& F, const Args& a) {
    LAS float* sl = (LAS float*)(F.lds);
    LAS float* part = sl + 2048;
    if (F.bid >= 192) return;
    const int l = F.bid / 96, nb = F.bid % 96;
    for (int i = F.tid; i < 2048; i += NTHR) { const float v = i < 1024 ? a.in[I_C][i] : a.in[I_CCTX][i - 1024]; sl[i] = siluf_(v); }
    __syncthreads();
    const int col = F.tid & 63, kg = F.tid >> 6, n = nb * 64 + col;
    const float* W = a.in[I_MODW] + (size_t)l * DM * 6144 + n;
    float aL = 0.f, aC = 0.f;
#pragma unroll 8
    for (int k = kg * 128; k < kg * 128 + 128; ++k) { const float w = W[(size_t)k * 6144]; aL += sl[k] * w; aC += sl[1024 + k] * w; }
    part[(kg * 64 + col) * 2] = aL; part[(kg * 64 + col) * 2 + 1] = aC;
    __syncthreads();
    if (F.tid < 128) { const int c2 = F.tid & 63, which = F.tid >> 6; float s = 0.f;
#pragma unroll
        for (int k = 0; k < 8; ++k) s += part[(k * 64 + c2) * 2 + which];
        const int nn = nb * 64 + c2;
        ((float*)(F.ws + WS_MODV))[(size_t)(l * 2 + which) * 6144 + nn] = s + a.in[I_MODB][(size_t)l * 6144 + nn]; }
    __syncthreads();
}

__device__ __forceinline__ void norm_rows(const Frame& F, const float* src, int src_row0, int m0, int m1, const float* g, const float* sh, const float* sc, bf16_t* dst) {
    f32x4 ca[4], cb[4];
#pragma unroll
    for (int j = 0; j < 4; ++j) { const int d = F.lane * 4 + 256 * j; const f32x4 gg = *(const f32x4*)(g + d), s1 = *(const f32x4*)(sc + d); ca[j] = gg * (s1 + 1.0f); cb[j] = *(const f32x4*)(sh + d); }
    const int gw = F.vcu * NWAVES + F.wave, NGW = F.G * NWAVES;
    for (int mm = gw; mm < (m1 - m0) * PROBE_ROW; mm += NGW) { const int m = m0 + mm % (m1 - m0);
        const f32x4* xr = (const f32x4*)(src + (size_t)(m - src_row0) * DM) + F.lane;
        f32x4 v[4]; float s = 0.f;
#pragma unroll
        for (int j = 0; j < 4; ++j) { v[j] = xr[64 * j]; s += (v[j].x * v[j].x + v[j].y * v[j].y) + (v[j].z * v[j].z + v[j].w * v[j].w); }
        const float rstd = rsqrtf(wave_sum(s) * (1.f / DM) + NORM_EPS);
        u32x2* o8 = (u32x2*)(dst + (size_t)m * DM) + F.lane;
#pragma unroll
        for (int j = 0; j < 4; ++j) { const f32x4 y = v[j] * rstd * ca[j] + cb[j]; u32x2 w; w.x = cvtpk(y.x, y.y); w.y = cvtpk(y.z, y.w); o8[64 * j] = w; }
    }
}

using pg8::Unit;
struct EpiZ {
    bf16_t *za, *zn, *zr;
    __device__ __forceinline__ void operator()(const f32x4 (&acc)[2][2][4][2], const Unit& u, int wr, int wc, int fr, int fq) const {
        bf16_t* base; int ld, ct;
        if (u.pn < 3) { base = za; ld = ZA_LD; ct = u.pn; } else if (u.pn < 9) { base = zn; ld = ZN_LD; ct = u.pn - 3; } else { base = zr; ld = ZR_LD; ct = u.pn - 9; }
        const int cshift = (ct - u.pn) * 256;
        pg8::epi_each(acc, u, wr, wc, fr, fq, [&](int row, int col, f32x4 v0, f32x4 v1) { pg8::st_bf16x8(base + (size_t)row * ld + col + cshift, v0, v1); });
    }
};
struct EpiBf {
    bf16_t* o; int ld;
    __device__ __forceinline__ void operator()(const f32x4 (&acc)[2][2][4][2], const Unit& u, int wr, int wc, int fr, int fq) const {
        pg8::epi_each(acc, u, wr, wc, fr, fq, [&](int row, int col, f32x4 v0, f32x4 v1) { pg8::st_bf16x8(o + (size_t)row * ld + col, v0, v1); });
    }
};
__device__ __forceinline__ f32x4 lora_fn(f32x4 v, const float* bias, int seg) {
    if (seg < 4) { const f32x4 b = *(const f32x4*)bias;
#pragma unroll
        for (int e = 0; e < 4; ++e) { const float x = b[e] + v[e];
            if (seg < 2) { const float y = -x; const float sp = fmaxf(y, 0.f) + __logf(1.f + __expf(-fabsf(y))); v[e] = -__expf(-sp - 0.5f); }
            else v[e] = sigmoidf_(x); } }
    return v;
}
struct EpiLora {
    bf16_t* o; const float* w0; const float* a0;
    __device__ __forceinline__ void operator()(const f32x4 (&acc)[2][2][4][2], const Unit& u, int wr, int wc, int fr, int fq) const {
        const int seg = u.pn >> 1;
        const float* bias = seg < 2 ? w0 : a0 - 1024;
        pg8::epi_each(acc, u, wr, wc, fr, fq, [&](int row, int col, f32x4 v0, f32x4 v1) {
            const f32x4 r0 = lora_fn(v0, bias + col, seg), r1 = lora_fn(v1, bias + col + 4, seg);
            pg8::st_bf16x8(o + (size_t)row * LO_LD + col, r0, r1);
        });
    }
};
template <int MODE> struct EpiMerge {
    float* u32; bf16_t* ub; const bf16_t* zg; int goff;
    __device__ __forceinline__ void operator()(const f32x4 (&acc)[2][2][4][2], const Unit& u, int wr, int wc, int fr, int fq) const {
        pg8::epi_each(acc, u, wr, wc, fr, fq, [&](int row, int col, f32x4 v0, f32x4 v1) {
            const u32x4 gw = *(const u32x4*)(zg + (size_t)row * ZG_LD + goff + col);
            f32x4 g0 = {sigmoidf_(lo_bf(gw.x)), sigmoidf_(hi_bf(gw.x)), sigmoidf_(lo_bf(gw.y)), sigmoidf_(hi_bf(gw.y))};
            f32x4 g1 = {sigmoidf_(lo_bf(gw.z)), sigmoidf_(hi_bf(gw.z)), sigmoidf_(lo_bf(gw.w)), sigmoidf_(hi_bf(gw.w))};
            float* up = u32 + (size_t)row * DM + col;
            f32x4 r0 = g0 * v0, r1 = g1 * v1;
            if (MODE > 0) { r0 += *(const f32x4*)up; r1 += *(const f32x4*)(up + 4); }
            if (MODE < 2) { *(f32x4*)up = r0; *(f32x4*)(up + 4) = r1; }
            else pg8::st_bf16x8(ub + (size_t)row * DM + col, r0, r1);
        });
    }
};
struct EpiRes {
    const float* resL; const float* resC; float* outL; float* outC; const float* gateL; const float* gateC;
    __device__ __forceinline__ void operator()(const f32x4 (&acc)[2][2][4][2], const Unit& u, int wr, int wc, int fr, int fq) const {
        const bool isc = u.pm >= L / 256;
        const float* res = isc ? resC - (size_t)L * DM : resL; float* out = isc ? outC - (size_t)L * DM : outL; const float* gate = isc ? gateC : gateL;
        pg8::epi_each(acc, u, wr, wc, fr, fq, [&](int row, int col, f32x4 v0, f32x4 v1) {
            const size_t o = (size_t)row * DM + col;
            const f32x4 g0 = *(const f32x4*)(gate + col), g1 = *(const f32x4*)(gate + col + 4);
            *(f32x4*)(out + o) = *(const f32x4*)(res + o) + g0 * v0; *(f32x4*)(out + o + 4) = *(const f32x4*)(res + o + 4) + g1 * v1;
        });
    }
};
struct EpiSwiglu {
    bf16_t* o; int ld; int row_sub; int ct_mod;
    __device__ __forceinline__ void operator()(const f32x4 (&acc)[2][2][4][2], const Unit& u, int wr, int wc, int fr, int fq) const {
        const int row0 = u.pm * 256 + wr * 64 + fr - row_sub, col0 = (u.pn % ct_mod) * 128 + wc * 32 + 8 * fq;
#pragma unroll
        for (int ai = 0; ai < 2; ++ai)
#pragma unroll
            for (int m = 0; m < 4; ++m) {
                f32x4 r0, r1;
#pragma unroll
                for (int e = 0; e < 4; ++e) { r0[e] = siluf_(acc[ai][0][m][0][e]) * acc[ai][1][m][0][e]; r1[e] = siluf_(acc[ai][0][m][1][e]) * acc[ai][1][m][1][e]; }
                pg8::st_bf16x8(o + (size_t)(row0 + ai * 128 + m * 16) * ld + col0, r0, r1);
            }
    }
};
struct EpiMoe2 {
    bf16_t* ys; const float* rowgate;
    __device__ __forceinline__ void operator()(const f32x4 (&acc)[2][2][4][2], const Unit& u, int wr, int wc, int fr, int fq) const {
        const int cshift = ((u.pn & 3) - u.pn) * 256;
        pg8::epi_each(acc, u, wr, wc, fr, fq, [&](int row, int col, f32x4 v0, f32x4 v1) {
            const float g = rowgate[row];
            pg8::st_bf16x8(ys + (size_t)row * DM + col + cshift, v0 * g, v1 * g);
        });
    }
};
struct MoeOrder {
    int t0, t1, t2, t3, t4, t5, t6, t7, t8, nct, hi_shift, G, c, rep;
    __device__ bool next(int i, Unit& u) const {
        int idx = i * G + c; const int tot = (t8 - t0) * nct; if (idx >= tot * rep) return false; idx %= tot;
#define MOE_E(e, ta, tb_, sh) { const int w = (tb_) - (ta), n = w * nct; if (idx < n) { u.pm = (ta) + idx % w; u.pn = (e) * nct + idx / w + (sh); return true; } idx -= n; }
        MOE_E(0, t0, t1, 0) MOE_E(1, t1, t2, 0) MOE_E(2, t2, t3, 0) MOE_E(3, t3, t4, 0)
        MOE_E(4, t4, t5, hi_shift) MOE_E(5, t5, t6, hi_shift) MOE_E(6, t6, t7, hi_shift) MOE_E(7, t7, t8, hi_shift)
#undef MOE_E
        return false;
    }
};

__device__ __forceinline__ void prepare_rows(const Frame& F, const Args& a, int l) {
    const bf16_t* ZA = (const bf16_t*)(F.ws + WS_ZA); bf16_t* ZN = (bf16_t*)(F.ws + WS_ZN); const bf16_t* ZR = (const bf16_t*)(F.ws + WS_ZR);
    bf16_t* CQN = (bf16_t*)(F.ws + WS_CQN); bf16_t* CKVN = (bf16_t*)(F.ws + WS_CKVN); bf16_t* LA = (bf16_t*)(F.ws + WS_LA); bf16_t* KR = (bf16_t*)(F.ws + WS_KR);
    bf16_t* RKV = (bf16_t*)(F.ws + WS_RKV);
    const int lane = F.lane;
    float cqg[6], ckvg[4], qng[8], kng[8];
#pragma unroll
    for (int e = 0; e < 6; ++e) cqg[e] = a.in[I_CQG][l * 384 + lane * 6 + e];
#pragma unroll
    for (int e = 0; e < 4; ++e) ckvg[e] = a.in[I_CKVG][l * 256 + lane * 4 + e];
#pragma unroll
    for (int e = 0; e < 8; ++e) { qng[e] = a.in[I_NAQG][l * 64 + (lane & 7) * 8 + e] * (0.125f * LOG2E); kng[e] = a.in[I_NAKG][l * 64 + (lane & 7) * 8 + e]; }
    const float* mu0 = a.in[I_MU] + (size_t)l * 2 * 1920; const float* mu1 = mu0 + 1920;
    float kkv[8];
#pragma unroll
    for (int e = 0; e < 8; ++e) kkv[e] = a.in[I_KK][l * 512 + lane * 8 + e];
    const int gw = F.vcu * NWAVES + F.wave, NGW = F.G * NWAVES;
    for (int m = gw; m < R; m += NGW) {
        { const unsigned* p = (const unsigned*)(ZA + (size_t)m * ZA_LD) + lane * 3; const unsigned w0 = p[0], w1 = p[1], w2 = p[2];
          float v[6] = {lo_bf(w0), hi_bf(w0), lo_bf(w1), hi_bf(w1), lo_bf(w2), hi_bf(w2)}; float s = 0.f;
#pragma unroll
          for (int e = 0; e < 6; ++e) s += v[e] * v[e];
          const float rstd = rsqrtf(wave_sum(s) * (1.f / 384.f) + NORM_EPS);
          unsigned* o = (unsigned*)(CQN + (size_t)m * 384) + lane * 3;
          o[0] = cvtpk(v[0] * rstd * cqg[0], v[1] * rstd * cqg[1]); o[1] = cvtpk(v[2] * rstd * cqg[2], v[3] * rstd * cqg[3]); o[2] = cvtpk(v[4] * rstd * cqg[4], v[5] * rstd * cqg[5]); }
        { const u32x2 w = *((const u32x2*)(ZA + (size_t)m * ZA_LD + 384) + lane);
          float v[4] = {lo_bf(w.x), hi_bf(w.x), lo_bf(w.y), hi_bf(w.y)}; float s = v[0] * v[0] + v[1] * v[1] + v[2] * v[2] + v[3] * v[3];
          const float rstd = rsqrtf(wave_sum(s) * (1.f / 256.f) + NORM_EPS);
          u32x2 o; o.x = cvtpk(v[0] * rstd * ckvg[0], v[1] * rstd * ckvg[1]); o.y = cvtpk(v[2] * rstd * ckvg[2], v[3] * rstd * ckvg[3]);
          *((u32x2*)(CKVN + (size_t)m * 256) + lane) = o; }
        if (lane < 16) ((unsigned*)(KR + (size_t)m * 32))[lane] = ((const unsigned*)(ZA + (size_t)m * ZA_LD + 640))[lane];
#pragma unroll
        for (int qk = 0; qk < 2; ++qk) {
            u32x4* p = (u32x4*)(ZN + (size_t)m * ZN_LD + qk * 512) + lane; const u32x4 w = *p;
            float v[8] = {lo_bf(w.x), hi_bf(w.x), lo_bf(w.y), hi_bf(w.y), lo_bf(w.z), hi_bf(w.z), lo_bf(w.w), hi_bf(w.w)}; float s = 0.f;
#pragma unroll
            for (int e = 0; e < 8; ++e) s += v[e] * v[e];
            s += __shfl_xor(s, 1); s += __shfl_xor(s, 2); s += __shfl_xor(s, 4);
            const float rstd = rsqrtf(s * (1.f / 64.f) + NORM_EPS);
            u32x4 o;
            if (qk == 0) { o.x = cvtpk(v[0] * rstd * qng[0], v[1] * rstd * qng[1]); o.y = cvtpk(v[2] * rstd * qng[2], v[3] * rstd * qng[3]); o.z = cvtpk(v[4] * rstd * qng[4], v[5] * rstd * qng[5]); o.w = cvtpk(v[6] * rstd * qng[6], v[7] * rstd * qng[7]); }
            else { o.x = cvtpk(v[0] * rstd * kng[0], v[1] * rstd * kng[1]); o.y = cvtpk(v[2] * rstd * kng[2], v[3] * rstd * kng[3]); o.z = cvtpk(v[4] * rstd * kng[4], v[5] * rstd * kng[5]); o.w = cvtpk(v[6] * rstd * kng[6], v[7] * rstd * kng[7]); }
            *p = o;
        }
        const bool hasp = (m != 0) && (m != L), hasn = (m != L - 1) && (m != R - 1);
        const bf16_t* zc = ZR + (size_t)m * ZR_LD; const bf16_t* zp = zc - ZR_LD; const bf16_t* zn = zc + ZR_LD;
#pragma unroll
        for (int ch = 0; ch < 3; ++ch) {
            const int c0 = ch * 512 + lane * 8;
            const u32x4 wc_ = *(const u32x4*)(zc + c0); u32x4 wp = {0u, 0u, 0u, 0u}, wn = {0u, 0u, 0u, 0u};
            if (hasp) wp = *(const u32x4*)(zp + c0); if (hasn) wn = *(const u32x4*)(zn + c0);
            const float zcv[8] = {lo_bf(wc_.x), hi_bf(wc_.x), lo_bf(wc_.y), hi_bf(wc_.y), lo_bf(wc_.z), hi_bf(wc_.z), lo_bf(wc_.w), hi_bf(wc_.w)};
            const float zpv[8] = {lo_bf(wp.x), hi_bf(wp.x), lo_bf(wp.y), hi_bf(wp.y), lo_bf(wp.z), hi_bf(wp.z), lo_bf(wp.w), hi_bf(wp.w)};
            const float znv[8] = {lo_bf(wn.x), hi_bf(wn.x), lo_bf(wn.y), hi_bf(wn.y), lo_bf(wn.z), hi_bf(wn.z), lo_bf(wn.w), hi_bf(wn.w)};
            float o[8];
            const f32x4 ma = *(const f32x4*)(mu0 + c0), mb = *(const f32x4*)(mu0 + c0 + 4), na = *(const f32x4*)(mu1 + c0), nb = *(const f32x4*)(mu1 + c0 + 4);
            const float m0v[8] = {ma[0], ma[1], ma[2], ma[3], mb[0], mb[1], mb[2], mb[3]}, m1v[8] = {na[0], na[1], na[2], na[3], nb[0], nb[1], nb[2], nb[3]};
#pragma unroll
            for (int e = 0; e < 8; ++e) o[e] = zcv[e] + m0v[e] * (zpv[e] - zcv[e]) + m1v[e] * (znv[e] - zcv[e]);
            u32x4 w; w.x = cvtpk(o[0], o[1]); w.y = cvtpk(o[2], o[3]); w.z = cvtpk(o[4], o[5]); w.w = cvtpk(o[6], o[7]);
            *(u32x4*)(RKV + (size_t)m * RKV_LD + c0) = w;
            if (ch == 1) {
                const float kr_[8] = {lo_bf(w.x), hi_bf(w.x), lo_bf(w.y), hi_bf(w.y), lo_bf(w.z), hi_bf(w.z), lo_bf(w.w), hi_bf(w.w)};
                float s2 = 0.f;
#pragma unroll
                for (int e = 0; e < 8; ++e) { const float kx = kr_[e] * kkv[e]; s2 += kx * kx; }
                s2 += __shfl_xor(s2, 1); s2 += __shfl_xor(s2, 2); s2 += __shfl_xor(s2, 4);
                if ((lane & 7) == 0) ((float*)(F.ws + WS_KN))[(size_t)m * 8 + (lane >> 3)] = 1.f / fmaxf(sqrtf(s2), 1e-12f);
            }
        }
#pragma unroll
        for (int ch = 0; ch < 3; ++ch) {
            const int c0 = 1536 + ch * 128 + lane * 2;
            const unsigned wc_ = *(const unsigned*)(zc + c0); unsigned wp = 0u, wn = 0u;
            if (hasp) wp = *(const unsigned*)(zp + c0); if (hasn) wn = *(const unsigned*)(zn + c0);
            float o0 = lo_bf(wc_), o1 = hi_bf(wc_);
            o0 = o0 + mu0[c0] * (lo_bf(wp) - o0) + mu1[c0] * (lo_bf(wn) - o0);
            o1 = o1 + mu0[c0 + 1] * (hi_bf(wp) - o1) + mu1[c0 + 1] * (hi_bf(wn) - o1);
            if (ch == 0) { o0 = tanhf(o0); o1 = tanhf(o1); } else if (ch == 2) { o0 = sigmoidf_(o0); o1 = sigmoidf_(o1); }
            *(unsigned*)(LA + (size_t)m * 384 + ch * 128 + lane * 2) = cvtpk(o0, o1);
        }
    }
}

__device__ __forceinline__ void mla_fixup(const Frame& F, const Args& a, int l, bool need_ctx_q) {
    const bf16_t* QRAW = (const bf16_t*)(F.ws + WS_QRAW); const bf16_t* KVRAW = (const bf16_t*)(F.ws + WS_KVRAW); const bf16_t* KR = (const bf16_t*)(F.ws + WS_KR);
    bf16_t* Q = (bf16_t*)(F.ws + WS_Q); bf16_t* K = (bf16_t*)(F.ws + WS_K); bf16_t* V = (bf16_t*)(F.ws + WS_V);
    const int lane = F.lane, h = lane >> 3, sub = lane & 7;
    float qg[12], kg[12];
#pragma unroll
    for (int i = 0; i < 12; ++i) { qg[i] = a.in[I_QNG][l * 96 + sub + 8 * i] * (0.10206207261596575f * LOG2E); kg[i] = a.in[I_KNG][l * 96 + sub + 8 * i]; }
    const float freq = __expf(-9.210340371976184f * (float)sub * 0.125f);
    const int gw = F.vcu * NWAVES + F.wave, NGW = F.G * NWAVES;
    for (int m0 = gw; m0 < R * PROBE_ROW; m0 += NGW) { const int m = m0 % R;
        const bool lat = m < L;
        float cr = 1.f, sr = 0.f, cc = 1.f, sc = 0.f;
        if (lat) { sincosf((float)(m >> 6) * freq, &sr, &cr); sincosf((float)(m & 63) * freq, &sc, &cc); }
        if (lat || need_ctx_q) {
            float v[12]; float s = 0.f;
#pragma unroll
            for (int i = 0; i < 12; ++i) { v[i] = bf2f(QRAW[(size_t)m * 768 + h * 96 + sub + 8 * i]); s += v[i] * v[i]; }
            s += __shfl_xor(s, 1); s += __shfl_xor(s, 2); s += __shfl_xor(s, 4);
            const float rstd = rsqrtf(s * (1.f / 96.f) + NORM_EPS);
#pragma unroll
            for (int i = 0; i < 12; ++i) v[i] *= rstd * qg[i];
            { const float t1 = v[8], t2 = v[9]; v[8] = t1 * cr - t2 * sr; v[9] = t1 * sr + t2 * cr; }
            { const float t1 = v[10], t2 = v[11]; v[10] = t1 * cc - t2 * sc; v[11] = t1 * sc + t2 * cc; }
            bf16_t* qo = Q + ((size_t)h * R + m) * 96 + sub;
#pragma unroll
            for (int i = 0; i < 12; ++i) qo[8 * i] = (bf16_t)(cvtpk(v[i], 0.f) & 0xffffu);
        }
        {
            float v[12]; float s = 0.f;
#pragma unroll
            for (int i = 0; i < 8; ++i) v[i] = bf2f(KVRAW[(size_t)m * 1024 + h * 128 + sub + 8 * i]);
#pragma unroll
            for (int i = 0; i < 4; ++i) v[8 + i] = bf2f(KR[(size_t)m * 32 + sub + 8 * i]);
#pragma unroll
            for (int i = 0; i < 12; ++i) s += v[i] * v[i];
            s += __shfl_xor(s, 1); s += __shfl_xor(s, 2); s += __shfl_xor(s, 4);
            const float rstd = rsqrtf(s * (1.f / 96.f) + NORM_EPS);
#pragma unroll
            for (int i = 0; i < 12; ++i) v[i] *= rstd * kg[i];
            { const float t1 = v[8], t2 = v[9]; v[8] = t1 * cr - t2 * sr; v[9] = t1 * sr + t2 * cr; }
            { const float t1 = v[10], t2 = v[11]; v[10] = t1 * cc - t2 * sc; v[11] = t1 * sc + t2 * cc; }
            bf16_t* ko = K + ((size_t)h * R + m) * 96 + sub;
#pragma unroll
            for (int i = 0; i < 12; ++i) ko[8 * i] = (bf16_t)(cvtpk(v[i], 0.f) & 0xffffu);
            *(u32x4*)(V + ((size_t)h * R + m) * 64 + sub * 8) = *(const u32x4*)(KVRAW + (size_t)m * 1024 + h * 128 + 64 + sub * 8);
        }
    }
}

__device__ __forceinline__ void rwkv_output_rows(const Frame& F, const Args& a, int l, int m_end) {
    const bf16_t* RKV = (const bf16_t*)(F.ws + WS_RKV); const bf16_t* LO = (const bf16_t*)(F.ws + WS_LO);
    const bf16_t* YF = (const bf16_t*)(F.ws + WS_YF); const bf16_t* YBK = (const bf16_t*)(F.ws + WS_YBK); bf16_t* YR = (bf16_t*)(F.ws + WS_YR);
    const int lane = F.lane, c0 = lane * 8;
    float ka[8], rk[8], lg[8], lb[8];
#pragma unroll
    for (int e = 0; e < 8; ++e) { ka[e] = a.in[I_KA][l * 512 + c0 + e]; rk[e] = a.in[I_RK][l * 512 + c0 + e]; lg[e] = a.in[I_LNG][l * 512 + c0 + e]; lb[e] = a.in[I_LNB][l * 512 + c0 + e]; }
    const int gw = F.vcu * NWAVES + F.wave, NGW = F.G * NWAVES;
#define UNPK8(W, V) const float V[8] = {lo_bf(W.x), hi_bf(W.x), lo_bf(W.y), hi_bf(W.y), lo_bf(W.z), hi_bf(W.z), lo_bf(W.w), hi_bf(W.w)}
    for (int m0 = gw; m0 < m_end * PROBE_ROW; m0 += NGW) { const int m = m0 % m_end;
        const u32x4 wr_ = *(const u32x4*)(RKV + (size_t)m * RKV_LD + c0), wk_ = *(const u32x4*)(RKV + (size_t)m * RKV_LD + 512 + c0), wv_ = *(const u32x4*)(RKV + (size_t)m * RKV_LD + 1024 + c0);
        const u32x4 wa0 = *(const u32x4*)(LO + (size_t)m * LO_LD + 1024 + c0), wa1 = *(const u32x4*)(LO + (size_t)m * LO_LD + 1536 + c0), wg_ = *(const u32x4*)(LO + (size_t)m * LO_LD + 2048 + c0);
        const u32x4 wyf = *(const u32x4*)(YF + (size_t)m * 512 + c0), wyb = *(const u32x4*)(YBK + (size_t)m * 512 + c0);
        UNPK8(wr_, r); UNPK8(wk_, k); UNPK8(wv_, v); UNPK8(wa0, a0v); UNPK8(wa1, a1v); UNPK8(wg_, g); UNPK8(wyf, yf); UNPK8(wyb, yb);
        float y[8]; float s = 0.f, bs = 0.f;
#pragma unroll
        for (int e = 0; e < 8; ++e) { y[e] = yf[e] + yb[e]; s += y[e];
            const float kd0 = k[e] * (1.f + (a0v[e] - 1.f) * ka[e]), kd1 = k[e] * (1.f + (a1v[e] - 1.f) * ka[e]);
            bs += r[e] * rk[e] * (kd0 + kd1); }
        s += __shfl_xor(s, 1); s += __shfl_xor(s, 2); s += __shfl_xor(s, 4);
        bs += __shfl_xor(bs, 1); bs += __shfl_xor(bs, 2); bs += __shfl_xor(bs, 4);
        const float mean = s * (1.f / 64.f); float q = 0.f;
#pragma unroll
        for (int e = 0; e < 8; ++e) { const float d = y[e] - mean; q += d * d; }
        q += __shfl_xor(q, 1); q += __shfl_xor(q, 2); q += __shfl_xor(q, 4);
        const float rstd = rsqrtf(q * (1.f / 64.f) + 64e-5f);
        float o[8];
#pragma unroll
        for (int e = 0; e < 8; ++e) o[e] = ((y[e] - mean) * rstd * lg[e] + lb[e] + bs * v[e]) * g[e];
        u32x4 w; w.x = cvtpk(o[0], o[1]); w.y = cvtpk(o[2], o[3]); w.z = cvtpk(o[4], o[5]); w.w = cvtpk(o[6], o[7]);
        *(u32x4*)(YR + (size_t)m * 512 + c0) = w;
    }
#undef UNPK8
}

__device__ __forceinline__ int crow(int r, int hi) { return (r & 3) + 8 * (r >> 2) + 4 * hi; }
#define SBAR() __builtin_amdgcn_sched_barrier(0)
__device__ __forceinline__ s16x4 tr_read_at(unsigned addr) { s16x4 r; asm volatile("ds_read_b64_tr_b16 %0, %1" : "=&v"(r) : "v"(addr) : "memory"); return r; }
__device__ __forceinline__ float rowmax32(const f32x16& p0, const f32x16& p1) {
    float m = p0[0];
#pragma unroll
    for (int r = 1; r < 16; ++r) m = fmaxf(m, p0[r]);
#pragma unroll
    for (int r = 0; r < 16; ++r) m = fmaxf(m, p1[r]);
    auto rr = __builtin_amdgcn_permlane32_swap(__float_as_uint(m), __float_as_uint(m), false, false);
    return fmaxf(__uint_as_float(rr[0]), __uint_as_float(rr[1]));
}
__device__ __forceinline__ float halfsum(float s) {
    auto rr = __builtin_amdgcn_permlane32_swap(__float_as_uint(s), __float_as_uint(s), false, false);
    return __uint_as_float(rr[0]) + __uint_as_float(rr[1]);
}
__device__ __forceinline__ void pack_p(const f32x16& p0, const f32x16& p1, bf16x8 (&pa)[4]) {
#define PK8(P, B, OUT) do { u32x4 w = {cvtpk(P[B + 0], P[B + 1]), cvtpk(P[B + 2], P[B + 3]), cvtpk(P[B + 4], P[B + 5]), cvtpk(P[B + 6], P[B + 7])}; OUT = __builtin_bit_cast(bf16x8, w); } while (0)
    PK8(p0, 0, pa[0]); PK8(p0, 8, pa[1]); PK8(p1, 0, pa[2]); PK8(p1, 8, pa[3]);
#undef PK8
}

constexpr int AK_PITCH = 208, AK_BYTES = 64 * AK_PITCH, AV_BYTES = 8192;
constexpr int ALDS_K = 0, ALDS_V = 3 * AK_BYTES, ALDS_WS = ALDS_V + 3 * AV_BYTES, ALDS_Q = ALDS_WS + 8 * 256, ALDS_END = ALDS_Q + 8 * 6144;
typedef short v4i16_t __attribute__((ext_vector_type(4)));
__device__ __forceinline__ s16x4 vtr(LAS const unsigned char* p) { return __builtin_bit_cast(s16x4, __builtin_amdgcn_ds_read_tr16_b64_v4i16((LAS v4i16_t*)p)); }
__device__ __forceinline__ void mla_unit(const Frame& F, int h, int q0, int k0, int nt) {
    const bf16_t* Q = (const bf16_t*)(F.ws + WS_Q) + (size_t)h * R * 96; const bf16_t* K = (const bf16_t*)(F.ws + WS_K) + (size_t)h * R * 96 + (size_t)k0 * 96;
    const bf16_t* V = (const bf16_t*)(F.ws + WS_V) + (size_t)h * R * 64 + (size_t)k0 * 64; bf16_t* YA = (bf16_t*)(F.ws + WS_YA);
    LAS unsigned char* lds = F.lds;
    const int tid = F.tid, lane = F.lane, wid = F.wave, r32 = lane & 31, hi = lane >> 5;
    LAS float* wsf = (LAS float*)(lds + ALDS_WS) + wid * 64;
    bf16x8 qr[6];
    { const bf16_t* qp = Q + (size_t)(q0 + wid * 32 + r32) * 96 + hi * 8;
#pragma unroll
      for (int s = 0; s < 6; ++s) qr[s] = *(const bf16x8*)(qp + s * 16); }
    const int kc0 = tid, kc1 = 512 + tid; const bool k2 = tid < 256;
    const int kr0 = kc0 / 12, kq0 = kc0 % 12, kr1 = kc1 / 12, kq1 = kc1 % 12;
    const int vkey = tid >> 3, vc8 = tid & 7;
    const unsigned kdst0 = kr0 * AK_PITCH + kq0 * 16, kdst1 = kr1 * AK_PITCH + kq1 * 16;
    const unsigned vdst = (vc8 >> 2) * 4096 + vkey * 64 + (vc8 & 3) * 16;
    u32x4 sk0, sk1, sv;
#define A_LOAD(t) do { const bf16_t* kt = K + (size_t)(t) * 64 * 96; sk0 = *(const u32x4*)(kt + kr0 * 96 + kq0 * 8); if (k2) sk1 = *(const u32x4*)(kt + kr1 * 96 + kq1 * 8); \
        sv = *(const u32x4*)(V + (size_t)(t) * 64 * 64 + vkey * 64 + vc8 * 8); } while (0)
#define A_WRITE(sl) do { *(LAS u32x4*)(lds + ALDS_K + (sl) * AK_BYTES + kdst0) = sk0; if (k2) *(LAS u32x4*)(lds + ALDS_K + (sl) * AK_BYTES + kdst1) = sk1; \
        *(LAS u32x4*)(lds + ALDS_V + (sl) * AV_BYTES + vdst) = sv; } while (0)
    f32x16 o[2]; o[0] = f32x16{}; o[1] = f32x16{};
    float mref = 0.f, lsum = 0.f; f32x16 negm = f32x16{};
    LAS const unsigned char* kb_rd = lds + ALDS_K + r32 * AK_PITCH + hi * 16;
    LAS const unsigned char* vb_rd = lds + ALDS_V + ((lane >> 4) & 1) * 32 + (lane & 3) * 8 + (4 * hi + ((lane & 15) >> 2)) * 64;
#define PIN(x) asm volatile("" : "+v"(x))
#define A_QKT(C0, C1, sl) do { LAS const unsigned char* kt_ = kb_rd + (sl) * AK_BYTES; C0 = negm; C1 = negm; \
        _Pragma("unroll") for (int s = 0; s < 6; ++s) { const bf16x8 a0 = *(LAS const bf16x8*)(kt_ + s * 32); const bf16x8 a1 = *(LAS const bf16x8*)(kt_ + 32 * AK_PITCH + s * 32); \
            C0 = __builtin_amdgcn_mfma_f32_32x32x16_bf16(a0, qr[s], C0, 0, 0, 0); C1 = __builtin_amdgcn_mfma_f32_32x32x16_bf16(a1, qr[s], C1, 0, 0, 0); } } while (0)
#define A_MAX(C0, C1, al) do { const float rm_ = rowmax32(C0, C1); al = 1.f; \
        if (__builtin_expect(__any(rm_ > 8.f), 0)) { const float dl_ = fmaxf(rm_, 0.f); mref += dl_; al = __builtin_amdgcn_exp2f(-dl_); \
            _Pragma("unroll") for (int r = 0; r < 16; ++r) { C0[r] -= dl_; C1[r] -= dl_; negm[r] = -mref; } } } while (0)
#define A_RESC(al) do { if (__any((al) < 1.f)) { if (hi == 0) wsf[r32] = (al); LDS_WAIT(); \
        _Pragma("unroll") for (int r = 0; r < 16; ++r) { const float f_ = wsf[crow(r, hi)]; o[0][r] *= f_; o[1][r] *= f_; } } } while (0)
#define A_STEP(C0, C1, P0, P1, sk_, sv_, alP, alC) do { \
        LAS const unsigned char* kt_ = kb_rd + (sk_) * AK_BYTES; LAS const unsigned char* vt_ = vb_rd + (sv_) * AV_BYTES; \
        bf16x8 ka_[2], kb_[2]; u32x4 pw_[4]; float ps0_ = 0.f, ps1_ = 0.f; \
        ka_[0] = *(LAS const bf16x8*)(kt_); kb_[0] = *(LAS const bf16x8*)(kt_ + 32 * AK_PITCH); SBAR(); \
        _Pragma("unroll") for (int s = 0; s < 6; ++s) { const int c_ = s & 1, n_ = c_ ^ 1; \
            if (s + 1 < 6) { ka_[n_] = *(LAS const bf16x8*)(kt_ + (s + 1) * 32); kb_[n_] = *(LAS const bf16x8*)(kt_ + 32 * AK_PITCH + (s + 1) * 32); } \
            if (s == 0) C0 = __builtin_amdgcn_mfma_f32_32x32x16_bf16(ka_[c_], qr[s], negm, 0, 0, 0); else C0 = __builtin_amdgcn_mfma_f32_32x32x16_bf16(ka_[c_], qr[s], C0, 0, 0, 0); \
            if (s < 4) { ps0_ += P0[4 * s] + P0[4 * s + 1]; ps1_ += P0[4 * s + 2] + P0[4 * s + 3]; PIN(ps0_); PIN(ps1_); } \
            else { pw_[2 * (s - 4)][0] = cvtpk(P0[8 * (s - 4)], P0[8 * (s - 4) + 1]); pw_[2 * (s - 4)][1] = cvtpk(P0[8 * (s - 4) + 2], P0[8 * (s - 4) + 3]); pw_[2 * (s - 4)][2] = cvtpk(P0[8 * (s - 4) + 4], P0[8 * (s - 4) + 5]); pw_[2 * (s - 4)][3] = cvtpk(P0[8 * (s - 4) + 6], P0[8 * (s - 4) + 7]); PIN(pw_[2 * (s - 4)]); } \
            SBAR(); \
            if (s == 0) C1 = __builtin_amdgcn_mfma_f32_32x32x16_bf16(kb_[c_], qr[s], negm, 0, 0, 0); else C1 = __builtin_amdgcn_mfma_f32_32x32x16_bf16(kb_[c_], qr[s], C1, 0, 0, 0); \
            if (s < 4) { ps0_ += P1[4 * s] + P1[4 * s + 1]; ps1_ += P1[4 * s + 2] + P1[4 * s + 3]; PIN(ps0_); PIN(ps1_); } \
            else { pw_[2 * (s - 4) + 1][0] = cvtpk(P1[8 * (s - 4)], P1[8 * (s - 4) + 1]); pw_[2 * (s - 4) + 1][1] = cvtpk(P1[8 * (s - 4) + 2], P1[8 * (s - 4) + 3]); pw_[2 * (s - 4) + 1][2] = cvtpk(P1[8 * (s - 4) + 4], P1[8 * (s - 4) + 5]); pw_[2 * (s - 4) + 1][3] = cvtpk(P1[8 * (s - 4) + 6], P1[8 * (s - 4) + 7]); PIN(pw_[2 * (s - 4) + 1]); } \
            SBAR(); } \
        lsum = lsum * (alP) + (ps0_ + ps1_); \
        A_MAX(C0, C1, alC); SBAR(); \
          \
        s16x4 vl_[2], vh_[2]; vl_[0] = vtr(vt_); vh_[0] = vtr(vt_ + 512); SBAR(); \
        _Pragma("unroll") for (int m_ = 0; m_ < 8; ++m_) { const int dt_ = m_ >> 2, s_ = m_ & 3, c_ = m_ & 1, n_ = c_ ^ 1; \
            if (m_ + 1 < 8) { vl_[n_] = vtr(vt_ + ((m_ + 1) >> 2) * 4096 + ((m_ + 1) & 3) * 1024); vh_[n_] = vtr(vt_ + ((m_ + 1) >> 2) * 4096 + ((m_ + 1) & 3) * 1024 + 512); } \
            const bf16x8 vf_ = {vl_[c_][0], vl_[c_][1], vl_[c_][2], vl_[c_][3], vh_[c_][0], vh_[c_][1], vh_[c_][2], vh_[c_][3]}; \
            const int pi_ = (s_ == 0) ? 0 : (s_ == 1) ? 2 : (s_ == 2) ? 1 : 3; \
            o[dt_] = __builtin_amdgcn_mfma_f32_32x32x16_bf16(__builtin_bit_cast(bf16x8, pw_[pi_]), vf_, o[dt_], 0, 0, 0); \
            if (m_ < 4) { C0[4 * m_] = __builtin_amdgcn_exp2f(C0[4 * m_]); C0[4 * m_ + 1] = __builtin_amdgcn_exp2f(C0[4 * m_ + 1]); C0[4 * m_ + 2] = __builtin_amdgcn_exp2f(C0[4 * m_ + 2]); C0[4 * m_ + 3] = __builtin_amdgcn_exp2f(C0[4 * m_ + 3]); PIN(C0); } \
            else { C1[4 * (m_ - 4)] = __builtin_amdgcn_exp2f(C1[4 * (m_ - 4)]); C1[4 * (m_ - 4) + 1] = __builtin_amdgcn_exp2f(C1[4 * (m_ - 4) + 1]); C1[4 * (m_ - 4) + 2] = __builtin_amdgcn_exp2f(C1[4 * (m_ - 4) + 2]); C1[4 * (m_ - 4) + 3] = __builtin_amdgcn_exp2f(C1[4 * (m_ - 4) + 3]); PIN(C1); } \
            SBAR(); } \
    } while (0)
    f32x16 pA0, pA1, pB0, pB1; float alA = 1.f, alB = 1.f;
    A_LOAD(0); A_WRITE(0); A_LOAD(1); A_WRITE(1); A_LOAD(2); __syncthreads();
    A_QKT(pA0, pA1, 0); A_MAX(pA0, pA1, alA);
#pragma unroll
    for (int r = 0; r < 16; ++r) { pA0[r] = __builtin_amdgcn_exp2f(pA0[r]); pA1[r] = __builtin_amdgcn_exp2f(pA1[r]); }
    A_WRITE(2); __syncthreads();
    alA = 1.f;
    int sk = 1, sv_ = 0, sw = 0;
    for (int t = 1; t + 1 < nt; t += 2) {
        if (t + 2 < nt) A_LOAD(t + 2);
        A_STEP(pB0, pB1, pA0, pA1, sk, sv_, alA, alB);
        __syncthreads(); if (t + 2 < nt) A_WRITE(sw); A_RESC(alB);
        sv_ = sk; sk = (sk == 2) ? 0 : sk + 1; sw = (sw == 2) ? 0 : sw + 1;
        if (t + 3 < nt) A_LOAD(t + 3);
        A_STEP(pA0, pA1, pB0, pB1, sk, sv_, alB, alA);
        __syncthreads(); if (t + 3 < nt) A_WRITE(sw); A_RESC(alA);
        sv_ = sk; sk = (sk == 2) ? 0 : sk + 1; sw = (sw == 2) ? 0 : sw + 1;
    }
    A_STEP(pB0, pB1, pA0, pA1, sk, sv_, alA, alB);
    A_RESC(alB);
    { float ps = 0.f;
#pragma unroll
      for (int r = 0; r < 16; ++r) ps += pB0[r] + pB1[r];
      lsum = lsum * alB + ps;
      bf16x8 pa[4]; pack_p(pB0, pB1, pa);
      LAS const unsigned char* vt_ = vb_rd + sk * AV_BYTES;
#pragma unroll
      for (int dt = 0; dt < 2; ++dt)
#pragma unroll
          for (int s = 0; s < 4; ++s) { const s16x4 lo_ = vtr(vt_ + dt * 4096 + s * 1024), hh_ = vtr(vt_ + dt * 4096 + s * 1024 + 512);
              const bf16x8 vf = {lo_[0], lo_[1], lo_[2], lo_[3], hh_[0], hh_[1], hh_[2], hh_[3]};
              o[dt] = __builtin_amdgcn_mfma_f32_32x32x16_bf16(pa[s], vf, o[dt], 0, 0, 0); } }
    lsum = halfsum(lsum);
    if (hi == 0) wsf[r32] = lsum; LDS_WAIT();
#pragma unroll
    for (int r = 0; r < 16; ++r) { const float inv = 1.f / wsf[crow(r, hi)]; const int row = q0 + wid * 32 + crow(r, hi);
        bf16_t* op = YA + (size_t)row * 512 + h * 64 + r32;
        op[0] = (bf16_t)(cvtpk(o[0][r] * inv, 0.f) & 0xffffu); op[32] = (bf16_t)(cvtpk(o[1][r] * inv, 0.f) & 0xffffu); }
    __syncthreads();
#undef A_LOAD
#undef A_WRITE
#undef A_QKT
#undef A_MAX
#undef A_RESC
#undef A_STEP
#undef PIN
}

constexpr int NLDS_V = 0, NLDS_RPB = 8 * 8192, NLDS_WS = NLDS_RPB + 8 * 2048, NLDS_END = NLDS_WS + 8 * 256;
__device__ __forceinline__ void na_unit(const Frame& F, const float* rpb_l, int unit, bool ctxq, int qt) {
    const bf16_t* ZN = (const bf16_t*)(F.ws + WS_ZN); bf16_t* YB = (bf16_t*)(F.ws + WS_YB);
    LAS unsigned char* lds = F.lds;
    const int lane = F.lane, h = F.wave, r32 = lane & 31, hi = lane >> 5;
    LAS unsigned char* vlds = lds + NLDS_V + h * 8192; LAS float* rpbs = (LAS float*)(lds + NLDS_RPB + h * 2048); LAS float* wsf = (LAS float*)(lds + NLDS_WS) + h * 64;
    const int qrow0 = ctxq ? L + unit * 64 : unit * 64;
    const int rs = ctxq ? 0 : min(max(unit - 4, 0), 256 - 8);
    for (int i = lane; i < 15 * 31; i += 64) rpbs[i] = rpb_l[h * 465 + i] * LOG2E;
    bf16x8 qr[4];
#pragma unroll
    for (int s = 0; s < 4; ++s) qr[s] = *(const bf16x8*)(ZN + (size_t)(qrow0 + qt * 32 + r32) * ZN_LD + h * 64 + s * 16 + hi * 8);
    f32x16 o[2]; o[0] = f32x16{}; o[1] = f32x16{};
    float mref = -1e30f, lsum = 0.f;
    const unsigned vb_rd = (unsigned)(uintptr_t)vlds + ((lane >> 4) & 1) * 32 + (lane & 3) * 8 + (4 * hi + ((lane & 15) >> 2)) * 64;
    const int ntl = ctxq ? 0 : 8, nt = ntl + 4;
    LDS_WAIT();
    for (int t = 0; t < nt; ++t) {
        const bool local = t < ntl;
        const int krow0 = local ? (rs + t) * 64 : L + (t - ntl) * 64;
#pragma unroll
        for (int hv = 0; hv < 2; ++hv) {
            u32x4 sv[4];
#pragma unroll
            for (int i = 0; i < 4; ++i) { const int c = (hv * 4 + i) * 64 + lane; sv[i] = *(const u32x4*)(ZN + (size_t)(krow0 + (c >> 3)) * ZN_LD + 1024 + h * 64 + (c & 7) * 8); }
#pragma unroll
            for (int i = 0; i < 4; ++i) { const int c = (hv * 4 + i) * 64 + lane; const int key = c >> 3, c8 = c & 7; *(LAS u32x4*)(vlds + (c8 >> 2) * 4096 + key * 64 + (c8 & 3) * 16) = sv[i]; }
        }
        bf16x8 kf[2][4];
#pragma unroll
        for (int hf = 0; hf < 2; ++hf)
#pragma unroll
            for (int s = 0; s < 4; ++s) kf[hf][s] = *(const bf16x8*)(ZN + (size_t)(krow0 + hf * 32 + r32) * ZN_LD + 512 + h * 64 + s * 16 + hi * 8);
        LDS_WAIT();
        const int dr = rs + t - unit + 7;
        {
            f32x16 p0 = f32x16{}, p1 = f32x16{};
#pragma unroll
            for (int s = 0; s < 4; ++s) { p0 = __builtin_amdgcn_mfma_f32_32x32x16_bf16(kf[0][s], qr[s], p0, 0, 0, 0); p1 = __builtin_amdgcn_mfma_f32_32x32x16_bf16(kf[1][s], qr[s], p1, 0, 0, 0); }
            if (local) {
                const int qc = qt * 32 + r32, cs = min(max(qc - 8, 0), 48);
#pragma unroll
                for (int r = 0; r < 16; ++r) { const int kc0 = crow(r, hi), kc1 = kc0 + 32;
                    const bool v0 = (kc0 >= cs) && (kc0 < cs + 16), v1 = (kc1 >= cs) && (kc1 < cs + 16);
                    const int d0 = v0 ? kc0 - qc + 15 : 0, d1 = v1 ? kc1 - qc + 15 : 0;
                    const float b0 = rpbs[dr * 31 + d0], b1 = rpbs[dr * 31 + d1];
                    p0[r] = v0 ? p0[r] + b0 : -1e30f; p1[r] = v1 ? p1[r] + b1 : -1e30f; }
            }
            const float rm = rowmax32(p0, p1);
            if (__any(rm > mref + 8.f)) {
                const float mn = fmaxf(mref, rm); const float al = __builtin_amdgcn_exp2f(mref - mn); mref = mn; lsum *= al;
                if (hi == 0) wsf[r32] = al; LDS_WAIT();
#pragma unroll
                for (int r = 0; r < 16; ++r) { const float f = wsf[crow(r, hi)]; o[0][r] *= f; o[1][r] *= f; }
                LDS_WAIT();
            }
            float ps = 0.f;
#pragma unroll
            for (int r = 0; r < 16; ++r) { p0[r] = __builtin_amdgcn_exp2f(p0[r] - mref); p1[r] = __builtin_amdgcn_exp2f(p1[r] - mref); ps += p0[r] + p1[r]; }
            lsum += ps;
            bf16x8 pa[4]; pack_p(p0, p1, pa);
#pragma unroll
            for (int dt = 0; dt < 2; ++dt) {
                s16x4 lo[4], hh[4];
#pragma unroll
                for (int s = 0; s < 4; ++s) { lo[s] = tr_read_at(vb_rd + dt * 4096 + s * 1024); hh[s] = tr_read_at(vb_rd + dt * 4096 + s * 1024 + 512); }
                LDS_WAIT(); SBAR();
#pragma unroll
                for (int s = 0; s < 4; ++s) { const bf16x8 vf = {lo[s][0], lo[s][1], lo[s][2], lo[s][3], hh[s][0], hh[s][1], hh[s][2], hh[s][3]};
                    o[dt] = __builtin_amdgcn_mfma_f32_32x32x16_bf16(pa[s], vf, o[dt], 0, 0, 0); }
            }
        }
        LDS_WAIT(); SBAR();
    }
    {
        const float ls = halfsum(lsum);
        if (hi == 0) wsf[r32] = ls; LDS_WAIT();
#pragma unroll
        for (int r = 0; r < 16; ++r) { const float inv = 1.f / wsf[crow(r, hi)]; const int row = qrow0 + qt * 32 + crow(r, hi);
            bf16_t* op = YB + (size_t)row * 512 + h * 64 + r32;
            op[0] = (bf16_t)(cvtpk(o[0][r] * inv, 0.f) & 0xffffu); op[32] = (bf16_t)(cvtpk(o[1][r] * inv, 0.f) & 0xffffu); }
        LDS_WAIT();
    }
}

__device__ __forceinline__ int rw_row2(int d, int seq, int t) {
    if (seq == 0) return d == 0 ? L + t : L + (CT - 1) - t;
    return d == 0 ? t : (L - 1) - t;
}
constexpr int RWB = 4, RWB3 = 4;
constexpr int RW_LDS_PER_WAVE = RWB * 2 * 5 * 64 * 4;

template <bool CTX> __device__ __forceinline__ void rwkv_pass1_item(const Frame& F, const Args& a, int l, int d, int h, int ci) {
    const bf16_t* RKV = (const bf16_t*)(F.ws + WS_RKV); const bf16_t* LO = (const bf16_t*)(F.ws + WS_LO); const float* KN = (const float*)(F.ws + WS_KN);
    const int lane = F.lane, c = h * 64 + lane;
    LAS float* sl = (LAS float*)(F.lds + F.wave * RW_LDS_PER_WAVE);
    const float kkp = a.in[I_KK][l * 512 + c], kap = a.in[I_KA][l * 512 + c];
    if (CTX) __builtin_amdgcn_s_setprio(3);
    float sq[64], sp[64];
    int ln_ = lane; asm volatile("" : "+v"(ln_));
#pragma unroll
    for (int j = 0; j < 64; ++j) { sq[j] = 0.f; sp[j] = (j == ln_) ? 1.f : 0.f; }
    unsigned short rk[RWB], rv[RWB], ra[RWB], rl[RWB]; float rn[RWB];
#define RW_LOAD(bi) do { _Pragma("unroll") for (int s = 0; s < RWB; ++s) { const size_t row = (size_t)rw_row2(d, CTX ? 0 : 1, (CTX ? 0 : (ci - 1) * TCH) + (bi) * RWB + s); \
        rk[s] = RKV[row * RKV_LD + 512 + c]; rv[s] = RKV[row * RKV_LD + 1024 + c]; rl[s] = LO[row * LO_LD + d * 512 + c]; ra[s] = LO[row * LO_LD + 1024 + d * 512 + c]; rn[s] = KN[row * 8 + h]; } } while (0)
    RW_LOAD(0);
    constexpr int NB = (CTX ? CT : TCH) / RWB;
    for (int bi = 0; bi < NB; ++bi) {
        float vv[RWB];
#pragma unroll
        for (int s = 0; s < RWB; ++s) {
            const float k = bf2f(rk[s]), av = bf2f(ra[s]), lw = bf2f(rl[s]); vv[s] = bf2f(rv[s]);
            const float kk = k * kkp * rn[s];
            sl[(s * 5 + 0) * 64 + lane] = kk; sl[(s * 5 + 1) * 64 + lane] = __expf(lw); sl[(s * 5 + 2) * 64 + lane] = kk * av; sl[(s * 5 + 3) * 64 + lane] = k * (1.f + (av - 1.f) * kap);
        }
        if (bi + 1 < NB) RW_LOAD(bi + 1);
        LDS_WAIT();
#pragma unroll 1
        for (int s = 0; s < RWB; ++s) {
            const LAS f32x4* vk = (const LAS f32x4*)(sl + (s * 5 + 0) * 64); const LAS f32x4* vw = (const LAS f32x4*)(sl + (s * 5 + 1) * 64);
            const LAS f32x4* vb = (const LAS f32x4*)(sl + (s * 5 + 2) * 64); const LAS f32x4* vd = (const LAS f32x4*)(sl + (s * 5 + 3) * 64);
            float q0 = 0.f, q1 = 0.f, p0 = 0.f, p1 = 0.f;
            f32x4 kc = vk[0], kn = vk[1];
#pragma unroll
            for (int j4 = 0; j4 < 16; ++j4) {
                f32x4 kf = kn; if (j4 + 2 < 16) kf = vk[j4 + 2];
                q0 -= sq[4 * j4] * kc[0]; q1 -= sq[4 * j4 + 1] * kc[1]; q0 -= sq[4 * j4 + 2] * kc[2]; q1 -= sq[4 * j4 + 3] * kc[3];
                if (!CTX) { p0 -= sp[4 * j4] * kc[0]; p1 -= sp[4 * j4 + 1] * kc[1]; p0 -= sp[4 * j4 + 2] * kc[2]; p1 -= sp[4 * j4 + 3] * kc[3]; }
                kc = kn; kn = kf; __builtin_amdgcn_sched_barrier(0); }
            const float saq = q0 + q1, sap = p0 + p1;
            float vi = vv[0];
#pragma unroll
            for (int s2 = 1; s2 < RWB; ++s2) vi = (s == s2) ? vv[s2] : vi;
            f32x4 wc_ = vw[0], bc = vb[0], dc = vd[0];
#pragma unroll
            for (int j4 = 0; j4 < 16; ++j4) {
                f32x4 wn = wc_, bn = bc, dn = dc; if (j4 + 1 < 16) { wn = vw[j4 + 1]; bn = vb[j4 + 1]; dn = vd[j4 + 1]; }
#pragma unroll
                for (int e = 0; e < 4; ++e) { sq[4 * j4 + e] = sq[4 * j4 + e] * wc_[e] + (saq * bc[e] + vi * dc[e]); if (!CTX) sp[4 * j4 + e] = sp[4 * j4 + e] * wc_[e] + sap * bc[e]; }
                wc_ = wn; bc = bn; dc = dn; __builtin_amdgcn_sched_barrier(0); }
        }
        LDS_WAIT();
        if (CTX && bi == TCH / RWB - 1) {
            float* Qm = (float*)(F.ws + WS_QST) + ((size_t)(d * 8 + h) * NCH + (NCH - 1)) * 4096 + lane * 64;
#pragma unroll
            for (int j4 = 0; j4 < 16; ++j4) *(f32x4*)(Qm + 4 * j4) = (f32x4){sq[4 * j4], sq[4 * j4 + 1], sq[4 * j4 + 2], sq[4 * j4 + 3]};
        }
    }
#undef RW_LOAD
    float* Qo = (float*)(F.ws + WS_QST) + ((size_t)(d * 8 + h) * NCH + ci) * 4096 + lane * 64;
    bf16_t* Po = (bf16_t*)(F.ws + WS_PST) + ((size_t)(d * 8 + h) * NCH + ci) * 4096 + ((lane & 0x33) | ((lane & 4) << 1) | ((lane & 8) >> 1));
#pragma unroll
    for (int j4 = 0; j4 < 16; ++j4) { *(f32x4*)(Qo + 4 * j4) = (f32x4){sq[4 * j4], sq[4 * j4 + 1], sq[4 * j4 + 2], sq[4 * j4 + 3]}; if (!CTX) {
#pragma unroll
            for (int e = 0; e < 4; ++e) Po[(4 * j4 + e) * 64] = (bf16_t)(cvtpk(sp[4 * j4 + e], 0.f) & 0xffffu); } }
    if (CTX) __builtin_amdgcn_s_setprio(0);
}

__device__ __forceinline__ void rwkv_pass2(const Frame& F, int dh, int it) {
    const int lane = F.lane, r32 = lane & 31, hi = lane >> 5;
    float* Qb = (float*)(F.ws + WS_QST) + (size_t)dh * NCH * 4096;
    f32x16 X[2];
#pragma unroll
    for (int jt = 0; jt < 2; ++jt)
#pragma unroll
        for (int r = 0; r < 16; ++r) X[jt][r] = Qb[(size_t)(32 * it + r32) * 64 + 32 * jt + crow(r, hi)];
    bf16x8 pnx[2][2][2]; f32x4 qn[2][4];
    const bf16_t* PTb = (const bf16_t*)(F.ws + WS_PST) + (size_t)dh * NCH * 4096;
#define P2_LOAD(ci_) do { const bf16_t* P_ = PTb + (size_t)(ci_) * 4096; const float* Q_ = Qb + (size_t)(ci_) * 4096 + (size_t)(32 * it + r32) * 64 + 4 * hi; \
        _Pragma("unroll") for (int jn = 0; jn < 2; ++jn) _Pragma("unroll") for (int jt = 0; jt < 2; ++jt) _Pragma("unroll") for (int s = 0; s < 2; ++s) pnx[jn][jt][s] = *(const bf16x8*)(P_ + (size_t)(32 * jn + r32) * 64 + jt * 32 + s * 16 + hi * 8); \
        _Pragma("unroll") for (int jt = 0; jt < 2; ++jt) _Pragma("unroll") for (int g = 0; g < 4; ++g) qn[jt][g] = *(const f32x4*)(Q_ + 32 * jt + 8 * g); } while (0)
    P2_LOAD(1);
    for (int ci = 1; ci < NCH - 1; ++ci) {
        float* Qc = Qb + (size_t)ci * 4096;
        bf16x8 pa[2][2][2]; f32x16 N[2];
#pragma unroll
        for (int jn = 0; jn < 2; ++jn)
#pragma unroll
            for (int jt = 0; jt < 2; ++jt)
#pragma unroll
                for (int s = 0; s < 2; ++s) pa[jn][jt][s] = pnx[jn][jt][s];
#pragma unroll
        for (int jt = 0; jt < 2; ++jt)
#pragma unroll
            for (int r = 0; r < 16; ++r) N[jt][r] = qn[jt][r >> 2][r & 3];
        if (ci + 1 < NCH - 1) P2_LOAD(ci + 1);
        bf16x8 bh[2][2], bl[2][2];
#pragma unroll
        for (int jt = 0; jt < 2; ++jt)
#pragma unroll
            for (int s = 0; s < 2; ++s) {
                unsigned wh[4], wl[4];
#pragma unroll
                for (int e2 = 0; e2 < 4; ++e2) { const float x0 = X[jt][8 * s + 2 * e2], x1 = X[jt][8 * s + 2 * e2 + 1]; const unsigned h = cvtpk(x0, x1); wh[e2] = h; wl[e2] = cvtpk(x0 - lo_bf(h), x1 - hi_bf(h)); }
                u32x4 a = {wh[0], wh[1], wh[2], wh[3]}, b = {wl[0], wl[1], wl[2], wl[3]}; bh[jt][s] = __builtin_bit_cast(bf16x8, a); bl[jt][s] = __builtin_bit_cast(bf16x8, b);
            }
#pragma unroll
        for (int jn = 0; jn < 2; ++jn)
#pragma unroll
            for (int jt = 0; jt < 2; ++jt)
#pragma unroll
                for (int s = 0; s < 2; ++s) { N[jn] = __builtin_amdgcn_mfma_f32_32x32x16_bf16(pa[jn][jt][s], bh[jt][s], N[jn], 0, 0, 0); N[jn] = __builtin_amdgcn_mfma_f32_32x32x16_bf16(pa[jn][jt][s], bl[jt][s], N[jn], 0, 0, 0); }
        X[0] = N[0]; X[1] = N[1];
#pragma unroll
        for (int jt = 0; jt < 2; ++jt)
#pragma unroll
            for (int r = 0; r < 16; ++r) Qc[(size_t)(32 * it + r32) * 64 + 32 * jt + crow(r, hi)] = X[jt][r];
    }
#undef P2_LOAD
}

__device__ __forceinline__ void rwkv_pass3_item(const Frame& F, const Args& a, int l, int d, int hp, int pc) {
    const bf16_t* RKV = (const bf16_t*)(F.ws + WS_RKV); const bf16_t* LO = (const bf16_t*)(F.ws + WS_LO); const float* KN = (const float*)(F.ws + WS_KN);
    bf16_t* Y = (bf16_t*)(F.ws + (d == 0 ? WS_YF : WS_YBK));
    const int lane = F.lane, hs = lane >> 5, ri = lane & 31, hme = 2 * hp + hs;
    LAS float* sl = (LAS float*)(F.lds + F.wave * RW_LDS_PER_WAVE);
    float kkp[2], kap[2];
#pragma unroll
    for (int hh = 0; hh < 2; ++hh) { kkp[hh] = a.in[I_KK][l * 512 + (2 * hp + hh) * 64 + lane]; kap[hh] = a.in[I_KA][l * 512 + (2 * hp + hh) * 64 + lane]; }
    float sa[64], sb[64];
    const int seq = pc < 2 ? 0 : 1, tbase = pc < 2 ? pc * TCH : (pc - 2) * TCH;
    const int slot = pc == 1 ? NCH - 1 : pc - 2;
    if (pc == 0) {
#pragma unroll
        for (int j = 0; j < 64; ++j) { sa[j] = 0.f; sb[j] = 0.f; }
    } else {
        const float* S0 = (const float*)(F.ws + WS_QST) + ((size_t)(d * 8 + hme) * NCH + slot) * 4096 + ri * 64;
#pragma unroll
        for (int j4 = 0; j4 < 16; ++j4) { const f32x4 t = *(const f32x4*)(S0 + 4 * j4), u = *(const f32x4*)(S0 + 2048 + 4 * j4);
            sa[4 * j4] = t[0]; sa[4 * j4 + 1] = t[1]; sa[4 * j4 + 2] = t[2]; sa[4 * j4 + 3] = t[3]; sb[4 * j4] = u[0]; sb[4 * j4 + 1] = u[1]; sb[4 * j4 + 2] = u[2]; sb[4 * j4 + 3] = u[3]; }
    }
    unsigned rka[2][RWB3], rlr[2][RWB3], rvv[RWB3]; float rn[2][RWB3];
#define RW_LOAD(bi) do { _Pragma("unroll") for (int s = 0; s < RWB3; ++s) { const size_t row = (size_t)rw_row2(d, seq, tbase + (bi) * RWB3 + s); \
        _Pragma("unroll") for (int hh = 0; hh < 2; ++hh) { const int c = (2 * hp + hh) * 64 + lane; \
            rka[hh][s] = (unsigned)RKV[row * RKV_LD + 512 + c] | ((unsigned)LO[row * LO_LD + 1024 + d * 512 + c] << 16); \
            rlr[hh][s] = (unsigned)LO[row * LO_LD + d * 512 + c] | ((unsigned)RKV[row * RKV_LD + c] << 16); rn[hh][s] = KN[row * 8 + 2 * hp + hh]; } \
        rvv[s] = (unsigned)RKV[row * RKV_LD + 1024 + hme * 64 + ri] | ((unsigned)RKV[row * RKV_LD + 1024 + hme * 64 + ri + 32] << 16); } } while (0)
    RW_LOAD(0);
    for (int bi = 0; bi < TCH / RWB3; ++bi) {
        float va[RWB3], vb_[RWB3];
#pragma unroll
        for (int s = 0; s < RWB3; ++s) {
            va[s] = lo_bf(rvv[s]); vb_[s] = hi_bf(rvv[s]);
#pragma unroll
            for (int hh = 0; hh < 2; ++hh) {
                const float k = lo_bf(rka[hh][s]), av = hi_bf(rka[hh][s]), lw = lo_bf(rlr[hh][s]);
                const float kk = k * kkp[hh] * rn[hh][s];
                LAS float* o = sl + ((s * 2 + hh) * 5) * 64 + lane;
                o[0] = kk; o[64] = __expf(lw); o[128] = kk * av; o[192] = k * (1.f + (av - 1.f) * kap[hh]); o[256] = hi_bf(rlr[hh][s]);
            }
        }
        if (bi + 1 < TCH / RWB3) RW_LOAD(bi + 1);
        LDS_WAIT();
#pragma unroll 1
        for (int s = 0; s < RWB3; ++s) {
            const LAS float* base = sl + ((s * 2 + hs) * 5) * 64;
            const LAS f32x4* vk = (const LAS f32x4*)(base); const LAS f32x4* vw = (const LAS f32x4*)(base + 64);
            const LAS f32x4* vb = (const LAS f32x4*)(base + 128); const LAS f32x4* vd = (const LAS f32x4*)(base + 192); const LAS f32x4* vr = (const LAS f32x4*)(base + 256);
            float q0 = 0.f, q1 = 0.f, p0 = 0.f, p1 = 0.f;
            f32x4 kc = vk[0], kn = vk[1];
#pragma unroll
            for (int j4 = 0; j4 < 16; ++j4) {
                f32x4 kf = kn; if (j4 + 2 < 16) kf = vk[j4 + 2];
                q0 -= sa[4 * j4] * kc[0]; q1 -= sa[4 * j4 + 1] * kc[1]; q0 -= sa[4 * j4 + 2] * kc[2]; q1 -= sa[4 * j4 + 3] * kc[3];
                p0 -= sb[4 * j4] * kc[0]; p1 -= sb[4 * j4 + 1] * kc[1]; p0 -= sb[4 * j4 + 2] * kc[2]; p1 -= sb[4 * j4 + 3] * kc[3];
                kc = kn; kn = kf; __builtin_amdgcn_sched_barrier(0); }
            const float saa = q0 + q1, sab = p0 + p1;
            float via = va[0], vib = vb_[0];
#pragma unroll
            for (int s2 = 1; s2 < RWB3; ++s2) { via = (s == s2) ? va[s2] : via; vib = (s == s2) ? vb_[s2] : vib; }
            f32x2 ya2 = {0.f, 0.f}, yb2 = {0.f, 0.f};
            f32x4 wc_ = vw[0], bc = vb[0], dc = vd[0], rc = vr[0];
#pragma unroll
            for (int j4 = 0; j4 < 16; ++j4) {
                f32x4 wn = wc_, bn = bc, dn = dc, rn_ = rc; if (j4 + 1 < 16) { wn = vw[j4 + 1]; bn = vb[j4 + 1]; dn = vd[j4 + 1]; rn_ = vr[j4 + 1]; }
#pragma unroll
                for (int e2 = 0; e2 < 2; ++e2) {
                    const f32x2 w2 = {wc_[2 * e2], wc_[2 * e2 + 1]}, b2 = {bc[2 * e2], bc[2 * e2 + 1]}, d2 = {dc[2 * e2], dc[2 * e2 + 1]}, r2 = {rc[2 * e2], rc[2 * e2 + 1]};
                    const f32x2 oa = {sa[4 * j4 + 2 * e2], sa[4 * j4 + 2 * e2 + 1]}, ob = {sb[4 * j4 + 2 * e2], sb[4 * j4 + 2 * e2 + 1]};
                    const f32x2 na = oa * w2 + (b2 * saa + d2 * via), nb = ob * w2 + (b2 * sab + d2 * vib);
                    sa[4 * j4 + 2 * e2] = na[0]; sa[4 * j4 + 2 * e2 + 1] = na[1]; sb[4 * j4 + 2 * e2] = nb[0]; sb[4 * j4 + 2 * e2 + 1] = nb[1];
                    ya2 += na * r2; yb2 += nb * r2; }
                wc_ = wn; bc = bn; dc = dn; rc = rn_; __builtin_amdgcn_sched_barrier(0); }
            const int row = rw_row2(d, seq, tbase + bi * RWB3 + s);
            bf16_t* yo = Y + (size_t)row * 512 + hme * 64 + ri;
            yo[0] = (bf16_t)(cvtpk(ya2[0] + ya2[1], 0.f) & 0xffffu); yo[32] = (bf16_t)(cvtpk(yb2[0] + yb2[1], 0.f) & 0xffffu);
        }
        LDS_WAIT();
    }
#undef RW_LOAD
}

namespace rwmm {
#define RW_BAR() asm volatile("s_waitcnt lgkmcnt(0)\n\ts_barrier" ::: "memory")
constexpr int PITCH = 144, MB = 64 * PITCH;
enum { B_PR = 0, B_PT, B_QR, B_QT, B_KR, B_KT, B_VR, B_RT, B_W0, B_W1, B_W2, B_W3, B_W4, B_W5, B_SB, B_NBUF };
constexpr int OFF_GC = B_NBUF * MB, OFF_TOT = OFF_GC + 256, LDS_END = OFF_TOT + 8 * 64 * 4;
static_assert(LDS_END <= 146432, "rwmm LDS");
__device__ __forceinline__ LAS unsigned char* buf(LAS unsigned char* lds, int b) { return lds + b * MB; }
__device__ __forceinline__ f32x16 mm_acc(LAS const unsigned char* A, LAS const unsigned char* B, int mt, int nt, int r32, int hi, f32x16 acc) {
    LAS const unsigned char* ap = A + (32 * mt + r32) * PITCH + hi * 16; LAS const unsigned char* bp = B + (32 * nt + r32) * PITCH + hi * 16;
#pragma unroll
    for (int ks = 0; ks < 4; ++ks) acc = __builtin_amdgcn_mfma_f32_32x32x16_bf16(*(LAS const bf16x8*)(ap + ks * 32), *(LAS const bf16x8*)(bp + ks * 32), acc, 0, 0, 0);
    return acc;
}
__device__ __forceinline__ void store_T(const f32x16& c, LAS unsigned char* b, int mt, int nt, int r32, int hi) {
#pragma unroll
    for (int g = 0; g < 4; ++g) { u32x2 w = {cvtpk(c[4 * g], c[4 * g + 1]), cvtpk(c[4 * g + 2], c[4 * g + 3])}; *(LAS u32x2*)(b + (32 * nt + r32) * PITCH + (32 * mt + 8 * g + 4 * hi) * 2) = w; }
}
__device__ __forceinline__ void store_N(const f32x16& c, LAS unsigned char* b, int mt, int nt, int r32, int hi) {
#pragma unroll
    for (int r = 0; r < 16; ++r) *(LAS bf16_t*)(b + (32 * mt + crow(r, hi)) * PITCH + (32 * nt + r32) * 2) = (bf16_t)(cvtpk(c[r], 0.f) & 0xffffu);
}
__device__ __forceinline__ f32x16 load_T(LAS const unsigned char* b, int mt, int nt, int r32, int hi) {
    f32x16 c;
#pragma unroll
    for (int g = 0; g < 4; ++g) { const u32x2 w = *(LAS const u32x2*)(b + (32 * nt + r32) * PITCH + (32 * mt + 8 * g + 4 * hi) * 2); c[4 * g] = lo_bf(w.x); c[4 * g + 1] = hi_bf(w.x); c[4 * g + 2] = lo_bf(w.y); c[4 * g + 3] = hi_bf(w.y); }
    return c;
}
template <bool STRICT> __device__ __forceinline__ void mask_upper(f32x16& c, int mt, int nt, int r32, int hi) {
#pragma unroll
    for (int r = 0; r < 16; ++r) { const int s = 32 * mt + crow(r, hi), t = 32 * nt + r32; const bool keep = STRICT ? (s < t) : (s <= t); c[r] = keep ? c[r] : 0.f; }
}

struct Raw { unsigned ka[8], lr[8], vv[4]; float kn[8]; };
__device__ __forceinline__ void prep_load(const Frame& F, int d, int h, int seq, int t0, Raw& R_) {
    const bf16_t* RKV = (const bf16_t*)(F.ws + WS_RKV); const bf16_t* LO = (const bf16_t*)(F.ws + WS_LO); const float* KN = (const float*)(F.ws + WS_KN);
    const int c = h * 64 + F.lane;
    const unsigned cu = (unsigned)c;
#pragma unroll
    for (int e = 0; e < 8; ++e) { const int row = __builtin_amdgcn_readfirstlane(rw_row2(d, seq, t0 + 8 * F.wave + e));
        const bf16_t* rb = RKV + (size_t)row * RKV_LD; const bf16_t* lb = LO + (size_t)row * LO_LD + d * 512;
        R_.ka[e] = (unsigned)rb[512u + cu] | ((unsigned)lb[1024u + cu] << 16);
        R_.lr[e] = (unsigned)lb[cu] | ((unsigned)rb[cu] << 16);
        const unsigned v = rb[1024u + cu]; if (e & 1) R_.vv[e >> 1] |= v << 16; else R_.vv[e >> 1] = v;
        R_.kn[e] = KN[row * 8 + h]; }
}
template <bool PASS3> __device__ __forceinline__ void prep(const Frame& F, const Args& a, int l, int h, const Raw& R_) {
    LAS unsigned char* lds = F.lds; const int lane = F.lane, w = F.wave, c = h * 64 + lane;
    const float kkp = a.in[I_KK][l * 512 + c], kap = a.in[I_KA][l * 512 + c];
    float G[8]; float run = 0.f;
#pragma unroll
    for (int e = 0; e < 8; ++e) { run += lo_bf(R_.lr[e]); G[e] = run; }
    LAS float* tot = (LAS float*)(lds + OFF_TOT);
    tot[w * 64 + lane] = run;
    RW_BAR();
    float off = 0.f;
#pragma unroll
    for (int ww = 0; ww < 7; ++ww) off += (ww < w) ? tot[ww * 64 + lane] : 0.f;
    unsigned pr[4], qr_[4], kr_[4];
#pragma unroll
    for (int e2 = 0; e2 < 4; ++e2) {
        float Pv[2], Qv[2], Kv[2];
#pragma unroll
        for (int u = 0; u < 2; ++u) { const int e = 2 * e2 + u, t = 8 * w + e;
            const float k = lo_bf(R_.ka[e]), av = hi_bf(R_.ka[e]), lw = lo_bf(R_.lr[e]), rr = hi_bf(R_.lr[e]);
            const float kx = k * kkp * R_.kn[e], kd = k * (1.f + (av - 1.f) * kap);
            const float g = G[e] + off; const float gam = __expf(g), inv = __expf(-g), gprev = __expf(g - lw);
            Pv[u] = -kx * gprev; Qv[u] = kx * av * inv; Kv[u] = kd * inv; const float Rv = rr * gam;
            *(LAS bf16_t*)(buf(lds, B_PT) + t * PITCH + lane * 2) = (bf16_t)(cvtpk(Pv[u], 0.f) & 0xffffu);
            *(LAS bf16_t*)(buf(lds, B_QT) + t * PITCH + lane * 2) = (bf16_t)(cvtpk(Qv[u], 0.f) & 0xffffu);
            *(LAS bf16_t*)(buf(lds, B_KT) + t * PITCH + lane * 2) = (bf16_t)(cvtpk(Kv[u], 0.f) & 0xffffu);
            if (PASS3) *(LAS bf16_t*)(buf(lds, B_RT) + t * PITCH + lane * 2) = (bf16_t)(cvtpk(Rv, 0.f) & 0xffffu);
            if (t == 63) ((LAS float*)(lds + OFF_GC))[lane] = gam; }
        pr[e2] = cvtpk(Pv[0], Pv[1]); qr_[e2] = cvtpk(Qv[0], Qv[1]); kr_[e2] = cvtpk(Kv[0], Kv[1]);
    }
    *(LAS u32x4*)(buf(lds, B_PR) + lane * PITCH + w * 16) = (u32x4){pr[0], pr[1], pr[2], pr[3]};
    *(LAS u32x4*)(buf(lds, B_QR) + lane * PITCH + w * 16) = (u32x4){qr_[0], qr_[1], qr_[2], qr_[3]};
    *(LAS u32x4*)(buf(lds, B_KR) + lane * PITCH + w * 16) = (u32x4){kr_[0], kr_[1], kr_[2], kr_[3]};
    *(LAS u32x4*)(buf(lds, B_VR) + lane * PITCH + w * 16) = (u32x4){R_.vv[0], R_.vv[1], R_.vv[2], R_.vv[3]};
    RW_BAR();
}

__device__ __forceinline__ f32x16 mm_accT(LAS const unsigned char* At, LAS const unsigned char* B, int mt, int nt, int lane, f32x16 acc) {
    const int r32 = lane & 31, hi = lane >> 5;
    LAS const unsigned char* ap = At + (8 * hi + ((lane & 15) >> 2)) * PITCH + (32 * mt + 16 * ((lane >> 4) & 1) + 4 * (lane & 3)) * 2;
    LAS const unsigned char* bp = B + (32 * nt + r32) * PITCH + hi * 16;
#pragma unroll
    for (int ks = 0; ks < 4; ++ks) { const s16x4 lo = vtr(ap + ks * 16 * PITCH), hh = vtr(ap + ks * 16 * PITCH + 4 * PITCH);
        const bf16x8 af = {lo[0], lo[1], lo[2], lo[3], hh[0], hh[1], hh[2], hh[3]};
        acc = __builtin_amdgcn_mfma_f32_32x32x16_bf16(af, *(LAS const bf16x8*)(bp + ks * 32), acc, 0, 0, 0); }
    return acc;
}
template <bool PASS3> __device__ __forceinline__ void core(const Frame& F, bool sT  , f32x16& vk, f32x16& ye) {
    LAS unsigned char* lds = F.lds; const int lane = F.lane, r32 = lane & 31, hi = lane >> 5, q = F.wave & 3, mt = q >> 1, nt = q & 1; const bool g0 = F.wave < 4;
    const f32x16 Z16 = f32x16{};
    f32x16 Tacc = Z16, a1 = Z16;
    if (g0) { f32x16 n = mm_acc(buf(lds, B_QT), buf(lds, B_PT), mt, nt, r32, hi, Z16); mask_upper<true>(n, mt, nt, r32, hi); store_T(n, buf(lds, B_W0), mt, nt, r32, hi);
        Tacc = n;
#pragma unroll
        for (int r = 0; r < 16; ++r) Tacc[r] += (mt == nt && crow(r, hi) == r32) ? 1.f : 0.f;
        store_T(Tacc, buf(lds, B_W2), mt, nt, r32, hi);
    } else { f32x16 m = mm_acc(buf(lds, B_KT), buf(lds, B_PT), mt, nt, r32, hi, Z16); mask_upper<true>(m, mt, nt, r32, hi); store_T(m, buf(lds, B_W3), mt, nt, r32, hi); }
    RW_BAR();
    if (!g0) { const f32x16 n2 = mm_accT(buf(lds, B_W0), buf(lds, B_W0), mt, nt, lane, Z16); store_T(n2, buf(lds, B_W1), mt, nt, r32, hi); }
    else if (PASS3) { f32x16 g3 = mm_acc(buf(lds, B_QT), buf(lds, B_RT), mt, nt, r32, hi, Z16); mask_upper<false>(g3, mt, nt, r32, hi); store_T(g3, buf(lds, B_W4), mt, nt, r32, hi); }
    else { const f32x16 vm = mm_acc(buf(lds, B_VR), buf(lds, B_W3), mt, nt, r32, hi, Z16); store_T(vm, buf(lds, B_W4), mt, nt, r32, hi); }
    RW_BAR();
#pragma unroll
    for (int k = 0; k < 4; ++k) {
        const int cP = (k & 1) ? B_W0 : B_W1, nP = (k & 1) ? B_W1 : B_W0, tIn = (k & 1) ? B_W5 : B_W2, tOut = (k & 1) ? B_W2 : B_W5;
        if (!g0) { const f32x16 p2 = mm_accT(buf(lds, cP), buf(lds, cP), mt, nt, lane, Z16); store_T(p2, buf(lds, nP), mt, nt, r32, hi);
            if (PASS3) {
                if (k == 0) { f32x16 g4 = mm_acc(buf(lds, B_KT), buf(lds, B_RT), mt, nt, r32, hi, Z16); mask_upper<false>(g4, mt, nt, r32, hi); store_T(g4, buf(lds, B_QT), mt, nt, r32, hi); }
                if (k == 1) ye = sT ? mm_accT(buf(lds, B_SB), buf(lds, B_RT), mt, nt, lane, Z16) : mm_acc(buf(lds, B_SB), buf(lds, B_RT), mt, nt, r32, hi, Z16);
                if (k == 2) ye = mm_acc(buf(lds, B_VR), buf(lds, B_QT), mt, nt, r32, hi, ye);
            }
        } else { Tacc = mm_accT(buf(lds, tIn), buf(lds, cP), mt, nt, lane, Tacc); store_T(Tacc, buf(lds, tOut), mt, nt, r32, hi);
            if (PASS3) {
                if (k == 0) a1 = sT ? mm_accT(buf(lds, B_SB), buf(lds, B_PT), mt, nt, lane, Z16) : mm_acc(buf(lds, B_SB), buf(lds, B_PT), mt, nt, r32, hi, Z16);
                if (k == 1) { a1 = mm_acc(buf(lds, B_VR), buf(lds, B_W3), mt, nt, r32, hi, a1); store_T(a1, buf(lds, B_KT), mt, nt, r32, hi); }
                if (k == 2) vk = mm_acc(buf(lds, B_VR), buf(lds, B_KR), mt, nt, r32, hi, Z16);
            }
        }
        RW_BAR();
    }
    if (g0) { Tacc = mm_accT(buf(lds, B_W2), buf(lds, B_W1), mt, nt, lane, Tacc); store_T(Tacc, buf(lds, B_W5), mt, nt, r32, hi); }
    else if (!PASS3) vk = mm_acc(buf(lds, B_VR), buf(lds, B_KR), mt, nt, r32, hi, Z16);
    RW_BAR();
    if (g0) { const f32x16 e = mm_accT(buf(lds, B_W5), buf(lds, B_QR), mt, nt, lane, Z16); store_T(e, buf(lds, B_W0), mt, nt, r32, hi); }
    else if (PASS3) { const f32x16 f = mm_accT(buf(lds, B_W5), buf(lds, B_W4), mt, nt, lane, Z16); store_T(f, buf(lds, B_W1), mt, nt, r32, hi); }
    RW_BAR();
}

__device__ __forceinline__ void pass1_item(const Frame& F, const Args& a, int l, int d, int h, int ci) {
    LAS unsigned char* lds = F.lds; const int lane = F.lane, r32 = lane & 31, hi = lane >> 5, q = F.wave & 3, mt = q >> 1, nt = q & 1; const bool g0 = F.wave < 4;
    const bool ctx = ci == 0; const int nsub = ctx ? 4 : 2, seq = ctx ? 0 : 1, tb = ctx ? 0 : (ci - 1) * TCH;
    float* Qs = (float*)(F.ws + WS_QST) + (size_t)(d * 8 + h) * NCH * 4096; bf16_t* PTg = (bf16_t*)(F.ws + WS_PST) + ((size_t)(d * 8 + h) * NCH + ci) * 4096;
    const f32x16 Z16 = f32x16{};
    for (int sb = 0; sb < nsub; ++sb) {
        { Raw raw; prep_load(F, d, h, seq, tb + 64 * sb, raw); prep<false>(F, a, l, h, raw); }
        f32x16 vk = Z16, ye = Z16;
        core<false>(F, false, vk, ye);
        const float gc = ((LAS const float*)(lds + OFF_GC))[32 * nt + r32];
        f32x16 pq = Z16;
        if (g0) { if (!ctx) { pq = mm_acc(buf(lds, B_PR), buf(lds, B_W0), mt, nt, r32, hi, Z16);
#pragma unroll
                for (int r = 0; r < 16; ++r) pq[r] = (pq[r] + ((mt == nt && crow(r, hi) == r32) ? 1.f : 0.f)) * gc;
                store_T(pq, buf(lds, B_W2), mt, nt, r32, hi); if (sb == 0) store_T(pq, buf(lds, B_SB), mt, nt, r32, hi); }
            else if (sb > 0) { pq = mm_acc(buf(lds, B_PR), buf(lds, B_W0), mt, nt, r32, hi, Z16);
#pragma unroll
                for (int r = 0; r < 16; ++r) pq[r] = (pq[r] + ((mt == nt && crow(r, hi) == r32) ? 1.f : 0.f)) * gc;
                store_T(pq, buf(lds, B_W2), mt, nt, r32, hi); }
        } else { pq = mm_accT(buf(lds, B_W4), buf(lds, B_W0), mt, nt, lane, vk);
#pragma unroll
            for (int r = 0; r < 16; ++r) pq[r] *= gc;
            if (sb == 0) store_T(pq, buf(lds, B_RT), mt, nt, r32, hi); }
        RW_BAR();
        if (sb > 0) {
            if (g0) { if (!ctx) pq = mm_accT(buf(lds, B_SB), buf(lds, B_W2), mt, nt, lane, Z16); }
            else pq = mm_accT(buf(lds, B_RT), buf(lds, B_W2), mt, nt, lane, pq);
            RW_BAR();
            const bool last = sb == nsub - 1;
            if (!g0) {
                if (!last) store_T(pq, buf(lds, B_RT), mt, nt, r32, hi);
                if (last || (ctx && sb == 1)) {
                    float* o = Qs + (size_t)((ctx && sb == 1) ? NCH - 1 : ci) * 4096;
#pragma unroll
                    for (int r = 0; r < 16; ++r) o[(32 * mt + crow(r, hi)) * 64 + 32 * nt + r32] = pq[r];
                }
            } else if (!ctx) {
                if (!last) store_T(pq, buf(lds, B_SB), mt, nt, r32, hi);
                else {
#pragma unroll
                    for (int g = 0; g < 4; ++g) { const int pos = (mt << 5) | ((g >> 1) << 4) | (hi << 3) | ((g & 1) << 2);
                        u32x2 wv = {cvtpk(pq[4 * g], pq[4 * g + 1]), cvtpk(pq[4 * g + 2], pq[4 * g + 3])}; *(u32x2*)(PTg + (32 * nt + r32) * 64 + pos) = wv; }
                }
            }
            RW_BAR();
        }
    }
}
__device__ __forceinline__ void pass3_item(const Frame& F, const Args& a, int l, int d, int h, int pc) {
    LAS unsigned char* lds = F.lds; const int lane = F.lane, r32 = lane & 31, hi = lane >> 5, q = F.wave & 3, mt = q >> 1, nt = q & 1; const bool g0 = F.wave < 4;
    const int seq = pc < 2 ? 0 : 1, tb = pc < 2 ? pc * TCH : (pc - 2) * TCH, slot = pc == 1 ? NCH - 1 : pc - 2;
    bf16_t* Y = (bf16_t*)(F.ws + (d == 0 ? WS_YF : WS_YBK));
    const float* S0g = (const float*)(F.ws + WS_QST) + ((size_t)(d * 8 + h) * NCH + slot) * 4096;
    { const int i = F.tid >> 3, c8 = (F.tid & 7) * 8; u32x4 wv = {0u, 0u, 0u, 0u};
      if (pc != 0) { const float* S0 = S0g + i * 64 + c8; const f32x4 x0 = *(const f32x4*)S0, x1 = *(const f32x4*)(S0 + 4);
          wv = (u32x4){cvtpk(x0[0], x0[1]), cvtpk(x0[2], x0[3]), cvtpk(x1[0], x1[1]), cvtpk(x1[2], x1[3])}; }
      *(LAS u32x4*)(buf(lds, B_SB) + i * PITCH + c8 * 2) = wv; }
    const f32x16 Z16 = f32x16{};
    for (int sb = 0; sb < 2; ++sb) {
        { Raw raw; prep_load(F, d, h, seq, tb + 64 * sb, raw); prep<true>(F, a, l, h, raw); }
        f32x16 vk = Z16, ye = Z16;
        core<true>(F, sb == 1, vk, ye);
        f32x16 s1 = Z16;
        if (!g0) {
            const f32x16 y = mm_accT(buf(lds, B_KT), buf(lds, B_W1), mt, nt, lane, ye);
            const size_t row = (size_t)rw_row2(d, seq, tb + 64 * sb + 32 * nt + r32);
#pragma unroll
            for (int g = 0; g < 4; ++g) { u32x2 wv = {cvtpk(y[4 * g], y[4 * g + 1]), cvtpk(y[4 * g + 2], y[4 * g + 3])}; *(u32x2*)(Y + row * 512 + h * 64 + 32 * mt + 8 * g + 4 * hi) = wv; }
        } else if (sb == 0) {
            const float gc = ((LAS const float*)(lds + OFF_GC))[32 * nt + r32];
            s1 = vk;
            if (pc != 0) {
#pragma unroll
                for (int r = 0; r < 16; ++r) s1[r] += S0g[(32 * mt + crow(r, hi)) * 64 + 32 * nt + r32]; }
            s1 = mm_accT(buf(lds, B_KT), buf(lds, B_W0), mt, nt, lane, s1);
#pragma unroll
            for (int r = 0; r < 16; ++r) s1[r] *= gc;
        }
        RW_BAR();
        if (g0 && sb == 0) store_T(s1, buf(lds, B_SB), mt, nt, r32, hi);
        RW_BAR();
    }
}
#undef RW_BAR
}

__device__ __forceinline__ void norm2_route_rows(const Frame& F, const Args& a, int l, const float* src, const float* g, const float* sh, const float* sc) {
    bf16_t* H = (bf16_t*)(F.ws + WS_H);
    int* ridx = (int*)(F.ws + WS_RT_IDX); int* rpos = (int*)(F.ws + WS_RT_POS); float* rgate = (float*)(F.ws + WS_RT_GATE);
    unsigned* cnt = (unsigned*)(F.ws + WS_CTL) + CW_MOECNT;
    const float* rw = a.in[I_ROUTER];
    f32x4 ca[4], cb[4];
#pragma unroll
    for (int j = 0; j < 4; ++j) { const int d = F.lane * 4 + 256 * j; const f32x4 gg = *(const f32x4*)(g + d), s1 = *(const f32x4*)(sc + d); ca[j] = gg * (s1 + 1.0f); cb[j] = *(const f32x4*)(sh + d); }
    const int gw = F.vcu * NWAVES + F.wave, NGW = F.G * NWAVES;
    for (int m = gw; m < L; m += NGW) {
        const f32x4* xr = (const f32x4*)(src + (size_t)m * DM) + F.lane;
        f32x4 v[4]; float s = 0.f;
#pragma unroll
        for (int j = 0; j < 4; ++j) { v[j] = xr[64 * j]; s += (v[j].x * v[j].x + v[j].y * v[j].y) + (v[j].z * v[j].z + v[j].w * v[j].w); }
        const float rstd = rsqrtf(wave_sum(s) * (1.f / DM) + NORM_EPS);
        u32x2* o8 = (u32x2*)(H + (size_t)m * DM) + F.lane;
        float lg[8] = {0.f, 0.f, 0.f, 0.f, 0.f, 0.f, 0.f, 0.f};
#pragma unroll
        for (int j = 0; j < 4; ++j) { const f32x4 y = v[j] * rstd * ca[j] + cb[j]; u32x2 w; w.x = cvtpk(y.x, y.y); w.y = cvtpk(y.z, y.w); o8[64 * j] = w;
            const float* rp = rw + (size_t)(F.lane * 4 + 256 * j) * 8;
#pragma unroll
            for (int e4 = 0; e4 < 4; ++e4) { const f32x4 w0 = *(const f32x4*)(rp + e4 * 8), w1 = *(const f32x4*)(rp + e4 * 8 + 4);
                const float yy = y[e4];
                lg[0] += yy * w0[0]; lg[1] += yy * w0[1]; lg[2] += yy * w0[2]; lg[3] += yy * w0[3]; lg[4] += yy * w1[0]; lg[5] += yy * w1[1]; lg[6] += yy * w1[2]; lg[7] += yy * w1[3]; } }
#pragma unroll
        for (int e = 0; e < 8; ++e) lg[e] = wave_sum(lg[e]);
        if (F.lane == 0) {
            int i1 = 0; float l1 = lg[0];
#pragma unroll
            for (int e = 1; e < 8; ++e) if (lg[e] > l1) { l1 = lg[e]; i1 = e; }
            int i2 = -1; float l2 = -3.0e38f;
#pragma unroll
            for (int e = 0; e < 8; ++e) if (e != i1 && lg[e] > l2) { l2 = lg[e]; i2 = e; }
            const float g2v = 1.f / (1.f + __expf(l1 - l2)), g1v = 1.f - g2v;
            const unsigned p1 = __hip_atomic_fetch_add(cnt + 64 * i1, 1u, __ATOMIC_RELAXED, __HIP_MEMORY_SCOPE_AGENT);
            const unsigned p2 = __hip_atomic_fetch_add(cnt + 64 * i2, 1u, __ATOMIC_RELAXED, __HIP_MEMORY_SCOPE_AGENT);
            ridx[2 * m] = i1; ridx[2 * m + 1] = i2; rpos[2 * m] = (int)p1; rpos[2 * m + 1] = (int)p2; rgate[2 * m] = g1v; rgate[2 * m + 1] = g2v;
        }
    }
}
__device__ __forceinline__ void moe_tile_bases(const Frame& F, int (&tb)[9]) {
    const unsigned* cnt = (const unsigned*)(F.ws + WS_CTL) + CW_MOECNT;
    int acc = 0;
#pragma unroll
    for (int e = 0; e < 8; ++e) { tb[e] = acc; const unsigned c = __hip_atomic_load(cnt + 64 * e, __ATOMIC_RELAXED, __HIP_MEMORY_SCOPE_AGENT); acc += (int)((c + 255u) >> 8); }
    tb[8] = acc;
}
__device__ __forceinline__ void moe_gather(const Frame& F) {
    const bf16_t* H = (const bf16_t*)(F.ws + WS_H); bf16_t* H2G = (bf16_t*)(F.ws + WS_H2G);
    const int* ridx = (const int*)(F.ws + WS_RT_IDX); const int* rpos = (const int*)(F.ws + WS_RT_POS); const float* rgate = (const float*)(F.ws + WS_RT_GATE);
    float* rowgate = (float*)(F.ws + WS_RT_ROWGATE);
    const unsigned* cnt = (const unsigned*)(F.ws + WS_CTL) + CW_MOECNT;
    int tb[9]; moe_tile_bases(F, tb);
    const int gw = F.vcu * NWAVES + F.wave, NGW = F.G * NWAVES;
    for (int m = gw; m < L; m += NGW) {
        const u32x4 r0 = *((const u32x4*)(H + (size_t)m * DM) + F.lane), r1 = *((const u32x4*)(H + (size_t)m * DM) + 64 + F.lane);
#pragma unroll
        for (int s = 0; s < 2; ++s) {
            const int e = ridx[2 * m + s]; int base = 0;
#pragma unroll
            for (int k = 0; k < 8; ++k) base = (e == k) ? tb[k] : base;
            const size_t row = (size_t)base * 256 + rpos[2 * m + s];
            *((u32x4*)(H2G + row * DM) + F.lane) = r0; *((u32x4*)(H2G + row * DM) + 64 + F.lane) = r1;
            if (F.lane == 0) rowgate[row] = rgate[2 * m + s];
        }
    }
#pragma unroll
    for (int e = 0; e < 8; ++e) {
        const int c = (int)__hip_atomic_load(cnt + 64 * e, __ATOMIC_RELAXED, __HIP_MEMORY_SCOPE_AGENT);
        const int lo = tb[e] * 256 + c, hi_ = tb[e + 1] * 256;
        for (int row = lo + gw; row < hi_; row += NGW) { *((u32x4*)(H2G + (size_t)row * DM) + F.lane) = (u32x4){0u, 0u, 0u, 0u}; *((u32x4*)(H2G + (size_t)row * DM) + 64 + F.lane) = (u32x4){0u, 0u, 0u, 0u}; if (F.lane == 0) rowgate[row] = 0.f; }
    }
}
__device__ __forceinline__ void moe_combine(const Frame& F, float* out, const float* gt2) {
    const bf16_t* YS = (const bf16_t*)(F.ws + WS_H2G);
    const int* ridx = (const int*)(F.ws + WS_RT_IDX); const int* rpos = (const int*)(F.ws + WS_RT_POS);
    int tb[9]; moe_tile_bases(F, tb);
    const int gw = F.vcu * NWAVES + F.wave, NGW = F.G * NWAVES;
    for (int m = gw; m < L; m += NGW) {
        size_t rows[2];
#pragma unroll
        for (int s = 0; s < 2; ++s) { const int e = ridx[2 * m + s]; int base = 0;
#pragma unroll
            for (int k = 0; k < 8; ++k) base = (e == k) ? tb[k] : base;
            rows[s] = (size_t)base * 256 + rpos[2 * m + s]; }
#pragma unroll
        for (int hf = 0; hf < 2; ++hf) {
            const int c0 = hf * 512 + F.lane * 8;
            const u32x4 a0 = *(const u32x4*)(YS + rows[0] * DM + c0), a1 = *(const u32x4*)(YS + rows[1] * DM + c0);
            float* op = out + (size_t)m * DM + c0;
            const f32x4 g0 = *(const f32x4*)(gt2 + c0), g1 = *(const f32x4*)(gt2 + c0 + 4);
            f32x4 x0 = *(const f32x4*)op, x1 = *(const f32x4*)(op + 4);
            x0 += g0 * (f32x4){lo_bf(a0.x) + lo_bf(a1.x), hi_bf(a0.x) + hi_bf(a1.x), lo_bf(a0.y) + lo_bf(a1.y), hi_bf(a0.y) + hi_bf(a1.y)};
            x1 += g1 * (f32x4){lo_bf(a0.z) + lo_bf(a1.z), hi_bf(a0.z) + hi_bf(a1.z), lo_bf(a0.w) + lo_bf(a1.w), hi_bf(a0.w) + hi_bf(a1.w)};
            *(f32x4*)op = x0; *(f32x4*)(op + 4) = x1;
        }
    }
}

#ifndef PROBE_MOE
#define PROBE_MOE 1
#endif
#ifndef PROBE_NA
#define PROBE_NA 1
#endif
#ifndef PROBE_MLA
#define PROBE_MLA 1
#endif
#ifndef PROBE_GEMM
#define PROBE_GEMM 1
#endif
#ifndef PROBE_RW1
#define PROBE_RW1 1
#endif
#ifndef REP_MLA
#define REP_MLA 1
#endif
#ifndef REP_NA
#define REP_NA 1
#endif
#ifndef REP_RW1
#define REP_RW1 1
#endif
#ifndef REP_RW3
#define REP_RW3 1
#endif
#ifndef REP_GEMM
#define REP_GEMM 1
#endif
#ifndef REP_ROW
#define REP_ROW 1
#endif
constexpr int PH_PER_LAYER = 24;
constexpr int N_PHASES = 1 + 2 * PH_PER_LAYER;
__global__ void __launch_bounds__(NTHR, 2) mega_fwd(Args args) {
    extern __shared__ __attribute__((aligned(16))) unsigned char lds_raw[];
    Frame F;
    F.lds = (LAS unsigned char*)lds_raw; F.ws = args.ws;
    F.tid = threadIdx.x; F.lane = F.tid & 63; F.wave = __builtin_amdgcn_readfirstlane((int)threadIdx.x >> 6);
    F.G = gridDim.x; F.bid = blockIdx.x; F.vcu = (F.G % 8 == 0) ? (F.bid % 8) * (F.G / 8) + F.bid / 8 : F.bid;
    volatile LAS unsigned* MISC = (volatile LAS unsigned*)(F.lds + LDS_MISC_OFF);
    if (F.tid < 64) MISC[F.tid] = 0u;
    __syncthreads();
    const int lo = args.ph_lo, hi = args.ph_hi;
    const bool multi = (hi - lo) > 1;
    XcdBarrier bar; bar.bar = (unsigned*)(F.ws + WS_CTL) + CW_BAR; bar.x = 0; bar.st = MISC + 8;
    if (multi) bar = xcd_barrier_post((unsigned*)(F.ws + WS_CTL) + CW_BAR, MISC + 8);
#define IN(k) (lo <= (k) && (k) < hi)
    const Frame F0 = F;
#define SEAM(k) do { if (multi) xcd_barrier(bar); } while (0)
    LAS unsigned char* lds = F.lds;
    float* MODV = (float*)(F.ws + WS_MODV);
    float* out = args.out;

    if (IN(0)) { const Frame F = launder(F0); prologue_mod(F, args); prologue_weights(F, args); }
    SEAM(0);

#pragma unroll
    for (int l = 0; l < 2; ++l) {
        const int pb = 1 + l * PH_PER_LAYER;
        const bool need_ctx = (l == 0);
        unsigned char* wb = F.ws + WS_W + (size_t)l * WB_SIZE;
        const float* modL = MODV + (size_t)(l * 2) * 6144; const float* modC = modL + 6144;
        float* X1 = (float*)(F.ws + WS_X1); float* CM = (float*)(F.ws + WS_CM);
        bf16_t* H = (bf16_t*)(F.ws + WS_H);
        const int nMall = R / 256, nMlat = L / 256;

        if (IN(pb + 0)) { const Frame F = launder(F0);
            if (l == 0) { norm_rows(F, args.in[I_X], 0, 0, L, args.in[I_N1G] + l * DM, modL, modL + 1024, H);
                          norm_rows(F, args.in[I_CTX], L, L, R, args.in[I_N1G] + l * DM, modC, modC + 1024, H); }
            else { norm_rows(F, X1, 0, 0, L, args.in[I_N1G] + l * DM, modL, modL + 1024, H);
                   norm_rows(F, X1, 0, L, R, args.in[I_N1G] + l * DM, modC, modC + 1024, H); }
        }
        SEAM(pb + 0);
        if (IN(pb + 1)) { const Frame F = launder(F0);
            pg8::Gemm g{H, DM, (const bf16_t*)(wb + WB_WINM), DM}; pg8::StaticOrder S; S.init(nMall, ZM_N / 256, F.G, F.bid, PROBE_GEMM);
            EpiZ E{(bf16_t*)(F.ws + WS_ZA), (bf16_t*)(F.ws + WS_ZN), (bf16_t*)(F.ws + WS_ZR)};
            pg8::gemm_phase(lds, F.tid, g, S, E);
        }
        SEAM(pb + 1);
        if (IN(pb + 2)) { const Frame F = launder(F0); prepare_rows(F, args, l); }
        SEAM(pb + 2);
        if (IN(pb + 3)) { const Frame F = launder(F0);
            { pg8::Gemm g{(const bf16_t*)(F.ws + WS_CQN), 384, (const bf16_t*)(wb + WB_WUQ), 384}; pg8::StaticOrder S; S.init(nMall, 3, F.G, F.bid, PROBE_GEMM);
              EpiBf E{(bf16_t*)(F.ws + WS_QRAW), 768}; pg8::gemm_phase(lds, F.tid, g, S, E); }
            { pg8::Gemm g{(const bf16_t*)(F.ws + WS_CKVN), 256, (const bf16_t*)(wb + WB_WUKV), 256}; pg8::StaticOrder S; S.init(nMall, 4, F.G, F.bid, PROBE_GEMM);
              EpiBf E{(bf16_t*)(F.ws + WS_KVRAW), 1024}; pg8::gemm_phase(lds, F.tid, g, S, E); }
            { pg8::Gemm g{(const bf16_t*)(F.ws + WS_LA), 384, (const bf16_t*)(wb + WB_WLORA), 384}; pg8::StaticOrder S; S.init(nMall, 10, F.G, F.bid, PROBE_GEMM);
              EpiLora E{(bf16_t*)(F.ws + WS_LO), args.in[I_W0] + (size_t)l * 1024, args.in[I_A0] + (size_t)l * 1024}; pg8::gemm_phase(lds, F.tid, g, S, E); }
        }
        SEAM(pb + 3);
        if (IN(pb + 4)) { const Frame F = launder(F0); mla_fixup(F, args, l, need_ctx); }
        SEAM(pb + 4);
        if (IN(pb + 5)) { const Frame F = launder(F0);
            const int xcd = F.bid % 8, idx = F.bid / 8, per = F.G / 8;
            for (int u0 = idx; u0 < 64 * PROBE_MLA + ((need_ctx && idx == 0) ? per : 0); u0 += per) { const int u = u0 >= 64 * PROBE_MLA ? 64 : u0 % 64;
                const bool cu = u >= 64;
                mla_unit(F, xcd, cu ? L : u * 256, cu ? L : 0, cu ? CT / 64 : R / 64);
            }
        }
        SEAM(pb + 5);
        if (IN(pb + 6)) { const Frame F = launder(F0);
            for (int it = F.bid; it < PROBE_RW1 * 16 * 128; it += F.G) { const int ci = (it >> 4) & 127, dh = it & 15;
                rwmm::pass1_item(F, args, l, dh >> 3, dh & 7, ci);
            }
        }
        SEAM(pb + 6);
        if (IN(pb + 7)) { const Frame F = launder(F0);
            const int nrw = F.G > 64 ? 16 : 0;
            if (F.bid < nrw) { if (F.wave < 2) rwkv_pass2(F, F.bid, F.wave); }
            else {
                if (nrw == 0 && F.bid < 16 && F.wave < 2) rwkv_pass2(F, F.bid, F.wave);
                __syncthreads();
                if (need_ctx && F.bid >= F.G - 32) { const int k = F.bid - (F.G - 32); rwmm::pass3_item(F, args, l, k >> 4, (k >> 1) & 7, k & 1); }
                const float* rpb_l = args.in[I_RPB] + (size_t)l * 8 * 465;
                for (int u0 = F.bid - nrw; u0 < PROBE_NA * 2 * (256 + (need_ctx ? 4 : 0)); u0 += F.G - nrw) { const int u = u0 % (2 * (256 + (need_ctx ? 4 : 0))); const int un = u >> 1; na_unit(F, rpb_l, un < 256 ? un : un - 256, un >= 256, u & 1); }
            }
        }
        SEAM(pb + 7);
        if (IN(pb + 8)) { const Frame F = launder(F0);
            for (int it = F.bid; it < 16 * 128; it += F.G) { const int dh = it & 15, pc = 2 + (it >> 4);
                rwmm::pass3_item(F, args, l, dh >> 3, dh & 7, pc);
            }
        }
        SEAM(pb + 8);
        if (IN(pb + 10)) { const Frame F = launder(F0);
            rwkv_output_rows(F, args, l, need_ctx ? R : L);
            __syncthreads();
            pg8::Gemm g{H, DM, (const bf16_t*)(wb + WB_WING), DM}; pg8::StaticOrder S; S.init(need_ctx ? nMall : nMlat, 12, F.G, F.bid, PROBE_GEMM);
            EpiBf E{(bf16_t*)(F.ws + WS_ZG), ZG_LD}; pg8::gemm_phase(lds, F.tid, g, S, E);
        }
        SEAM(pb + 10);
        if (IN(pb + 11)) { const Frame F = launder(F0);
            const int nM = need_ctx ? nMall : nMlat;
            float* U32 = (float*)(F.ws + WS_U32); bf16_t* U = (bf16_t*)(F.ws + WS_U); const bf16_t* ZG = (const bf16_t*)(F.ws + WS_ZG);
            { pg8::Gemm g{(const bf16_t*)(F.ws + WS_YA), 512, (const bf16_t*)(wb + WB_WOA), 512}; pg8::StaticOrder S; S.init(nM, 4, F.G, F.bid);
              EpiMerge<0> E{U32, U, ZG, 0}; pg8::gemm_phase(lds, F.tid, g, S, E); }
            { pg8::Gemm g{(const bf16_t*)(F.ws + WS_YB), 512, (const bf16_t*)(wb + WB_WOB), 512}; pg8::StaticOrder S; S.init(nM, 4, F.G, F.bid);
              EpiMerge<1> E{U32, U, ZG, 1024}; pg8::gemm_phase(lds, F.tid, g, S, E); }
            { pg8::Gemm g{(const bf16_t*)(F.ws + WS_YR), 512, (const bf16_t*)(wb + WB_WOR), 512}; pg8::StaticOrder S; S.init(nM, 4, F.G, F.bid);
              EpiMerge<2> E{U32, U, ZG, 2048}; pg8::gemm_phase(lds, F.tid, g, S, E); }
        }
        SEAM(pb + 11);
        if (IN(pb + 12)) { const Frame F = launder(F0);
            pg8::Gemm g{(const bf16_t*)(F.ws + WS_U), DM, (const bf16_t*)(wb + WB_WOUT), DM}; pg8::StaticOrder S; S.init(need_ctx ? nMall : nMlat, 4, F.G, F.bid, PROBE_GEMM);
            EpiRes E{l == 0 ? args.in[I_X] : X1, l == 0 ? args.in[I_CTX] : X1 + (size_t)L * DM, out, CM, modL + 2048, modC + 2048};
            pg8::gemm_phase(lds, F.tid, g, S, E);
        }
        SEAM(pb + 12);
        if (l == 0) {
            if (IN(pb + 13)) { const Frame F = launder(F0); norm_rows(F, out, 0, 0, L, args.in[I_N2G] + l * DM, modL + 3072, modL + 4096, H);
                               norm_rows(F, CM, L, L, R, args.in[I_N2G] + l * DM, modC + 3072, modC + 4096, H); }
            SEAM(pb + 13);
            if (IN(pb + 14)) { const Frame F = launder(F0);
                pg8::Gemm g{H, DM, (const bf16_t*)(F.ws + WS_W13), DM}; pg8::StaticOrder S; S.init(nMall, 22, F.G, F.bid, PROBE_GEMM);
                EpiSwiglu E{(bf16_t*)(F.ws + WS_G), FF, 0, 1 << 20}; pg8::gemm_phase(lds, F.tid, g, S, E);
            }
            SEAM(pb + 14);
            if (IN(pb + 15)) { const Frame F = launder(F0);
                pg8::Gemm g{(const bf16_t*)(F.ws + WS_G), FF, (const bf16_t*)(F.ws + WS_W2), FF}; pg8::StaticOrder S; S.init(nMall, 4, F.G, F.bid, PROBE_GEMM);
                EpiRes E{out, CM, X1, X1 + (size_t)L * DM, modL + 5120, modC + 5120};
                pg8::gemm_phase(lds, F.tid, g, S, E);
            }
            SEAM(pb + 15);
        } else {
            if (IN(pb + 13)) { const Frame F = launder(F0); norm2_route_rows(F, args, l, out, args.in[I_N2G] + l * DM, modL + 3072, modL + 4096); }
            SEAM(pb + 13);
            if (IN(pb + 14)) { const Frame F = launder(F0); moe_gather(F); moe_weights(F, args, 0); }
            SEAM(pb + 14);
            int tb[9]; moe_tile_bases(F, tb);
            if (IN(pb + 15)) { const Frame F = launder(F0);
                moe_weights(F, args, 1);
                __syncthreads();
                MoeOrder S{tb[0], tb[1], tb[2], tb[3], tb[4], tb[5], tb[6], tb[7], tb[8], 28, 0, F.G, F.bid, PROBE_MOE};
                pg8::Gemm g{(const bf16_t*)(F.ws + WS_H2G), DM, (const bf16_t*)(F.ws + WS_W13E), DM};
                EpiSwiglu E{(bf16_t*)(F.ws + WS_HID), FFE, 0, 28}; pg8::gemm_phase(lds, F.tid, g, S, E);
            }
            SEAM(pb + 15);
            if (IN(pb + 17)) { const Frame F = launder(F0);
                MoeOrder S{tb[0], tb[1], tb[2], tb[3], tb[4], tb[5], tb[6], tb[7], tb[8], 4, W2E_HI_TILE_SHIFT, F.G, F.bid, PROBE_MOE};
                pg8::Gemm g{(const bf16_t*)(F.ws + WS_HID), FFE, (const bf16_t*)(F.ws + WS_W2E_LO), FFE};
                EpiMoe2 E{(bf16_t*)(F.ws + WS_H2G), (const float*)(F.ws + WS_RT_ROWGATE)}; pg8::gemm_phase(lds, F.tid, g, S, E);
            }
            SEAM(pb + 17);
            if (IN(pb + 19)) { const Frame F = launder(F0); moe_combine(F, out, modL + 5120); }
        }
    }
#undef IN
#undef SEAM
}

#ifndef MK_PER_PHASE
#define MK_PER_PHASE 0
#endif
extern "C" void kernel_launch(void* const* d_in, const int* in_sizes, int n_in, void* d_out, int out_size, void* d_ws, size_t ws_size, hipStream_t stream) {
    static int grid = 0;
    if (grid == 0) {
        if (n_in != 40 || out_size != L * DM || ws_size < 560 * MiB) { fprintf(stderr, "kernel_launch: unexpected shapes (n_in %d out %d ws %zu)\n", n_in, out_size, ws_size); grid = -1; return; }
        int dev = 0, cus = 0, per_cu = 0;
        if (hipGetDevice(&dev) != hipSuccess || hipDeviceGetAttribute(&cus, hipDeviceAttributeMultiprocessorCount, dev) != hipSuccess) { grid = -1; return; }
        if (hipFuncSetAttribute((const void*)mega_fwd, hipFuncAttributeMaxDynamicSharedMemorySize, LDS_BYTES) != hipSuccess) { fprintf(stderr, "kernel_launch: hipFuncSetAttribute failed\n"); grid = -1; return; }
        if (hipOccupancyMaxActiveBlocksPerMultiprocessor(&per_cu, (const void*)mega_fwd, NTHR, LDS_BYTES) != hipSuccess || per_cu < 1) fprintf(stderr, "kernel_launch: occupancy query says %d\n", per_cu);
        (void)hipGetLastError();
        grid = cus;
    }
    if (grid < 0) return;
    (void)hipMemsetAsync((char*)d_ws + WS_CTL, 0, CTL_ZERO_BYTES, stream);
    Args a{};
    for (int i = 0; i < 40; ++i) a.in[i] = (const float*)d_in[i];
    a.out = (float*)d_out; a.ws = (unsigned char*)d_ws;
#if MK_PER_PHASE
    for (int p = 0; p < N_PHASES; ++p) { a.ph_lo = p; a.ph_hi = p + 1; hipLaunchKernelGGL(mega_fwd, dim3(grid), dim3(NTHR), LDS_BYTES, stream, a); }
#else
    a.ph_lo = 0; a.ph_hi = N_PHASES;
    hipLaunchKernelGGL(mega_fwd, dim3(grid), dim3(NTHR), LDS_BYTES, stream, a);
#endif
    const hipError_t le = hipPeekAtLastError();
    if (le != hipSuccess) fprintf(stderr, "kernel_launch: launch failed: %s\n", hipGetErrorName(le));
}
```

```cpp
#include <hip/hip_runtime.h>
#include <cstdio>
#include <cstdint>

#define LAS __attribute__((address_space(3)))
#define GAS __attribute__((address_space(1)))
typedef unsigned short bf16_t;
typedef short bf16x8 __attribute__((ext_vector_type(8)));
typedef short s16x4 __attribute__((ext_vector_type(4)));
typedef float f32x4 __attribute__((ext_vector_type(4)));
typedef float f32x2 __attribute__((ext_vector_type(2)));
typedef float f32x16 __attribute__((ext_vector_type(16)));
typedef unsigned u32x4 __attribute__((ext_vector_type(4)));
typedef unsigned u32x2 __attribute__((ext_vector_type(2)));
typedef __bf16 bf16x2_t __attribute__((ext_vector_type(2)));

constexpr int L = 16384, CT = 256, R = L + CT, DM = 1024, GW = 64;
constexpr int NWAVES = 8, NTHR = 512;
constexpr int ZA_LD = 768, ZN_LD = 1536, ZR_LD = 2048, ZM_N = 4352, ZG_LD = 3072;
constexpr int LO_LD = 2560, RKV_LD = 1536;
constexpr int FF = 2816, FFE = 3584, NEXP = 8;
constexpr int MOE_ROWS = 2 * L + NEXP * 256;
constexpr float NORM_EPS = 1e-6f;
constexpr float LOG2E = 1.4426950408889634f;
constexpr int TCH = 128, NCH = 129;

constexpr size_t MiB = 1u << 20;
constexpr size_t WS_CTL = 0, CTL_ZERO_BYTES = 1 * MiB;
constexpr size_t WS_W = 1 * MiB;
constexpr size_t WB_WINM = 0;
constexpr size_t WB_WING = WB_WINM + (size_t)ZM_N * DM * 2;
constexpr size_t WB_WUQ = WB_WING + (size_t)ZG_LD * DM * 2;
constexpr size_t WB_WUKV = WB_WUQ + (size_t)768 * 384 * 2;
constexpr size_t WB_WLORA = WB_WUKV + (size_t)1024 * 256 * 2;
constexpr size_t WB_WOA = WB_WLORA + (size_t)2560 * 384 * 2;
constexpr size_t WB_WOB = WB_WOA + (size_t)1024 * 512 * 2;
constexpr size_t WB_WOR = WB_WOB + (size_t)1024 * 512 * 2;
constexpr size_t WB_WOUT = WB_WOR + (size_t)1024 * 512 * 2;
constexpr size_t WB_SIZE = WB_WOUT + (size_t)1024 * 1024 * 2;
constexpr size_t WS_W13 = WS_W + 2 * WB_SIZE;
constexpr size_t WS_W2 = WS_W13 + (size_t)2 * FF * DM * 2;
constexpr size_t WS_W_END = WS_W2 + (size_t)DM * FF * 2;
static_assert(WS_W_END <= 67 * MiB, "weights region");
constexpr size_t WS_X1 = 67 * MiB;
constexpr size_t WS_CM = 132 * MiB;
constexpr size_t WS_H = 135 * MiB;
constexpr size_t WS_MISC = 168 * MiB;
constexpr size_t WS_MODV = WS_MISC;
constexpr size_t WS_RT_IDX = WS_MISC + 128 * 1024;
constexpr size_t WS_RT_POS = WS_RT_IDX + 128 * 1024;
constexpr size_t WS_RT_GATE = WS_RT_POS + 128 * 1024;
constexpr size_t WS_RT_ROWGATE = WS_RT_GATE + 128 * 1024;
constexpr size_t WS_KN = WS_MISC + 1 * MiB;
constexpr size_t WS_BIG = 170 * MiB;
constexpr size_t WS_ZN = WS_BIG;
constexpr size_t WS_Q = 219 * MiB, WS_K = 244 * MiB, WS_V = 269 * MiB;
constexpr size_t WS_RKV = 286 * MiB;
constexpr size_t WS_LO = 335 * MiB;
constexpr size_t WS_CQN = 417 * MiB, WS_CKVN = 430 * MiB, WS_LA = 439 * MiB, WS_KR = 452 * MiB;
constexpr size_t WS_YA = 417 * MiB, WS_YB = 434 * MiB;
constexpr size_t WS_ZA = 453 * MiB, WS_ZR = 478 * MiB;
constexpr size_t WS_QRAW = 453 * MiB, WS_KVRAW = 478 * MiB;
constexpr size_t WS_PST = 453 * MiB, WS_QST = 486 * MiB, WS_YF = 519 * MiB, WS_YBK = 536 * MiB, WS_YR = 269 * MiB;
constexpr size_t WS_ZG = WS_BIG;
constexpr size_t WS_U32 = 335 * MiB;
constexpr size_t WS_U = 286 * MiB;
constexpr size_t WS_G = WS_BIG;
constexpr size_t WS_H2G = 67 * MiB;
constexpr size_t WS_W13E = 170 * MiB;
constexpr size_t WS_W2E_LO = 135 * MiB;
constexpr size_t WS_W2E_HI = 282 * MiB;
constexpr int W2E_HI_TILE_SHIFT = (int)((WS_W2E_HI - WS_W2E_LO) / ((size_t)256 * FFE * 2)) - 16;
static_assert((WS_W2E_HI - WS_W2E_LO) % ((size_t)256 * FFE * 2) == 0 && (W2E_HI_TILE_SHIFT % 4) == 0, "W2E split");
constexpr size_t WS_HID = 310 * MiB;
constexpr size_t WS_END = 553 * MiB;
static_assert((size_t)16 * NCH * 4096 * 4 <= 33 * MiB, "state slots");
static_assert(WS_ZR + (size_t)R * ZR_LD * 2 <= WS_END, "ws map");
static_assert(WS_HID + (size_t)MOE_ROWS * FFE * 2 <= 549 * MiB, "hid");
constexpr int CW_BAR = 4096;
constexpr int CW_MOECNT = 1024;

#ifndef PROBE_CVT
#define PROBE_CVT 1
#endif
#ifndef PROBE_ROW
#define PROBE_ROW 1
#endif
__device__ __forceinline__ float bf2f(unsigned b) { return __uint_as_float(b << 16); }
__device__ __forceinline__ unsigned cvtpk(float lo, float hi) { f32x2 v = {lo, hi}; bf16x2_t b = __builtin_convertvector(v, bf16x2_t); return __builtin_bit_cast(unsigned, b); }
__device__ __forceinline__ float lo_bf(unsigned w) { return __uint_as_float(w << 16); }
__device__ __forceinline__ float hi_bf(unsigned w) { return __uint_as_float(w & 0xffff0000u); }
__device__ __forceinline__ float wave_sum(float v) {
#pragma unroll
    for (int o = 1; o < 64; o <<= 1) v += __shfl_xor(v, o);
    return v;
}
__device__ __forceinline__ float sigmoidf_(float x) { return 1.f / (1.f + __expf(-x)); }
__device__ __forceinline__ float siluf_(float x) { return x / (1.f + __expf(-x)); }
#define LDS_WAIT() asm volatile("s_waitcnt lgkmcnt(0)" ::: "memory")
#define VM_WAIT() asm volatile("s_waitcnt vmcnt(0)" ::: "memory")

namespace pg8 {
constexpr int BM = 256, BK = 64, HALF = 128, HTB = HALF * BK * 2, STAGE_BYTES = 8 * HTB, NXCD = 8, WGM = 8;
__device__ __forceinline__ int lds_byte(int r, int c) { const int st = (r >> 4) * 2 + (c >> 5), rr = r & 15, cc = c & 31, ob = rr * 64 + cc * 2; return st * 1024 + (ob ^ (((ob >> 9) & 1) << 5)); }
__device__ __forceinline__ void stage_rc(int b, int& R_, int& C_) { const int st = b / 1024, sb = b % 1024, swz = sb ^ (((sb >> 9) & 1) << 5); R_ = (st >> 1) * 16 + swz / 64; C_ = (st & 1) * 32 + (swz % 64) / 2; }
__device__ __forceinline__ int perm32(int rho) { const int n = rho >> 4, i = rho & 15; return 8 * (i >> 2) + 4 * n + (i & 3); }

struct Unit { int pm, pn; };
struct Gemm { const bf16_t* A; int lda; const bf16_t* Bt; int K; };

struct StaticOrder {
    int nM, nN, nwg, G, c, rep;
    __device__ void init(int nM_, int nN_, int G_, int c_, int rep_ = 1) { nM = nM_; nN = nN_; nwg = nM * nN; G = G_; c = c_; rep = rep_; }
    __device__ bool next(int i, Unit& u) const {
        const long Lx = (long)i * G + c; if (Lx >= (long)nwg * rep) return false;
        int wgid = (int)(Lx % nwg); { const int q = nwg / NXCD, r = nwg % NXCD, xcd = wgid % NXCD, off = wgid / NXCD; wgid = (xcd < r ? xcd * (q + 1) : r * (q + 1) + (xcd - r) * q) + off; }
        const int nig = WGM * nN, gid = wgid / nig, fm = gid * WGM, gsz = (nM - fm) < WGM ? (nM - fm) : WGM;
        u.pm = fm + ((wgid % nig) % gsz); u.pn = (wgid % nig) / gsz; return true;
    }
};

template <class Epi, class Sched>
__device__ __forceinline__ void gemm_phase(LAS unsigned char* lds, const int tid, const Gemm g, const Sched& S, const Epi& E) {
    const int wid = __builtin_amdgcn_readfirstlane(tid >> 6), lane = tid & 63, wr = wid >> 2, wc = wid & 3, fr = lane & 15, fq = lane >> 4;
    const int K = g.K, nt = K / BK;
    unsigned voffA[2], voffB[2];
#pragma unroll
    for (int i = 0; i < 2; ++i) { int R_, C_; stage_rc(tid * 16 + i * 8192, R_, C_); const int Rb = (R_ & ~31) + perm32(R_ & 31);
        voffA[i] = (unsigned)(R_ * g.lda + C_) * 2u; voffB[i] = (unsigned)(Rb * K + C_) * 2u; }
    const size_t kstep = (size_t)(BK * 2);
    const size_t hstepA = (size_t)HALF * g.lda * 2, hstepB = (size_t)HALF * K * 2;
    const size_t tstepA = 2 * hstepA, tstepB = 2 * hstepB;
    const unsigned ldsw = (unsigned)wid * 1024u;
    const int aoff = lds_byte(wr * 64 + fr, fq * 8), boff = lds_byte(wc * 32 + fr, fq * 8);
#define PG8_SA(b, h) (((b) * 2 + (h)) * HTB)
#define PG8_SB(b, h) ((4 + (b) * 2 + (h)) * HTB)
#define PG8_STAGE(bufoff, gbase, voff) do { _Pragma("unroll") for (int _i = 0; _i < 2; ++_i) \
        __builtin_amdgcn_global_load_lds((const unsigned*)((const char*)(gbase) + (voff)[_i]), (LAS unsigned*)(lds + (bufoff) + ldsw + _i * 8192), 16, 0, 0); } while (0)
#define PG8_LDA(dst, b, h) do { _Pragma("unroll") for (int m = 0; m < 4; ++m) _Pragma("unroll") for (int k = 0; k < 2; ++k) dst[m][k] = *(const LAS bf16x8*)(lds + PG8_SA(b, h) + aoff + m * 2048 + k * 1024); } while (0)
#define PG8_LDB(dst, b, h) do { _Pragma("unroll") for (int n = 0; n < 2; ++n) _Pragma("unroll") for (int k = 0; k < 2; ++k) dst[n][k] = *(const LAS bf16x8*)(lds + PG8_SB(b, h) + boff + n * 2048 + k * 1024); } while (0)
#define PG8_MMA(ai, bj, At, Bt) do { __builtin_amdgcn_s_setprio(1); _Pragma("unroll") for (int m = 0; m < 4; ++m) _Pragma("unroll") for (int n = 0; n < 2; ++n) _Pragma("unroll") for (int k = 0; k < 2; ++k) \
        acc[ai][bj][m][n] = __builtin_amdgcn_mfma_f32_16x16x32_bf16(Bt[n][k], At[m][k], acc[ai][bj][m][n], 0, 0, 0); __builtin_amdgcn_s_setprio(0); } while (0)
#define PG8_WAIT_V(n) asm volatile("s_waitcnt vmcnt(" #n ")" ::: "memory")
#define PG8_WAIT_L(n) asm volatile("s_waitcnt lgkmcnt(" #n ")" ::: "memory")
#define PG8_BAR __builtin_amdgcn_s_barrier()
#define PG8_SCHED __builtin_amdgcn_sched_barrier(0)
    Unit cur, nxt; int ui = 0;
    if (!S.next(0, cur)) return;
    f32x4 acc[2][2][4][2];
#pragma unroll
    for (int a = 0; a < 2; ++a)
#pragma unroll
        for (int b = 0; b < 2; ++b)
#pragma unroll
            for (int m = 0; m < 4; ++m)
#pragma unroll
                for (int n = 0; n < 2; ++n) acc[a][b][m][n] = (f32x4){0.f, 0.f, 0.f, 0.f};
    bf16x8 At[4][2], B0[2][2], B1[2][2];
    const char* cA = (const char*)g.A + (size_t)cur.pm * tstepA; const char* cB = (const char*)g.Bt + (size_t)cur.pn * tstepB;
    PG8_STAGE(PG8_SB(0, 0), cB, voffB); PG8_STAGE(PG8_SB(0, 1), cB + hstepB, voffB); PG8_STAGE(PG8_SA(0, 0), cA, voffA); PG8_STAGE(PG8_SA(0, 1), cA + hstepA, voffA);
    if (wr == 1) PG8_BAR;
    PG8_WAIT_V(2); PG8_BAR;
    PG8_STAGE(PG8_SB(1, 0), cB + kstep, voffB); PG8_STAGE(PG8_SA(1, 0), cA + kstep, voffA); PG8_STAGE(PG8_SB(1, 1), cB + hstepB + kstep, voffB);
    PG8_WAIT_V(6); PG8_BAR;
    for (;;) {
        const bool has_next = S.next(ui + 1, nxt);
        const char* nA = has_next ? (const char*)g.A + (size_t)nxt.pm * tstepA : cA; const char* nB = has_next ? (const char*)g.Bt + (size_t)nxt.pn * tstepB : cB;
        for (int t = 0; t < nt; t += 2) {
            const bool last = (t == nt - 2);
            const char* a1 = cA + (size_t)(t + 1) * kstep;
            const char* a2 = last ? nA : cA + (size_t)(t + 2) * kstep; const char* b2 = last ? nB : cB + (size_t)(t + 2) * kstep;
            const char* a3 = a2 + kstep; const char* b3 = b2 + kstep;
            PG8_LDB(B0, 0, 0); PG8_LDB(B1, 0, 1); PG8_SCHED; PG8_LDA(At, 0, 0); PG8_STAGE(PG8_SA(1, 1), a1 + hstepA, voffA);
            PG8_WAIT_V(8); PG8_WAIT_L(0); PG8_BAR; PG8_MMA(0, 0, At, B0); PG8_MMA(0, 1, At, B1); PG8_BAR; PG8_SCHED;
            PG8_LDA(At, 0, 1); PG8_STAGE(PG8_SB(0, 0), b2, voffB); PG8_STAGE(PG8_SB(0, 1), b2 + hstepB, voffB); PG8_STAGE(PG8_SA(0, 0), a2, voffA);
            PG8_WAIT_V(8); PG8_WAIT_L(0); PG8_BAR; PG8_MMA(1, 0, At, B0); PG8_MMA(1, 1, At, B1); PG8_BAR; PG8_SCHED;
            PG8_LDB(B0, 1, 0); PG8_LDB(B1, 1, 1); PG8_SCHED; PG8_LDA(At, 1, 0); PG8_STAGE(PG8_SA(0, 1), a2 + hstepA, voffA);
            PG8_WAIT_V(8); PG8_WAIT_L(0); PG8_BAR; PG8_MMA(0, 0, At, B0); PG8_MMA(0, 1, At, B1); PG8_BAR; PG8_SCHED;
            PG8_LDA(At, 1, 1); PG8_STAGE(PG8_SB(1, 0), b3, voffB); PG8_STAGE(PG8_SB(1, 1), b3 + hstepB, voffB); PG8_STAGE(PG8_SA(1, 0), a3, voffA);
            PG8_WAIT_V(8); PG8_WAIT_L(0); PG8_BAR; PG8_MMA(1, 0, At, B0); PG8_MMA(1, 1, At, B1); PG8_BAR; PG8_SCHED;
        }
        if (wr == 0) PG8_BAR;
        E(acc, cur, wr, wc, fr, fq);
        if (!has_next) break;
#pragma unroll
        for (int a = 0; a < 2; ++a)
#pragma unroll
            for (int b = 0; b < 2; ++b)
#pragma unroll
                for (int m = 0; m < 4; ++m)
#pragma unroll
                    for (int n = 0; n < 2; ++n) acc[a][b][m][n] = (f32x4){0.f, 0.f, 0.f, 0.f};
        cur = nxt; cA = nA; cB = nB; ++ui;
        if (wr == 1) PG8_BAR;
    }
    PG8_WAIT_V(0);
    PG8_BAR;
#undef PG8_SA
#undef PG8_SB
#undef PG8_STAGE
#undef PG8_LDA
#undef PG8_LDB
#undef PG8_MMA
#undef PG8_WAIT_V
#undef PG8_WAIT_L
#undef PG8_BAR
#undef PG8_SCHED
}

template <class F> __device__ __forceinline__ void epi_each(const f32x4 (&acc)[2][2][4][2], const Unit& u, int wr, int wc, int fr, int fq, F&& f) {
    const int row0 = u.pm * BM + wr * 64 + fr, col0 = u.pn * BM + wc * 32 + 8 * fq;
#pragma unroll
    for (int ai = 0; ai < 2; ++ai)
#pragma unroll
        for (int m = 0; m < 4; ++m)
#pragma unroll
            for (int bj = 0; bj < 2; ++bj) f(row0 + ai * HALF + m * 16, col0 + bj * HALF, acc[ai][bj][m][0], acc[ai][bj][m][1]);
}
__device__ __forceinline__ void st_bf16x8(bf16_t* p, f32x4 v0, f32x4 v1) {
    u32x4 w; w.x = cvtpk(v0[0], v0[1]); w.y = cvtpk(v0[2], v0[3]); w.z = cvtpk(v1[0], v1[1]); w.w = cvtpk(v1[2], v1[3]); *(u32x4*)p = w;
}
}
#include <hip/hip_runtime.h>
#include <cstdio>
#include <cstdint>
#include <cstdlib>
#include <vector>

#define XB_TMO      128
#define XB_XCNT(j)  (256  + 64 * (j))
#define XB_XSUB(j)  (1280 + 64 * (j))
#define XB_XGEN(j)  (2304 + 64 * (j))
#define XB_TOP      3328
#define XB_TOPGEN   3392
#define XCD_BAR_WORDS 3456
#define XB_SPIN_CAP (1u << 18)

__device__ __forceinline__ unsigned xb_ld(unsigned* p)              { return __hip_atomic_load(p, __ATOMIC_RELAXED, __HIP_MEMORY_SCOPE_AGENT); }
__device__ __forceinline__ unsigned xb_add(unsigned* p, unsigned v) { return __hip_atomic_fetch_add(p, v, __ATOMIC_RELAXED, __HIP_MEMORY_SCOPE_AGENT); }
__device__ __forceinline__ unsigned xb_xcc_id() { return (unsigned)__builtin_amdgcn_s_getreg((3 << 11) | 20) & 0xFu; }
#define XB_SPIN(cond, bar) do { unsigned _sp = 0; while (cond) { __builtin_amdgcn_s_sleep(1); \
    if ((++_sp & 255u) == 0u) { if (xb_ld(&(bar)[XB_TMO])) break; if (_sp > XB_SPIN_CAP) { atomicAdd(&(bar)[XB_TMO], 1u); break; } } } } while (0)

struct XcdBarrier {
    unsigned* bar; unsigned x;
    volatile LAS unsigned* st;
};

__device__ __forceinline__ XcdBarrier xcd_barrier_post(unsigned* bar, volatile LAS unsigned* st) {
    XcdBarrier b; b.bar = bar; b.x = xb_xcc_id(); b.st = st;
    if (threadIdx.x == 0) (void)xb_add(&bar[XB_XCNT(b.x)], 1u);
    return b;
}
__device__ __forceinline__ void xcd_barrier_complete(unsigned* bar, unsigned x, unsigned& nloc, unsigned& nx) {
    const unsigned G = gridDim.x * gridDim.y * gridDim.z;
    unsigned sum, cnt, mine, sp = 0u;
    for (;;) {
        sum = 0u; cnt = 0u; mine = 0u;
#pragma unroll
        for (unsigned j = 0; j < 16; ++j) { const unsigned c = xb_ld(&bar[XB_XCNT(j)]); sum += c; cnt += (c > 0u) ? 1u : 0u; mine = (j == x) ? c : mine; }
        if (sum == G) break;
        __builtin_amdgcn_s_sleep(1);
        if ((++sp & 255u) == 0u) { if (xb_ld(&bar[XB_TMO])) break; if (sp > XB_SPIN_CAP) { atomicAdd(&bar[XB_TMO], 1u); break; } }
    }
    nloc = mine > 0u ? mine : 1u; nx = cnt > 0u ? cnt : 1u;
}

__device__ __forceinline__ void xcd_barrier(const XcdBarrier& b) {
    asm volatile("s_waitcnt vmcnt(0)" ::: "memory");
    __syncthreads();
    if (threadIdx.x == 0) {
        unsigned* bar = b.bar;
        __builtin_amdgcn_s_waitcnt(0);
        unsigned nloc = b.st[0], nx = b.st[1];
        if (nloc == 0u) { xcd_barrier_complete(bar, b.x, nloc, nx); b.st[0] = nloc; b.st[1] = nx; }
        const unsigned old = xb_add(&bar[XB_XSUB(b.x)], 1u);
        const unsigned gen = old / nloc;
        if (old + 1u == (gen + 1u) * nloc) {
            __builtin_amdgcn_fence(__ATOMIC_RELEASE, "agent");
            asm volatile("s_waitcnt vmcnt(0)" ::: "memory");
            const unsigned og = xb_add(&bar[XB_TOP], 1u);
            const unsigned tg = og / nx;
            if (og + 1u == (tg + 1u) * nx) xb_add(&bar[XB_TOPGEN], 1u);
            else XB_SPIN(xb_ld(&bar[XB_TOPGEN]) == tg, bar);
            __builtin_amdgcn_fence(__ATOMIC_ACQUIRE, "agent");
            xb_add(&bar[XB_XGEN(b.x)], 1u);
            asm volatile("s_waitcnt vmcnt(0)" ::: "memory");
        } else {
            XB_SPIN(xb_ld(&bar[XB_XGEN(b.x)]) == gen, bar);
            __builtin_amdgcn_fence(__ATOMIC_ACQUIRE, "agent");
            asm volatile("s_waitcnt vmcnt(0)" ::: "memory");
        }
    }
    __syncthreads();
}


constexpr int LDS_BYTES = 147456;
constexpr int LDS_MISC_OFF = 146432;
struct Args { const float* in[40]; float* out; unsigned char* ws; int ph_lo, ph_hi; };
enum { I_X = 0, I_C, I_CTX, I_CCTX, I_MODW, I_MODB, I_N1G, I_N2G, I_WIN, I_CQG, I_WUQ, I_CKVG, I_WUKV, I_QNG, I_KNG, I_MLAWO,
       I_NAQG, I_NAKG, I_RPB, I_NAWO, I_MU, I_W0, I_W2, I_A0, I_A2, I_G2, I_KK, I_KA, I_RK, I_LNG, I_LNB, I_RWWO, I_WOUT,
       I_F1, I_F3, I_F2, I_ROUTER, I_M1, I_M3, I_M2 };

struct Frame {
    LAS unsigned char* lds;
    unsigned char* ws;
    int tid, lane, wave, G, vcu, bid;
};

__device__ __forceinline__ Frame launder(const Frame& F) {
    Frame P = F; int w = F.wave, v = F.vcu, b = F.bid; unsigned long long wi = (unsigned long long)F.ws;
    asm volatile("" : "+s"(w), "+s"(v), "+s"(b), "+s"(wi));
    int ln = (int)__builtin_amdgcn_mbcnt_hi(~0u, __builtin_amdgcn_mbcnt_lo(~0u, 0u));
    asm volatile("" : "+v"(ln));
    P.tid = w * 64 + ln; P.lane = ln; P.wave = w; P.vcu = v; P.bid = b;
    P.ws = (unsigned char*)(GAS unsigned char*)wi;
    return P;
}
__device__ __forceinline__ void tr_item(const float* src, int lds_, int scol0, bf16_t* dst, int ldd, int drow0, int koff, int nblk, int ileave, int item, LAS float* scr, int lane) {
    const int kb = item / nblk, nb = item - kb * nblk, k0 = 64 * kb, n0 = 32 * nb;
#pragma unroll 8
    for (int i = 0; i < 32; ++i) { const int kk = 2 * i + (lane >> 5); scr[kk * 33 + (lane & 31)] = src[(size_t)(k0 + kk) * lds_ + scol0 + n0 + (lane & 31)]; }
    LDS_WAIT(); asm volatile("" ::: "memory");
    const int c = lane & 7;
#pragma unroll
    for (int j = 0; j < 4; ++j) { const int n = (lane >> 3) + 8 * j; const LAS float* s = scr + (8 * c) * 33 + n;
        u32x4 o; o.x = cvtpk(s[0 * 33], s[1 * 33]); o.y = cvtpk(s[2 * 33], s[3 * 33]); o.z = cvtpk(s[4 * 33], s[5 * 33]); o.w = cvtpk(s[6 * 33], s[7 * 33]);
        const int nn = n0 + n; const int drow = ileave ? drow0 + (nn >> 7) * 256 + (nn & 127) : drow0 + nn;
        *(u32x4*)(dst + (size_t)drow * ldd + koff + k0 + 8 * c) = o; }
    LDS_WAIT(); asm volatile("" ::: "memory");
}
__device__ __forceinline__ void zero_item(bf16_t* dst, int ldd, int drow0, int koff, int nblk, int item, int lane) {
    const int kb = item / nblk, nb = item - kb * nblk, k0 = 64 * kb, n0 = 32 * nb, c = lane & 7;
#pragma unroll
    for (int j = 0; j < 4; ++j) { const int n = (lane >> 3) + 8 * j; *(u32x4*)(dst + (size_t)(drow0 + n0 + n) * ldd + koff + k0 + 8 * c) = (u32x4){0u, 0u, 0u, 0u}; }
}

#define TRJOB(NITEMS, CALL) { const int _n = (NITEMS); if (r < _n) { CALL; continue; } r -= _n; }
__device__ __forceinline__ void prologue_weights(const Frame& F, const Args& a) {
    LAS float* scr = (LAS float*)(F.lds + F.wave * 16384);
    const int gw = F.vcu * NWAVES + F.wave, NGW = F.G * NWAVES;
    constexpr int PER_LAYER = 16 * 21 + 16 * 3   + 16 * 108   + 16 * 4   + 16 * 96
                              + 6 * 24   + 4 * 32   + 6 * 80   + 3 * 8 * 32   + 16 * 32  ;
    constexpr int FFN_ITEMS = 2 * 16 * 88 + 44 * 32;
    constexpr int NITEMS = 2 * PER_LAYER + FFN_ITEMS;
    for (int it0 = gw; it0 < NITEMS * PROBE_CVT; it0 += NGW) { const int it = it0 % NITEMS;
        int r = it;
        bool done = false;
        for (int l = 0; l < 2 && !done; ++l) {
            if (r >= PER_LAYER) { r -= PER_LAYER; continue; }
            done = true;
            unsigned char* wb = F.ws + WS_W + (size_t)l * WB_SIZE;
            bf16_t* WinM = (bf16_t*)(wb + WB_WINM); bf16_t* WinG = (bf16_t*)(wb + WB_WING);
            const float* win = a.in[I_WIN] + (size_t)l * DM * 7200;
            do {
                if (r < 16 * 21) { tr_item(win, 7200, 0, WinM, DM, 0, 0, 21, 0, r, scr, F.lane); break; } r -= 16 * 21;
                if (r < 16 * 3) { zero_item(WinM, DM, 672, 0, 3, r, F.lane); break; } r -= 16 * 3;
                if (r < 16 * 108) { tr_item(win, 7200, 672, WinM, DM, 768, 0, 108, 0, r, scr, F.lane); break; } r -= 16 * 108;
                if (r < 16 * 4) { zero_item(WinM, DM, 4224, 0, 4, r, F.lane); break; } r -= 16 * 4;
                if (r < 16 * 96) { tr_item(win, 7200, 4128, WinG, DM, 0, 0, 96, 0, r, scr, F.lane); break; } r -= 16 * 96;
                if (r < 6 * 24) { tr_item(a.in[I_WUQ] + (size_t)l * 384 * 768, 768, 0, (bf16_t*)(wb + WB_WUQ), 384, 0, 0, 24, 0, r, scr, F.lane); break; } r -= 6 * 24;
                if (r < 4 * 32) { tr_item(a.in[I_WUKV] + (size_t)l * 256 * 1024, 1024, 0, (bf16_t*)(wb + WB_WUKV), 256, 0, 0, 32, 0, r, scr, F.lane); break; } r -= 4 * 32;
                if (r < 6 * 80) {
                    bf16_t* Wl = (bf16_t*)(wb + WB_WLORA);
                    const int kb = r / 80, nb = r % 80, s = nb / 16;
                    const int koff = s < 4 ? 64 * s : 256, Ks = s < 4 ? 64 : 128;
                    const int k0 = 64 * kb;
                    if (k0 >= koff && k0 < koff + Ks) {
                        const float* src = s < 2 ? a.in[I_W2] + ((size_t)l * 2 + s) * 64 * 512 : s < 4 ? a.in[I_A2] + ((size_t)l * 2 + (s - 2)) * 64 * 512 : a.in[I_G2] + (size_t)l * 128 * 512;
                        const int sub = ((k0 - koff) / 64) * 16 + (nb % 16);
                        tr_item(src, 512, 0, Wl, 384, 512 * s, koff, 16, 0, sub, scr, F.lane);
                    } else zero_item(Wl, 384, 0, 0, 80, r, F.lane);
                    break; } r -= 6 * 80;
                if (r < 3 * 8 * 32) { const int b = r / 256, rr = r % 256;
                    const float* src = (b == 0 ? a.in[I_MLAWO] : b == 1 ? a.in[I_NAWO] : a.in[I_RWWO]) + (size_t)l * 512 * 1024;
                    tr_item(src, 1024, 0, (bf16_t*)(wb + (b == 0 ? WB_WOA : b == 1 ? WB_WOB : WB_WOR)), 512, 0, 0, 32, 0, rr, scr, F.lane); break; } r -= 3 * 8 * 32;
                tr_item(a.in[I_WOUT] + (size_t)l * 1024 * 1024, 1024, 0, (bf16_t*)(wb + WB_WOUT), 1024, 0, 0, 32, 0, r, scr, F.lane);
            } while (0);
        }
        if (done) continue;
        if (r < 16 * 88) { tr_item(a.in[I_F1], FF, 0, (bf16_t*)(F.ws + WS_W13), DM, 0, 0, 88, 1, r, scr, F.lane); continue; } r -= 16 * 88;
        if (r < 16 * 88) { tr_item(a.in[I_F3], FF, 0, (bf16_t*)(F.ws + WS_W13), DM, 128, 0, 88, 1, r, scr, F.lane); continue; } r -= 16 * 88;
        tr_item(a.in[I_F2], DM, 0, (bf16_t*)(F.ws + WS_W2), FF, 0, 0, 32, 0, r, scr, F.lane);
    }
}
__device__ __forceinline__ void moe_weights(const Frame& F, const Args& a, int part) {
    LAS float* scr = (LAS float*)(F.lds + F.wave * 16384);
    const int gw = F.vcu * NWAVES + F.wave, NGW = F.G * NWAVES;
    constexpr int I13 = 16 * 112, I2 = 56 * 32;
    if (part == 0) {
        constexpr int NIT = NEXP * 2 * I13 + 4 * I2;
        for (int it0 = gw; it0 < NIT * PROBE_CVT; it0 += NGW) { const int it = it0 % NIT;
            if (it < NEXP * 2 * I13) { const int e = it / (2 * I13); int r = it - e * 2 * I13;
                bf16_t* w13 = (bf16_t*)(F.ws + WS_W13E) + (size_t)e * 2 * FFE * DM;
                if (r < I13) tr_item(a.in[I_M1] + (size_t)e * DM * FFE, FFE, 0, w13, DM, 0, 0, 112, 1, r, scr, F.lane);
                else tr_item(a.in[I_M3] + (size_t)e * DM * FFE, FFE, 0, w13, DM, 128, 0, 112, 1, r - I13, scr, F.lane);
            } else { const int q = it - NEXP * 2 * I13, e = 4 + q / I2, r = q % I2;
                tr_item(a.in[I_M2] + (size_t)e * FFE * DM, DM, 0, (bf16_t*)(F.ws + WS_W2E_HI) + (size_t)(e - 4) * DM * FFE, FFE, 0, 0, 32, 0, r, scr, F.lane); }
        }
    } else {
        for (int it = gw; it < 4 * I2; it += NGW) { const int e = it / I2, r = it % I2;
            tr_item(a.in[I_M2] + (size_t)e * FFE * DM, DM, 0, (bf16_t*)(F.ws + WS_W2E_LO) + (size_t)e * DM * FFE, FFE, 0, 0, 32, 0, r, scr, F.lane); }
    }
}

__device__ __forceinline__ void prologue_mod(const Frame& F, const Args& a) {
    LAS float* sl = (LAS float*)(F.lds);
    LAS float* part = sl + 2048;
    if (F.bid >= 192) return;
    const int l = F.bid / 96, nb = F.bid % 96;
    for (int i = F.tid; i < 2048; i += NTHR) { const float v = i < 1024 ? a.in[I_C][i] : a.in[I_CCTX][i - 1024]; sl[i] = siluf_(v); }
    __syncthreads();
    const int col = F.tid & 63, kg = F.tid >> 6, n = nb * 64 + col;
    const float* W = a.in[I_MODW] + (size_t)l * DM * 6144 + n;
    float aL = 0.f, aC = 0.f;
#pragma unroll 8
    for (int k = kg * 128; k < kg * 128 + 128; ++k) { const float w = W[(size_t)k * 6144]; aL += sl[k] * w; aC += sl[1024 + k] * w; }
    part[(kg * 64 + col) * 2] = aL; part[(kg * 64 + col) * 2 + 1] = aC;
    __syncthreads();
    if (F.tid < 128) { const int c2 = F.tid & 63, which = F.tid >> 6; float s = 0.f;
#pragma unroll
        for (int k = 0; k < 8; ++k) s += part[(k * 64 + c2) * 2 + which];
        const int nn = nb * 64 + c2;
        ((float*)(F.ws + WS_MODV))[(size_t)(l * 2 + which) * 6144 + nn] = s + a.in[I_MODB][(size_t)l * 6144 + nn]; }
    __syncthreads();
}

__device__ __forceinline__ void norm_rows(const Frame& F, const float* src, int src_row0, int m0, int m1, const float* g, const float* sh, const float* sc, bf16_t* dst) {
    f32x4 ca[4], cb[4];
#pragma unroll
    for (int j = 0; j < 4; ++j) { const int d = F.lane * 4 + 256 * j; const f32x4 gg = *(const f32x4*)(g + d), s1 = *(const f32x4*)(sc + d); ca[j] = gg * (s1 + 1.0f); cb[j] = *(const f32x4*)(sh + d); }
    const int gw = F.vcu * NWAVES + F.wave, NGW = F.G * NWAVES;
    for (int mm = gw; mm < (m1 - m0) * PROBE_ROW; mm += NGW) { const int m = m0 + mm % (m1 - m0);
        const f32x4* xr = (const f32x4*)(src + (size_t)(m - src_row0) * DM) + F.lane;
        f32x4 v[4]; float s = 0.f;
#pragma unroll
        for (int j = 0; j < 4; ++j) { v[j] = xr[64 * j]; s += (v[j].x * v[j].x + v[j].y * v[j].y) + (v[j].z * v[j].z + v[j].w * v[j].w); }
        const float rstd = rsqrtf(wave_sum(s) * (1.f / DM) + NORM_EPS);
        u32x2* o8 = (u32x2*)(dst + (size_t)m * DM) + F.lane;
#pragma unroll
        for (int j = 0; j < 4; ++j) { const f32x4 y = v[j] * rstd * ca[j] + cb[j]; u32x2 w; w.x = cvtpk(y.x, y.y); w.y = cvtpk(y.z, y.w); o8[64 * j] = w; }
    }
}

using pg8::Unit;
struct EpiZ {
    bf16_t *za, *zn, *zr;
    __device__ __forceinline__ void operator()(const f32x4 (&acc)[2][2][4][2], const Unit& u, int wr, int wc, int fr, int fq) const {
        bf16_t* base; int ld, ct;
        if (u.pn < 3) { base = za; ld = ZA_LD; ct = u.pn; } else if (u.pn < 9) { base = zn; ld = ZN_LD; ct = u.pn - 3; } else { base = zr; ld = ZR_LD; ct = u.pn - 9; }
        const int cshift = (ct - u.pn) * 256;
        pg8::epi_each(acc, u, wr, wc, fr, fq, [&](int row, int col, f32x4 v0, f32x4 v1) { pg8::st_bf16x8(base + (size_t)row * ld + col + cshift, v0, v1); });
    }
};
struct EpiBf {
    bf16_t* o; int ld;
    __device__ __forceinline__ void operator()(const f32x4 (&acc)[2][2][4][2], const Unit& u, int wr, int wc, int fr, int fq) const {
        pg8::epi_each(acc, u, wr, wc, fr, fq, [&](int row, int col, f32x4 v0, f32x4 v1) { pg8::st_bf16x8(o + (size_t)row * ld + col, v0, v1); });
    }
};
__device__ __forceinline__ f32x4 lora_fn(f32x4 v, const float* bias, int seg) {
    if (seg < 4) { const f32x4 b = *(const f32x4*)bias;
#pragma unroll
        for (int e = 0; e < 4; ++e) { const float x = b[e] + v[e];
            if (seg < 2) { const float y = -x; const float sp = fmaxf(y, 0.f) + __logf(1.f + __expf(-fabsf(y))); v[e] = -__expf(-sp - 0.5f); }
            else v[e] = sigmoidf_(x); } }
    return v;
}
struct EpiLora {
    bf16_t* o; const float* w0; const float* a0;
    __device__ __forceinline__ void operator()(const f32x4 (&acc)[2][2][4][2], const Unit& u, int wr, int wc, int fr, int fq) const {
        const int seg = u.pn >> 1;
        const float* bias = seg < 2 ? w0 : a0 - 1024;
        pg8::epi_each(acc, u, wr, wc, fr, fq, [&](int row, int col, f32x4 v0, f32x4 v1) {
            const f32x4 r0 = lora_fn(v0, bias + col, seg), r1 = lora_fn(v1, bias + col + 4, seg);
            pg8::st_bf16x8(o + (size_t)row * LO_LD + col, r0, r1);
        });
    }
};
template <int MODE> struct EpiMerge {
    float* u32; bf16_t* ub; const bf16_t* zg; int goff;
    __device__ __forceinline__ void operator()(const f32x4 (&acc)[2][2][4][2], const Unit& u, int wr, int wc, int fr, int fq) const {
        pg8::epi_each(acc, u, wr, wc, fr, fq, [&](int row, int col, f32x4 v0, f32x4 v1) {
            const u32x4 gw = *(const u32x4*)(zg + (size_t)row * ZG_LD + goff + col);
            f32x4 g0 = {sigmoidf_(lo_bf(gw.x)), sigmoidf_(hi_bf(gw.x)), sigmoidf_(lo_bf(gw.y)), sigmoidf_(hi_bf(gw.y))};
            f32x4 g1 = {sigmoidf_(lo_bf(gw.z)), sigmoidf_(hi_bf(gw.z)), sigmoidf_(lo_bf(gw.w)), sigmoidf_(hi_bf(gw.w))};
            float* up = u32 + (size_t)row * DM + col;
            f32x4 r0 = g0 * v0, r1 = g1 * v1;
            if (MODE > 0) { r0 += *(const f32x4*)up; r1 += *(const f32x4*)(up + 4); }
            if (MODE < 2) { *(f32x4*)up = r0; *(f32x4*)(up + 4) = r1; }
            else pg8::st_bf16x8(ub + (size_t)row * DM + col, r0, r1);
        });
    }
};
struct EpiRes {
    const float* resL; const float* resC; float* outL; float* outC; const float* gateL; const float* gateC;
    __device__ __forceinline__ void operator()(const f32x4 (&acc)[2][2][4][2], const Unit& u, int wr, int wc, int fr, int fq) const {
        const bool isc = u.pm >= L / 256;
        const float* res = isc ? resC - (size_t)L * DM : resL; float* out = isc ? outC - (size_t)L * DM : outL; const float* gate = isc ? gateC : gateL;
        pg8::epi_each(acc, u, wr, wc, fr, fq, [&](int row, int col, f32x4 v0, f32x4 v1) {
            const size_t o = (size_t)row * DM + col;
            const f32x4 g0 = *(const f32x4*)(gate + col), g1 = *(const f32x4*)(gate + col + 4);
            *(f32x4*)(out + o) = *(const f32x4*)(res + o) + g0 * v0; *(f32x4*)(out + o + 4) = *(const f32x4*)(res + o + 4) + g1 * v1;
        });
    }
};
struct EpiSwiglu {
    bf16_t* o; int ld; int row_sub; int ct_mod;
    __device__ __forceinline__ void operator()(const f32x4 (&acc)[2][2][4][2], const Unit& u, int wr, int wc, int fr, int fq) const {
        const int row0 = u.pm * 256 + wr * 64 + fr - row_sub, col0 = (u.pn % ct_mod) * 128 + wc * 32 + 8 * fq;
#pragma unroll
        for (int ai = 0; ai < 2; ++ai)
#pragma unroll
            for (int m = 0; m < 4; ++m) {
                f32x4 r0, r1;
#pragma unroll
                for (int e = 0; e < 4; ++e) { r0[e] = siluf_(acc[ai][0][m][0][e]) * acc[ai][1][m][0][e]; r1[e] = siluf_(acc[ai][0][m][1][e]) * acc[ai][1][m][1][e]; }
                pg8::st_bf16x8(o + (size_t)(row0 + ai * 128 + m * 16) * ld + col0, r0, r1);
            }
    }
};
struct EpiMoe2 {
    bf16_t* ys; const float* rowgate;
    __device__ __forceinline__ void operator()(const f32x4 (&acc)[2][2][4][2], const Unit& u, int wr, int wc, int fr, int fq) const {
        const int cshift = ((u.pn & 3) - u.pn) * 256;
        pg8::epi_each(acc, u, wr, wc, fr, fq, [&](int row, int col, f32x4 v0, f32x4 v1) {
            const float g = rowgate[row];
            pg8::st_bf16x8(ys + (size_t)row * DM + col + cshift, v0 * g, v1 * g);
        });
    }
};
struct MoeOrder {
    int t0, t1, t2, t3, t4, t5, t6, t7, t8, nct, hi_shift, G, c, rep;
    __device__ bool next(int i, Unit& u) const {
        int idx = i * G + c; const int tot = (t8 - t0) * nct; if (idx >= tot * rep) return false; idx %= tot;
#define MOE_E(e, ta, tb_, sh) { const int w = (tb_) - (ta), n = w * nct; if (idx < n) { u.pm = (ta) + idx % w; u.pn = (e) * nct + idx / w + (sh); return true; } idx -= n; }
        MOE_E(0, t0, t1, 0) MOE_E(1, t1, t2, 0) MOE_E(2, t2, t3, 0) MOE_E(3, t3, t4, 0)
        MOE_E(4, t4, t5, hi_shift) MOE_E(5, t5, t6, hi_shift) MOE_E(6, t6, t7, hi_shift) MOE_E(7, t7, t8, hi_shift)
#undef MOE_E
        return false;
    }
};

__device__ __forceinline__ void prepare_rows(const Frame& F, const Args& a, int l) {
    const bf16_t* ZA = (const bf16_t*)(F.ws + WS_ZA); bf16_t* ZN = (bf16_t*)(F.ws + WS_ZN); const bf16_t* ZR = (const bf16_t*)(F.ws + WS_ZR);
    bf16_t* CQN = (bf16_t*)(F.ws + WS_CQN); bf16_t* CKVN = (bf16_t*)(F.ws + WS_CKVN); bf16_t* LA = (bf16_t*)(F.ws + WS_LA); bf16_t* KR = (bf16_t*)(F.ws + WS_KR);
    bf16_t* RKV = (bf16_t*)(F.ws + WS_RKV);
    const int lane = F.lane;
    float cqg[6], ckvg[4], qng[8], kng[8];
#pragma unroll
    for (int e = 0; e < 6; ++e) cqg[e] = a.in[I_CQG][l * 384 + lane * 6 + e];
#pragma unroll
    for (int e = 0; e < 4; ++e) ckvg[e] = a.in[I_CKVG][l * 256 + lane * 4 + e];
#pragma unroll
    for (int e = 0; e < 8; ++e) { qng[e] = a.in[I_NAQG][l * 64 + (lane & 7) * 8 + e] * (0.125f * LOG2E); kng[e] = a.in[I_NAKG][l * 64 + (lane & 7) * 8 + e]; }
    const float* mu0 = a.in[I_MU] + (size_t)l * 2 * 1920; const float* mu1 = mu0 + 1920;
    float kkv[8];
#pragma unroll
    for (int e = 0; e < 8; ++e) kkv[e] = a.in[I_KK][l * 512 + lane * 8 + e];
    const int gw = F.vcu * NWAVES + F.wave, NGW = F.G * NWAVES;
    for (int m = gw; m < R; m += NGW) {
        { const unsigned* p = (const unsigned*)(ZA + (size_t)m * ZA_LD) + lane * 3; const unsigned w0 = p[0], w1 = p[1], w2 = p[2];
          float v[6] = {lo_bf(w0), hi_bf(w0), lo_bf(w1), hi_bf(w1), lo_bf(w2), hi_bf(w2)}; float s = 0.f;
#pragma unroll
          for (int e = 0; e < 6; ++e) s += v[e] * v[e];
          const float rstd = rsqrtf(wave_sum(s) * (1.f / 384.f) + NORM_EPS);
          unsigned* o = (unsigned*)(CQN + (size_t)m * 384) + lane * 3;
          o[0] = cvtpk(v[0] * rstd * cqg[0], v[1] * rstd * cqg[1]); o[1] = cvtpk(v[2] * rstd * cqg[2], v[3] * rstd * cqg[3]); o[2] = cvtpk(v[4] * rstd * cqg[4], v[5] * rstd * cqg[5]); }
        { const u32x2 w = *((const u32x2*)(ZA + (size_t)m * ZA_LD + 384) + lane);
          float v[4] = {lo_bf(w.x), hi_bf(w.x), lo_bf(w.y), hi_bf(w.y)}; float s = v[0] * v[0] + v[1] * v[1] + v[2] * v[2] + v[3] * v[3];
          const float rstd = rsqrtf(wave_sum(s) * (1.f / 256.f) + NORM_EPS);
          u32x2 o; o.x = cvtpk(v[0] * rstd * ckvg[0], v[1] * rstd * ckvg[1]); o.y = cvtpk(v[2] * rstd * ckvg[2], v[3] * rstd * ckvg[3]);
          *((u32x2*)(CKVN + (size_t)m * 256) + lane) = o; }
        if (lane < 16) ((unsigned*)(KR + (size_t)m * 32))[lane] = ((const unsigned*)(ZA + (size_t)m * ZA_LD + 640))[lane];
#pragma unroll
        for (int qk = 0; qk < 2; ++qk) {
            u32x4* p = (u32x4*)(ZN + (size_t)m * ZN_LD + qk * 512) + lane; const u32x4 w = *p;
            float v[8] = {lo_bf(w.x), hi_bf(w.x), lo_bf(w.y), hi_bf(w.y), lo_bf(w.z), hi_bf(w.z), lo_bf(w.w), hi_bf(w.w)}; float s = 0.f;
#pragma unroll
            for (int e = 0; e < 8; ++e) s += v[e] * v[e];
            s += __shfl_xor(s, 1); s += __shfl_xor(s, 2); s += __shfl_xor(s, 4);
            const float rstd = rsqrtf(s * (1.f / 64.f) + NORM_EPS);
            u32x4 o;
            if (qk == 0) { o.x = cvtpk(v[0] * rstd * qng[0], v[1] * rstd * qng[1]); o.y = cvtpk(v[2] * rstd * qng[2], v[3] * rstd * qng[3]); o.z = cvtpk(v[4] * rstd * qng[4], v[5] * rstd * qng[5]); o.w = cvtpk(v[6] * rstd * qng[6], v[7] * rstd * qng[7]); }
            else { o.x = cvtpk(v[0] * rstd * kng[0], v[1] * rstd * kng[1]); o.y = cvtpk(v[2] * rstd * kng[2], v[3] * rstd * kng[3]); o.z = cvtpk(v[4] * rstd * kng[4], v[5] * rstd * kng[5]); o.w = cvtpk(v[6] * rstd * kng[6], v[7] * rstd * kng[7]); }
            *p = o;
        }
        const bool hasp = (m != 0) && (m != L), hasn = (m != L - 1) && (m != R - 1);
        const bf16_t* zc = ZR + (size_t)m * ZR_LD; const bf16_t* zp = zc - ZR_LD; const bf16_t* zn = zc + ZR_LD;
#pragma unroll
        for (int ch = 0; ch < 3; ++ch) {
            const int c0 = ch * 512 + lane * 8;
            const u32x4 wc_ = *(const u32x4*)(zc + c0); u32x4 wp = {0u, 0u, 0u, 0u}, wn = {0u, 0u, 0u, 0u};
            if (hasp) wp = *(const u32x4*)(zp + c0); if (hasn) wn = *(const u32x4*)(zn + c0);
            const float zcv[8] = {lo_bf(wc_.x), hi_bf(wc_.x), lo_bf(wc_.y), hi_bf(wc_.y), lo_bf(wc_.z), hi_bf(wc_.z), lo_bf(wc_.w), hi_bf(wc_.w)};
            const float zpv[8] = {lo_bf(wp.x), hi_bf(wp.x), lo_bf(wp.y), hi_bf(wp.y), lo_bf(wp.z), hi_bf(wp.z), lo_bf(wp.w), hi_bf(wp.w)};
            const float znv[8] = {lo_bf(wn.x), hi_bf(wn.x), lo_bf(wn.y), hi_bf(wn.y), lo_bf(wn.z), hi_bf(wn.z), lo_bf(wn.w), hi_bf(wn.w)};
            float o[8];
            const f32x4 ma = *(const f32x4*)(mu0 + c0), mb = *(const f32x4*)(mu0 + c0 + 4), na = *(const f32x4*)(mu1 + c0), nb = *(const f32x4*)(mu1 + c0 + 4);
            const float m0v[8] = {ma[0], ma[1], ma[2], ma[3], mb[0], mb[1], mb[2], mb[3]}, m1v[8] = {na[0], na[1], na[2], na[3], nb[0], nb[1], nb[2], nb[3]};
#pragma unroll
            for (int e = 0; e < 8; ++e) o[e] = zcv[e] + m0v[e] * (zpv[e] - zcv[e]) + m1v[e] * (znv[e] - zcv[e]);
            u32x4 w; w.x = cvtpk(o[0], o[1]); w.y = cvtpk(o[2], o[3]); w.z = cvtpk(o[4], o[5]); w.w = cvtpk(o[6], o[7]);
            *(u32x4*)(RKV + (size_t)m * RKV_LD + c0) = w;
            if (ch == 1) {
                const float kr_[8] = {lo_bf(w.x), hi_bf(w.x), lo_bf(w.y), hi_bf(w.y), lo_bf(w.z), hi_bf(w.z), lo_bf(w.w), hi_bf(w.w)};
                float s2 = 0.f;
#pragma unroll
                for (int e = 0; e < 8; ++e) { const float kx = kr_[e] * kkv[e]; s2 += kx * kx; }
                s2 += __shfl_xor(s2, 1); s2 += __shfl_xor(s2, 2); s2 += __shfl_xor(s2, 4);
                if ((lane & 7) == 0) ((float*)(F.ws + WS_KN))[(size_t)m * 8 + (lane >> 3)] = 1.f / fmaxf(sqrtf(s2), 1e-12f);
            }
        }
#pragma unroll
        for (int ch = 0; ch < 3; ++ch) {
            const int c0 = 1536 + ch * 128 + lane * 2;
            const unsigned wc_ = *(const unsigned*)(zc + c0); unsigned wp = 0u, wn = 0u;
            if (hasp) wp = *(const unsigned*)(zp + c0); if (hasn) wn = *(const unsigned*)(zn + c0);
            float o0 = lo_bf(wc_), o1 = hi_bf(wc_);
            o0 = o0 + mu0[c0] * (lo_bf(wp) - o0) + mu1[c0] * (lo_bf(wn) - o0);
            o1 = o1 + mu0[c0 + 1] * (hi_bf(wp) - o1) + mu1[c0 + 1] * (hi_bf(wn) - o1);
            if (ch == 0) { o0 = tanhf(o0); o1 = tanhf(o1); } else if (ch == 2) { o0 = sigmoidf_(o0); o1 = sigmoidf_(o1); }
            *(unsigned*)(LA + (size_t)m * 384 + ch * 128 + lane * 2) = cvtpk(o0, o1);
        }
    }
}

__device__ __forceinline__ void mla_fixup(const Frame& F, const Args& a, int l, bool need_ctx_q) {
    const bf16_t* QRAW = (const bf16_t*)(F.ws + WS_QRAW); const bf16_t* KVRAW = (const bf16_t*)(F.ws + WS_KVRAW); const bf16_t* KR = (const bf16_t*)(F.ws + WS_KR);
    bf16_t* Q = (bf16_t*)(F.ws + WS_Q); bf16_t* K = (bf16_t*)(F.ws + WS_K); bf16_t* V = (bf16_t*)(F.ws + WS_V);
    const int lane = F.lane, h = lane >> 3, sub = lane & 7;
    float qg[12], kg[12];
#pragma unroll
    for (int i = 0; i < 12; ++i) { qg[i] = a.in[I_QNG][l * 96 + sub + 8 * i] * (0.10206207261596575f * LOG2E); kg[i] = a.in[I_KNG][l * 96 + sub + 8 * i]; }
    const float freq = __expf(-9.210340371976184f * (float)sub * 0.125f);
    const int gw = F.vcu * NWAVES + F.wave, NGW = F.G * NWAVES;
    for (int m0 = gw; m0 < R * PROBE_ROW; m0 += NGW) { const int m = m0 % R;
        const bool lat = m < L;
        float cr = 1.f, sr = 0.f, cc = 1.f, sc = 0.f;
        if (lat) { sincosf((float)(m >> 6) * freq, &sr, &cr); sincosf((float)(m & 63) * freq, &sc, &cc); }
        if (lat || need_ctx_q) {
            float v[12]; float s = 0.f;
#pragma unroll
            for (int i = 0; i < 12; ++i) { v[i] = bf2f(QRAW[(size_t)m * 768 + h * 96 + sub + 8 * i]); s += v[i] * v[i]; }
            s += __shfl_xor(s, 1); s += __shfl_xor(s, 2); s += __shfl_xor(s, 4);
            const float rstd = rsqrtf(s * (1.f / 96.f) + NORM_EPS);
#pragma unroll
            for (int i = 0; i < 12; ++i) v[i] *= rstd * qg[i];
            { const float t1 = v[8], t2 = v[9]; v[8] = t1 * cr - t2 * sr; v[9] = t1 * sr + t2 * cr; }
            { const float t1 = v[10], t2 = v[11]; v[10] = t1 * cc - t2 * sc; v[11] = t1 * sc + t2 * cc; }
            bf16_t* qo = Q + ((size_t)h * R + m) * 96 + sub;
#pragma unroll
            for (int i = 0; i < 12; ++i) qo[8 * i] = (bf16_t)(cvtpk(v[i], 0.f) & 0xffffu);
        }
        {
            float v[12]; float s = 0.f;
#pragma unroll
            for (int i = 0; i < 8; ++i) v[i] = bf2f(KVRAW[(size_t)m * 1024 + h * 128 + sub + 8 * i]);
#pragma unroll
            for (int i = 0; i < 4; ++i) v[8 + i] = bf2f(KR[(size_t)m * 32 + sub + 8 * i]);
#pragma unroll
            for (int i = 0; i < 12; ++i) s += v[i] * v[i];
            s += __shfl_xor(s, 1); s += __shfl_xor(s, 2); s += __shfl_xor(s, 4);
            const float rstd = rsqrtf(s * (1.f / 96.f) + NORM_EPS);
#pragma unroll
            for (int i = 0; i < 12; ++i) v[i] *= rstd * kg[i];
            { const float t1 = v[8], t2 = v[9]; v[8] = t1 * cr - t2 * sr; v[9] = t1 * sr + t2 * cr; }
            { const float t1 = v[10], t2 = v[11]; v[10] = t1 * cc - t2 * sc; v[11] = t1 * sc + t2 * cc; }
            bf16_t* ko = K + ((size_t)h * R + m) * 96 + sub;
#pragma unroll
            for (int i = 0; i < 12; ++i) ko[8 * i] = (bf16_t)(cvtpk(v[i], 0.f) & 0xffffu);
            *(u32x4*)(V + ((size_t)h * R + m) * 64 + sub * 8) = *(const u32x4*)(KVRAW + (size_t)m * 1024 + h * 128 + 64 + sub * 8);
        }
    }
}

__device__ __forceinline__ void rwkv_output_rows(const Frame& F, const Args& a, int l, int m_end) {
    const bf16_t* RKV = (const bf16_t*)(F.ws + WS_RKV); const bf16_t* LO = (const bf16_t*)(F.ws + WS_LO);
    const bf16_t* YF = (const bf16_t*)(F.ws + WS_YF); const bf16_t* YBK = (const bf16_t*)(F.ws + WS_YBK); bf16_t* YR = (bf16_t*)(F.ws + WS_YR);
    const int lane = F.lane, c0 = lane * 8;
    float ka[8], rk[8], lg[8], lb[8];
#pragma unroll
    for (int e = 0; e < 8; ++e) { ka[e] = a.in[I_KA][l * 512 + c0 + e]; rk[e] = a.in[I_RK][l * 512 + c0 + e]; lg[e] = a.in[I_LNG][l * 512 + c0 + e]; lb[e] = a.in[I_LNB][l * 512 + c0 + e]; }
    const int gw = F.vcu * NWAVES + F.wave, NGW = F.G * NWAVES;
#define UNPK8(W, V) const float V[8] = {lo_bf(W.x), hi_bf(W.x), lo_bf(W.y), hi_bf(W.y), lo_bf(W.z), hi_bf(W.z), lo_bf(W.w), hi_bf(W.w)}
    for (int m0 = gw; m0 < m_end * PROBE_ROW; m0 += NGW) { const int m = m0 % m_end;
        const u32x4 wr_ = *(const u32x4*)(RKV + (size_t)m * RKV_LD + c0), wk_ = *(const u32x4*)(RKV + (size_t)m * RKV_LD + 512 + c0), wv_ = *(const u32x4*)(RKV + (size_t)m * RKV_LD + 1024 + c0);
        const u32x4 wa0 = *(const u32x4*)(LO + (size_t)m * LO_LD + 1024 + c0), wa1 = *(const u32x4*)(LO + (size_t)m * LO_LD + 1536 + c0), wg_ = *(const u32x4*)(LO + (size_t)m * LO_LD + 2048 + c0);
        const u32x4 wyf = *(const u32x4*)(YF + (size_t)m * 512 + c0), wyb = *(const u32x4*)(YBK + (size_t)m * 512 + c0);
        UNPK8(wr_, r); UNPK8(wk_, k); UNPK8(wv_, v); UNPK8(wa0, a0v); UNPK8(wa1, a1v); UNPK8(wg_, g); UNPK8(wyf, yf); UNPK8(wyb, yb);
        float y[8]; float s = 0.f, bs = 0.f;
#pragma unroll
        for (int e = 0; e < 8; ++e) { y[e] = yf[e] + yb[e]; s += y[e];
            const float kd0 = k[e] * (1.f + (a0v[e] - 1.f) * ka[e]), kd1 = k[e] * (1.f + (a1v[e] - 1.f) * ka[e]);
            bs += r[e] * rk[e] * (kd0 + kd1); }
        s += __shfl_xor(s, 1); s += __shfl_xor(s, 2); s += __shfl_xor(s, 4);
        bs += __shfl_xor(bs, 1); bs += __shfl_xor(bs, 2); bs += __shfl_xor(bs, 4);
        const float mean = s * (1.f / 64.f); float q = 0.f;
#pragma unroll
        for (int e = 0; e < 8; ++e) { const float d = y[e] - mean; q += d * d; }
        q += __shfl_xor(q, 1); q += __shfl_xor(q, 2); q += __shfl_xor(q, 4);
        const float rstd = rsqrtf(q * (1.f / 64.f) + 64e-5f);
        float o[8];
#pragma unroll
        for (int e = 0; e < 8; ++e) o[e] = ((y[e] - mean) * rstd * lg[e] + lb[e] + bs * v[e]) * g[e];
        u32x4 w; w.x = cvtpk(o[0], o[1]); w.y = cvtpk(o[2], o[3]); w.z = cvtpk(o[4], o[5]); w.w = cvtpk(o[6], o[7]);
        *(u32x4*)(YR + (size_t)m * 512 + c0) = w;
    }
#undef UNPK8
}

__device__ __forceinline__ int crow(int r, int hi) { return (r & 3) + 8 * (r >> 2) + 4 * hi; }
#define SBAR() __builtin_amdgcn_sched_barrier(0)
__device__ __forceinline__ s16x4 tr_read_at(unsigned addr) { s16x4 r; asm volatile("ds_read_b64_tr_b16 %0, %1" : "=&v"(r) : "v"(addr) : "memory"); return r; }
__device__ __forceinline__ float rowmax32(const f32x16& p0, const f32x16& p1) {
    float m = p0[0];
#pragma unroll
    for (int r = 1; r < 16; ++r) m = fmaxf(m, p0[r]);
#pragma unroll
    for (int r = 0; r < 16; ++r) m = fmaxf(m, p1[r]);
    auto rr = __builtin_amdgcn_permlane32_swap(__float_as_uint(m), __float_as_uint(m), false, false);
    return fmaxf(__uint_as_float(rr[0]), __uint_as_float(rr[1]));
}
__device__ __forceinline__ float halfsum(float s) {
    auto rr = __builtin_amdgcn_permlane32_swap(__float_as_uint(s), __float_as_uint(s), false, false);
    return __uint_as_float(rr[0]) + __uint_as_float(rr[1]);
}
__device__ __forceinline__ void pack_p(const f32x16& p0, const f32x16& p1, bf16x8 (&pa)[4]) {
#define PK8(P, B, OUT) do { u32x4 w = {cvtpk(P[B + 0], P[B + 1]), cvtpk(P[B + 2], P[B + 3]), cvtpk(P[B + 4], P[B + 5]), cvtpk(P[B + 6], P[B + 7])}; OUT = __builtin_bit_cast(bf16x8, w); } while (0)
    PK8(p0, 0, pa[0]); PK8(p0, 8, pa[1]); PK8(p1, 0, pa[2]); PK8(p1, 8, pa[3]);
#undef PK8
}

constexpr int AK_PITCH = 208, AK_BYTES = 64 * AK_PITCH, AV_BYTES = 8192;
constexpr int ANSLOT = 6;
constexpr int ALDS_K = 0, ALDS_V = ANSLOT * AK_BYTES, ALDS_WS = ALDS_V + ANSLOT * AV_BYTES, ALDS_END = ALDS_WS + 8 * 256;
static_assert(ALDS_END <= 131072, "MLA LDS");
typedef short v4i16_t __attribute__((ext_vector_type(4)));
__device__ __forceinline__ s16x4 vtr(LAS const unsigned char* p) { return __builtin_bit_cast(s16x4, __builtin_amdgcn_ds_read_tr16_b64_v4i16((LAS v4i16_t*)p)); }
__device__ __forceinline__ void mla_unit(const Frame& F, int h, int q0, int k0, int nt) {
    const bf16_t* Q = (const bf16_t*)(F.ws + WS_Q) + (size_t)h * R * 96; const bf16_t* K = (const bf16_t*)(F.ws + WS_K) + (size_t)h * R * 96 + (size_t)k0 * 96;
    const bf16_t* V = (const bf16_t*)(F.ws + WS_V) + (size_t)h * R * 64 + (size_t)k0 * 64; bf16_t* YA = (bf16_t*)(F.ws + WS_YA);
    LAS unsigned char* lds = F.lds;
    const int tid = F.tid, lane = F.lane, wid = F.wave, r32 = lane & 31, hi = lane >> 5;
    LAS float* wsf = (LAS float*)(lds + ALDS_WS) + wid * 64;
    bf16x8 qr[6];
    { const bf16_t* qp = Q + (size_t)(q0 + wid * 32 + r32) * 96 + hi * 8;
#pragma unroll
      for (int s = 0; s < 6; ++s) qr[s] = *(const bf16x8*)(qp + s * 16); }
    const int kc0 = tid, kc1 = 512 + tid; const bool k2 = tid < 256;
    const int kr0 = kc0 / 12, kq0 = kc0 % 12, kr1 = kc1 / 12, kq1 = kc1 % 12;
    const int vkey = tid >> 3, vc8 = tid & 7;
    const unsigned kdst0 = kr0 * AK_PITCH + kq0 * 16, kdst1 = kr1 * AK_PITCH + kq1 * 16;
    const unsigned vdst = (vc8 >> 2) * 4096 + vkey * 64 + (vc8 & 3) * 16;
    u32x4 sk0, sk1, sv, tk0, tk1, tv;
#define A_LOAD(t) do { const bf16_t* kt = K + (size_t)(t) * 64 * 96; sk0 = *(const u32x4*)(kt + kr0 * 96 + kq0 * 8); if (k2) sk1 = *(const u32x4*)(kt + kr1 * 96 + kq1 * 8); \
        sv = *(const u32x4*)(V + (size_t)(t) * 64 * 64 + vkey * 64 + vc8 * 8); } while (0)
#define A_WRITE(sl) do { *(LAS u32x4*)(lds + ALDS_K + (sl) * AK_BYTES + kdst0) = sk0; if (k2) *(LAS u32x4*)(lds + ALDS_K + (sl) * AK_BYTES + kdst1) = sk1; \
        *(LAS u32x4*)(lds + ALDS_V + (sl) * AV_BYTES + vdst) = sv; } while (0)
#define A_LOAD2(t) do { const bf16_t* kt = K + (size_t)(t) * 64 * 96; tk0 = *(const u32x4*)(kt + kr0 * 96 + kq0 * 8); if (k2) tk1 = *(const u32x4*)(kt + kr1 * 96 + kq1 * 8); \
        tv = *(const u32x4*)(V + (size_t)(t) * 64 * 64 + vkey * 64 + vc8 * 8); } while (0)
#define A_WRITE2(sl) do { *(LAS u32x4*)(lds + ALDS_K + (sl) * AK_BYTES + kdst0) = tk0; if (k2) *(LAS u32x4*)(lds + ALDS_K + (sl) * AK_BYTES + kdst1) = tk1; \
        *(LAS u32x4*)(lds + ALDS_V + (sl) * AV_BYTES + vdst) = tv; } while (0)
    f32x16 o[2]; o[0] = f32x16{}; o[1] = f32x16{};
    float mref = 0.f, lsum = 0.f; f32x16 negm = f32x16{};
    LAS const unsigned char* kb_rd = lds + ALDS_K + r32 * AK_PITCH + hi * 16;
    LAS const unsigned char* vb_rd = lds + ALDS_V + ((lane >> 4) & 1) * 32 + (lane & 3) * 8 + (4 * hi + ((lane & 15) >> 2)) * 64;
#define PIN(x) asm volatile("" : "+v"(x))
#define A_QKT(C0, C1, sl) do { LAS const unsigned char* kt_ = kb_rd + (sl) * AK_BYTES; C0 = negm; C1 = negm; \
        _Pragma("unroll") for (int s = 0; s < 6; ++s) { const bf16x8 a0 = *(LAS const bf16x8*)(kt_ + s * 32); const bf16x8 a1 = *(LAS const bf16x8*)(kt_ + 32 * AK_PITCH + s * 32); \
            C0 = __builtin_amdgcn_mfma_f32_32x32x16_bf16(a0, qr[s], C0, 0, 0, 0); C1 = __builtin_amdgcn_mfma_f32_32x32x16_bf16(a1, qr[s], C1, 0, 0, 0); } } while (0)
#define A_MAX(C0, C1, al) do { const float rm_ = rowmax32(C0, C1); al = 1.f; \
        if (__builtin_expect(__any(rm_ > 8.f), 0)) { const float dl_ = fmaxf(rm_, 0.f); mref += dl_; al = __builtin_amdgcn_exp2f(-dl_); \
            _Pragma("unroll") for (int r = 0; r < 16; ++r) { C0[r] -= dl_; C1[r] -= dl_; negm[r] = -mref; } } } while (0)
#define A_RESC(al) do { if (__any((al) < 1.f)) { if (hi == 0) wsf[r32] = (al); LDS_WAIT(); \
        _Pragma("unroll") for (int r = 0; r < 16; ++r) { const float f_ = wsf[crow(r, hi)]; o[0][r] *= f_; o[1][r] *= f_; } } } while (0)
#define A_STEP(C0, C1, P0, P1, sk_, sv_, alP, alC) do { \
        LAS const unsigned char* kt_ = kb_rd + (sk_) * AK_BYTES; LAS const unsigned char* vt_ = vb_rd + (sv_) * AV_BYTES; \
        bf16x8 ka_[2], kb_[2]; u32x4 pw_[4]; float ps0_ = 0.f, ps1_ = 0.f; \
        ka_[0] = *(LAS const bf16x8*)(kt_); kb_[0] = *(LAS const bf16x8*)(kt_ + 32 * AK_PITCH); SBAR(); \
        _Pragma("unroll") for (int s = 0; s < 6; ++s) { const int c_ = s & 1, n_ = c_ ^ 1; \
            if (s + 1 < 6) { ka_[n_] = *(LAS const bf16x8*)(kt_ + (s + 1) * 32); kb_[n_] = *(LAS const bf16x8*)(kt_ + 32 * AK_PITCH + (s + 1) * 32); } \
            if (s == 0) C0 = __builtin_amdgcn_mfma_f32_32x32x16_bf16(ka_[c_], qr[s], negm, 0, 0, 0); else C0 = __builtin_amdgcn_mfma_f32_32x32x16_bf16(ka_[c_], qr[s], C0, 0, 0, 0); \
            if (s < 4) { ps0_ += P0[4 * s] + P0[4 * s + 1]; ps1_ += P0[4 * s + 2] + P0[4 * s + 3]; PIN(ps0_); PIN(ps1_); } \
            else { pw_[2 * (s - 4)][0] = cvtpk(P0[8 * (s - 4)], P0[8 * (s - 4) + 1]); pw_[2 * (s - 4)][1] = cvtpk(P0[8 * (s - 4) + 2], P0[8 * (s - 4) + 3]); pw_[2 * (s - 4)][2] = cvtpk(P0[8 * (s - 4) + 4], P0[8 * (s - 4) + 5]); pw_[2 * (s - 4)][3] = cvtpk(P0[8 * (s - 4) + 6], P0[8 * (s - 4) + 7]); PIN(pw_[2 * (s - 4)]); } \
            SBAR(); \
            if (s == 0) C1 = __builtin_amdgcn_mfma_f32_32x32x16_bf16(kb_[c_], qr[s], negm, 0, 0, 0); else C1 = __builtin_amdgcn_mfma_f32_32x32x16_bf16(kb_[c_], qr[s], C1, 0, 0, 0); \
            if (s < 4) { ps0_ += P1[4 * s] + P1[4 * s + 1]; ps1_ += P1[4 * s + 2] + P1[4 * s + 3]; PIN(ps0_); PIN(ps1_); } \
            else { pw_[2 * (s - 4) + 1][0] = cvtpk(P1[8 * (s - 4)], P1[8 * (s - 4) + 1]); pw_[2 * (s - 4) + 1][1] = cvtpk(P1[8 * (s - 4) + 2], P1[8 * (s - 4) + 3]); pw_[2 * (s - 4) + 1][2] = cvtpk(P1[8 * (s - 4) + 4], P1[8 * (s - 4) + 5]); pw_[2 * (s - 4) + 1][3] = cvtpk(P1[8 * (s - 4) + 6], P1[8 * (s - 4) + 7]); PIN(pw_[2 * (s - 4) + 1]); } \
            SBAR(); } \
        lsum = lsum * (alP) + (ps0_ + ps1_); \
        A_MAX(C0, C1, alC); SBAR(); \
          \
        s16x4 vl_[2], vh_[2]; vl_[0] = vtr(vt_); vh_[0] = vtr(vt_ + 512); SBAR(); \
        _Pragma("unroll") for (int m_ = 0; m_ < 8; ++m_) { const int dt_ = m_ >> 2, s_ = m_ & 3, c_ = m_ & 1, n_ = c_ ^ 1; \
            if (m_ + 1 < 8) { vl_[n_] = vtr(vt_ + ((m_ + 1) >> 2) * 4096 + ((m_ + 1) & 3) * 1024); vh_[n_] = vtr(vt_ + ((m_ + 1) >> 2) * 4096 + ((m_ + 1) & 3) * 1024 + 512); } \
            const bf16x8 vf_ = {vl_[c_][0], vl_[c_][1], vl_[c_][2], vl_[c_][3], vh_[c_][0], vh_[c_][1], vh_[c_][2], vh_[c_][3]}; \
            const int pi_ = (s_ == 0) ? 0 : (s_ == 1) ? 2 : (s_ == 2) ? 1 : 3; \
            o[dt_] = __builtin_amdgcn_mfma_f32_32x32x16_bf16(__builtin_bit_cast(bf16x8, pw_[pi_]), vf_, o[dt_], 0, 0, 0); \
            if (m_ < 4) { C0[4 * m_] = __builtin_amdgcn_exp2f(C0[4 * m_]); C0[4 * m_ + 1] = __builtin_amdgcn_exp2f(C0[4 * m_ + 1]); C0[4 * m_ + 2] = __builtin_amdgcn_exp2f(C0[4 * m_ + 2]); C0[4 * m_ + 3] = __builtin_amdgcn_exp2f(C0[4 * m_ + 3]); PIN(C0); } \
            else { C1[4 * (m_ - 4)] = __builtin_amdgcn_exp2f(C1[4 * (m_ - 4)]); C1[4 * (m_ - 4) + 1] = __builtin_amdgcn_exp2f(C1[4 * (m_ - 4) + 1]); C1[4 * (m_ - 4) + 2] = __builtin_amdgcn_exp2f(C1[4 * (m_ - 4) + 2]); C1[4 * (m_ - 4) + 3] = __builtin_amdgcn_exp2f(C1[4 * (m_ - 4) + 3]); PIN(C1); } \
            SBAR(); } \
    } while (0)
    f32x16 pA0, pA1, pB0, pB1; float alA = 1.f, alB = 1.f;
    A_LOAD(0); A_WRITE(0); A_LOAD(1); A_WRITE(1); A_LOAD(2); A_LOAD2(3); __syncthreads();
    A_QKT(pA0, pA1, 0); A_MAX(pA0, pA1, alA);
#pragma unroll
    for (int r = 0; r < 16; ++r) { pA0[r] = __builtin_amdgcn_exp2f(pA0[r]); pA1[r] = __builtin_amdgcn_exp2f(pA1[r]); }
    A_WRITE(2); A_WRITE2(3);
    if (nt > 4) { A_LOAD(4); A_LOAD2(5); A_WRITE(4); A_WRITE2(5); }
    __syncthreads();
    alA = 1.f;
    int sk = 1, sv_ = 0, sw = 0;
#define A_NEXT(x) ((x) == ANSLOT - 1 ? 0 : (x) + 1)
    for (int t = 1; t + 1 < nt; t += 2) {
        const bool st = t + 6 < nt;
        if (st) { A_LOAD(t + 5); A_LOAD2(t + 6); }
        A_STEP(pB0, pB1, pA0, pA1, sk, sv_, alA, alB);
        A_RESC(alB);
        sv_ = sk; sk = A_NEXT(sk);
        A_STEP(pA0, pA1, pB0, pB1, sk, sv_, alB, alA);
        __syncthreads(); if (st) { A_WRITE(sw); A_WRITE2(A_NEXT(sw)); } A_RESC(alA);
        sv_ = sk; sk = A_NEXT(sk); sw = A_NEXT(A_NEXT(sw));
    }
    A_STEP(pB0, pB1, pA0, pA1, sk, sv_, alA, alB);
    A_RESC(alB);
    { float ps = 0.f;
#pragma unroll
      for (int r = 0; r < 16; ++r) ps += pB0[r] + pB1[r];
      lsum = lsum * alB + ps;
      bf16x8 pa[4]; pack_p(pB0, pB1, pa);
      LAS const unsigned char* vt_ = vb_rd + sk * AV_BYTES;
#pragma unroll
      for (int dt = 0; dt < 2; ++dt)
#pragma unroll
          for (int s = 0; s < 4; ++s) { const s16x4 lo_ = vtr(vt_ + dt * 4096 + s * 1024), hh_ = vtr(vt_ + dt * 4096 + s * 1024 + 512);
              const bf16x8 vf = {lo_[0], lo_[1], lo_[2], lo_[3], hh_[0], hh_[1], hh_[2], hh_[3]};
              o[dt] = __builtin_amdgcn_mfma_f32_32x32x16_bf16(pa[s], vf, o[dt], 0, 0, 0); } }
    lsum = halfsum(lsum);
    if (hi == 0) wsf[r32] = lsum; LDS_WAIT();
#pragma unroll
    for (int r = 0; r < 16; ++r) { const float inv = 1.f / wsf[crow(r, hi)]; const int row = q0 + wid * 32 + crow(r, hi);
        bf16_t* op = YA + (size_t)row * 512 + h * 64 + r32;
        op[0] = (bf16_t)(cvtpk(o[0][r] * inv, 0.f) & 0xffffu); op[32] = (bf16_t)(cvtpk(o[1][r] * inv, 0.f) & 0xffffu); }
    __syncthreads();
#undef A_LOAD
#undef A_WRITE
#undef A_LOAD2
#undef A_WRITE2
#undef A_NEXT
#undef A_QKT
#undef A_MAX
#undef A_RESC
#undef A_STEP
#undef PIN
}

constexpr int NLDS_V = 0, NLDS_RPB = 8 * 8192, NLDS_WS = NLDS_RPB + 8 * 2048, NLDS_END = NLDS_WS + 8 * 256;
__device__ __forceinline__ void na_unit(const Frame& F, const float* rpb_l, int unit, bool ctxq, int qt) {
    const bf16_t* ZN = (const bf16_t*)(F.ws + WS_ZN); bf16_t* YB = (bf16_t*)(F.ws + WS_YB);
    LAS unsigned char* lds = F.lds;
    const int lane = F.lane, h = F.wave, r32 = lane & 31, hi = lane >> 5;
    LAS unsigned char* vlds = lds + NLDS_V + h * 8192; LAS float* rpbs = (LAS float*)(lds + NLDS_RPB + h * 2048); LAS float* wsf = (LAS float*)(lds + NLDS_WS) + h * 64;
    const int qrow0 = ctxq ? L + unit * 64 : unit * 64;
    const int rs = ctxq ? 0 : min(max(unit - 4, 0), 256 - 8);
    for (int i = lane; i < 15 * 31; i += 64) rpbs[i] = rpb_l[h * 465 + i] * LOG2E;
    bf16x8 qr[4];
#pragma unroll
    for (int s = 0; s < 4; ++s) qr[s] = *(const bf16x8*)(ZN + (size_t)(qrow0 + qt * 32 + r32) * ZN_LD + h * 64 + s * 16 + hi * 8);
    f32x16 o[2]; o[0] = f32x16{}; o[1] = f32x16{};
    float mref = -1e30f, lsum = 0.f;
    const unsigned vb_rd = (unsigned)(uintptr_t)vlds + ((lane >> 4) & 1) * 32 + (lane & 3) * 8 + (4 * hi + ((lane & 15) >> 2)) * 64;
    const int ntl = ctxq ? 0 : 8, nt = ntl + 4;
    LDS_WAIT();
    for (int t = 0; t < nt; ++t) {
        const bool local = t < ntl;
        const int krow0 = local ? (rs + t) * 64 : L + (t - ntl) * 64;
        bf16x8 kf[2][4];
#pragma unroll
        for (int hf = 0; hf < 2; ++hf)
#pragma unroll
            for (int s = 0; s < 4; ++s) kf[hf][s] = *(const bf16x8*)(ZN + (size_t)(krow0 + hf * 32 + r32) * ZN_LD + 512 + h * 64 + s * 16 + hi * 8);
        u32x4 sv[8];
#pragma unroll
        for (int i = 0; i < 8; ++i) { const int c = i * 64 + lane; sv[i] = *(const u32x4*)(ZN + (size_t)(krow0 + (c >> 3)) * ZN_LD + 1024 + h * 64 + (c & 7) * 8); }
#pragma unroll
        for (int i = 0; i < 8; ++i) { const int c = i * 64 + lane; const int key = c >> 3, c8 = c & 7; *(LAS u32x4*)(vlds + (c8 >> 2) * 4096 + key * 64 + (c8 & 3) * 16) = sv[i]; }
        LDS_WAIT();
        const int dr = rs + t - unit + 7;
        {
            f32x16 p0 = f32x16{}, p1 = f32x16{};
#pragma unroll
            for (int s = 0; s < 4; ++s) { p0 = __builtin_amdgcn_mfma_f32_32x32x16_bf16(kf[0][s], qr[s], p0, 0, 0, 0); p1 = __builtin_amdgcn_mfma_f32_32x32x16_bf16(kf[1][s], qr[s], p1, 0, 0, 0); }
            if (local) {
                const int qc = qt * 32 + r32, cs = min(max(qc - 8, 0), 48);
#pragma unroll
                for (int r = 0; r < 16; ++r) { const int kc0 = crow(r, hi), kc1 = kc0 + 32;
                    const bool v0 = (kc0 >= cs) && (kc0 < cs + 16), v1 = (kc1 >= cs) && (kc1 < cs + 16);
                    const int d0 = v0 ? kc0 - qc + 15 : 0, d1 = v1 ? kc1 - qc + 15 : 0;
                    const float b0 = rpbs[dr * 31 + d0], b1 = rpbs[dr * 31 + d1];
                    p0[r] = v0 ? p0[r] + b0 : -1e30f; p1[r] = v1 ? p1[r] + b1 : -1e30f; }
            }
            const float rm = rowmax32(p0, p1);
            if (__any(rm > mref + 8.f)) {
                const float mn = fmaxf(mref, rm); const float al = __builtin_amdgcn_exp2f(mref - mn); mref = mn; lsum *= al;
                if (hi == 0) wsf[r32] = al; LDS_WAIT();
#pragma unroll
                for (int r = 0; r < 16; ++r) { const float f = wsf[crow(r, hi)]; o[0][r] *= f; o[1][r] *= f; }
                LDS_WAIT();
            }
            float ps = 0.f;
#pragma unroll
            for (int r = 0; r < 16; ++r) { p0[r] = __builtin_amdgcn_exp2f(p0[r] - mref); p1[r] = __builtin_amdgcn_exp2f(p1[r] - mref); ps += p0[r] + p1[r]; }
            lsum += ps;
            bf16x8 pa[4]; pack_p(p0, p1, pa);
#pragma unroll
            for (int dt = 0; dt < 2; ++dt) {
                s16x4 lo[4], hh[4];
#pragma unroll
                for (int s = 0; s < 4; ++s) { lo[s] = tr_read_at(vb_rd + dt * 4096 + s * 1024); hh[s] = tr_read_at(vb_rd + dt * 4096 + s * 1024 + 512); }
                LDS_WAIT(); SBAR();
#pragma unroll
                for (int s = 0; s < 4; ++s) { const bf16x8 vf = {lo[s][0], lo[s][1], lo[s][2], lo[s][3], hh[s][0], hh[s][1], hh[s][2], hh[s][3]};
                    o[dt] = __builtin_amdgcn_mfma_f32_32x32x16_bf16(pa[s], vf, o[dt], 0, 0, 0); }
            }
        }
        LDS_WAIT(); SBAR();
    }
    {
        const float ls = halfsum(lsum);
        if (hi == 0) wsf[r32] = ls; LDS_WAIT();
#pragma unroll
        for (int r = 0; r < 16; ++r) { const float inv = 1.f / wsf[crow(r, hi)]; const int row = qrow0 + qt * 32 + crow(r, hi);
            bf16_t* op = YB + (size_t)row * 512 + h * 64 + r32;
            op[0] = (bf16_t)(cvtpk(o[0][r] * inv, 0.f) & 0xffffu); op[32] = (bf16_t)(cvtpk(o[1][r] * inv, 0.f) & 0xffffu); }
        LDS_WAIT();
    }
}

__device__ __forceinline__ int rw_row2(int d, int seq, int t) {
    if (seq == 0) return d == 0 ? L + t : L + (CT - 1) - t;
    return d == 0 ? t : (L - 1) - t;
}
__device__ __forceinline__ void rwkv_pass2(const Frame& F, int dh, int it) {
    const int lane = F.lane, r32 = lane & 31, hi = lane >> 5;
    float* Qb = (float*)(F.ws + WS_QST) + (size_t)dh * NCH * 4096;
    f32x16 X[2];
#pragma unroll
    for (int jt = 0; jt < 2; ++jt)
#pragma unroll
        for (int r = 0; r < 16; ++r) X[jt][r] = Qb[(size_t)(32 * it + r32) * 64 + 32 * jt + crow(r, hi)];
    bf16x8 pnx[2][2][2]; f32x4 qn[2][4];
    const bf16_t* PTb = (const bf16_t*)(F.ws + WS_PST) + (size_t)dh * NCH * 4096;
#define P2_LOAD(ci_) do { const bf16_t* P_ = PTb + (size_t)(ci_) * 4096; const float* Q_ = Qb + (size_t)(ci_) * 4096 + (size_t)(32 * it + r32) * 64 + 4 * hi; \
        _Pragma("unroll") for (int jn = 0; jn < 2; ++jn) _Pragma("unroll") for (int jt = 0; jt < 2; ++jt) _Pragma("unroll") for (int s = 0; s < 2; ++s) pnx[jn][jt][s] = *(const bf16x8*)(P_ + (size_t)(32 * jn + r32) * 64 + jt * 32 + s * 16 + hi * 8); \
        _Pragma("unroll") for (int jt = 0; jt < 2; ++jt) _Pragma("unroll") for (int g = 0; g < 4; ++g) qn[jt][g] = *(const f32x4*)(Q_ + 32 * jt + 8 * g); } while (0)
    P2_LOAD(1);
    for (int ci = 1; ci < NCH - 1; ++ci) {
        float* Qc = Qb + (size_t)ci * 4096;
        bf16x8 pa[2][2][2]; f32x16 N[2];
#pragma unroll
        for (int jn = 0; jn < 2; ++jn)
#pragma unroll
            for (int jt = 0; jt < 2; ++jt)
#pragma unroll
                for (int s = 0; s < 2; ++s) pa[jn][jt][s] = pnx[jn][jt][s];
#pragma unroll
        for (int jt = 0; jt < 2; ++jt)
#pragma unroll
            for (int r = 0; r < 16; ++r) N[jt][r] = qn[jt][r >> 2][r & 3];
        if (ci + 1 < NCH - 1) P2_LOAD(ci + 1);
        bf16x8 bh[2][2], bl[2][2];
#pragma unroll
        for (int jt = 0; jt < 2; ++jt)
#pragma unroll
            for (int s = 0; s < 2; ++s) {
                unsigned wh[4], wl[4];
#pragma unroll
                for (int e2 = 0; e2 < 4; ++e2) { const float x0 = X[jt][8 * s + 2 * e2], x1 = X[jt][8 * s + 2 * e2 + 1]; const unsigned h = cvtpk(x0, x1); wh[e2] = h; wl[e2] = cvtpk(x0 - lo_bf(h), x1 - hi_bf(h)); }
                u32x4 a = {wh[0], wh[1], wh[2], wh[3]}, b = {wl[0], wl[1], wl[2], wl[3]}; bh[jt][s] = __builtin_bit_cast(bf16x8, a); bl[jt][s] = __builtin_bit_cast(bf16x8, b);
            }
#pragma unroll
        for (int jn = 0; jn < 2; ++jn)
#pragma unroll
            for (int jt = 0; jt < 2; ++jt)
#pragma unroll
                for (int s = 0; s < 2; ++s) { N[jn] = __builtin_amdgcn_mfma_f32_32x32x16_bf16(pa[jn][jt][s], bh[jt][s], N[jn], 0, 0, 0); N[jn] = __builtin_amdgcn_mfma_f32_32x32x16_bf16(pa[jn][jt][s], bl[jt][s], N[jn], 0, 0, 0); }
        X[0] = N[0]; X[1] = N[1];
#pragma unroll
        for (int jt = 0; jt < 2; ++jt)
#pragma unroll
            for (int r = 0; r < 16; ++r) Qc[(size_t)(32 * it + r32) * 64 + 32 * jt + crow(r, hi)] = X[jt][r];
    }
#undef P2_LOAD
}


namespace rwmm {
#define RW_BAR() asm volatile("s_waitcnt lgkmcnt(0)\n\ts_barrier" ::: "memory")
constexpr int PITCH = 144, MB = 64 * PITCH;
enum { B_PR = 0, B_PT, B_QR, B_QT, B_KR, B_KT, B_VR, B_RT, B_W0, B_W1, B_W2, B_W3, B_W4, B_W5, B_SB, B_NBUF };
constexpr int OFF_GC = B_NBUF * MB, OFF_TOT = OFF_GC + 256, LDS_END = OFF_TOT + 8 * 64 * 4;
static_assert(LDS_END <= 146432, "rwmm LDS");
__device__ __forceinline__ LAS unsigned char* buf(LAS unsigned char* lds, int b) { return lds + b * MB; }
__device__ __forceinline__ f32x16 mm_acc(LAS const unsigned char* A, LAS const unsigned char* B, int mt, int nt, int r32, int hi, f32x16 acc) {
    LAS const unsigned char* ap = A + (32 * mt + r32) * PITCH + hi * 16; LAS const unsigned char* bp = B + (32 * nt + r32) * PITCH + hi * 16;
#pragma unroll
    for (int ks = 0; ks < 4; ++ks) acc = __builtin_amdgcn_mfma_f32_32x32x16_bf16(*(LAS const bf16x8*)(ap + ks * 32), *(LAS const bf16x8*)(bp + ks * 32), acc, 0, 0, 0);
    return acc;
}
__device__ __forceinline__ void store_T(const f32x16& c, LAS unsigned char* b, int mt, int nt, int r32, int hi) {
#pragma unroll
    for (int g = 0; g < 4; ++g) { u32x2 w = {cvtpk(c[4 * g], c[4 * g + 1]), cvtpk(c[4 * g + 2], c[4 * g + 3])}; *(LAS u32x2*)(b + (32 * nt + r32) * PITCH + (32 * mt + 8 * g + 4 * hi) * 2) = w; }
}
__device__ __forceinline__ void store_N(const f32x16& c, LAS unsigned char* b, int mt, int nt, int r32, int hi) {
#pragma unroll
    for (int r = 0; r < 16; ++r) *(LAS bf16_t*)(b + (32 * mt + crow(r, hi)) * PITCH + (32 * nt + r32) * 2) = (bf16_t)(cvtpk(c[r], 0.f) & 0xffffu);
}
__device__ __forceinline__ f32x16 load_T(LAS const unsigned char* b, int mt, int nt, int r32, int hi) {
    f32x16 c;
#pragma unroll
    for (int g = 0; g < 4; ++g) { const u32x2 w = *(LAS const u32x2*)(b + (32 * nt + r32) * PITCH + (32 * mt + 8 * g + 4 * hi) * 2); c[4 * g] = lo_bf(w.x); c[4 * g + 1] = hi_bf(w.x); c[4 * g + 2] = lo_bf(w.y); c[4 * g + 3] = hi_bf(w.y); }
    return c;
}
template <bool STRICT> __device__ __forceinline__ void mask_upper(f32x16& c, int mt, int nt, int r32, int hi) {
#pragma unroll
    for (int r = 0; r < 16; ++r) { const int s = 32 * mt + crow(r, hi), t = 32 * nt + r32; const bool keep = STRICT ? (s < t) : (s <= t); c[r] = keep ? c[r] : 0.f; }
}

struct Raw { unsigned ka[8], lr[8], vv[4]; float kn[8]; };
__device__ __forceinline__ void prep_load(const Frame& F, int d, int h, int seq, int t0, Raw& R_) {
    const bf16_t* RKV = (const bf16_t*)(F.ws + WS_RKV); const bf16_t* LO = (const bf16_t*)(F.ws + WS_LO); const float* KN = (const float*)(F.ws + WS_KN);
    const int c = h * 64 + F.lane;
    const unsigned cu = (unsigned)c;
#pragma unroll
    for (int e = 0; e < 8; ++e) { const int row = __builtin_amdgcn_readfirstlane(rw_row2(d, seq, t0 + 8 * F.wave + e));
        const bf16_t* rb = RKV + (size_t)row * RKV_LD; const bf16_t* lb = LO + (size_t)row * LO_LD + d * 512;
        R_.ka[e] = (unsigned)rb[512u + cu] | ((unsigned)lb[1024u + cu] << 16);
        R_.lr[e] = (unsigned)lb[cu] | ((unsigned)rb[cu] << 16);
        const unsigned v = rb[1024u + cu]; if (e & 1) R_.vv[e >> 1] |= v << 16; else R_.vv[e >> 1] = v;
        R_.kn[e] = KN[row * 8 + h]; }
}
template <bool PASS3> __device__ __forceinline__ void prep(const Frame& F, const Args& a, int l, int h, const Raw& R_) {
    LAS unsigned char* lds = F.lds; const int lane = F.lane, w = F.wave, c = h * 64 + lane;
    const float kkp = a.in[I_KK][l * 512 + c], kap = a.in[I_KA][l * 512 + c];
    float G[8]; float run = 0.f;
#pragma unroll
    for (int e = 0; e < 8; ++e) { run += lo_bf(R_.lr[e]); G[e] = run; }
    LAS float* tot = (LAS float*)(lds + OFF_TOT);
    tot[w * 64 + lane] = run;
    RW_BAR();
    float off = 0.f;
#pragma unroll
    for (int ww = 0; ww < 7; ++ww) off += (ww < w) ? tot[ww * 64 + lane] : 0.f;
    unsigned pr[4], qr_[4], kr_[4];
#pragma unroll
    for (int e2 = 0; e2 < 4; ++e2) {
        float Pv[2], Qv[2], Kv[2];
#pragma unroll
        for (int u = 0; u < 2; ++u) { const int e = 2 * e2 + u, t = 8 * w + e;
            const float k = lo_bf(R_.ka[e]), av = hi_bf(R_.ka[e]), lw = lo_bf(R_.lr[e]), rr = hi_bf(R_.lr[e]);
            const float kx = k * kkp * R_.kn[e], kd = k * (1.f + (av - 1.f) * kap);
            const float g = G[e] + off; const float gam = __expf(g), inv = __expf(-g), gprev = __expf(g - lw);
            Pv[u] = -kx * gprev; Qv[u] = kx * av * inv; Kv[u] = kd * inv; const float Rv = rr * gam;
            *(LAS bf16_t*)(buf(lds, B_PT) + t * PITCH + lane * 2) = (bf16_t)(cvtpk(Pv[u], 0.f) & 0xffffu);
            *(LAS bf16_t*)(buf(lds, B_QT) + t * PITCH + lane * 2) = (bf16_t)(cvtpk(Qv[u], 0.f) & 0xffffu);
            *(LAS bf16_t*)(buf(lds, B_KT) + t * PITCH + lane * 2) = (bf16_t)(cvtpk(Kv[u], 0.f) & 0xffffu);
            if (PASS3) *(LAS bf16_t*)(buf(lds, B_RT) + t * PITCH + lane * 2) = (bf16_t)(cvtpk(Rv, 0.f) & 0xffffu);
            if (t == 63) ((LAS float*)(lds + OFF_GC))[lane] = gam; }
        pr[e2] = cvtpk(Pv[0], Pv[1]); qr_[e2] = cvtpk(Qv[0], Qv[1]); kr_[e2] = cvtpk(Kv[0], Kv[1]);
    }
    *(LAS u32x4*)(buf(lds, B_PR) + lane * PITCH + w * 16) = (u32x4){pr[0], pr[1], pr[2], pr[3]};
    *(LAS u32x4*)(buf(lds, B_QR) + lane * PITCH + w * 16) = (u32x4){qr_[0], qr_[1], qr_[2], qr_[3]};
    *(LAS u32x4*)(buf(lds, B_KR) + lane * PITCH + w * 16) = (u32x4){kr_[0], kr_[1], kr_[2], kr_[3]};
    *(LAS u32x4*)(buf(lds, B_VR) + lane * PITCH + w * 16) = (u32x4){R_.vv[0], R_.vv[1], R_.vv[2], R_.vv[3]};
    RW_BAR();
}

__device__ __forceinline__ f32x16 mm_accT(LAS const unsigned char* At, LAS const unsigned char* B, int mt, int nt, int lane, f32x16 acc) {
    const int r32 = lane & 31, hi = lane >> 5;
    LAS const unsigned char* ap = At + (8 * hi + ((lane & 15) >> 2)) * PITCH + (32 * mt + 16 * ((lane >> 4) & 1) + 4 * (lane & 3)) * 2;
    LAS const unsigned char* bp = B + (32 * nt + r32) * PITCH + hi * 16;
#pragma unroll
    for (int ks = 0; ks < 4; ++ks) { const s16x4 lo = vtr(ap + ks * 16 * PITCH), hh = vtr(ap + ks * 16 * PITCH + 4 * PITCH);
        const bf16x8 af = {lo[0], lo[1], lo[2], lo[3], hh[0], hh[1], hh[2], hh[3]};
        acc = __builtin_amdgcn_mfma_f32_32x32x16_bf16(af, *(LAS const bf16x8*)(bp + ks * 32), acc, 0, 0, 0); }
    return acc;
}
template <bool PASS3> __device__ __forceinline__ void core(const Frame& F, bool sT  , f32x16& vk, f32x16& ye) {
    LAS unsigned char* lds = F.lds; const int lane = F.lane, r32 = lane & 31, hi = lane >> 5, q = F.wave & 3, mt = q >> 1, nt = q & 1; const bool g0 = F.wave < 4;
    const f32x16 Z16 = f32x16{};
    f32x16 Tacc = Z16, a1 = Z16;
    if (g0) { f32x16 n = mm_acc(buf(lds, B_QT), buf(lds, B_PT), mt, nt, r32, hi, Z16); mask_upper<true>(n, mt, nt, r32, hi); store_T(n, buf(lds, B_W0), mt, nt, r32, hi);
        Tacc = n;
#pragma unroll
        for (int r = 0; r < 16; ++r) Tacc[r] += (mt == nt && crow(r, hi) == r32) ? 1.f : 0.f;
        store_T(Tacc, buf(lds, B_W2), mt, nt, r32, hi);
    } else { f32x16 m = mm_acc(buf(lds, B_KT), buf(lds, B_PT), mt, nt, r32, hi, Z16); mask_upper<true>(m, mt, nt, r32, hi); store_T(m, buf(lds, B_W3), mt, nt, r32, hi); }
    RW_BAR();
    if (!g0) { const f32x16 n2 = mm_accT(buf(lds, B_W0), buf(lds, B_W0), mt, nt, lane, Z16); store_T(n2, buf(lds, B_W1), mt, nt, r32, hi); }
    else if (PASS3) { f32x16 g3 = mm_acc(buf(lds, B_QT), buf(lds, B_RT), mt, nt, r32, hi, Z16); mask_upper<false>(g3, mt, nt, r32, hi); store_T(g3, buf(lds, B_W4), mt, nt, r32, hi); }
    else { const f32x16 vm = mm_acc(buf(lds, B_VR), buf(lds, B_W3), mt, nt, r32, hi, Z16); store_T(vm, buf(lds, B_W4), mt, nt, r32, hi); }
    RW_BAR();
#pragma unroll
    for (int k = 0; k < 4; ++k) {
        const int cP = (k & 1) ? B_W0 : B_W1, nP = (k & 1) ? B_W1 : B_W0, tIn = (k & 1) ? B_W5 : B_W2, tOut = (k & 1) ? B_W2 : B_W5;
        if (!g0) { const f32x16 p2 = mm_accT(buf(lds, cP), buf(lds, cP), mt, nt, lane, Z16); store_T(p2, buf(lds, nP), mt, nt, r32, hi);
            if (PASS3) {
                if (k == 0) { f32x16 g4 = mm_acc(buf(lds, B_KT), buf(lds, B_RT), mt, nt, r32, hi, Z16); mask_upper<false>(g4, mt, nt, r32, hi); store_T(g4, buf(lds, B_QT), mt, nt, r32, hi); }
                if (k == 1) ye = sT ? mm_accT(buf(lds, B_SB), buf(lds, B_RT), mt, nt, lane, Z16) : mm_acc(buf(lds, B_SB), buf(lds, B_RT), mt, nt, r32, hi, Z16);
                if (k == 2) ye = mm_acc(buf(lds, B_VR), buf(lds, B_QT), mt, nt, r32, hi, ye);
            }
        } else { Tacc = mm_accT(buf(lds, tIn), buf(lds, cP), mt, nt, lane, Tacc); store_T(Tacc, buf(lds, tOut), mt, nt, r32, hi);
            if (PASS3) {
                if (k == 0) a1 = sT ? mm_accT(buf(lds, B_SB), buf(lds, B_PT), mt, nt, lane, Z16) : mm_acc(buf(lds, B_SB), buf(lds, B_PT), mt, nt, r32, hi, Z16);
                if (k == 1) { a1 = mm_acc(buf(lds, B_VR), buf(lds, B_W3), mt, nt, r32, hi, a1); store_T(a1, buf(lds, B_KT), mt, nt, r32, hi); }
                if (k == 2) vk = mm_acc(buf(lds, B_VR), buf(lds, B_KR), mt, nt, r32, hi, Z16);
            }
        }
        RW_BAR();
    }
    if (g0) { Tacc = mm_accT(buf(lds, B_W2), buf(lds, B_W1), mt, nt, lane, Tacc); store_T(Tacc, buf(lds, B_W5), mt, nt, r32, hi); }
    else if (!PASS3) vk = mm_acc(buf(lds, B_VR), buf(lds, B_KR), mt, nt, r32, hi, Z16);
    RW_BAR();
    if (g0) { const f32x16 e = mm_accT(buf(lds, B_W5), buf(lds, B_QR), mt, nt, lane, Z16); store_T(e, buf(lds, B_W0), mt, nt, r32, hi); }
    else if (PASS3) { const f32x16 f = mm_accT(buf(lds, B_W5), buf(lds, B_W4), mt, nt, lane, Z16); store_T(f, buf(lds, B_W1), mt, nt, r32, hi); }
    RW_BAR();
}

__device__ __forceinline__ void pass1_item(const Frame& F, const Args& a, int l, int d, int h, int ci) {
    LAS unsigned char* lds = F.lds; const int lane = F.lane, r32 = lane & 31, hi = lane >> 5, q = F.wave & 3, mt = q >> 1, nt = q & 1; const bool g0 = F.wave < 4;
    const bool ctx = ci == 0; const int nsub = ctx ? 4 : 2, seq = ctx ? 0 : 1, tb = ctx ? 0 : (ci - 1) * TCH;
    float* Qs = (float*)(F.ws + WS_QST) + (size_t)(d * 8 + h) * NCH * 4096; bf16_t* PTg = (bf16_t*)(F.ws + WS_PST) + ((size_t)(d * 8 + h) * NCH + ci) * 4096;
    const f32x16 Z16 = f32x16{};
    for (int sb = 0; sb < nsub; ++sb) {
        { Raw raw; prep_load(F, d, h, seq, tb + 64 * sb, raw); prep<false>(F, a, l, h, raw); }
        f32x16 vk = Z16, ye = Z16;
        core<false>(F, false, vk, ye);
        const float gc = ((LAS const float*)(lds + OFF_GC))[32 * nt + r32];
        f32x16 pq = Z16;
        if (g0) { if (!ctx) { pq = mm_acc(buf(lds, B_PR), buf(lds, B_W0), mt, nt, r32, hi, Z16);
#pragma unroll
                for (int r = 0; r < 16; ++r) pq[r] = (pq[r] + ((mt == nt && crow(r, hi) == r32) ? 1.f : 0.f)) * gc;
                store_T(pq, buf(lds, B_W2), mt, nt, r32, hi); if (sb == 0) store_T(pq, buf(lds, B_SB), mt, nt, r32, hi); }
            else if (sb > 0) { pq = mm_acc(buf(lds, B_PR), buf(lds, B_W0), mt, nt, r32, hi, Z16);
#pragma unroll
                for (int r = 0; r < 16; ++r) pq[r] = (pq[r] + ((mt == nt && crow(r, hi) == r32) ? 1.f : 0.f)) * gc;
                store_T(pq, buf(lds, B_W2), mt, nt, r32, hi); }
        } else { pq = mm_accT(buf(lds, B_W4), buf(lds, B_W0), mt, nt, lane, vk);
#pragma unroll
            for (int r = 0; r < 16; ++r) pq[r] *= gc;
            if (sb == 0) store_T(pq, buf(lds, B_RT), mt, nt, r32, hi); }
        RW_BAR();
        if (sb > 0) {
            if (g0) { if (!ctx) pq = mm_accT(buf(lds, B_SB), buf(lds, B_W2), mt, nt, lane, Z16); }
            else pq = mm_accT(buf(lds, B_RT), buf(lds, B_W2), mt, nt, lane, pq);
            RW_BAR();
            const bool last = sb == nsub - 1;
            if (!g0) {
                if (!last) store_T(pq, buf(lds, B_RT), mt, nt, r32, hi);
                if (last || (ctx && sb == 1)) {
                    float* o = Qs + (size_t)((ctx && sb == 1) ? NCH - 1 : ci) * 4096;
#pragma unroll
                    for (int r = 0; r < 16; ++r) o[(32 * mt + crow(r, hi)) * 64 + 32 * nt + r32] = pq[r];
                }
            } else if (!ctx) {
                if (!last) store_T(pq, buf(lds, B_SB), mt, nt, r32, hi);
                else {
#pragma unroll
                    for (int g = 0; g < 4; ++g) { const int pos = (mt << 5) | ((g >> 1) << 4) | (hi << 3) | ((g & 1) << 2);
                        u32x2 wv = {cvtpk(pq[4 * g], pq[4 * g + 1]), cvtpk(pq[4 * g + 2], pq[4 * g + 3])}; *(u32x2*)(PTg + (32 * nt + r32) * 64 + pos) = wv; }
                }
            }
            RW_BAR();
        }
    }
}
__device__ __forceinline__ void pass3_item(const Frame& F, const Args& a, int l, int d, int h, int pc) {
    LAS unsigned char* lds = F.lds; const int lane = F.lane, r32 = lane & 31, hi = lane >> 5, q = F.wave & 3, mt = q >> 1, nt = q & 1; const bool g0 = F.wave < 4;
    const int seq = pc < 2 ? 0 : 1, tb = pc < 2 ? pc * TCH : (pc - 2) * TCH, slot = pc == 1 ? NCH - 1 : pc - 2;
    bf16_t* Y = (bf16_t*)(F.ws + (d == 0 ? WS_YF : WS_YBK));
    const float* S0g = (const float*)(F.ws + WS_QST) + ((size_t)(d * 8 + h) * NCH + slot) * 4096;
    { const int i = F.tid >> 3, c8 = (F.tid & 7) * 8; u32x4 wv = {0u, 0u, 0u, 0u};
      if (pc != 0) { const float* S0 = S0g + i * 64 + c8; const f32x4 x0 = *(const f32x4*)S0, x1 = *(const f32x4*)(S0 + 4);
          wv = (u32x4){cvtpk(x0[0], x0[1]), cvtpk(x0[2], x0[3]), cvtpk(x1[0], x1[1]), cvtpk(x1[2], x1[3])}; }
      *(LAS u32x4*)(buf(lds, B_SB) + i * PITCH + c8 * 2) = wv; }
    const f32x16 Z16 = f32x16{};
    for (int sb = 0; sb < 2; ++sb) {
        { Raw raw; prep_load(F, d, h, seq, tb + 64 * sb, raw); prep<true>(F, a, l, h, raw); }
        f32x16 vk = Z16, ye = Z16;
        core<true>(F, sb == 1, vk, ye);
        f32x16 s1 = Z16;
        if (!g0) {
            const f32x16 y = mm_accT(buf(lds, B_KT), buf(lds, B_W1), mt, nt, lane, ye);
            const size_t row = (size_t)rw_row2(d, seq, tb + 64 * sb + 32 * nt + r32);
#pragma unroll
            for (int g = 0; g < 4; ++g) { u32x2 wv = {cvtpk(y[4 * g], y[4 * g + 1]), cvtpk(y[4 * g + 2], y[4 * g + 3])}; *(u32x2*)(Y + row * 512 + h * 64 + 32 * mt + 8 * g + 4 * hi) = wv; }
        } else if (sb == 0) {
            const float gc = ((LAS const float*)(lds + OFF_GC))[32 * nt + r32];
            s1 = vk;
            if (pc != 0) {
#pragma unroll
                for (int r = 0; r < 16; ++r) s1[r] += S0g[(32 * mt + crow(r, hi)) * 64 + 32 * nt + r32]; }
            s1 = mm_accT(buf(lds, B_KT), buf(lds, B_W0), mt, nt, lane, s1);
#pragma unroll
            for (int r = 0; r < 16; ++r) s1[r] *= gc;
        }
        RW_BAR();
        if (g0 && sb == 0) store_T(s1, buf(lds, B_SB), mt, nt, r32, hi);
        RW_BAR();
    }
}
#undef RW_BAR
}

__device__ __forceinline__ void norm2_route_rows(const Frame& F, const Args& a, int l, const float* src, const float* g, const float* sh, const float* sc) {
    bf16_t* H = (bf16_t*)(F.ws + WS_H);
    int* ridx = (int*)(F.ws + WS_RT_IDX); int* rpos = (int*)(F.ws + WS_RT_POS); float* rgate = (float*)(F.ws + WS_RT_GATE);
    unsigned* cnt = (unsigned*)(F.ws + WS_CTL) + CW_MOECNT;
    const float* rw = a.in[I_ROUTER];
    f32x4 ca[4], cb[4];
#pragma unroll
    for (int j = 0; j < 4; ++j) { const int d = F.lane * 4 + 256 * j; const f32x4 gg = *(const f32x4*)(g + d), s1 = *(const f32x4*)(sc + d); ca[j] = gg * (s1 + 1.0f); cb[j] = *(const f32x4*)(sh + d); }
    const int gw = F.vcu * NWAVES + F.wave, NGW = F.G * NWAVES;
    for (int m = gw; m < L; m += NGW) {
        const f32x4* xr = (const f32x4*)(src + (size_t)m * DM) + F.lane;
        f32x4 v[4]; float s = 0.f;
#pragma unroll
        for (int j = 0; j < 4; ++j) { v[j] = xr[64 * j]; s += (v[j].x * v[j].x + v[j].y * v[j].y) + (v[j].z * v[j].z + v[j].w * v[j].w); }
        const float rstd = rsqrtf(wave_sum(s) * (1.f / DM) + NORM_EPS);
        u32x2* o8 = (u32x2*)(H + (size_t)m * DM) + F.lane;
        float lg[8] = {0.f, 0.f, 0.f, 0.f, 0.f, 0.f, 0.f, 0.f};
#pragma unroll
        for (int j = 0; j < 4; ++j) { const f32x4 y = v[j] * rstd * ca[j] + cb[j]; u32x2 w; w.x = cvtpk(y.x, y.y); w.y = cvtpk(y.z, y.w); o8[64 * j] = w;
            const float* rp = rw + (size_t)(F.lane * 4 + 256 * j) * 8;
#pragma unroll
            for (int e4 = 0; e4 < 4; ++e4) { const f32x4 w0 = *(const f32x4*)(rp + e4 * 8), w1 = *(const f32x4*)(rp + e4 * 8 + 4);
                const float yy = y[e4];
                lg[0] += yy * w0[0]; lg[1] += yy * w0[1]; lg[2] += yy * w0[2]; lg[3] += yy * w0[3]; lg[4] += yy * w1[0]; lg[5] += yy * w1[1]; lg[6] += yy * w1[2]; lg[7] += yy * w1[3]; } }
#pragma unroll
        for (int e = 0; e < 8; ++e) lg[e] = wave_sum(lg[e]);
        if (F.lane == 0) {
            int i1 = 0; float l1 = lg[0];
#pragma unroll
            for (int e = 1; e < 8; ++e) if (lg[e] > l1) { l1 = lg[e]; i1 = e; }
            int i2 = -1; float l2 = -3.0e38f;
#pragma unroll
            for (int e = 0; e < 8; ++e) if (e != i1 && lg[e] > l2) { l2 = lg[e]; i2 = e; }
            const float g2v = 1.f / (1.f + __expf(l1 - l2)), g1v = 1.f - g2v;
            const unsigned p1 = __hip_atomic_fetch_add(cnt + 64 * i1, 1u, __ATOMIC_RELAXED, __HIP_MEMORY_SCOPE_AGENT);
            const unsigned p2 = __hip_atomic_fetch_add(cnt + 64 * i2, 1u, __ATOMIC_RELAXED, __HIP_MEMORY_SCOPE_AGENT);
            ridx[2 * m] = i1; ridx[2 * m + 1] = i2; rpos[2 * m] = (int)p1; rpos[2 * m + 1] = (int)p2; rgate[2 * m] = g1v; rgate[2 * m + 1] = g2v;
        }
    }
}
__device__ __forceinline__ void moe_tile_bases(const Frame& F, int (&tb)[9]) {
    const unsigned* cnt = (const unsigned*)(F.ws + WS_CTL) + CW_MOECNT;
    int acc = 0;
#pragma unroll
    for (int e = 0; e < 8; ++e) { tb[e] = acc; const unsigned c = __hip_atomic_load(cnt + 64 * e, __ATOMIC_RELAXED, __HIP_MEMORY_SCOPE_AGENT); acc += (int)((c + 255u) >> 8); }
    tb[8] = acc;
}
__device__ __forceinline__ void moe_gather(const Frame& F) {
    const bf16_t* H = (const bf16_t*)(F.ws + WS_H); bf16_t* H2G = (bf16_t*)(F.ws + WS_H2G);
    const int* ridx = (const int*)(F.ws + WS_RT_IDX); const int* rpos = (const int*)(F.ws + WS_RT_POS); const float* rgate = (const float*)(F.ws + WS_RT_GATE);
    float* rowgate = (float*)(F.ws + WS_RT_ROWGATE);
    const unsigned* cnt = (const unsigned*)(F.ws + WS_CTL) + CW_MOECNT;
    int tb[9]; moe_tile_bases(F, tb);
    const int gw = F.vcu * NWAVES + F.wave, NGW = F.G * NWAVES;
    for (int m = gw; m < L; m += NGW) {
        const u32x4 r0 = *((const u32x4*)(H + (size_t)m * DM) + F.lane), r1 = *((const u32x4*)(H + (size_t)m * DM) + 64 + F.lane);
#pragma unroll
        for (int s = 0; s < 2; ++s) {
            const int e = ridx[2 * m + s]; int base = 0;
#pragma unroll
            for (int k = 0; k < 8; ++k) base = (e == k) ? tb[k] : base;
            const size_t row = (size_t)base * 256 + rpos[2 * m + s];
            *((u32x4*)(H2G + row * DM) + F.lane) = r0; *((u32x4*)(H2G + row * DM) + 64 + F.lane) = r1;
            if (F.lane == 0) rowgate[row] = rgate[2 * m + s];
        }
    }
#pragma unroll
    for (int e = 0; e < 8; ++e) {
        const int c = (int)__hip_atomic_load(cnt + 64 * e, __ATOMIC_RELAXED, __HIP_MEMORY_SCOPE_AGENT);
        const int lo = tb[e] * 256 + c, hi_ = tb[e + 1] * 256;
        for (int row = lo + gw; row < hi_; row += NGW) { *((u32x4*)(H2G + (size_t)row * DM) + F.lane) = (u32x4){0u, 0u, 0u, 0u}; *((u32x4*)(H2G + (size_t)row * DM) + 64 + F.lane) = (u32x4){0u, 0u, 0u, 0u}; if (F.lane == 0) rowgate[row] = 0.f; }
    }
}
__device__ __forceinline__ void moe_combine(const Frame& F, float* out, const float* gt2) {
    const bf16_t* YS = (const bf16_t*)(F.ws + WS_H2G);
    const int* ridx = (const int*)(F.ws + WS_RT_IDX); const int* rpos = (const int*)(F.ws + WS_RT_POS);
    int tb[9]; moe_tile_bases(F, tb);
    const int gw = F.vcu * NWAVES + F.wave, NGW = F.G * NWAVES;
    for (int m = gw; m < L; m += NGW) {
        size_t rows[2];
#pragma unroll
        for (int s = 0; s < 2; ++s) { const int e = ridx[2 * m + s]; int base = 0;
#pragma unroll
            for (int k = 0; k < 8; ++k) base = (e == k) ? tb[k] : base;
            rows[s] = (size_t)base * 256 + rpos[2 * m + s]; }
#pragma unroll
        for (int hf = 0; hf < 2; ++hf) {
            const int c0 = hf * 512 + F.lane * 8;
            const u32x4 a0 = *(const u32x4*)(YS + rows[0] * DM + c0), a1 = *(const u32x4*)(YS + rows[1] * DM + c0);
            float* op = out + (size_t)m * DM + c0;
            const f32x4 g0 = *(const f32x4*)(gt2 + c0), g1 = *(const f32x4*)(gt2 + c0 + 4);
            f32x4 x0 = *(const f32x4*)op, x1 = *(const f32x4*)(op + 4);
            x0 += g0 * (f32x4){lo_bf(a0.x) + lo_bf(a1.x), hi_bf(a0.x) + hi_bf(a1.x), lo_bf(a0.y) + lo_bf(a1.y), hi_bf(a0.y) + hi_bf(a1.y)};
            x1 += g1 * (f32x4){lo_bf(a0.z) + lo_bf(a1.z), hi_bf(a0.z) + hi_bf(a1.z), lo_bf(a0.w) + lo_bf(a1.w), hi_bf(a0.w) + hi_bf(a1.w)};
            *(f32x4*)op = x0; *(f32x4*)(op + 4) = x1;
        }
    }
}

#ifndef PROBE_MOE
#define PROBE_MOE 1
#endif
#ifndef PROBE_NA
#define PROBE_NA 1
#endif
#ifndef PROBE_MLA
#define PROBE_MLA 1
#endif
#ifndef PROBE_GEMM
#define PROBE_GEMM 1
#endif
#ifndef PROBE_RW3
#define PROBE_RW3 1
#endif
#ifndef PROBE_RW1
#define PROBE_RW1 1
#endif
#ifndef REP_MLA
#define REP_MLA 1
#endif
#ifndef REP_NA
#define REP_NA 1
#endif
#ifndef REP_RW1
#define REP_RW1 1
#endif
#ifndef REP_RW3
#define REP_RW3 1
#endif
#ifndef REP_GEMM
#define REP_GEMM 1
#endif
#ifndef REP_ROW
#define REP_ROW 1
#endif
constexpr int PH_PER_LAYER = 24;
constexpr int N_PHASES = 1 + 2 * PH_PER_LAYER;
__global__ void __launch_bounds__(NTHR, 2) mega_fwd(Args args) {
    extern __shared__ __attribute__((aligned(16))) unsigned char lds_raw[];
    Frame F;
    F.lds = (LAS unsigned char*)lds_raw; F.ws = args.ws;
    F.tid = threadIdx.x; F.lane = F.tid & 63; F.wave = __builtin_amdgcn_readfirstlane((int)threadIdx.x >> 6);
    F.G = gridDim.x; F.bid = blockIdx.x; F.vcu = (F.G % 8 == 0) ? (F.bid % 8) * (F.G / 8) + F.bid / 8 : F.bid;
    volatile LAS unsigned* MISC = (volatile LAS unsigned*)(F.lds + LDS_MISC_OFF);
    if (F.tid < 64) MISC[F.tid] = 0u;
    __syncthreads();
    const int lo = args.ph_lo, hi = args.ph_hi;
    const bool multi = (hi - lo) > 1;
    XcdBarrier bar; bar.bar = (unsigned*)(F.ws + WS_CTL) + CW_BAR; bar.x = 0; bar.st = MISC + 8;
    if (multi) bar = xcd_barrier_post((unsigned*)(F.ws + WS_CTL) + CW_BAR, MISC + 8);
#define IN(k) (lo <= (k) && (k) < hi)
    const Frame F0 = F;
#define SEAM(k) do { if (multi) xcd_barrier(bar); } while (0)
    LAS unsigned char* lds = F.lds;
    float* MODV = (float*)(F.ws + WS_MODV);
    float* out = args.out;

    if (IN(0)) { const Frame F = launder(F0); prologue_mod(F, args); prologue_weights(F, args); }
    SEAM(0);

#pragma unroll
    for (int l = 0; l < 2; ++l) {
        const int pb = 1 + l * PH_PER_LAYER;
        const bool need_ctx = (l == 0);
        unsigned char* wb = F.ws + WS_W + (size_t)l * WB_SIZE;
        const float* modL = MODV + (size_t)(l * 2) * 6144; const float* modC = modL + 6144;
        float* X1 = (float*)(F.ws + WS_X1); float* CM = (float*)(F.ws + WS_CM);
        bf16_t* H = (bf16_t*)(F.ws + WS_H);
        const int nMall = R / 256, nMlat = L / 256;

        if (IN(pb + 0)) { const Frame F = launder(F0);
            if (l == 0) { norm_rows(F, args.in[I_X], 0, 0, L, args.in[I_N1G] + l * DM, modL, modL + 1024, H);
                          norm_rows(F, args.in[I_CTX], L, L, R, args.in[I_N1G] + l * DM, modC, modC + 1024, H); }
            else { norm_rows(F, X1, 0, 0, L, args.in[I_N1G] + l * DM, modL, modL + 1024, H);
                   norm_rows(F, X1, 0, L, R, args.in[I_N1G] + l * DM, modC, modC + 1024, H); }
        }
        SEAM(pb + 0);
        if (IN(pb + 1)) { const Frame F = launder(F0);
            pg8::Gemm g{H, DM, (const bf16_t*)(wb + WB_WINM), DM}; pg8::StaticOrder S; S.init(nMall, ZM_N / 256, F.G, F.bid, PROBE_GEMM);
            EpiZ E{(bf16_t*)(F.ws + WS_ZA), (bf16_t*)(F.ws + WS_ZN), (bf16_t*)(F.ws + WS_ZR)};
            pg8::gemm_phase(lds, F.tid, g, S, E);
        }
        SEAM(pb + 1);
        if (IN(pb + 2)) { const Frame F = launder(F0); prepare_rows(F, args, l); }
        SEAM(pb + 2);
        if (IN(pb + 3)) { const Frame F = launder(F0);
            { pg8::Gemm g{(const bf16_t*)(F.ws + WS_CQN), 384, (const bf16_t*)(wb + WB_WUQ), 384}; pg8::StaticOrder S; S.init(nMall, 3, F.G, F.bid, PROBE_GEMM);
              EpiBf E{(bf16_t*)(F.ws + WS_QRAW), 768}; pg8::gemm_phase(lds, F.tid, g, S, E); }
            { pg8::Gemm g{(const bf16_t*)(F.ws + WS_CKVN), 256, (const bf16_t*)(wb + WB_WUKV), 256}; pg8::StaticOrder S; S.init(nMall, 4, F.G, F.bid, PROBE_GEMM);
              EpiBf E{(bf16_t*)(F.ws + WS_KVRAW), 1024}; pg8::gemm_phase(lds, F.tid, g, S, E); }
            { pg8::Gemm g{(const bf16_t*)(F.ws + WS_LA), 384, (const bf16_t*)(wb + WB_WLORA), 384}; pg8::StaticOrder S; S.init(nMall, 10, F.G, F.bid, PROBE_GEMM);
              EpiLora E{(bf16_t*)(F.ws + WS_LO), args.in[I_W0] + (size_t)l * 1024, args.in[I_A0] + (size_t)l * 1024}; pg8::gemm_phase(lds, F.tid, g, S, E); }
        }
        SEAM(pb + 3);
        if (IN(pb + 4)) { const Frame F = launder(F0); mla_fixup(F, args, l, need_ctx); }
        SEAM(pb + 4);
        if (IN(pb + 5)) { const Frame F = launder(F0);
            const int xcd = F.bid % 8, idx = F.bid / 8, per = F.G / 8;
            for (int u0 = idx; u0 < 64 * PROBE_MLA + ((need_ctx && idx == 0) ? per : 0); u0 += per) { const int u = u0 >= 64 * PROBE_MLA ? 64 : u0 % 64;
                const bool cu = u >= 64;
                mla_unit(F, xcd, cu ? L : u * 256, cu ? L : 0, cu ? CT / 64 : R / 64);
            }
        }
        SEAM(pb + 5);
        if (IN(pb + 6)) { const Frame F = launder(F0);
            for (int it = F.bid; it < PROBE_RW1 * 16 * 128; it += F.G) { const int ci = (it >> 4) & 127, dh = it & 15;
                rwmm::pass1_item(F, args, l, dh >> 3, dh & 7, ci);
            }
        }
        SEAM(pb + 6);
        if (IN(pb + 7)) { const Frame F = launder(F0);
            const int nrw = F.G > 64 ? 16 : 0;
            if (F.bid < nrw) { if (F.wave < 2) rwkv_pass2(F, F.bid, F.wave); }
            else {
                if (nrw == 0 && F.bid < 16 && F.wave < 2) rwkv_pass2(F, F.bid, F.wave);
                __syncthreads();
                if (need_ctx && F.bid >= F.G - 32) { const int k = F.bid - (F.G - 32); rwmm::pass3_item(F, args, l, k >> 4, (k >> 1) & 7, k & 1); }
                const float* rpb_l = args.in[I_RPB] + (size_t)l * 8 * 465;
                for (int u0 = F.bid - nrw; u0 < PROBE_NA * 2 * (256 + (need_ctx ? 4 : 0)); u0 += F.G - nrw) { const int u = u0 % (2 * (256 + (need_ctx ? 4 : 0))); const int un = u >> 1; na_unit(F, rpb_l, un < 256 ? un : un - 256, un >= 256, u & 1); }
            }
        }
        SEAM(pb + 7);
        if (IN(pb + 8)) { const Frame F = launder(F0);
            for (int it = F.bid; it < PROBE_RW3 * 16 * 128; it += F.G) { const int dh = it & 15, pc = 2 + ((it >> 4) & 127);
                rwmm::pass3_item(F, args, l, dh >> 3, dh & 7, pc);
            }
        }
        SEAM(pb + 8);
        if (IN(pb + 10)) { const Frame F = launder(F0);
            rwkv_output_rows(F, args, l, need_ctx ? R : L);
            __syncthreads();
            pg8::Gemm g{H, DM, (const bf16_t*)(wb + WB_WING), DM}; pg8::StaticOrder S; S.init(need_ctx ? nMall : nMlat, 12, F.G, F.bid, PROBE_GEMM);
            EpiBf E{(bf16_t*)(F.ws + WS_ZG), ZG_LD}; pg8::gemm_phase(lds, F.tid, g, S, E);
        }
        SEAM(pb + 10);
        if (IN(pb + 11)) { const Frame F = launder(F0);
            const int nM = need_ctx ? nMall : nMlat;
            float* U32 = (float*)(F.ws + WS_U32); bf16_t* U = (bf16_t*)(F.ws + WS_U); const bf16_t* ZG = (const bf16_t*)(F.ws + WS_ZG);
            { pg8::Gemm g{(const bf16_t*)(F.ws + WS_YA), 512, (const bf16_t*)(wb + WB_WOA), 512}; pg8::StaticOrder S; S.init(nM, 4, F.G, F.bid);
              EpiMerge<0> E{U32, U, ZG, 0}; pg8::gemm_phase(lds, F.tid, g, S, E); }
            { pg8::Gemm g{(const bf16_t*)(F.ws + WS_YB), 512, (const bf16_t*)(wb + WB_WOB), 512}; pg8::StaticOrder S; S.init(nM, 4, F.G, F.bid);
              EpiMerge<1> E{U32, U, ZG, 1024}; pg8::gemm_phase(lds, F.tid, g, S, E); }
            { pg8::Gemm g{(const bf16_t*)(F.ws + WS_YR), 512, (const bf16_t*)(wb + WB_WOR), 512}; pg8::StaticOrder S; S.init(nM, 4, F.G, F.bid);
              EpiMerge<2> E{U32, U, ZG, 2048}; pg8::gemm_phase(lds, F.tid, g, S, E); }
        }
        SEAM(pb + 11);
        if (IN(pb + 12)) { const Frame F = launder(F0);
            pg8::Gemm g{(const bf16_t*)(F.ws + WS_U), DM, (const bf16_t*)(wb + WB_WOUT), DM}; pg8::StaticOrder S; S.init(need_ctx ? nMall : nMlat, 4, F.G, F.bid, PROBE_GEMM);
            EpiRes E{l == 0 ? args.in[I_X] : X1, l == 0 ? args.in[I_CTX] : X1 + (size_t)L * DM, out, CM, modL + 2048, modC + 2048};
            pg8::gemm_phase(lds, F.tid, g, S, E);
        }
        SEAM(pb + 12);
        if (l == 0) {
            if (IN(pb + 13)) { const Frame F = launder(F0); norm_rows(F, out, 0, 0, L, args.in[I_N2G] + l * DM, modL + 3072, modL + 4096, H);
                               norm_rows(F, CM, L, L, R, args.in[I_N2G] + l * DM, modC + 3072, modC + 4096, H); }
            SEAM(pb + 13);
            if (IN(pb + 14)) { const Frame F = launder(F0);
                pg8::Gemm g{H, DM, (const bf16_t*)(F.ws + WS_W13), DM}; pg8::StaticOrder S; S.init(nMall, 22, F.G, F.bid, PROBE_GEMM);
                EpiSwiglu E{(bf16_t*)(F.ws + WS_G), FF, 0, 1 << 20}; pg8::gemm_phase(lds, F.tid, g, S, E);
            }
            SEAM(pb + 14);
            if (IN(pb + 15)) { const Frame F = launder(F0);
                pg8::Gemm g{(const bf16_t*)(F.ws + WS_G), FF, (const bf16_t*)(F.ws + WS_W2), FF}; pg8::StaticOrder S; S.init(nMall, 4, F.G, F.bid, PROBE_GEMM);
                EpiRes E{out, CM, X1, X1 + (size_t)L * DM, modL + 5120, modC + 5120};
                pg8::gemm_phase(lds, F.tid, g, S, E);
            }
            SEAM(pb + 15);
        } else {
            if (IN(pb + 13)) { const Frame F = launder(F0); norm2_route_rows(F, args, l, out, args.in[I_N2G] + l * DM, modL + 3072, modL + 4096); }
            SEAM(pb + 13);
            if (IN(pb + 14)) { const Frame F = launder(F0); moe_gather(F); moe_weights(F, args, 0); }
            SEAM(pb + 14);
            int tb[9]; moe_tile_bases(F, tb);
            if (IN(pb + 15)) { const Frame F = launder(F0);
                moe_weights(F, args, 1);
                __syncthreads();
                MoeOrder S{tb[0], tb[1], tb[2], tb[3], tb[4], tb[5], tb[6], tb[7], tb[8], 28, 0, F.G, F.bid, PROBE_MOE};
                pg8::Gemm g{(const bf16_t*)(F.ws + WS_H2G), DM, (const bf16_t*)(F.ws + WS_W13E), DM};
                EpiSwiglu E{(bf16_t*)(F.ws + WS_HID), FFE, 0, 28}; pg8::gemm_phase(lds, F.tid, g, S, E);
            }
            SEAM(pb + 15);
            if (IN(pb + 17)) { const Frame F = launder(F0);
                MoeOrder S{tb[0], tb[1], tb[2], tb[3], tb[4], tb[5], tb[6], tb[7], tb[8], 4, W2E_HI_TILE_SHIFT, F.G, F.bid, PROBE_MOE};
                pg8::Gemm g{(const bf16_t*)(F.ws + WS_HID), FFE, (const bf16_t*)(F.ws + WS_W2E_LO), FFE};
                EpiMoe2 E{(bf16_t*)(F.ws + WS_H2G), (const float*)(F.ws + WS_RT_ROWGATE)}; pg8::gemm_phase(lds, F.tid, g, S, E);
            }
            SEAM(pb + 17);
            if (IN(pb + 19)) { const Frame F = launder(F0); moe_combine(F, out, modL + 5120); }
        }
    }
#undef IN
#undef SEAM
}

#ifndef MK_PER_PHASE
#define MK_PER_PHASE 0
#endif
extern "C" void kernel_launch(void* const* d_in, const int* in_sizes, int n_in, void* d_out, int out_size, void* d_ws, size_t ws_size, hipStream_t stream) {
    static int grid = 0;
    if (grid == 0) {
        if (n_in != 40 || out_size != L * DM || ws_size < 560 * MiB) { fprintf(stderr, "kernel_launch: unexpected shapes (n_in %d out %d ws %zu)\n", n_in, out_size, ws_size); grid = -1; return; }
        int dev = 0, cus = 0, per_cu = 0;
        if (hipGetDevice(&dev) != hipSuccess || hipDeviceGetAttribute(&cus, hipDeviceAttributeMultiprocessorCount, dev) != hipSuccess) { grid = -1; return; }
        if (hipFuncSetAttribute((const void*)mega_fwd, hipFuncAttributeMaxDynamicSharedMemorySize, LDS_BYTES) != hipSuccess) { fprintf(stderr, "kernel_launch: hipFuncSetAttribute failed\n"); grid = -1; return; }
        if (hipOccupancyMaxActiveBlocksPerMultiprocessor(&per_cu, (const void*)mega_fwd, NTHR, LDS_BYTES) != hipSuccess || per_cu < 1) fprintf(stderr, "kernel_launch: occupancy query says %d\n", per_cu);
        (void)hipGetLastError();
        grid = cus;
    }
    if (grid < 0) return;
    (void)hipMemsetAsync((char*)d_ws + WS_CTL, 0, CTL_ZERO_BYTES, stream);
    Args a{};
    for (int i = 0; i < 40; ++i) a.in[i] = (const float*)d_in[i];
    a.out = (float*)d_out; a.ws = (unsigned char*)d_ws;
#if MK_PER_PHASE
    for (int p = 0; p < N_PHASES; ++p) { a.ph_lo = p; a.ph_hi = p + 1; hipLaunchKernelGGL(mega_fwd, dim3(grid), dim3(NTHR), LDS_BYTES, stream, a); }
#else
    a.ph_lo = 0; a.ph_hi = N_PHASES;
    hipLaunchKernelGGL(mega_fwd, dim3(grid), dim3(NTHR), LDS_BYTES, stream, a);
#endif
    const hipError_t le = hipPeekAtLastError();
    if (le != hipSuccess) fprintf(stderr, "kernel_launch: launch failed: %s\n", hipGetErrorName(le));
}
```

```cpp
#include <hip/hip_runtime.h>
#include <cstdio>
#include <cstdint>

#define LAS __attribute__((address_space(3)))
#define GAS __attribute__((address_space(1)))
typedef unsigned short bf16_t;
typedef short bf16x8 __attribute__((ext_vector_type(8)));
typedef short s16x4 __attribute__((ext_vector_type(4)));
typedef float f32x4 __attribute__((ext_vector_type(4)));
typedef float f32x2 __attribute__((ext_vector_type(2)));
typedef float f32x16 __attribute__((ext_vector_type(16)));
typedef unsigned u32x4 __attribute__((ext_vector_type(4)));
typedef unsigned u32x2 __attribute__((ext_vector_type(2)));
typedef __bf16 bf16x2_t __attribute__((ext_vector_type(2)));

constexpr int L = 16384, CT = 256, R = L + CT, DM = 1024, GW = 64;
constexpr int NWAVES = 8, NTHR = 512;
constexpr int ZA_LD = 768, ZN_LD = 1536, ZR_LD = 2048, ZM_N = 4352, ZG_LD = 3072;
constexpr int LO_LD = 2560, RKV_LD = 1536;
constexpr int FF = 2816, FFE = 3584, NEXP = 8;
constexpr int MOE_ROWS = 2 * L + NEXP * 256;
constexpr float NORM_EPS = 1e-6f;
constexpr float LOG2E = 1.4426950408889634f;
constexpr int TCH = 128, NCH = 129;

constexpr size_t MiB = 1u << 20;
constexpr size_t WS_CTL = 0, CTL_ZERO_BYTES = 1 * MiB;
constexpr size_t WS_W = 1 * MiB;
constexpr size_t WB_WINM = 0;
constexpr size_t WB_WING = WB_WINM + (size_t)ZM_N * DM * 2;
constexpr size_t WB_WUQ = WB_WING + (size_t)ZG_LD * DM * 2;
constexpr size_t WB_WUKV = WB_WUQ + (size_t)768 * 384 * 2;
constexpr size_t WB_WLORA = WB_WUKV + (size_t)1024 * 256 * 2;
constexpr size_t WB_WOA = WB_WLORA + (size_t)2560 * 384 * 2;
constexpr size_t WB_WOB = WB_WOA + (size_t)1024 * 512 * 2;
constexpr size_t WB_WOR = WB_WOB + (size_t)1024 * 512 * 2;
constexpr size_t WB_WOUT = WB_WOR + (size_t)1024 * 512 * 2;
constexpr size_t WB_SIZE = WB_WOUT + (size_t)1024 * 1024 * 2;
constexpr size_t WS_W13 = WS_W + 2 * WB_SIZE;
constexpr size_t WS_W2 = WS_W13 + (size_t)2 * FF * DM * 2;
constexpr size_t WS_W_END = WS_W2 + (size_t)DM * FF * 2;
static_assert(WS_W_END <= 67 * MiB, "weights region");
constexpr size_t WS_X1 = 67 * MiB;
constexpr size_t WS_CM = 132 * MiB;
constexpr size_t WS_H = 135 * MiB;
constexpr size_t WS_MISC = 168 * MiB;
constexpr size_t WS_MODV = WS_MISC;
constexpr size_t WS_RT_IDX = WS_MISC + 128 * 1024;
constexpr size_t WS_RT_POS = WS_RT_IDX + 128 * 1024;
constexpr size_t WS_RT_GATE = WS_RT_POS + 128 * 1024;
constexpr size_t WS_RT_ROWGATE = WS_RT_GATE + 128 * 1024;
constexpr size_t WS_KN = WS_MISC + 1 * MiB;
constexpr size_t WS_BIG = 170 * MiB;
constexpr size_t WS_ZN = WS_BIG;
constexpr size_t WS_Q = 219 * MiB, WS_K = 244 * MiB, WS_V = 269 * MiB;
constexpr size_t WS_RKV = 286 * MiB;
constexpr size_t WS_LO = 335 * MiB;
constexpr size_t WS_CQN = 417 * MiB, WS_CKVN = 430 * MiB, WS_LA = 439 * MiB, WS_KR = 452 * MiB;
constexpr size_t WS_YA = 417 * MiB, WS_YB = 434 * MiB;
constexpr size_t WS_ZA = 453 * MiB, WS_ZR = 478 * MiB;
constexpr size_t WS_QRAW = 453 * MiB, WS_KVRAW = 478 * MiB;
constexpr size_t WS_PST = 219 * MiB, WS_QST = 486 * MiB, WS_YF = 519 * MiB, WS_YBK = 536 * MiB, WS_YR = 451 * MiB;
static_assert(WS_YR - WS_YB == WS_YB - WS_YA && WB_WOR - WB_WOB == WB_WOB - WB_WOA, "merge segments");
constexpr size_t WS_ZG = WS_BIG;
constexpr size_t WS_U32 = 335 * MiB;
constexpr size_t WS_U = 286 * MiB;
constexpr size_t WS_G = WS_BIG;
constexpr size_t WS_H2G = 67 * MiB;
constexpr size_t WS_W13E = 170 * MiB;
constexpr size_t WS_W2E_LO = 135 * MiB;
constexpr size_t WS_W2E_HI = 282 * MiB;
constexpr int W2E_HI_TILE_SHIFT = (int)((WS_W2E_HI - WS_W2E_LO) / ((size_t)256 * FFE * 2)) - 16;
static_assert((WS_W2E_HI - WS_W2E_LO) % ((size_t)256 * FFE * 2) == 0 && (W2E_HI_TILE_SHIFT % 4) == 0, "W2E split");
constexpr size_t WS_HID = 310 * MiB;
constexpr size_t WS_END = 553 * MiB;
static_assert((size_t)16 * NCH * 4096 * 4 <= 33 * MiB, "state slots");
static_assert(WS_ZR + (size_t)R * ZR_LD * 2 <= WS_END, "ws map");
static_assert(WS_HID + (size_t)MOE_ROWS * FFE * 2 <= 549 * MiB, "hid");
constexpr int CW_BAR = 4096;
constexpr int CW_MOECNT = 1024;

#ifndef PROBE_CVT
#define PROBE_CVT 1
#endif
#ifndef PROBE_ROW
#define PROBE_ROW 1
#endif
__device__ __forceinline__ float bf2f(unsigned b) { return __uint_as_float(b << 16); }
__device__ __forceinline__ unsigned cvtpk(float lo, float hi) { f32x2 v = {lo, hi}; bf16x2_t b = __builtin_convertvector(v, bf16x2_t); return __builtin_bit_cast(unsigned, b); }
__device__ __forceinline__ float lo_bf(unsigned w) { return __uint_as_float(w << 16); }
__device__ __forceinline__ float hi_bf(unsigned w) { return __uint_as_float(w & 0xffff0000u); }
__device__ __forceinline__ float wave_sum(float v) {
#pragma unroll
    for (int o = 1; o < 64; o <<= 1) v += __shfl_xor(v, o);
    return v;
}
__device__ __forceinline__ float sigmoidf_(float x) { return 1.f / (1.f + __expf(-x)); }
__device__ __forceinline__ float siluf_(float x) { return x / (1.f + __expf(-x)); }
#define LDS_WAIT() asm volatile("s_waitcnt lgkmcnt(0)" ::: "memory")
#define VM_WAIT() asm volatile("s_waitcnt vmcnt(0)" ::: "memory")

namespace pg8 {
constexpr int BM = 256, BK = 64, HALF = 128, HTB = HALF * BK * 2, STAGE_BYTES = 8 * HTB, NXCD = 8, WGM = 8;
__device__ __forceinline__ int lds_byte(int r, int c) { const int st = (r >> 4) * 2 + (c >> 5), rr = r & 15, cc = c & 31, ob = rr * 64 + cc * 2; return st * 1024 + (ob ^ (((ob >> 9) & 1) << 5)); }
__device__ __forceinline__ void stage_rc(int b, int& R_, int& C_) { const int st = b / 1024, sb = b % 1024, swz = sb ^ (((sb >> 9) & 1) << 5); R_ = (st >> 1) * 16 + swz / 64; C_ = (st & 1) * 32 + (swz % 64) / 2; }
__device__ __forceinline__ int perm32(int rho) { const int n = rho >> 4, i = rho & 15; return 8 * (i >> 2) + 4 * n + (i & 3); }

struct Unit { int pm, pn, seg; };
struct Gemm { const bf16_t* A; int lda; const bf16_t* Bt; int K; unsigned segA = 0, segB = 0; };
template <class E> __device__ __forceinline__ bool epi_done(const E&, const Unit&) { return true; }

struct StaticOrder {
    int nM, nN, nwg, G, c, rep;
    __device__ void init(int nM_, int nN_, int G_, int c_, int rep_ = 1) { nM = nM_; nN = nN_; nwg = nM * nN; G = G_; c = c_; rep = rep_; }
    __device__ bool next(int i, Unit& u) const {
        const long Lx = (long)i * G + c; if (Lx >= (long)nwg * rep) return false;
        int wgid = (int)(Lx % nwg); { const int q = nwg / NXCD, r = nwg % NXCD, xcd = wgid % NXCD, off = wgid / NXCD; wgid = (xcd < r ? xcd * (q + 1) : r * (q + 1) + (xcd - r) * q) + off; }
        const int nig = WGM * nN, gid = wgid / nig, fm = gid * WGM, gsz = (nM - fm) < WGM ? (nM - fm) : WGM;
        u.pm = fm + ((wgid % nig) % gsz); u.pn = (wgid % nig) / gsz; u.seg = 0; return true;
    }
};

struct SegOrder3 { StaticOrder S; __device__ bool next(int i, Unit& u) const { if (!S.next(i / 3, u)) return false; u.seg = i % 3; return true; } };
template <class Epi, class Sched>
__device__ __forceinline__ void gemm_phase(LAS unsigned char* lds, const int tid, const Gemm g, const Sched& S, const Epi& E) {
    const int wid = __builtin_amdgcn_readfirstlane(tid >> 6), lane = tid & 63, wr = wid >> 2, wc = wid & 3, fr = lane & 15, fq = lane >> 4;
    const int K = g.K, nt = K / BK;
    unsigned voffA[2], voffB[2];
#pragma unroll
    for (int i = 0; i < 2; ++i) { int R_, C_; stage_rc(tid * 16 + i * 8192, R_, C_); const int Rb = (R_ & ~31) + perm32(R_ & 31);
        voffA[i] = (unsigned)(R_ * g.lda + C_) * 2u; voffB[i] = (unsigned)(Rb * K + C_) * 2u; }
    const size_t kstep = (size_t)(BK * 2);
    const size_t hstepA = (size_t)HALF * g.lda * 2, hstepB = (size_t)HALF * K * 2;
    const size_t tstepA = 2 * hstepA, tstepB = 2 * hstepB;
    const unsigned ldsw = (unsigned)wid * 1024u;
    const int aoff = lds_byte(wr * 64 + fr, fq * 8), boff = lds_byte(wc * 32 + fr, fq * 8);
#define PG8_SA(b, h) (((b) * 2 + (h)) * HTB)
#define PG8_SB(b, h) ((4 + (b) * 2 + (h)) * HTB)
#define PG8_STAGE(bufoff, gbase, voff) do { _Pragma("unroll") for (int _i = 0; _i < 2; ++_i) \
        __builtin_amdgcn_global_load_lds((const unsigned*)((const char*)(gbase) + (voff)[_i]), (LAS unsigned*)(lds + (bufoff) + ldsw + _i * 8192), 16, 0, 0); } while (0)
#define PG8_LDA(dst, b, h) do { _Pragma("unroll") for (int m = 0; m < 4; ++m) _Pragma("unroll") for (int k = 0; k < 2; ++k) dst[m][k] = *(const LAS bf16x8*)(lds + PG8_SA(b, h) + aoff + m * 2048 + k * 1024); } while (0)
#define PG8_LDB(dst, b, h) do { _Pragma("unroll") for (int n = 0; n < 2; ++n) _Pragma("unroll") for (int k = 0; k < 2; ++k) dst[n][k] = *(const LAS bf16x8*)(lds + PG8_SB(b, h) + boff + n * 2048 + k * 1024); } while (0)
#define PG8_MMA(ai, bj, At, Bt) do { __builtin_amdgcn_s_setprio(1); _Pragma("unroll") for (int m = 0; m < 4; ++m) _Pragma("unroll") for (int n = 0; n < 2; ++n) _Pragma("unroll") for (int k = 0; k < 2; ++k) \
        acc[ai][bj][m][n] = __builtin_amdgcn_mfma_f32_16x16x32_bf16(Bt[n][k], At[m][k], acc[ai][bj][m][n], 0, 0, 0); __builtin_amdgcn_s_setprio(0); } while (0)
#define PG8_WAIT_V(n) asm volatile("s_waitcnt vmcnt(" #n ")" ::: "memory")
#define PG8_WAIT_L(n) asm volatile("s_waitcnt lgkmcnt(" #n ")" ::: "memory")
#define PG8_BAR __builtin_amdgcn_s_barrier()
#define PG8_SCHED __builtin_amdgcn_sched_barrier(0)
    Unit cur, nxt; int ui = 0;
    if (!S.next(0, cur)) return;
    f32x4 acc[2][2][4][2];
#pragma unroll
    for (int a = 0; a < 2; ++a)
#pragma unroll
        for (int b = 0; b < 2; ++b)
#pragma unroll
            for (int m = 0; m < 4; ++m)
#pragma unroll
                for (int n = 0; n < 2; ++n) acc[a][b][m][n] = (f32x4){0.f, 0.f, 0.f, 0.f};
    bf16x8 At[4][2], B0[2][2], B1[2][2];
    const char* cA = (const char*)g.A + (size_t)cur.pm * tstepA + (size_t)cur.seg * g.segA; const char* cB = (const char*)g.Bt + (size_t)cur.pn * tstepB + (size_t)cur.seg * g.segB;
    PG8_STAGE(PG8_SB(0, 0), cB, voffB); PG8_STAGE(PG8_SB(0, 1), cB + hstepB, voffB); PG8_STAGE(PG8_SA(0, 0), cA, voffA); PG8_STAGE(PG8_SA(0, 1), cA + hstepA, voffA);
    if (wr == 1) PG8_BAR;
    PG8_WAIT_V(2); PG8_BAR;
    PG8_STAGE(PG8_SB(1, 0), cB + kstep, voffB); PG8_STAGE(PG8_SA(1, 0), cA + kstep, voffA); PG8_STAGE(PG8_SB(1, 1), cB + hstepB + kstep, voffB);
    PG8_WAIT_V(6); PG8_BAR;
    for (;;) {
        const bool has_next = S.next(ui + 1, nxt);
        const char* nA = has_next ? (const char*)g.A + (size_t)nxt.pm * tstepA + (size_t)nxt.seg * g.segA : cA; const char* nB = has_next ? (const char*)g.Bt + (size_t)nxt.pn * tstepB + (size_t)nxt.seg * g.segB : cB;
        for (int t = 0; t < nt; t += 2) {
            const bool last = (t == nt - 2);
            const char* a1 = cA + (size_t)(t + 1) * kstep;
            const char* a2 = last ? nA : cA + (size_t)(t + 2) * kstep; const char* b2 = last ? nB : cB + (size_t)(t + 2) * kstep;
            const char* a3 = a2 + kstep; const char* b3 = b2 + kstep;
            PG8_LDB(B0, 0, 0); PG8_LDB(B1, 0, 1); PG8_SCHED; PG8_LDA(At, 0, 0); PG8_STAGE(PG8_SA(1, 1), a1 + hstepA, voffA);
            PG8_WAIT_V(8); PG8_WAIT_L(0); PG8_BAR; PG8_MMA(0, 0, At, B0); PG8_MMA(0, 1, At, B1); PG8_BAR; PG8_SCHED;
            PG8_LDA(At, 0, 1); PG8_STAGE(PG8_SB(0, 0), b2, voffB); PG8_STAGE(PG8_SB(0, 1), b2 + hstepB, voffB); PG8_STAGE(PG8_SA(0, 0), a2, voffA);
            PG8_WAIT_V(8); PG8_WAIT_L(0); PG8_BAR; PG8_MMA(1, 0, At, B0); PG8_MMA(1, 1, At, B1); PG8_BAR; PG8_SCHED;
            PG8_LDB(B0, 1, 0); PG8_LDB(B1, 1, 1); PG8_SCHED; PG8_LDA(At, 1, 0); PG8_STAGE(PG8_SA(0, 1), a2 + hstepA, voffA);
            PG8_WAIT_V(8); PG8_WAIT_L(0); PG8_BAR; PG8_MMA(0, 0, At, B0); PG8_MMA(0, 1, At, B1); PG8_BAR; PG8_SCHED;
            PG8_LDA(At, 1, 1); PG8_STAGE(PG8_SB(1, 0), b3, voffB); PG8_STAGE(PG8_SB(1, 1), b3 + hstepB, voffB); PG8_STAGE(PG8_SA(1, 0), a3, voffA);
            PG8_WAIT_V(8); PG8_WAIT_L(0); PG8_BAR; PG8_MMA(1, 0, At, B0); PG8_MMA(1, 1, At, B1); PG8_BAR; PG8_SCHED;
        }
        if (wr == 0) PG8_BAR;
        E(acc, cur, wr, wc, fr, fq);
        if (!has_next) break;
        if (epi_done(E, cur)) {
#pragma unroll
        for (int a = 0; a < 2; ++a)
#pragma unroll
            for (int b = 0; b < 2; ++b)
#pragma unroll
                for (int m = 0; m < 4; ++m)
#pragma unroll
                    for (int n = 0; n < 2; ++n) acc[a][b][m][n] = (f32x4){0.f, 0.f, 0.f, 0.f};
        }
        cur = nxt; cA = nA; cB = nB; ++ui;
        if (wr == 1) PG8_BAR;
    }
    PG8_WAIT_V(0);
    PG8_BAR;
#undef PG8_SA
#undef PG8_SB
#undef PG8_STAGE
#undef PG8_LDA
#undef PG8_LDB
#undef PG8_MMA
#undef PG8_WAIT_V
#undef PG8_WAIT_L
#undef PG8_BAR
#undef PG8_SCHED
}

template <class F> __device__ __forceinline__ void epi_each(const f32x4 (&acc)[2][2][4][2], const Unit& u, int wr, int wc, int fr, int fq, F&& f) {
    const int row0 = u.pm * BM + wr * 64 + fr, col0 = u.pn * BM + wc * 32 + 8 * fq;
#pragma unroll
    for (int ai = 0; ai < 2; ++ai)
#pragma unroll
        for (int m = 0; m < 4; ++m)
#pragma unroll
            for (int bj = 0; bj < 2; ++bj) f(row0 + ai * HALF + m * 16, col0 + bj * HALF, acc[ai][bj][m][0], acc[ai][bj][m][1]);
}
__device__ __forceinline__ void st_bf16x8(bf16_t* p, f32x4 v0, f32x4 v1) {
    u32x4 w; w.x = cvtpk(v0[0], v0[1]); w.y = cvtpk(v0[2], v0[3]); w.z = cvtpk(v1[0], v1[1]); w.w = cvtpk(v1[2], v1[3]); *(u32x4*)p = w;
}
}
#include <hip/hip_runtime.h>
#include <cstdio>
#include <cstdint>
#include <cstdlib>
#include <vector>

#define XB_TMO      128
#define XB_XCNT(j)  (256  + 64 * (j))
#define XB_XSUB(j)  (1280 + 64 * (j))
#define XB_XGEN(j)  (2304 + 64 * (j))
#define XB_TOP      3328
#define XB_TOPGEN   3392
#define XCD_BAR_WORDS 3456
#define XB_SPIN_CAP (1u << 18)

__device__ __forceinline__ unsigned xb_ld(unsigned* p)              { return __hip_atomic_load(p, __ATOMIC_RELAXED, __HIP_MEMORY_SCOPE_AGENT); }
__device__ __forceinline__ unsigned xb_add(unsigned* p, unsigned v) { return __hip_atomic_fetch_add(p, v, __ATOMIC_RELAXED, __HIP_MEMORY_SCOPE_AGENT); }
__device__ __forceinline__ unsigned xb_xcc_id() { return (unsigned)__builtin_amdgcn_s_getreg((3 << 11) | 20) & 0xFu; }
#define XB_SPIN(cond, bar) do { unsigned _sp = 0; while (cond) { __builtin_amdgcn_s_sleep(1); \
    if ((++_sp & 255u) == 0u) { if (xb_ld(&(bar)[XB_TMO])) break; if (_sp > XB_SPIN_CAP) { atomicAdd(&(bar)[XB_TMO], 1u); break; } } } } while (0)

struct XcdBarrier {
    unsigned* bar; unsigned x;
    volatile LAS unsigned* st;
};

__device__ __forceinline__ XcdBarrier xcd_barrier_post(unsigned* bar, volatile LAS unsigned* st) {
    XcdBarrier b; b.bar = bar; b.x = xb_xcc_id(); b.st = st;
    if (threadIdx.x == 0) (void)xb_add(&bar[XB_XCNT(b.x)], 1u);
    return b;
}
__device__ __forceinline__ void xcd_barrier_complete(unsigned* bar, unsigned x, unsigned& nloc, unsigned& nx) {
    const unsigned G = gridDim.x * gridDim.y * gridDim.z;
    unsigned sum, cnt, mine, sp = 0u;
    for (;;) {
        sum = 0u; cnt = 0u; mine = 0u;
#pragma unroll
        for (unsigned j = 0; j < 16; ++j) { const unsigned c = xb_ld(&bar[XB_XCNT(j)]); sum += c; cnt += (c > 0u) ? 1u : 0u; mine = (j == x) ? c : mine; }
        if (sum == G) break;
        __builtin_amdgcn_s_sleep(1);
        if ((++sp & 255u) == 0u) { if (xb_ld(&bar[XB_TMO])) break; if (sp > XB_SPIN_CAP) { atomicAdd(&bar[XB_TMO], 1u); break; } }
    }
    nloc = mine > 0u ? mine : 1u; nx = cnt > 0u ? cnt : 1u;
}

__device__ __forceinline__ void xcd_barrier(const XcdBarrier& b) {
    asm volatile("s_waitcnt vmcnt(0)" ::: "memory");
    __syncthreads();
    if (threadIdx.x == 0) {
        unsigned* bar = b.bar;
        __builtin_amdgcn_s_waitcnt(0);
        unsigned nloc = b.st[0], nx = b.st[1];
        if (nloc == 0u) { xcd_barrier_complete(bar, b.x, nloc, nx); b.st[0] = nloc; b.st[1] = nx; }
        const unsigned old = xb_add(&bar[XB_XSUB(b.x)], 1u);
        const unsigned gen = old / nloc;
        if (old + 1u == (gen + 1u) * nloc) {
            __builtin_amdgcn_fence(__ATOMIC_RELEASE, "agent");
            asm volatile("s_waitcnt vmcnt(0)" ::: "memory");
            const unsigned og = xb_add(&bar[XB_TOP], 1u);
            const unsigned tg = og / nx;
            if (og + 1u == (tg + 1u) * nx) xb_add(&bar[XB_TOPGEN], 1u);
            else XB_SPIN(xb_ld(&bar[XB_TOPGEN]) == tg, bar);
            __builtin_amdgcn_fence(__ATOMIC_ACQUIRE, "agent");
            xb_add(&bar[XB_XGEN(b.x)], 1u);
            asm volatile("s_waitcnt vmcnt(0)" ::: "memory");
        } else {
            XB_SPIN(xb_ld(&bar[XB_XGEN(b.x)]) == gen, bar);
            __builtin_amdgcn_fence(__ATOMIC_ACQUIRE, "agent");
            asm volatile("s_waitcnt vmcnt(0)" ::: "memory");
        }
    }
    __syncthreads();
}


constexpr int LDS_BYTES = 147456;
constexpr int LDS_MISC_OFF = 146432;
struct Args { const float* in[40]; float* out; unsigned char* ws; int ph_lo, ph_hi; };
enum { I_X = 0, I_C, I_CTX, I_CCTX, I_MODW, I_MODB, I_N1G, I_N2G, I_WIN, I_CQG, I_WUQ, I_CKVG, I_WUKV, I_QNG, I_KNG, I_MLAWO,
       I_NAQG, I_NAKG, I_RPB, I_NAWO, I_MU, I_W0, I_W2, I_A0, I_A2, I_G2, I_KK, I_KA, I_RK, I_LNG, I_LNB, I_RWWO, I_WOUT,
       I_F1, I_F3, I_F2, I_ROUTER, I_M1, I_M3, I_M2 };

struct Frame {
    LAS unsigned char* lds;
    unsigned char* ws;
    int tid, lane, wave, G, vcu, bid;
};

__device__ __forceinline__ Frame launder(const Frame& F) {
    Frame P = F; int w = F.wave, v = F.vcu, b = F.bid; unsigned long long wi = (unsigned long long)F.ws;
    asm volatile("" : "+s"(w), "+s"(v), "+s"(b), "+s"(wi));
    int ln = (int)__builtin_amdgcn_mbcnt_hi(~0u, __builtin_amdgcn_mbcnt_lo(~0u, 0u));
    asm volatile("" : "+v"(ln));
    P.tid = w * 64 + ln; P.lane = ln; P.wave = w; P.vcu = v; P.bid = b;
    P.ws = (unsigned char*)(GAS unsigned char*)wi;
    return P;
}
__device__ __forceinline__ void tr_item(const float* src, int lds_, int scol0, bf16_t* dst, int ldd, int drow0, int koff, int nblk, int ileave, int item, LAS float* scr, int lane) {
    const int kb = item / nblk, nb = item - kb * nblk, k0 = 64 * kb, n0 = 32 * nb;
#pragma unroll 8
    for (int i = 0; i < 32; ++i) { const int kk = 2 * i + (lane >> 5); scr[kk * 33 + (lane & 31)] = src[(size_t)(k0 + kk) * lds_ + scol0 + n0 + (lane & 31)]; }
    LDS_WAIT(); asm volatile("" ::: "memory");
    const int c = lane & 7;
#pragma unroll
    for (int j = 0; j < 4; ++j) { const int n = (lane >> 3) + 8 * j; const LAS float* s = scr + (8 * c) * 33 + n;
        u32x4 o; o.x = cvtpk(s[0 * 33], s[1 * 33]); o.y = cvtpk(s[2 * 33], s[3 * 33]); o.z = cvtpk(s[4 * 33], s[5 * 33]); o.w = cvtpk(s[6 * 33], s[7 * 33]);
        const int nn = n0 + n; const int drow = ileave ? drow0 + (nn >> 7) * 256 + (nn & 127) : drow0 + nn;
        *(u32x4*)(dst + (size_t)drow * ldd + koff + k0 + 8 * c) = o; }
    LDS_WAIT(); asm volatile("" ::: "memory");
}
__device__ __forceinline__ void zero_item(bf16_t* dst, int ldd, int drow0, int koff, int nblk, int item, int lane) {
    const int kb = item / nblk, nb = item - kb * nblk, k0 = 64 * kb, n0 = 32 * nb, c = lane & 7;
#pragma unroll
    for (int j = 0; j < 4; ++j) { const int n = (lane >> 3) + 8 * j; *(u32x4*)(dst + (size_t)(drow0 + n0 + n) * ldd + koff + k0 + 8 * c) = (u32x4){0u, 0u, 0u, 0u}; }
}

#define TRJOB(NITEMS, CALL) { const int _n = (NITEMS); if (r < _n) { CALL; continue; } r -= _n; }
__device__ __forceinline__ void prologue_weights(const Frame& F, const Args& a) {
    LAS float* scr = (LAS float*)(F.lds + F.wave * 16384);
    const int gw = F.vcu * NWAVES + F.wave, NGW = F.G * NWAVES;
    constexpr int PER_LAYER = 16 * 21 + 16 * 3   + 16 * 108   + 16 * 4   + 16 * 96
                              + 6 * 24   + 4 * 32   + 6 * 80   + 3 * 8 * 32   + 16 * 32  ;
    constexpr int FFN_ITEMS = 2 * 16 * 88 + 44 * 32;
    constexpr int NITEMS = 2 * PER_LAYER + FFN_ITEMS;
    for (int it0 = gw; it0 < NITEMS * PROBE_CVT; it0 += NGW) { const int it = it0 % NITEMS;
        int r = it;
        bool done = false;
        for (int l = 0; l < 2 && !done; ++l) {
            if (r >= PER_LAYER) { r -= PER_LAYER; continue; }
            done = true;
            unsigned char* wb = F.ws + WS_W + (size_t)l * WB_SIZE;
            bf16_t* WinM = (bf16_t*)(wb + WB_WINM); bf16_t* WinG = (bf16_t*)(wb + WB_WING);
            const float* win = a.in[I_WIN] + (size_t)l * DM * 7200;
            do {
                if (r < 16 * 21) { tr_item(win, 7200, 0, WinM, DM, 0, 0, 21, 0, r, scr, F.lane); break; } r -= 16 * 21;
                if (r < 16 * 3) { zero_item(WinM, DM, 672, 0, 3, r, F.lane); break; } r -= 16 * 3;
                if (r < 16 * 108) { tr_item(win, 7200, 672, WinM, DM, 768, 0, 108, 0, r, scr, F.lane); break; } r -= 16 * 108;
                if (r < 16 * 4) { zero_item(WinM, DM, 4224, 0, 4, r, F.lane); break; } r -= 16 * 4;
                if (r < 16 * 96) { tr_item(win, 7200, 4128, WinG, DM, 0, 0, 96, 0, r, scr, F.lane); break; } r -= 16 * 96;
                if (r < 6 * 24) { tr_item(a.in[I_WUQ] + (size_t)l * 384 * 768, 768, 0, (bf16_t*)(wb + WB_WUQ), 384, 0, 0, 24, 0, r, scr, F.lane); break; } r -= 6 * 24;
                if (r < 4 * 32) { tr_item(a.in[I_WUKV] + (size_t)l * 256 * 1024, 1024, 0, (bf16_t*)(wb + WB_WUKV), 256, 0, 0, 32, 0, r, scr, F.lane); break; } r -= 4 * 32;
                if (r < 6 * 80) {
                    bf16_t* Wl = (bf16_t*)(wb + WB_WLORA);
                    const int kb = r / 80, nb = r % 80, s = nb / 16;
                    const int koff = s < 4 ? 64 * s : 256, Ks = s < 4 ? 64 : 128;
                    const int k0 = 64 * kb;
                    if (k0 >= koff && k0 < koff + Ks) {
                        const float* src = s < 2 ? a.in[I_W2] + ((size_t)l * 2 + s) * 64 * 512 : s < 4 ? a.in[I_A2] + ((size_t)l * 2 + (s - 2)) * 64 * 512 : a.in[I_G2] + (size_t)l * 128 * 512;
                        const int sub = ((k0 - koff) / 64) * 16 + (nb % 16);
                        tr_item(src, 512, 0, Wl, 384, 512 * s, koff, 16, 0, sub, scr, F.lane);
                    } else zero_item(Wl, 384, 0, 0, 80, r, F.lane);
                    break; } r -= 6 * 80;
                if (r < 3 * 8 * 32) { const int b = r / 256, rr = r % 256;
                    const float* src = (b == 0 ? a.in[I_MLAWO] : b == 1 ? a.in[I_NAWO] : a.in[I_RWWO]) + (size_t)l * 512 * 1024;
                    tr_item(src, 1024, 0, (bf16_t*)(wb + (b == 0 ? WB_WOA : b == 1 ? WB_WOB : WB_WOR)), 512, 0, 0, 32, 0, rr, scr, F.lane); break; } r -= 3 * 8 * 32;
                tr_item(a.in[I_WOUT] + (size_t)l * 1024 * 1024, 1024, 0, (bf16_t*)(wb + WB_WOUT), 1024, 0, 0, 32, 0, r, scr, F.lane);
            } while (0);
        }
        if (done) continue;
        if (r < 16 * 88) { tr_item(a.in[I_F1], FF, 0, (bf16_t*)(F.ws + WS_W13), DM, 0, 0, 88, 1, r, scr, F.lane); continue; } r -= 16 * 88;
        if (r < 16 * 88) { tr_item(a.in[I_F3], FF, 0, (bf16_t*)(F.ws + WS_W13), DM, 128, 0, 88, 1, r, scr, F.lane); continue; } r -= 16 * 88;
        tr_item(a.in[I_F2], DM, 0, (bf16_t*)(F.ws + WS_W2), FF, 0, 0, 32, 0, r, scr, F.lane);
    }
}
__device__ __forceinline__ void moe_weights(const Frame& F, const Args& a, int part) {
    LAS float* scr = (LAS float*)(F.lds + F.wave * 16384);
    const int gw = F.vcu * NWAVES + F.wave, NGW = F.G * NWAVES;
    constexpr int I13 = 16 * 112, I2 = 56 * 32;
    if (part == 0) {
        constexpr int NIT = NEXP * 2 * I13 + 4 * I2;
        for (int it0 = gw; it0 < NIT * PROBE_CVT; it0 += NGW) { const int it = it0 % NIT;
            if (it < NEXP * 2 * I13) { const int e = it / (2 * I13); int r = it - e * 2 * I13;
                bf16_t* w13 = (bf16_t*)(F.ws + WS_W13E) + (size_t)e * 2 * FFE * DM;
                if (r < I13) tr_item(a.in[I_M1] + (size_t)e * DM * FFE, FFE, 0, w13, DM, 0, 0, 112, 1, r, scr, F.lane);
                else tr_item(a.in[I_M3] + (size_t)e * DM * FFE, FFE, 0, w13, DM, 128, 0, 112, 1, r - I13, scr, F.lane);
            } else { const int q = it - NEXP * 2 * I13, e = 4 + q / I2, r = q % I2;
                tr_item(a.in[I_M2] + (size_t)e * FFE * DM, DM, 0, (bf16_t*)(F.ws + WS_W2E_HI) + (size_t)(e - 4) * DM * FFE, FFE, 0, 0, 32, 0, r, scr, F.lane); }
        }
    } else {
        for (int it = gw; it < 4 * I2; it += NGW) { const int e = it / I2, r = it % I2;
            tr_item(a.in[I_M2] + (size_t)e * FFE * DM, DM, 0, (bf16_t*)(F.ws + WS_W2E_LO) + (size_t)e * DM * FFE, FFE, 0, 0, 32, 0, r, scr, F.lane); }
    }
}

__device__ __forceinline__ void prologue_mod(const Frame& F, const Args& a) {
    LAS float* sl = (LAS float*)(F.lds);
    LAS float* part = sl + 2048;
    if (F.bid >= 192) return;
    const int l = F.bid / 96, nb = F.bid % 96;
    for (int i = F.tid; i < 2048; i += NTHR) { const float v = i < 1024 ? a.in[I_C][i] : a.in[I_CCTX][i - 1024]; sl[i] = siluf_(v); }
    __syncthreads();
    const int col = F.tid & 63, kg = F.tid >> 6, n = nb * 64 + col;
    const float* W = a.in[I_MODW] + (size_t)l * DM * 6144 + n;
    float aL = 0.f, aC = 0.f;
#pragma unroll 8
    for (int k = kg * 128; k < kg * 128 + 128; ++k) { const float w = W[(size_t)k * 6144]; aL += sl[k] * w; aC += sl[1024 + k] * w; }
    part[(kg * 64 + col) * 2] = aL; part[(kg * 64 + col) * 2 + 1] = aC;
    __syncthreads();
    if (F.tid < 128) { const int c2 = F.tid & 63, which = F.tid >> 6; float s = 0.f;
#pragma unroll
        for (int k = 0; k < 8; ++k) s += part[(k * 64 + c2) * 2 + which];
        const int nn = nb * 64 + c2;
        ((float*)(F.ws + WS_MODV))[(size_t)(l * 2 + which) * 6144 + nn] = s + a.in[I_MODB][(size_t)l * 6144 + nn]; }
    __syncthreads();
}

__device__ __forceinline__ void norm_rows(const Frame& F, const float* src, int src_row0, int m0, int m1, const float* g, const float* sh, const float* sc, bf16_t* dst) {
    f32x4 ca[4], cb[4];
#pragma unroll
    for (int j = 0; j < 4; ++j) { const int d = F.lane * 4 + 256 * j; const f32x4 gg = *(const f32x4*)(g + d), s1 = *(const f32x4*)(sc + d); ca[j] = gg * (s1 + 1.0f); cb[j] = *(const f32x4*)(sh + d); }
    const int gw = F.vcu * NWAVES + F.wave, NGW = F.G * NWAVES;
    for (int mm = gw; mm < (m1 - m0) * PROBE_ROW; mm += NGW) { const int m = m0 + mm % (m1 - m0);
        const f32x4* xr = (const f32x4*)(src + (size_t)(m - src_row0) * DM) + F.lane;
        f32x4 v[4]; float s = 0.f;
#pragma unroll
        for (int j = 0; j < 4; ++j) { v[j] = xr[64 * j]; s += (v[j].x * v[j].x + v[j].y * v[j].y) + (v[j].z * v[j].z + v[j].w * v[j].w); }
        const float rstd = rsqrtf(wave_sum(s) * (1.f / DM) + NORM_EPS);
        u32x2* o8 = (u32x2*)(dst + (size_t)m * DM) + F.lane;
#pragma unroll
        for (int j = 0; j < 4; ++j) { const f32x4 y = v[j] * rstd * ca[j] + cb[j]; u32x2 w; w.x = cvtpk(y.x, y.y); w.y = cvtpk(y.z, y.w); o8[64 * j] = w; }
    }
}

using pg8::Unit;
struct EpiZ {
    bf16_t *za, *zn, *zr;
    __device__ __forceinline__ void operator()(const f32x4 (&acc)[2][2][4][2], const Unit& u, int wr, int wc, int fr, int fq) const {
        bf16_t* base; int ld, ct;
        if (u.pn < 3) { base = za; ld = ZA_LD; ct = u.pn; } else if (u.pn < 9) { base = zn; ld = ZN_LD; ct = u.pn - 3; } else { base = zr; ld = ZR_LD; ct = u.pn - 9; }
        const int cshift = (ct - u.pn) * 256;
        pg8::epi_each(acc, u, wr, wc, fr, fq, [&](int row, int col, f32x4 v0, f32x4 v1) { pg8::st_bf16x8(base + (size_t)row * ld + col + cshift, v0, v1); });
    }
};
struct EpiBf {
    bf16_t* o; int ld;
    __device__ __forceinline__ void operator()(const f32x4 (&acc)[2][2][4][2], const Unit& u, int wr, int wc, int fr, int fq) const {
        pg8::epi_each(acc, u, wr, wc, fr, fq, [&](int row, int col, f32x4 v0, f32x4 v1) { pg8::st_bf16x8(o + (size_t)row * ld + col, v0, v1); });
    }
};
__device__ __forceinline__ f32x4 lora_fn(f32x4 v, const float* bias, int seg) {
    if (seg < 4) { const f32x4 b = *(const f32x4*)bias;
#pragma unroll
        for (int e = 0; e < 4; ++e) { const float x = b[e] + v[e];
            if (seg < 2) { const float y = -x; const float sp = fmaxf(y, 0.f) + __logf(1.f + __expf(-fabsf(y))); v[e] = -__expf(-sp - 0.5f); }
            else v[e] = sigmoidf_(x); } }
    return v;
}
struct EpiLora {
    bf16_t* o; const float* w0; const float* a0;
    __device__ __forceinline__ void operator()(const f32x4 (&acc)[2][2][4][2], const Unit& u, int wr, int wc, int fr, int fq) const {
        const int seg = u.pn >> 1;
        const float* bias = seg < 2 ? w0 : a0 - 1024;
        pg8::epi_each(acc, u, wr, wc, fr, fq, [&](int row, int col, f32x4 v0, f32x4 v1) {
            const f32x4 r0 = lora_fn(v0, bias + col, seg), r1 = lora_fn(v1, bias + col + 4, seg);
            pg8::st_bf16x8(o + (size_t)row * LO_LD + col, r0, r1);
        });
    }
};
struct EpiSig {
    bf16_t* o; int ld;
    __device__ __forceinline__ void operator()(const f32x4 (&acc)[2][2][4][2], const Unit& u, int wr, int wc, int fr, int fq) const {
        pg8::epi_each(acc, u, wr, wc, fr, fq, [&](int row, int col, f32x4 v0, f32x4 v1) {
            f32x4 r0, r1;
#pragma unroll
            for (int e = 0; e < 4; ++e) { r0[e] = fmaxf(sigmoidf_(v0[e]), 1e-13f); r1[e] = fmaxf(sigmoidf_(v1[e]), 1e-13f); }
            pg8::st_bf16x8(o + (size_t)row * ld + col, r0, r1); });
    }
};
struct EpiMerge3 {
    bf16_t* ub; const bf16_t* zg;
    __device__ __forceinline__ void operator()(f32x4 (&acc)[2][2][4][2], const Unit& u, int wr, int wc, int fr, int fq) const {
        const int row0 = u.pm * 256 + wr * 64 + fr, col0 = u.pn * 256 + wc * 32 + 8 * fq;
        if (u.seg < 2) {
            const bf16_t* z = zg + u.seg * 1024 + (size_t)row0 * ZG_LD + col0;
#pragma unroll
            for (int ai = 0; ai < 2; ++ai)
#pragma unroll
                for (int m = 0; m < 4; ++m)
#pragma unroll
                    for (int bj = 0; bj < 2; ++bj) {
                        const bf16_t* p = z + (size_t)(ai * 128 + m * 16) * ZG_LD + bj * 128;
                        const u32x4 ga = *(const u32x4*)p, gb = *(const u32x4*)(p + 1024);
                        const float a_[8] = {lo_bf(ga.x), hi_bf(ga.x), lo_bf(ga.y), hi_bf(ga.y), lo_bf(ga.z), hi_bf(ga.z), lo_bf(ga.w), hi_bf(ga.w)};
                        const float b_[8] = {lo_bf(gb.x), hi_bf(gb.x), lo_bf(gb.y), hi_bf(gb.y), lo_bf(gb.z), hi_bf(gb.z), lo_bf(gb.w), hi_bf(gb.w)};
#pragma unroll
                        for (int e = 0; e < 4; ++e) { acc[ai][bj][m][0][e] *= a_[e] * __builtin_amdgcn_rcpf(b_[e]); acc[ai][bj][m][1][e] *= a_[4 + e] * __builtin_amdgcn_rcpf(b_[4 + e]); }
                    }
        } else {
            const bf16_t* z = zg + 2048;
            pg8::epi_each(acc, u, wr, wc, fr, fq, [&](int row, int col, f32x4 v0, f32x4 v1) {
                const u32x4 gw = *(const u32x4*)(z + (size_t)row * ZG_LD + col);
                const f32x4 g0 = {lo_bf(gw.x), hi_bf(gw.x), lo_bf(gw.y), hi_bf(gw.y)}, g1 = {lo_bf(gw.z), hi_bf(gw.z), lo_bf(gw.w), hi_bf(gw.w)};
                pg8::st_bf16x8(ub + (size_t)row * DM + col, g0 * v0, g1 * v1); });
        }
    }
};
__device__ __forceinline__ bool epi_done(const EpiMerge3&, const Unit& u) { return u.seg == 2; }
struct EpiRes {
    const float* resL; const float* resC; float* outL; float* outC; const float* gateL; const float* gateC;
    __device__ __forceinline__ void operator()(const f32x4 (&acc)[2][2][4][2], const Unit& u, int wr, int wc, int fr, int fq) const {
        const bool isc = u.pm >= L / 256;
        const float* res = isc ? resC - (size_t)L * DM : resL; float* out = isc ? outC - (size_t)L * DM : outL; const float* gate = isc ? gateC : gateL;
        pg8::epi_each(acc, u, wr, wc, fr, fq, [&](int row, int col, f32x4 v0, f32x4 v1) {
            const size_t o = (size_t)row * DM + col;
            const f32x4 g0 = *(const f32x4*)(gate + col), g1 = *(const f32x4*)(gate + col + 4);
            *(f32x4*)(out + o) = *(const f32x4*)(res + o) + g0 * v0; *(f32x4*)(out + o + 4) = *(const f32x4*)(res + o + 4) + g1 * v1;
        });
    }
};
struct EpiSwiglu {
    bf16_t* o; int ld; int row_sub; int ct_mod;
    __device__ __forceinline__ void operator()(const f32x4 (&acc)[2][2][4][2], const Unit& u, int wr, int wc, int fr, int fq) const {
        const int row0 = u.pm * 256 + wr * 64 + fr - row_sub, col0 = (u.pn % ct_mod) * 128 + wc * 32 + 8 * fq;
#pragma unroll
        for (int ai = 0; ai < 2; ++ai)
#pragma unroll
            for (int m = 0; m < 4; ++m) {
                f32x4 r0, r1;
#pragma unroll
                for (int e = 0; e < 4; ++e) { r0[e] = siluf_(acc[ai][0][m][0][e]) * acc[ai][1][m][0][e]; r1[e] = siluf_(acc[ai][0][m][1][e]) * acc[ai][1][m][1][e]; }
                pg8::st_bf16x8(o + (size_t)(row0 + ai * 128 + m * 16) * ld + col0, r0, r1);
            }
    }
};
struct EpiMoe2 {
    bf16_t* ys; const float* rowgate;
    __device__ __forceinline__ void operator()(const f32x4 (&acc)[2][2][4][2], const Unit& u, int wr, int wc, int fr, int fq) const {
        const int cshift = ((u.pn & 3) - u.pn) * 256;
        pg8::epi_each(acc, u, wr, wc, fr, fq, [&](int row, int col, f32x4 v0, f32x4 v1) {
            const float g = rowgate[row];
            pg8::st_bf16x8(ys + (size_t)row * DM + col + cshift, v0 * g, v1 * g);
        });
    }
};
struct MoeOrder {
    int t0, t1, t2, t3, t4, t5, t6, t7, t8, nct, hi_shift, G, c, rep;
    __device__ bool next(int i, Unit& u) const {
        int idx = i * G + c; const int tot = (t8 - t0) * nct; if (idx >= tot * rep) return false; idx %= tot;
#define MOE_E(e, ta, tb_, sh) { const int w = (tb_) - (ta), n = w * nct; if (idx < n) { u.pm = (ta) + idx % w; u.pn = (e) * nct + idx / w + (sh); u.seg = 0; return true; } idx -= n; }
        MOE_E(0, t0, t1, 0) MOE_E(1, t1, t2, 0) MOE_E(2, t2, t3, 0) MOE_E(3, t3, t4, 0)
        MOE_E(4, t4, t5, hi_shift) MOE_E(5, t5, t6, hi_shift) MOE_E(6, t6, t7, hi_shift) MOE_E(7, t7, t8, hi_shift)
#undef MOE_E
        return false;
    }
};

struct PrepIn { unsigned za[3]; u32x2 zk; unsigned kr; u32x4 nq, nk; u32x4 zc[3], zp[3], zn[3]; unsigned tc[3], tp[3], tn[3]; };
__device__ __forceinline__ void prep_row_load(const Frame& F, int m, PrepIn& I) {
    const bf16_t* ZA = (const bf16_t*)(F.ws + WS_ZA); const bf16_t* ZN = (const bf16_t*)(F.ws + WS_ZN); const bf16_t* ZR = (const bf16_t*)(F.ws + WS_ZR);
    const int lane = F.lane;
    { const unsigned* p = (const unsigned*)(ZA + (size_t)m * ZA_LD) + lane * 3; I.za[0] = p[0]; I.za[1] = p[1]; I.za[2] = p[2]; }
    I.zk = *((const u32x2*)(ZA + (size_t)m * ZA_LD + 384) + lane);
    I.kr = ((const unsigned*)(ZA + (size_t)m * ZA_LD + 640))[lane & 15];
    I.nq = *((const u32x4*)(ZN + (size_t)m * ZN_LD) + lane); I.nk = *((const u32x4*)(ZN + (size_t)m * ZN_LD + 512) + lane);
    const bool hasp = (m != 0) && (m != L), hasn = (m != L - 1) && (m != R - 1);
    const bf16_t* zc = ZR + (size_t)m * ZR_LD; const bf16_t* zp = zc - ZR_LD; const bf16_t* zn = zc + ZR_LD;
#pragma unroll
    for (int ch = 0; ch < 3; ++ch) { const int c0 = ch * 512 + lane * 8;
        I.zc[ch] = *(const u32x4*)(zc + c0); I.zp[ch] = (u32x4){0u, 0u, 0u, 0u}; I.zn[ch] = (u32x4){0u, 0u, 0u, 0u};
        if (hasp) I.zp[ch] = *(const u32x4*)(zp + c0); if (hasn) I.zn[ch] = *(const u32x4*)(zn + c0);
        const int c1 = 1536 + ch * 128 + lane * 2;
        I.tc[ch] = *(const unsigned*)(zc + c1); I.tp[ch] = 0u; I.tn[ch] = 0u;
        if (hasp) I.tp[ch] = *(const unsigned*)(zp + c1); if (hasn) I.tn[ch] = *(const unsigned*)(zn + c1); }
}
__device__ __forceinline__ void prep_row_compute(const Frame& F, int m, const PrepIn& I, const float (&cqg)[6], const float (&ckvg)[4], const float (&qng)[8], const float (&kng)[8], const float (&kkv)[8], const float* mu0, const float* mu1) {
    bf16_t* ZN = (bf16_t*)(F.ws + WS_ZN);
    bf16_t* CQN = (bf16_t*)(F.ws + WS_CQN); bf16_t* CKVN = (bf16_t*)(F.ws + WS_CKVN); bf16_t* LA = (bf16_t*)(F.ws + WS_LA); bf16_t* KR = (bf16_t*)(F.ws + WS_KR);
    bf16_t* RKV = (bf16_t*)(F.ws + WS_RKV);
    const int lane = F.lane;
    { float v[6] = {lo_bf(I.za[0]), hi_bf(I.za[0]), lo_bf(I.za[1]), hi_bf(I.za[1]), lo_bf(I.za[2]), hi_bf(I.za[2])}; float s = 0.f;
#pragma unroll
      for (int e = 0; e < 6; ++e) s += v[e] * v[e];
      const float rstd = rsqrtf(wave_sum(s) * (1.f / 384.f) + NORM_EPS);
      unsigned* o = (unsigned*)(CQN + (size_t)m * 384) + lane * 3;
      o[0] = cvtpk(v[0] * rstd * cqg[0], v[1] * rstd * cqg[1]); o[1] = cvtpk(v[2] * rstd * cqg[2], v[3] * rstd * cqg[3]); o[2] = cvtpk(v[4] * rstd * cqg[4], v[5] * rstd * cqg[5]); }
    { float v[4] = {lo_bf(I.zk.x), hi_bf(I.zk.x), lo_bf(I.zk.y), hi_bf(I.zk.y)}; float s = v[0] * v[0] + v[1] * v[1] + v[2] * v[2] + v[3] * v[3];
      const float rstd = rsqrtf(wave_sum(s) * (1.f / 256.f) + NORM_EPS);
      u32x2 o; o.x = cvtpk(v[0] * rstd * ckvg[0], v[1] * rstd * ckvg[1]); o.y = cvtpk(v[2] * rstd * ckvg[2], v[3] * rstd * ckvg[3]);
      *((u32x2*)(CKVN + (size_t)m * 256) + lane) = o; }
    if (lane < 16) ((unsigned*)(KR + (size_t)m * 32))[lane] = I.kr;
#pragma unroll
    for (int qk = 0; qk < 2; ++qk) {
        const u32x4 w = qk == 0 ? I.nq : I.nk;
        float v[8] = {lo_bf(w.x), hi_bf(w.x), lo_bf(w.y), hi_bf(w.y), lo_bf(w.z), hi_bf(w.z), lo_bf(w.w), hi_bf(w.w)}; float s = 0.f;
#pragma unroll
        for (int e = 0; e < 8; ++e) s += v[e] * v[e];
        s += __shfl_xor(s, 1); s += __shfl_xor(s, 2); s += __shfl_xor(s, 4);
        const float rstd = rsqrtf(s * (1.f / 64.f) + NORM_EPS);
        u32x4 o;
        if (qk == 0) { o.x = cvtpk(v[0] * rstd * qng[0], v[1] * rstd * qng[1]); o.y = cvtpk(v[2] * rstd * qng[2], v[3] * rstd * qng[3]); o.z = cvtpk(v[4] * rstd * qng[4], v[5] * rstd * qng[5]); o.w = cvtpk(v[6] * rstd * qng[6], v[7] * rstd * qng[7]); }
        else { o.x = cvtpk(v[0] * rstd * kng[0], v[1] * rstd * kng[1]); o.y = cvtpk(v[2] * rstd * kng[2], v[3] * rstd * kng[3]); o.z = cvtpk(v[4] * rstd * kng[4], v[5] * rstd * kng[5]); o.w = cvtpk(v[6] * rstd * kng[6], v[7] * rstd * kng[7]); }
        *((u32x4*)(ZN + (size_t)m * ZN_LD + qk * 512) + lane) = o;
    }
#pragma unroll
    for (int ch = 0; ch < 3; ++ch) {
        const int c0 = ch * 512 + lane * 8;
        const u32x4 wc_ = I.zc[ch], wp = I.zp[ch], wn = I.zn[ch];
        const float zcv[8] = {lo_bf(wc_.x), hi_bf(wc_.x), lo_bf(wc_.y), hi_bf(wc_.y), lo_bf(wc_.z), hi_bf(wc_.z), lo_bf(wc_.w), hi_bf(wc_.w)};
        const float zpv[8] = {lo_bf(wp.x), hi_bf(wp.x), lo_bf(wp.y), hi_bf(wp.y), lo_bf(wp.z), hi_bf(wp.z), lo_bf(wp.w), hi_bf(wp.w)};
        const float znv[8] = {lo_bf(wn.x), hi_bf(wn.x), lo_bf(wn.y), hi_bf(wn.y), lo_bf(wn.z), hi_bf(wn.z), lo_bf(wn.w), hi_bf(wn.w)};
        float o[8];
        const f32x4 ma = *(const f32x4*)(mu0 + c0), mb = *(const f32x4*)(mu0 + c0 + 4), na = *(const f32x4*)(mu1 + c0), nb = *(const f32x4*)(mu1 + c0 + 4);
        const float m0v[8] = {ma[0], ma[1], ma[2], ma[3], mb[0], mb[1], mb[2], mb[3]}, m1v[8] = {na[0], na[1], na[2], na[3], nb[0], nb[1], nb[2], nb[3]};
#pragma unroll
        for (int e = 0; e < 8; ++e) o[e] = zcv[e] + m0v[e] * (zpv[e] - zcv[e]) + m1v[e] * (znv[e] - zcv[e]);
        u32x4 w; w.x = cvtpk(o[0], o[1]); w.y = cvtpk(o[2], o[3]); w.z = cvtpk(o[4], o[5]); w.w = cvtpk(o[6], o[7]);
        *(u32x4*)(RKV + (size_t)m * RKV_LD + c0) = w;
        if (ch == 1) {
            const float kr_[8] = {lo_bf(w.x), hi_bf(w.x), lo_bf(w.y), hi_bf(w.y), lo_bf(w.z), hi_bf(w.z), lo_bf(w.w), hi_bf(w.w)};
            float s2 = 0.f;
#pragma unroll
            for (int e = 0; e < 8; ++e) { const float kx = kr_[e] * kkv[e]; s2 += kx * kx; }
            s2 += __shfl_xor(s2, 1); s2 += __shfl_xor(s2, 2); s2 += __shfl_xor(s2, 4);
            if ((lane & 7) == 0) ((float*)(F.ws + WS_KN))[(size_t)m * 8 + (lane >> 3)] = 1.f / fmaxf(sqrtf(s2), 1e-12f);
        }
    }
#pragma unroll
    for (int ch = 0; ch < 3; ++ch) {
        const int c0 = 1536 + ch * 128 + lane * 2;
        float o0 = lo_bf(I.tc[ch]), o1 = hi_bf(I.tc[ch]);
        o0 = o0 + mu0[c0] * (lo_bf(I.tp[ch]) - o0) + mu1[c0] * (lo_bf(I.tn[ch]) - o0);
        o1 = o1 + mu0[c0 + 1] * (hi_bf(I.tp[ch]) - o1) + mu1[c0 + 1] * (hi_bf(I.tn[ch]) - o1);
        if (ch == 0) { o0 = tanhf(o0); o1 = tanhf(o1); } else if (ch == 2) { o0 = sigmoidf_(o0); o1 = sigmoidf_(o1); }
        *(unsigned*)(LA + (size_t)m * 384 + ch * 128 + lane * 2) = cvtpk(o0, o1);
    }
}
__device__ __forceinline__ void prepare_rows(const Frame& F, const Args& a, int l) {
    const int lane = F.lane;
    float cqg[6], ckvg[4], qng[8], kng[8];
#pragma unroll
    for (int e = 0; e < 6; ++e) cqg[e] = a.in[I_CQG][l * 384 + lane * 6 + e];
#pragma unroll
    for (int e = 0; e < 4; ++e) ckvg[e] = a.in[I_CKVG][l * 256 + lane * 4 + e];
#pragma unroll
    for (int e = 0; e < 8; ++e) { qng[e] = a.in[I_NAQG][l * 64 + (lane & 7) * 8 + e] * (0.125f * LOG2E); kng[e] = a.in[I_NAKG][l * 64 + (lane & 7) * 8 + e]; }
    const float* mu0 = a.in[I_MU] + (size_t)l * 2 * 1920; const float* mu1 = mu0 + 1920;
    float kkv[8];
#pragma unroll
    for (int e = 0; e < 8; ++e) kkv[e] = a.in[I_KK][l * 512 + lane * 8 + e];
    const int gw = F.vcu * NWAVES + F.wave, NGW = F.G * NWAVES;
    PrepIn cur, nxt;
    if (gw < R) prep_row_load(F, gw, cur);
    for (int m = gw; m < R; m += NGW) {
        if (m + NGW < R) prep_row_load(F, m + NGW, nxt);
        prep_row_compute(F, m, cur, cqg, ckvg, qng, kng, kkv, mu0, mu1);
        cur = nxt;
    }
}

__device__ __forceinline__ void mla_fixup(const Frame& F, const Args& a, int l, bool need_ctx_q) {
    const bf16_t* QRAW = (const bf16_t*)(F.ws + WS_QRAW); const bf16_t* KVRAW = (const bf16_t*)(F.ws + WS_KVRAW); const bf16_t* KR = (const bf16_t*)(F.ws + WS_KR);
    bf16_t* Q = (bf16_t*)(F.ws + WS_Q); bf16_t* K = (bf16_t*)(F.ws + WS_K); bf16_t* V = (bf16_t*)(F.ws + WS_V);
    const int lane = F.lane, h = lane >> 3, sub = lane & 7;
    float qg[12], kg[12];
#pragma unroll
    for (int i = 0; i < 12; ++i) { qg[i] = a.in[I_QNG][l * 96 + sub + 8 * i] * (0.10206207261596575f * LOG2E); kg[i] = a.in[I_KNG][l * 96 + sub + 8 * i]; }
    const float freq = __expf(-9.210340371976184f * (float)sub * 0.125f);
    const int gw = F.vcu * NWAVES + F.wave, NGW = F.G * NWAVES;
    for (int m0 = gw; m0 < R * PROBE_ROW; m0 += NGW) { const int m = m0 % R;
        const bool lat = m < L;
        float cr = 1.f, sr = 0.f, cc = 1.f, sc = 0.f;
        if (lat) { sincosf((float)(m >> 6) * freq, &sr, &cr); sincosf((float)(m & 63) * freq, &sc, &cc); }
        if (lat || need_ctx_q) {
            float v[12]; float s = 0.f;
#pragma unroll
            for (int i = 0; i < 12; ++i) { v[i] = bf2f(QRAW[(size_t)m * 768 + h * 96 + sub + 8 * i]); s += v[i] * v[i]; }
            s += __shfl_xor(s, 1); s += __shfl_xor(s, 2); s += __shfl_xor(s, 4);
            const float rstd = rsqrtf(s * (1.f / 96.f) + NORM_EPS);
#pragma unroll
            for (int i = 0; i < 12; ++i) v[i] *= rstd * qg[i];
            { const float t1 = v[8], t2 = v[9]; v[8] = t1 * cr - t2 * sr; v[9] = t1 * sr + t2 * cr; }
            { const float t1 = v[10], t2 = v[11]; v[10] = t1 * cc - t2 * sc; v[11] = t1 * sc + t2 * cc; }
            bf16_t* qo = Q + ((size_t)h * R + m) * 96 + sub;
#pragma unroll
            for (int i = 0; i < 12; ++i) qo[8 * i] = (bf16_t)(cvtpk(v[i], 0.f) & 0xffffu);
        }
        {
            float v[12]; float s = 0.f;
#pragma unroll
            for (int i = 0; i < 8; ++i) v[i] = bf2f(KVRAW[(size_t)m * 1024 + h * 128 + sub + 8 * i]);
#pragma unroll
            for (int i = 0; i < 4; ++i) v[8 + i] = bf2f(KR[(size_t)m * 32 + sub + 8 * i]);
#pragma unroll
            for (int i = 0; i < 12; ++i) s += v[i] * v[i];
            s += __shfl_xor(s, 1); s += __shfl_xor(s, 2); s += __shfl_xor(s, 4);
            const float rstd = rsqrtf(s * (1.f / 96.f) + NORM_EPS);
#pragma unroll
            for (int i = 0; i < 12; ++i) v[i] *= rstd * kg[i];
            { const float t1 = v[8], t2 = v[9]; v[8] = t1 * cr - t2 * sr; v[9] = t1 * sr + t2 * cr; }
            { const float t1 = v[10], t2 = v[11]; v[10] = t1 * cc - t2 * sc; v[11] = t1 * sc + t2 * cc; }
            bf16_t* ko = K + ((size_t)h * R + m) * 96 + sub;
#pragma unroll
            for (int i = 0; i < 12; ++i) ko[8 * i] = (bf16_t)(cvtpk(v[i], 0.f) & 0xffffu);
            *(u32x4*)(V + ((size_t)h * R + m) * 64 + sub * 8) = *(const u32x4*)(KVRAW + (size_t)m * 1024 + h * 128 + 64 + sub * 8);
        }
    }
}

__device__ __forceinline__ void rwkv_output_rows(const Frame& F, const Args& a, int l, int m_end) {
    const bf16_t* RKV = (const bf16_t*)(F.ws + WS_RKV); const bf16_t* LO = (const bf16_t*)(F.ws + WS_LO);
    const bf16_t* YF = (const bf16_t*)(F.ws + WS_YF); const bf16_t* YBK = (const bf16_t*)(F.ws + WS_YBK); bf16_t* YR = (bf16_t*)(F.ws + WS_YR);
    const int lane = F.lane, c0 = lane * 8;
    float ka[8], rk[8], lg[8], lb[8];
#pragma unroll
    for (int e = 0; e < 8; ++e) { ka[e] = a.in[I_KA][l * 512 + c0 + e]; rk[e] = a.in[I_RK][l * 512 + c0 + e]; lg[e] = a.in[I_LNG][l * 512 + c0 + e]; lb[e] = a.in[I_LNB][l * 512 + c0 + e]; }
    const int gw = F.vcu * NWAVES + F.wave, NGW = F.G * NWAVES;
#define UNPK8(W, V) const float V[8] = {lo_bf(W.x), hi_bf(W.x), lo_bf(W.y), hi_bf(W.y), lo_bf(W.z), hi_bf(W.z), lo_bf(W.w), hi_bf(W.w)}
    for (int m0 = gw; m0 < m_end * PROBE_ROW; m0 += NGW) { const int m = m0 % m_end;
        const u32x4 wr_ = *(const u32x4*)(RKV + (size_t)m * RKV_LD + c0), wk_ = *(const u32x4*)(RKV + (size_t)m * RKV_LD + 512 + c0), wv_ = *(const u32x4*)(RKV + (size_t)m * RKV_LD + 1024 + c0);
        const u32x4 wa0 = *(const u32x4*)(LO + (size_t)m * LO_LD + 1024 + c0), wa1 = *(const u32x4*)(LO + (size_t)m * LO_LD + 1536 + c0), wg_ = *(const u32x4*)(LO + (size_t)m * LO_LD + 2048 + c0);
        const u32x4 wyf = *(const u32x4*)(YF + (size_t)m * 512 + c0), wyb = *(const u32x4*)(YBK + (size_t)m * 512 + c0);
        UNPK8(wr_, r); UNPK8(wk_, k); UNPK8(wv_, v); UNPK8(wa0, a0v); UNPK8(wa1, a1v); UNPK8(wg_, g); UNPK8(wyf, yf); UNPK8(wyb, yb);
        float y[8]; float s = 0.f, bs = 0.f;
#pragma unroll
        for (int e = 0; e < 8; ++e) { y[e] = yf[e] + yb[e]; s += y[e];
            const float kd0 = k[e] * (1.f + (a0v[e] - 1.f) * ka[e]), kd1 = k[e] * (1.f + (a1v[e] - 1.f) * ka[e]);
            bs += r[e] * rk[e] * (kd0 + kd1); }
        s += __shfl_xor(s, 1); s += __shfl_xor(s, 2); s += __shfl_xor(s, 4);
        bs += __shfl_xor(bs, 1); bs += __shfl_xor(bs, 2); bs += __shfl_xor(bs, 4);
        const float mean = s * (1.f / 64.f); float q = 0.f;
#pragma unroll
        for (int e = 0; e < 8; ++e) { const float d = y[e] - mean; q += d * d; }
        q += __shfl_xor(q, 1); q += __shfl_xor(q, 2); q += __shfl_xor(q, 4);
        const float rstd = rsqrtf(q * (1.f / 64.f) + 64e-5f);
        float o[8];
#pragma unroll
        for (int e = 0; e < 8; ++e) o[e] = ((y[e] - mean) * rstd * lg[e] + lb[e] + bs * v[e]) * g[e];
        u32x4 w; w.x = cvtpk(o[0], o[1]); w.y = cvtpk(o[2], o[3]); w.z = cvtpk(o[4], o[5]); w.w = cvtpk(o[6], o[7]);
        *(u32x4*)(YR + (size_t)m * 512 + c0) = w;
    }
#undef UNPK8
}

__device__ __forceinline__ int crow(int r, int hi) { return (r & 3) + 8 * (r >> 2) + 4 * hi; }
#define SBAR() __builtin_amdgcn_sched_barrier(0)
__device__ __forceinline__ s16x4 tr_read_at(unsigned addr) { s16x4 r; asm volatile("ds_read_b64_tr_b16 %0, %1" : "=&v"(r) : "v"(addr) : "memory"); return r; }
__device__ __forceinline__ float rowmax32(const f32x16& p0, const f32x16& p1) {
    float m = p0[0];
#pragma unroll
    for (int r = 1; r < 16; ++r) m = fmaxf(m, p0[r]);
#pragma unroll
    for (int r = 0; r < 16; ++r) m = fmaxf(m, p1[r]);
    auto rr = __builtin_amdgcn_permlane32_swap(__float_as_uint(m), __float_as_uint(m), false, false);
    return fmaxf(__uint_as_float(rr[0]), __uint_as_float(rr[1]));
}
__device__ __forceinline__ float halfsum(float s) {
    auto rr = __builtin_amdgcn_permlane32_swap(__float_as_uint(s), __float_as_uint(s), false, false);
    return __uint_as_float(rr[0]) + __uint_as_float(rr[1]);
}
__device__ __forceinline__ void pack_p(const f32x16& p0, const f32x16& p1, bf16x8 (&pa)[4]) {
#define PK8(P, B, OUT) do { u32x4 w = {cvtpk(P[B + 0], P[B + 1]), cvtpk(P[B + 2], P[B + 3]), cvtpk(P[B + 4], P[B + 5]), cvtpk(P[B + 6], P[B + 7])}; OUT = __builtin_bit_cast(bf16x8, w); } while (0)
    PK8(p0, 0, pa[0]); PK8(p0, 8, pa[1]); PK8(p1, 0, pa[2]); PK8(p1, 8, pa[3]);
#undef PK8
}

constexpr int AK_PITCH = 208, AK_BYTES = 64 * AK_PITCH, AV_BYTES = 8192;
constexpr int ANSLOT = 6;
constexpr int ALDS_K = 0, ALDS_V = ANSLOT * AK_BYTES, ALDS_WS = ALDS_V + ANSLOT * AV_BYTES, ALDS_END = ALDS_WS + 8 * 256;
static_assert(ALDS_END <= 131072, "MLA LDS");
typedef short v4i16_t __attribute__((ext_vector_type(4)));
__device__ __forceinline__ s16x4 vtr(LAS const unsigned char* p) { return __builtin_bit_cast(s16x4, __builtin_amdgcn_ds_read_tr16_b64_v4i16((LAS v4i16_t*)p)); }
__device__ __forceinline__ void mla_unit(const Frame& F, int h, int q0, int k0, int nt) {
    const bf16_t* Q = (const bf16_t*)(F.ws + WS_Q) + (size_t)h * R * 96; const bf16_t* K = (const bf16_t*)(F.ws + WS_K) + (size_t)h * R * 96 + (size_t)k0 * 96;
    const bf16_t* V = (const bf16_t*)(F.ws + WS_V) + (size_t)h * R * 64 + (size_t)k0 * 64; bf16_t* YA = (bf16_t*)(F.ws + WS_YA);
    LAS unsigned char* lds = F.lds;
    const int tid = F.tid, lane = F.lane, wid = F.wave, r32 = lane & 31, hi = lane >> 5;
    LAS float* wsf = (LAS float*)(lds + ALDS_WS) + wid * 64;
    bf16x8 qr[6];
    { const bf16_t* qp = Q + (size_t)(q0 + wid * 32 + r32) * 96 + hi * 8;
#pragma unroll
      for (int s = 0; s < 6; ++s) qr[s] = *(const bf16x8*)(qp + s * 16); }
    const int kc0 = tid, kc1 = 512 + tid; const bool k2 = tid < 256;
    const int kr0 = kc0 / 12, kq0 = kc0 % 12, kr1 = kc1 / 12, kq1 = kc1 % 12;
    const int vkey = tid >> 3, vc8 = tid & 7;
    const unsigned kdst0 = kr0 * AK_PITCH + kq0 * 16, kdst1 = kr1 * AK_PITCH + kq1 * 16;
    const unsigned vdst = (vc8 >> 2) * 4096 + vkey * 64 + (vc8 & 3) * 16;
    u32x4 sk0, sk1, sv, tk0, tk1, tv;
#define A_LOAD(t) do { const bf16_t* kt = K + (size_t)(t) * 64 * 96; sk0 = *(const u32x4*)(kt + kr0 * 96 + kq0 * 8); if (k2) sk1 = *(const u32x4*)(kt + kr1 * 96 + kq1 * 8); \
        sv = *(const u32x4*)(V + (size_t)(t) * 64 * 64 + vkey * 64 + vc8 * 8); } while (0)
#define A_WRITE(sl) do { *(LAS u32x4*)(lds + ALDS_K + (sl) * AK_BYTES + kdst0) = sk0; if (k2) *(LAS u32x4*)(lds + ALDS_K + (sl) * AK_BYTES + kdst1) = sk1; \
        *(LAS u32x4*)(lds + ALDS_V + (sl) * AV_BYTES + vdst) = sv; } while (0)
#define A_LOAD2(t) do { const bf16_t* kt = K + (size_t)(t) * 64 * 96; tk0 = *(const u32x4*)(kt + kr0 * 96 + kq0 * 8); if (k2) tk1 = *(const u32x4*)(kt + kr1 * 96 + kq1 * 8); \
        tv = *(const u32x4*)(V + (size_t)(t) * 64 * 64 + vkey * 64 + vc8 * 8); } while (0)
#define A_WRITE2(sl) do { *(LAS u32x4*)(lds + ALDS_K + (sl) * AK_BYTES + kdst0) = tk0; if (k2) *(LAS u32x4*)(lds + ALDS_K + (sl) * AK_BYTES + kdst1) = tk1; \
        *(LAS u32x4*)(lds + ALDS_V + (sl) * AV_BYTES + vdst) = tv; } while (0)
    f32x16 o[2]; o[0] = f32x16{}; o[1] = f32x16{};
    float mref = 0.f, lsum = 0.f; f32x16 negm = f32x16{};
    LAS const unsigned char* kb_rd = lds + ALDS_K + r32 * AK_PITCH + hi * 16;
    LAS const unsigned char* vb_rd = lds + ALDS_V + ((lane >> 4) & 1) * 32 + (lane & 3) * 8 + (4 * hi + ((lane & 15) >> 2)) * 64;
#define PIN(x) asm volatile("" : "+v"(x))
#define A_QKT(C0, C1, sl) do { LAS const unsigned char* kt_ = kb_rd + (sl) * AK_BYTES; C0 = negm; C1 = negm; \
        _Pragma("unroll") for (int s = 0; s < 6; ++s) { const bf16x8 a0 = *(LAS const bf16x8*)(kt_ + s * 32); const bf16x8 a1 = *(LAS const bf16x8*)(kt_ + 32 * AK_PITCH + s * 32); \
            C0 = __builtin_amdgcn_mfma_f32_32x32x16_bf16(a0, qr[s], C0, 0, 0, 0); C1 = __builtin_amdgcn_mfma_f32_32x32x16_bf16(a1, qr[s], C1, 0, 0, 0); } } while (0)
#define A_MAX(C0, C1, al) do { const float rm_ = rowmax32(C0, C1); al = 1.f; \
        if (__builtin_expect(__any(rm_ > 8.f), 0)) { const float dl_ = fmaxf(rm_, 0.f); mref += dl_; al = __builtin_amdgcn_exp2f(-dl_); \
            _Pragma("unroll") for (int r = 0; r < 16; ++r) { C0[r] -= dl_; C1[r] -= dl_; negm[r] = -mref; } } } while (0)
#define A_RESC(al) do { if (__any((al) < 1.f)) { if (hi == 0) wsf[r32] = (al); LDS_WAIT(); \
        _Pragma("unroll") for (int r = 0; r < 16; ++r) { const float f_ = wsf[crow(r, hi)]; o[0][r] *= f_; o[1][r] *= f_; } } } while (0)
#define A_STEP(C0, C1, P0, P1, sk_, sv_, alP, alC) do { \
        LAS const unsigned char* kt_ = kb_rd + (sk_) * AK_BYTES; LAS const unsigned char* vt_ = vb_rd + (sv_) * AV_BYTES; \
        bf16x8 ka_[2], kb_[2]; u32x4 pw_[4]; float ps0_ = 0.f, ps1_ = 0.f; \
        ka_[0] = *(LAS const bf16x8*)(kt_); kb_[0] = *(LAS const bf16x8*)(kt_ + 32 * AK_PITCH); SBAR(); \
        _Pragma("unroll") for (int s = 0; s < 6; ++s) { const int c_ = s & 1, n_ = c_ ^ 1; \
            if (s + 1 < 6) { ka_[n_] = *(LAS const bf16x8*)(kt_ + (s + 1) * 32); kb_[n_] = *(LAS const bf16x8*)(kt_ + 32 * AK_PITCH + (s + 1) * 32); } \
            if (s == 0) C0 = __builtin_amdgcn_mfma_f32_32x32x16_bf16(ka_[c_], qr[s], negm, 0, 0, 0); else C0 = __builtin_amdgcn_mfma_f32_32x32x16_bf16(ka_[c_], qr[s], C0, 0, 0, 0); \
            if (s < 4) { ps0_ += P0[4 * s] + P0[4 * s + 1]; ps1_ += P0[4 * s + 2] + P0[4 * s + 3]; PIN(ps0_); PIN(ps1_); } \
            else { pw_[2 * (s - 4)][0] = cvtpk(P0[8 * (s - 4)], P0[8 * (s - 4) + 1]); pw_[2 * (s - 4)][1] = cvtpk(P0[8 * (s - 4) + 2], P0[8 * (s - 4) + 3]); pw_[2 * (s - 4)][2] = cvtpk(P0[8 * (s - 4) + 4], P0[8 * (s - 4) + 5]); pw_[2 * (s - 4)][3] = cvtpk(P0[8 * (s - 4) + 6], P0[8 * (s - 4) + 7]); PIN(pw_[2 * (s - 4)]); } \
            SBAR(); \
            if (s == 0) C1 = __builtin_amdgcn_mfma_f32_32x32x16_bf16(kb_[c_], qr[s], negm, 0, 0, 0); else C1 = __builtin_amdgcn_mfma_f32_32x32x16_bf16(kb_[c_], qr[s], C1, 0, 0, 0); \
            if (s < 4) { ps0_ += P1[4 * s] + P1[4 * s + 1]; ps1_ += P1[4 * s + 2] + P1[4 * s + 3]; PIN(ps0_); PIN(ps1_); } \
            else { pw_[2 * (s - 4) + 1][0] = cvtpk(P1[8 * (s - 4)], P1[8 * (s - 4) + 1]); pw_[2 * (s - 4) + 1][1] = cvtpk(P1[8 * (s - 4) + 2], P1[8 * (s - 4) + 3]); pw_[2 * (s - 4) + 1][2] = cvtpk(P1[8 * (s - 4) + 4], P1[8 * (s - 4) + 5]); pw_[2 * (s - 4) + 1][3] = cvtpk(P1[8 * (s - 4) + 6], P1[8 * (s - 4) + 7]); PIN(pw_[2 * (s - 4) + 1]); } \
            SBAR(); } \
        lsum = lsum * (alP) + (ps0_ + ps1_); \
        A_MAX(C0, C1, alC); SBAR(); \
          \
        s16x4 vl_[2], vh_[2]; vl_[0] = vtr(vt_); vh_[0] = vtr(vt_ + 512); SBAR(); \
        _Pragma("unroll") for (int m_ = 0; m_ < 8; ++m_) { const int dt_ = m_ >> 2, s_ = m_ & 3, c_ = m_ & 1, n_ = c_ ^ 1; \
            if (m_ + 1 < 8) { vl_[n_] = vtr(vt_ + ((m_ + 1) >> 2) * 4096 + ((m_ + 1) & 3) * 1024); vh_[n_] = vtr(vt_ + ((m_ + 1) >> 2) * 4096 + ((m_ + 1) & 3) * 1024 + 512); } \
            const bf16x8 vf_ = {vl_[c_][0], vl_[c_][1], vl_[c_][2], vl_[c_][3], vh_[c_][0], vh_[c_][1], vh_[c_][2], vh_[c_][3]}; \
            const int pi_ = (s_ == 0) ? 0 : (s_ == 1) ? 2 : (s_ == 2) ? 1 : 3; \
            o[dt_] = __builtin_amdgcn_mfma_f32_32x32x16_bf16(__builtin_bit_cast(bf16x8, pw_[pi_]), vf_, o[dt_], 0, 0, 0); \
            if (m_ < 4) { C0[4 * m_] = __builtin_amdgcn_exp2f(C0[4 * m_]); C0[4 * m_ + 1] = __builtin_amdgcn_exp2f(C0[4 * m_ + 1]); C0[4 * m_ + 2] = __builtin_amdgcn_exp2f(C0[4 * m_ + 2]); C0[4 * m_ + 3] = __builtin_amdgcn_exp2f(C0[4 * m_ + 3]); PIN(C0); } \
            else { C1[4 * (m_ - 4)] = __builtin_amdgcn_exp2f(C1[4 * (m_ - 4)]); C1[4 * (m_ - 4) + 1] = __builtin_amdgcn_exp2f(C1[4 * (m_ - 4) + 1]); C1[4 * (m_ - 4) + 2] = __builtin_amdgcn_exp2f(C1[4 * (m_ - 4) + 2]); C1[4 * (m_ - 4) + 3] = __builtin_amdgcn_exp2f(C1[4 * (m_ - 4) + 3]); PIN(C1); } \
            SBAR(); } \
    } while (0)
    f32x16 pA0, pA1, pB0, pB1; float alA = 1.f, alB = 1.f;
    A_LOAD(0); A_WRITE(0); A_LOAD(1); A_WRITE(1); A_LOAD(2); A_LOAD2(3); __syncthreads();
    A_QKT(pA0, pA1, 0); A_MAX(pA0, pA1, alA);
#pragma unroll
    for (int r = 0; r < 16; ++r) { pA0[r] = __builtin_amdgcn_exp2f(pA0[r]); pA1[r] = __builtin_amdgcn_exp2f(pA1[r]); }
    A_WRITE(2); A_WRITE2(3);
    if (nt > 4) { A_LOAD(4); A_LOAD2(5); A_WRITE(4); A_WRITE2(5); }
    __syncthreads();
    alA = 1.f;
    int sk = 1, sv_ = 0, sw = 0;
#define A_NEXT(x) ((x) == ANSLOT - 1 ? 0 : (x) + 1)
    for (int t = 1; t + 1 < nt; t += 2) {
        const bool st = t + 6 < nt;
        if (st) { A_LOAD(t + 5); A_LOAD2(t + 6); }
        A_STEP(pB0, pB1, pA0, pA1, sk, sv_, alA, alB);
        A_RESC(alB);
        sv_ = sk; sk = A_NEXT(sk);
        A_STEP(pA0, pA1, pB0, pB1, sk, sv_, alB, alA);
        __syncthreads(); if (st) { A_WRITE(sw); A_WRITE2(A_NEXT(sw)); } A_RESC(alA);
        sv_ = sk; sk = A_NEXT(sk); sw = A_NEXT(A_NEXT(sw));
    }
    A_STEP(pB0, pB1, pA0, pA1, sk, sv_, alA, alB);
    A_RESC(alB);
    { float ps = 0.f;
#pragma unroll
      for (int r = 0; r < 16; ++r) ps += pB0[r] + pB1[r];
      lsum = lsum * alB + ps;
      bf16x8 pa[4]; pack_p(pB0, pB1, pa);
      LAS const unsigned char* vt_ = vb_rd + sk * AV_BYTES;
#pragma unroll
      for (int dt = 0; dt < 2; ++dt)
#pragma unroll
          for (int s = 0; s < 4; ++s) { const s16x4 lo_ = vtr(vt_ + dt * 4096 + s * 1024), hh_ = vtr(vt_ + dt * 4096 + s * 1024 + 512);
              const bf16x8 vf = {lo_[0], lo_[1], lo_[2], lo_[3], hh_[0], hh_[1], hh_[2], hh_[3]};
              o[dt] = __builtin_amdgcn_mfma_f32_32x32x16_bf16(pa[s], vf, o[dt], 0, 0, 0); } }
    lsum = halfsum(lsum);
    if (hi == 0) wsf[r32] = lsum; LDS_WAIT();
#pragma unroll
    for (int r = 0; r < 16; ++r) { const float inv = 1.f / wsf[crow(r, hi)]; const int row = q0 + wid * 32 + crow(r, hi);
        bf16_t* op = YA + (size_t)row * 512 + h * 64 + r32;
        op[0] = (bf16_t)(cvtpk(o[0][r] * inv, 0.f) & 0xffffu); op[32] = (bf16_t)(cvtpk(o[1][r] * inv, 0.f) & 0xffffu); }
    __syncthreads();
#undef A_LOAD
#undef A_WRITE
#undef A_LOAD2
#undef A_WRITE2
#undef A_NEXT
#undef A_QKT
#undef A_MAX
#undef A_RESC
#undef A_STEP
#undef PIN
}

constexpr int NLDS_V = 0, NLDS_RPB = 8 * 8192, NLDS_WS = NLDS_RPB + 8 * 2048, NLDS_END = NLDS_WS + 8 * 256;
__device__ __forceinline__ void na_unit(const Frame& F, const float* rpb_l, int unit, bool ctxq, int qt) {
    const bf16_t* ZN = (const bf16_t*)(F.ws + WS_ZN); bf16_t* YB = (bf16_t*)(F.ws + WS_YB);
    LAS unsigned char* lds = F.lds;
    const int lane = F.lane, h = F.wave, r32 = lane & 31, hi = lane >> 5;
    LAS unsigned char* vlds = lds + NLDS_V + h * 8192; LAS float* rpbs = (LAS float*)(lds + NLDS_RPB + h * 2048); LAS float* wsf = (LAS float*)(lds + NLDS_WS) + h * 64;
    const int qrow0 = ctxq ? L + unit * 64 : unit * 64;
    const int rs = ctxq ? 0 : min(max(unit - 4, 0), 256 - 8);
    for (int i = lane; i < 15 * 31; i += 64) rpbs[i] = rpb_l[h * 465 + i] * LOG2E;
    bf16x8 qr[4];
#pragma unroll
    for (int s = 0; s < 4; ++s) qr[s] = *(const bf16x8*)(ZN + (size_t)(qrow0 + qt * 32 + r32) * ZN_LD + h * 64 + s * 16 + hi * 8);
    f32x16 o[2]; o[0] = f32x16{}; o[1] = f32x16{};
    float mref = -1e30f, lsum = 0.f;
    const unsigned vb_rd = (unsigned)(uintptr_t)vlds + ((lane >> 4) & 1) * 32 + (lane & 3) * 8 + (4 * hi + ((lane & 15) >> 2)) * 64;
    const int ntl = ctxq ? 0 : 8, nt = ntl + 4;
    LDS_WAIT();
    for (int t = 0; t < nt; ++t) {
        const bool local = t < ntl;
        const int krow0 = local ? (rs + t) * 64 : L + (t - ntl) * 64;
        bf16x8 kf[2][4];
#pragma unroll
        for (int hf = 0; hf < 2; ++hf)
#pragma unroll
            for (int s = 0; s < 4; ++s) kf[hf][s] = *(const bf16x8*)(ZN + (size_t)(krow0 + hf * 32 + r32) * ZN_LD + 512 + h * 64 + s * 16 + hi * 8);
        u32x4 sv[8];
#pragma unroll
        for (int i = 0; i < 8; ++i) { const int c = i * 64 + lane; sv[i] = *(const u32x4*)(ZN + (size_t)(krow0 + (c >> 3)) * ZN_LD + 1024 + h * 64 + (c & 7) * 8); }
#pragma unroll
        for (int i = 0; i < 8; ++i) { const int c = i * 64 + lane; const int key = c >> 3, c8 = c & 7; *(LAS u32x4*)(vlds + (c8 >> 2) * 4096 + key * 64 + (c8 & 3) * 16) = sv[i]; }
        LDS_WAIT();
        const int dr = rs + t - unit + 7;
        {
            f32x16 p0 = f32x16{}, p1 = f32x16{};
#pragma unroll
            for (int s = 0; s < 4; ++s) { p0 = __builtin_amdgcn_mfma_f32_32x32x16_bf16(kf[0][s], qr[s], p0, 0, 0, 0); p1 = __builtin_amdgcn_mfma_f32_32x32x16_bf16(kf[1][s], qr[s], p1, 0, 0, 0); }
            if (local) {
                const int qc = qt * 32 + r32, cs = min(max(qc - 8, 0), 48);
#pragma unroll
                for (int r = 0; r < 16; ++r) { const int kc0 = crow(r, hi), kc1 = kc0 + 32;
                    const bool v0 = (kc0 >= cs) && (kc0 < cs + 16), v1 = (kc1 >= cs) && (kc1 < cs + 16);
                    const int d0 = v0 ? kc0 - qc + 15 : 0, d1 = v1 ? kc1 - qc + 15 : 0;
                    const float b0 = rpbs[dr * 31 + d0], b1 = rpbs[dr * 31 + d1];
                    p0[r] = v0 ? p0[r] + b0 : -1e30f; p1[r] = v1 ? p1[r] + b1 : -1e30f; }
            }
            const float rm = rowmax32(p0, p1);
            if (__any(rm > mref + 8.f)) {
                const float mn = fmaxf(mref, rm); const float al = __builtin_amdgcn_exp2f(mref - mn); mref = mn; lsum *= al;
                if (hi == 0) wsf[r32] = al; LDS_WAIT();
#pragma unroll
                for (int r = 0; r < 16; ++r) { const float f = wsf[crow(r, hi)]; o[0][r] *= f; o[1][r] *= f; }
                LDS_WAIT();
            }
            float ps = 0.f;
#pragma unroll
            for (int r = 0; r < 16; ++r) { p0[r] = __builtin_amdgcn_exp2f(p0[r] - mref); p1[r] = __builtin_amdgcn_exp2f(p1[r] - mref); ps += p0[r] + p1[r]; }
            lsum += ps;
            bf16x8 pa[4]; pack_p(p0, p1, pa);
#pragma unroll
            for (int dt = 0; dt < 2; ++dt) {
                s16x4 lo[4], hh[4];
#pragma unroll
                for (int s = 0; s < 4; ++s) { lo[s] = tr_read_at(vb_rd + dt * 4096 + s * 1024); hh[s] = tr_read_at(vb_rd + dt * 4096 + s * 1024 + 512); }
                LDS_WAIT(); SBAR();
#pragma unroll
                for (int s = 0; s < 4; ++s) { const bf16x8 vf = {lo[s][0], lo[s][1], lo[s][2], lo[s][3], hh[s][0], hh[s][1], hh[s][2], hh[s][3]};
                    o[dt] = __builtin_amdgcn_mfma_f32_32x32x16_bf16(pa[s], vf, o[dt], 0, 0, 0); }
            }
        }
        LDS_WAIT(); SBAR();
    }
    {
        const float ls = halfsum(lsum);
        if (hi == 0) wsf[r32] = ls; LDS_WAIT();
#pragma unroll
        for (int r = 0; r < 16; ++r) { const float inv = 1.f / wsf[crow(r, hi)]; const int row = qrow0 + qt * 32 + crow(r, hi);
            bf16_t* op = YB + (size_t)row * 512 + h * 64 + r32;
            op[0] = (bf16_t)(cvtpk(o[0][r] * inv, 0.f) & 0xffffu); op[32] = (bf16_t)(cvtpk(o[1][r] * inv, 0.f) & 0xffffu); }
        LDS_WAIT();
    }
}

__device__ __forceinline__ int rw_row2(int d, int seq, int t) {
    if (seq == 0) return d == 0 ? L + t : L + (CT - 1) - t;
    return d == 0 ? t : (L - 1) - t;
}
__device__ __forceinline__ void rwkv_pass2(const Frame& F, int dh, int it) {
    const int lane = F.lane, r32 = lane & 31, hi = lane >> 5;
    float* Qb = (float*)(F.ws + WS_QST) + (size_t)dh * NCH * 4096;
    f32x16 X[2];
#pragma unroll
    for (int jt = 0; jt < 2; ++jt)
#pragma unroll
        for (int r = 0; r < 16; ++r) X[jt][r] = Qb[(size_t)(32 * it + r32) * 64 + 32 * jt + crow(r, hi)];
    bf16x8 pnx[2][2][2]; f32x4 qn[2][4];
    const bf16_t* PTb = (const bf16_t*)(F.ws + WS_PST) + (size_t)dh * NCH * 4096;
#define P2_LOAD(ci_) do { const bf16_t* P_ = PTb + (size_t)(ci_) * 4096; const float* Q_ = Qb + (size_t)(ci_) * 4096 + (size_t)(32 * it + r32) * 64 + 4 * hi; \
        _Pragma("unroll") for (int jn = 0; jn < 2; ++jn) _Pragma("unroll") for (int jt = 0; jt < 2; ++jt) _Pragma("unroll") for (int s = 0; s < 2; ++s) pnx[jn][jt][s] = *(const bf16x8*)(P_ + (size_t)(32 * jn + r32) * 64 + jt * 32 + s * 16 + hi * 8); \
        _Pragma("unroll") for (int jt = 0; jt < 2; ++jt) _Pragma("unroll") for (int g = 0; g < 4; ++g) qn[jt][g] = *(const f32x4*)(Q_ + 32 * jt + 8 * g); } while (0)
    P2_LOAD(1);
    for (int ci = 1; ci < NCH - 1; ++ci) {
        float* Qc = Qb + (size_t)ci * 4096;
        bf16x8 pa[2][2][2]; f32x16 N[2];
#pragma unroll
        for (int jn = 0; jn < 2; ++jn)
#pragma unroll
            for (int jt = 0; jt < 2; ++jt)
#pragma unroll
                for (int s = 0; s < 2; ++s) pa[jn][jt][s] = pnx[jn][jt][s];
#pragma unroll
        for (int jt = 0; jt < 2; ++jt)
#pragma unroll
            for (int r = 0; r < 16; ++r) N[jt][r] = qn[jt][r >> 2][r & 3];
        if (ci + 1 < NCH - 1) P2_LOAD(ci + 1);
        bf16x8 bh[2][2], bl[2][2];
#pragma unroll
        for (int jt = 0; jt < 2; ++jt)
#pragma unroll
            for (int s = 0; s < 2; ++s) {
                unsigned wh[4], wl[4];
#pragma unroll
                for (int e2 = 0; e2 < 4; ++e2) { const float x0 = X[jt][8 * s + 2 * e2], x1 = X[jt][8 * s + 2 * e2 + 1]; const unsigned h = cvtpk(x0, x1); wh[e2] = h; wl[e2] = cvtpk(x0 - lo_bf(h), x1 - hi_bf(h)); }
                u32x4 a = {wh[0], wh[1], wh[2], wh[3]}, b = {wl[0], wl[1], wl[2], wl[3]}; bh[jt][s] = __builtin_bit_cast(bf16x8, a); bl[jt][s] = __builtin_bit_cast(bf16x8, b);
            }
#pragma unroll
        for (int jn = 0; jn < 2; ++jn)
#pragma unroll
            for (int jt = 0; jt < 2; ++jt)
#pragma unroll
                for (int s = 0; s < 2; ++s) { N[jn] = __builtin_amdgcn_mfma_f32_32x32x16_bf16(pa[jn][jt][s], bh[jt][s], N[jn], 0, 0, 0); N[jn] = __builtin_amdgcn_mfma_f32_32x32x16_bf16(pa[jn][jt][s], bl[jt][s], N[jn], 0, 0, 0); }
        X[0] = N[0]; X[1] = N[1];
#pragma unroll
        for (int jt = 0; jt < 2; ++jt)
#pragma unroll
            for (int r = 0; r < 16; ++r) Qc[(size_t)(32 * it + r32) * 64 + 32 * jt + crow(r, hi)] = X[jt][r];
    }
#undef P2_LOAD
}


namespace rwmm {
#define RW_BAR() asm volatile("s_waitcnt lgkmcnt(0)\n\ts_barrier" ::: "memory")
constexpr int PITCH = 144, MB = 64 * PITCH;
enum { B_PR = 0, B_PT, B_QR, B_QT, B_KR, B_KT, B_VR, B_RT, B_W0, B_W1, B_W2, B_W3, B_W4, B_W5, B_SB, B_NBUF };
constexpr int OFF_GC = B_NBUF * MB, OFF_TOT = OFF_GC + 256, LDS_END = OFF_TOT + 8 * 64 * 4;
static_assert(LDS_END <= 146432, "rwmm LDS");
__device__ __forceinline__ LAS unsigned char* buf(LAS unsigned char* lds, int b) { return lds + b * MB; }
__device__ __forceinline__ f32x16 mm_acc(LAS const unsigned char* A, LAS const unsigned char* B, int mt, int nt, int r32, int hi, f32x16 acc) {
    LAS const unsigned char* ap = A + (32 * mt + r32) * PITCH + hi * 16; LAS const unsigned char* bp = B + (32 * nt + r32) * PITCH + hi * 16;
#pragma unroll
    for (int ks = 0; ks < 4; ++ks) acc = __builtin_amdgcn_mfma_f32_32x32x16_bf16(*(LAS const bf16x8*)(ap + ks * 32), *(LAS const bf16x8*)(bp + ks * 32), acc, 0, 0, 0);
    return acc;
}
__device__ __forceinline__ void store_T(const f32x16& c, LAS unsigned char* b, int mt, int nt, int r32, int hi) {
#pragma unroll
    for (int g = 0; g < 4; ++g) { u32x2 w = {cvtpk(c[4 * g], c[4 * g + 1]), cvtpk(c[4 * g + 2], c[4 * g + 3])}; *(LAS u32x2*)(b + (32 * nt + r32) * PITCH + (32 * mt + 8 * g + 4 * hi) * 2) = w; }
}
__device__ __forceinline__ void store_N(const f32x16& c, LAS unsigned char* b, int mt, int nt, int r32, int hi) {
#pragma unroll
    for (int r = 0; r < 16; ++r) *(LAS bf16_t*)(b + (32 * mt + crow(r, hi)) * PITCH + (32 * nt + r32) * 2) = (bf16_t)(cvtpk(c[r], 0.f) & 0xffffu);
}
__device__ __forceinline__ f32x16 load_T(LAS const unsigned char* b, int mt, int nt, int r32, int hi) {
    f32x16 c;
#pragma unroll
    for (int g = 0; g < 4; ++g) { const u32x2 w = *(LAS const u32x2*)(b + (32 * nt + r32) * PITCH + (32 * mt + 8 * g + 4 * hi) * 2); c[4 * g] = lo_bf(w.x); c[4 * g + 1] = hi_bf(w.x); c[4 * g + 2] = lo_bf(w.y); c[4 * g + 3] = hi_bf(w.y); }
    return c;
}
template <bool STRICT> __device__ __forceinline__ void mask_upper(f32x16& c, int mt, int nt, int r32, int hi) {
#pragma unroll
    for (int r = 0; r < 16; ++r) { const int s = 32 * mt + crow(r, hi), t = 32 * nt + r32; const bool keep = STRICT ? (s < t) : (s <= t); c[r] = keep ? c[r] : 0.f; }
}

struct Raw { unsigned ka[8], lr[8], vv[4]; float kn[8]; };
__device__ __forceinline__ void prep_load(const Frame& F, int d, int h, int seq, int t0, Raw& R_) {
    const bf16_t* RKV = (const bf16_t*)(F.ws + WS_RKV); const bf16_t* LO = (const bf16_t*)(F.ws + WS_LO); const float* KN = (const float*)(F.ws + WS_KN);
    const int c = h * 64 + F.lane;
    const unsigned cu = (unsigned)c;
#pragma unroll
    for (int e = 0; e < 8; ++e) { const int row = __builtin_amdgcn_readfirstlane(rw_row2(d, seq, t0 + 8 * F.wave + e));
        const bf16_t* rb = RKV + (size_t)row * RKV_LD; const bf16_t* lb = LO + (size_t)row * LO_LD + d * 512;
        R_.ka[e] = (unsigned)rb[512u + cu] | ((unsigned)lb[1024u + cu] << 16);
        R_.lr[e] = (unsigned)lb[cu] | ((unsigned)rb[cu] << 16);
        const unsigned v = rb[1024u + cu]; if (e & 1) R_.vv[e >> 1] |= v << 16; else R_.vv[e >> 1] = v;
        R_.kn[e] = KN[row * 8 + h]; }
}
template <bool PASS3> __device__ __forceinline__ void prep(const Frame& F, const Args& a, int l, int h, const Raw& R_) {
    LAS unsigned char* lds = F.lds; const int lane = F.lane, w = F.wave, c = h * 64 + lane;
    const float kkp = a.in[I_KK][l * 512 + c], kap = a.in[I_KA][l * 512 + c];
    float G[8]; float run = 0.f;
#pragma unroll
    for (int e = 0; e < 8; ++e) { run += lo_bf(R_.lr[e]); G[e] = run; }
    LAS float* tot = (LAS float*)(lds + OFF_TOT);
    tot[w * 64 + lane] = run;
    RW_BAR();
    float off = 0.f;
#pragma unroll
    for (int ww = 0; ww < 7; ++ww) off += (ww < w) ? tot[ww * 64 + lane] : 0.f;
    unsigned pr[4], qr_[4], kr_[4];
#pragma unroll
    for (int e2 = 0; e2 < 4; ++e2) {
        float Pv[2], Qv[2], Kv[2];
#pragma unroll
        for (int u = 0; u < 2; ++u) { const int e = 2 * e2 + u, t = 8 * w + e;
            const float k = lo_bf(R_.ka[e]), av = hi_bf(R_.ka[e]), lw = lo_bf(R_.lr[e]), rr = hi_bf(R_.lr[e]);
            const float kx = k * kkp * R_.kn[e], kd = k * (1.f + (av - 1.f) * kap);
            const float g = G[e] + off; const float gam = __expf(g), inv = __expf(-g), gprev = __expf(g - lw);
            Pv[u] = -kx * gprev; Qv[u] = kx * av * inv; Kv[u] = kd * inv; const float Rv = rr * gam;
            *(LAS bf16_t*)(buf(lds, B_PT) + t * PITCH + lane * 2) = (bf16_t)(cvtpk(Pv[u], 0.f) & 0xffffu);
            *(LAS bf16_t*)(buf(lds, B_QT) + t * PITCH + lane * 2) = (bf16_t)(cvtpk(Qv[u], 0.f) & 0xffffu);
            *(LAS bf16_t*)(buf(lds, B_KT) + t * PITCH + lane * 2) = (bf16_t)(cvtpk(Kv[u], 0.f) & 0xffffu);
            if (PASS3) *(LAS bf16_t*)(buf(lds, B_RT) + t * PITCH + lane * 2) = (bf16_t)(cvtpk(Rv, 0.f) & 0xffffu);
            if (t == 63) ((LAS float*)(lds + OFF_GC))[lane] = gam; }
        pr[e2] = cvtpk(Pv[0], Pv[1]); qr_[e2] = cvtpk(Qv[0], Qv[1]); kr_[e2] = cvtpk(Kv[0], Kv[1]);
    }
    *(LAS u32x4*)(buf(lds, B_PR) + lane * PITCH + w * 16) = (u32x4){pr[0], pr[1], pr[2], pr[3]};
    *(LAS u32x4*)(buf(lds, B_QR) + lane * PITCH + w * 16) = (u32x4){qr_[0], qr_[1], qr_[2], qr_[3]};
    *(LAS u32x4*)(buf(lds, B_KR) + lane * PITCH + w * 16) = (u32x4){kr_[0], kr_[1], kr_[2], kr_[3]};
    *(LAS u32x4*)(buf(lds, B_VR) + lane * PITCH + w * 16) = (u32x4){R_.vv[0], R_.vv[1], R_.vv[2], R_.vv[3]};
    RW_BAR();
}

__device__ __forceinline__ f32x16 mm_accT(LAS const unsigned char* At, LAS const unsigned char* B, int mt, int nt, int lane, f32x16 acc) {
    const int r32 = lane & 31, hi = lane >> 5;
    LAS const unsigned char* ap = At + (8 * hi + ((lane & 15) >> 2)) * PITCH + (32 * mt + 16 * ((lane >> 4) & 1) + 4 * (lane & 3)) * 2;
    LAS const unsigned char* bp = B + (32 * nt + r32) * PITCH + hi * 16;
#pragma unroll
    for (int ks = 0; ks < 4; ++ks) { const s16x4 lo = vtr(ap + ks * 16 * PITCH), hh = vtr(ap + ks * 16 * PITCH + 4 * PITCH);
        const bf16x8 af = {lo[0], lo[1], lo[2], lo[3], hh[0], hh[1], hh[2], hh[3]};
        acc = __builtin_amdgcn_mfma_f32_32x32x16_bf16(af, *(LAS const bf16x8*)(bp + ks * 32), acc, 0, 0, 0); }
    return acc;
}
template <bool PASS3> __device__ __forceinline__ void core(const Frame& F, bool sT  , f32x16& vk, f32x16& ye) {
    LAS unsigned char* lds = F.lds; const int lane = F.lane, r32 = lane & 31, hi = lane >> 5, q = F.wave & 3, mt = q >> 1, nt = q & 1; const bool g0 = F.wave < 4;
    const f32x16 Z16 = f32x16{};
    f32x16 Tacc = Z16, a1 = Z16;
    if (g0) { f32x16 n = mm_acc(buf(lds, B_QT), buf(lds, B_PT), mt, nt, r32, hi, Z16); mask_upper<true>(n, mt, nt, r32, hi); store_T(n, buf(lds, B_W0), mt, nt, r32, hi);
        Tacc = n;
#pragma unroll
        for (int r = 0; r < 16; ++r) Tacc[r] += (mt == nt && crow(r, hi) == r32) ? 1.f : 0.f;
        store_T(Tacc, buf(lds, B_W2), mt, nt, r32, hi);
    } else { f32x16 m = mm_acc(buf(lds, B_KT), buf(lds, B_PT), mt, nt, r32, hi, Z16); mask_upper<true>(m, mt, nt, r32, hi); store_T(m, buf(lds, B_W3), mt, nt, r32, hi); }
    RW_BAR();
    if (!g0) { const f32x16 n2 = mm_accT(buf(lds, B_W0), buf(lds, B_W0), mt, nt, lane, Z16); store_T(n2, buf(lds, B_W1), mt, nt, r32, hi); }
    else if (PASS3) { f32x16 g3 = mm_acc(buf(lds, B_QT), buf(lds, B_RT), mt, nt, r32, hi, Z16); mask_upper<false>(g3, mt, nt, r32, hi); store_T(g3, buf(lds, B_W4), mt, nt, r32, hi); }
    else { const f32x16 vm = mm_acc(buf(lds, B_VR), buf(lds, B_W3), mt, nt, r32, hi, Z16); store_T(vm, buf(lds, B_W4), mt, nt, r32, hi); }
    RW_BAR();
#pragma unroll
    for (int k = 0; k < 4; ++k) {
        const int cP = (k & 1) ? B_W0 : B_W1, nP = (k & 1) ? B_W1 : B_W0, tIn = (k & 1) ? B_W5 : B_W2, tOut = (k & 1) ? B_W2 : B_W5;
        if (!g0) { const f32x16 p2 = mm_accT(buf(lds, cP), buf(lds, cP), mt, nt, lane, Z16); store_T(p2, buf(lds, nP), mt, nt, r32, hi);
            if (PASS3) {
                if (k == 0) { f32x16 g4 = mm_acc(buf(lds, B_KT), buf(lds, B_RT), mt, nt, r32, hi, Z16); mask_upper<false>(g4, mt, nt, r32, hi); store_T(g4, buf(lds, B_QT), mt, nt, r32, hi); }
                if (k == 1) ye = sT ? mm_accT(buf(lds, B_SB), buf(lds, B_RT), mt, nt, lane, Z16) : mm_acc(buf(lds, B_SB), buf(lds, B_RT), mt, nt, r32, hi, Z16);
                if (k == 2) ye = mm_acc(buf(lds, B_VR), buf(lds, B_QT), mt, nt, r32, hi, ye);
            }
        } else { Tacc = mm_accT(buf(lds, tIn), buf(lds, cP), mt, nt, lane, Tacc); store_T(Tacc, buf(lds, tOut), mt, nt, r32, hi);
            if (PASS3) {
                if (k == 0) a1 = sT ? mm_accT(buf(lds, B_SB), buf(lds, B_PT), mt, nt, lane, Z16) : mm_acc(buf(lds, B_SB), buf(lds, B_PT), mt, nt, r32, hi, Z16);
                if (k == 1) { a1 = mm_acc(buf(lds, B_VR), buf(lds, B_W3), mt, nt, r32, hi, a1); store_T(a1, buf(lds, B_KT), mt, nt, r32, hi); }
                if (k == 2) vk = mm_acc(buf(lds, B_VR), buf(lds, B_KR), mt, nt, r32, hi, Z16);
            }
        }
        RW_BAR();
    }
    if (g0) { Tacc = mm_accT(buf(lds, B_W2), buf(lds, B_W1), mt, nt, lane, Tacc); store_T(Tacc, buf(lds, B_W5), mt, nt, r32, hi); }
    else if (!PASS3) vk = mm_acc(buf(lds, B_VR), buf(lds, B_KR), mt, nt, r32, hi, Z16);
    RW_BAR();
    if (g0) { const f32x16 e = mm_accT(buf(lds, B_W5), buf(lds, B_QR), mt, nt, lane, Z16); store_T(e, buf(lds, B_W0), mt, nt, r32, hi); }
    else if (PASS3) { const f32x16 f = mm_accT(buf(lds, B_W5), buf(lds, B_W4), mt, nt, lane, Z16); store_T(f, buf(lds, B_W1), mt, nt, r32, hi); }
    RW_BAR();
}

__device__ __forceinline__ void pass1_item(const Frame& F, const Args& a, int l, int d, int h, int ci) {
    LAS unsigned char* lds = F.lds; const int lane = F.lane, r32 = lane & 31, hi = lane >> 5, q = F.wave & 3, mt = q >> 1, nt = q & 1; const bool g0 = F.wave < 4;
    const bool ctx = ci == 0; const int nsub = ctx ? 4 : 2, seq = ctx ? 0 : 1, tb = ctx ? 0 : (ci - 1) * TCH;
    float* Qs = (float*)(F.ws + WS_QST) + (size_t)(d * 8 + h) * NCH * 4096; bf16_t* PTg = (bf16_t*)(F.ws + WS_PST) + ((size_t)(d * 8 + h) * NCH + ci) * 4096;
    const f32x16 Z16 = f32x16{};
    for (int sb = 0; sb < nsub; ++sb) {
        { Raw raw; prep_load(F, d, h, seq, tb + 64 * sb, raw); prep<false>(F, a, l, h, raw); }
        f32x16 vk = Z16, ye = Z16;
        core<false>(F, false, vk, ye);
        const float gc = ((LAS const float*)(lds + OFF_GC))[32 * nt + r32];
        f32x16 pq = Z16;
        if (g0) { if (!ctx) { pq = mm_acc(buf(lds, B_PR), buf(lds, B_W0), mt, nt, r32, hi, Z16);
#pragma unroll
                for (int r = 0; r < 16; ++r) pq[r] = (pq[r] + ((mt == nt && crow(r, hi) == r32) ? 1.f : 0.f)) * gc;
                store_T(pq, buf(lds, B_W2), mt, nt, r32, hi); if (sb == 0) store_T(pq, buf(lds, B_SB), mt, nt, r32, hi); }
            else if (sb > 0) { pq = mm_acc(buf(lds, B_PR), buf(lds, B_W0), mt, nt, r32, hi, Z16);
#pragma unroll
                for (int r = 0; r < 16; ++r) pq[r] = (pq[r] + ((mt == nt && crow(r, hi) == r32) ? 1.f : 0.f)) * gc;
                store_T(pq, buf(lds, B_W2), mt, nt, r32, hi); }
        } else { pq = mm_accT(buf(lds, B_W4), buf(lds, B_W0), mt, nt, lane, vk);
#pragma unroll
            for (int r = 0; r < 16; ++r) pq[r] *= gc;
            if (sb == 0) store_T(pq, buf(lds, B_RT), mt, nt, r32, hi); }
        RW_BAR();
        if (sb > 0) {
            if (g0) { if (!ctx) pq = mm_accT(buf(lds, B_SB), buf(lds, B_W2), mt, nt, lane, Z16); }
            else pq = mm_accT(buf(lds, B_RT), buf(lds, B_W2), mt, nt, lane, pq);
            RW_BAR();
            const bool last = sb == nsub - 1;
            if (!g0) {
                if (!last) store_T(pq, buf(lds, B_RT), mt, nt, r32, hi);
                if (last || (ctx && sb == 1)) {
                    float* o = Qs + (size_t)((ctx && sb == 1) ? NCH - 1 : ci) * 4096;
#pragma unroll
                    for (int r = 0; r < 16; ++r) o[(32 * mt + crow(r, hi)) * 64 + 32 * nt + r32] = pq[r];
                }
            } else if (!ctx) {
                if (!last) store_T(pq, buf(lds, B_SB), mt, nt, r32, hi);
                else {
#pragma unroll
                    for (int g = 0; g < 4; ++g) { const int pos = (mt << 5) | ((g >> 1) << 4) | (hi << 3) | ((g & 1) << 2);
                        u32x2 wv = {cvtpk(pq[4 * g], pq[4 * g + 1]), cvtpk(pq[4 * g + 2], pq[4 * g + 3])}; *(u32x2*)(PTg + (32 * nt + r32) * 64 + pos) = wv; }
                }
            }
            RW_BAR();
        }
    }
}
__device__ __forceinline__ void pass3_item(const Frame& F, const Args& a, int l, int d, int h, int pc) {
    LAS unsigned char* lds = F.lds; const int lane = F.lane, r32 = lane & 31, hi = lane >> 5, q = F.wave & 3, mt = q >> 1, nt = q & 1; const bool g0 = F.wave < 4;
    const int seq = pc < 2 ? 0 : 1, tb = pc < 2 ? pc * TCH : (pc - 2) * TCH, slot = pc == 1 ? NCH - 1 : pc - 2;
    bf16_t* Y = (bf16_t*)(F.ws + (d == 0 ? WS_YF : WS_YBK));
    const float* S0g = (const float*)(F.ws + WS_QST) + ((size_t)(d * 8 + h) * NCH + slot) * 4096;
    { const int i = F.tid >> 3, c8 = (F.tid & 7) * 8; u32x4 wv = {0u, 0u, 0u, 0u};
      if (pc != 0) { const float* S0 = S0g + i * 64 + c8; const f32x4 x0 = *(const f32x4*)S0, x1 = *(const f32x4*)(S0 + 4);
          wv = (u32x4){cvtpk(x0[0], x0[1]), cvtpk(x0[2], x0[3]), cvtpk(x1[0], x1[1]), cvtpk(x1[2], x1[3])}; }
      *(LAS u32x4*)(buf(lds, B_SB) + i * PITCH + c8 * 2) = wv; }
    const f32x16 Z16 = f32x16{};
    for (int sb = 0; sb < 2; ++sb) {
        { Raw raw; prep_load(F, d, h, seq, tb + 64 * sb, raw); prep<true>(F, a, l, h, raw); }
        f32x16 vk = Z16, ye = Z16;
        core<true>(F, sb == 1, vk, ye);
        f32x16 s1 = Z16;
        if (!g0) {
            const f32x16 y = mm_accT(buf(lds, B_KT), buf(lds, B_W1), mt, nt, lane, ye);
            const size_t row = (size_t)rw_row2(d, seq, tb + 64 * sb + 32 * nt + r32);
#pragma unroll
            for (int g = 0; g < 4; ++g) { u32x2 wv = {cvtpk(y[4 * g], y[4 * g + 1]), cvtpk(y[4 * g + 2], y[4 * g + 3])}; *(u32x2*)(Y + row * 512 + h * 64 + 32 * mt + 8 * g + 4 * hi) = wv; }
        } else if (sb == 0) {
            const float gc = ((LAS const float*)(lds + OFF_GC))[32 * nt + r32];
            s1 = vk;
            if (pc != 0) {
#pragma unroll
                for (int r = 0; r < 16; ++r) s1[r] += S0g[(32 * mt + crow(r, hi)) * 64 + 32 * nt + r32]; }
            s1 = mm_accT(buf(lds, B_KT), buf(lds, B_W0), mt, nt, lane, s1);
#pragma unroll
            for (int r = 0; r < 16; ++r) s1[r] *= gc;
        }
        RW_BAR();
        if (g0 && sb == 0) store_T(s1, buf(lds, B_SB), mt, nt, r32, hi);
        RW_BAR();
    }
}
#undef RW_BAR
}

__device__ __forceinline__ void norm2_route_rows(const Frame& F, const Args& a, int l, const float* src, const float* g, const float* sh, const float* sc) {
    bf16_t* H = (bf16_t*)(F.ws + WS_H);
    int* ridx = (int*)(F.ws + WS_RT_IDX); int* rpos = (int*)(F.ws + WS_RT_POS); float* rgate = (float*)(F.ws + WS_RT_GATE);
    unsigned* cnt = (unsigned*)(F.ws + WS_CTL) + CW_MOECNT;
    const float* rw = a.in[I_ROUTER];
    f32x4 ca[4], cb[4];
#pragma unroll
    for (int j = 0; j < 4; ++j) { const int d = F.lane * 4 + 256 * j; const f32x4 gg = *(const f32x4*)(g + d), s1 = *(const f32x4*)(sc + d); ca[j] = gg * (s1 + 1.0f); cb[j] = *(const f32x4*)(sh + d); }
    const int gw = F.vcu * NWAVES + F.wave, NGW = F.G * NWAVES;
    for (int m = gw; m < L; m += NGW) {
        const f32x4* xr = (const f32x4*)(src + (size_t)m * DM) + F.lane;
        f32x4 v[4]; float s = 0.f;
#pragma unroll
        for (int j = 0; j < 4; ++j) { v[j] = xr[64 * j]; s += (v[j].x * v[j].x + v[j].y * v[j].y) + (v[j].z * v[j].z + v[j].w * v[j].w); }
        const float rstd = rsqrtf(wave_sum(s) * (1.f / DM) + NORM_EPS);
        u32x2* o8 = (u32x2*)(H + (size_t)m * DM) + F.lane;
        float lg[8] = {0.f, 0.f, 0.f, 0.f, 0.f, 0.f, 0.f, 0.f};
#pragma unroll
        for (int j = 0; j < 4; ++j) { const f32x4 y = v[j] * rstd * ca[j] + cb[j]; u32x2 w; w.x = cvtpk(y.x, y.y); w.y = cvtpk(y.z, y.w); o8[64 * j] = w;
            const float* rp = rw + (size_t)(F.lane * 4 + 256 * j) * 8;
#pragma unroll
            for (int e4 = 0; e4 < 4; ++e4) { const f32x4 w0 = *(const f32x4*)(rp + e4 * 8), w1 = *(const f32x4*)(rp + e4 * 8 + 4);
                const float yy = y[e4];
                lg[0] += yy * w0[0]; lg[1] += yy * w0[1]; lg[2] += yy * w0[2]; lg[3] += yy * w0[3]; lg[4] += yy * w1[0]; lg[5] += yy * w1[1]; lg[6] += yy * w1[2]; lg[7] += yy * w1[3]; } }
#pragma unroll
        for (int e = 0; e < 8; ++e) lg[e] = wave_sum(lg[e]);
        if (F.lane == 0) {
            int i1 = 0; float l1 = lg[0];
#pragma unroll
            for (int e = 1; e < 8; ++e) if (lg[e] > l1) { l1 = lg[e]; i1 = e; }
            int i2 = -1; float l2 = -3.0e38f;
#pragma unroll
            for (int e = 0; e < 8; ++e) if (e != i1 && lg[e] > l2) { l2 = lg[e]; i2 = e; }
            const float g2v = 1.f / (1.f + __expf(l1 - l2)), g1v = 1.f - g2v;
            const unsigned p1 = __hip_atomic_fetch_add(cnt + 64 * i1, 1u, __ATOMIC_RELAXED, __HIP_MEMORY_SCOPE_AGENT);
            const unsigned p2 = __hip_atomic_fetch_add(cnt + 64 * i2, 1u, __ATOMIC_RELAXED, __HIP_MEMORY_SCOPE_AGENT);
            ridx[2 * m] = i1; ridx[2 * m + 1] = i2; rpos[2 * m] = (int)p1; rpos[2 * m + 1] = (int)p2; rgate[2 * m] = g1v; rgate[2 * m + 1] = g2v;
        }
    }
}
__device__ __forceinline__ void moe_tile_bases(const Frame& F, int (&tb)[9]) {
    const unsigned* cnt = (const unsigned*)(F.ws + WS_CTL) + CW_MOECNT;
    int acc = 0;
#pragma unroll
    for (int e = 0; e < 8; ++e) { tb[e] = acc; const unsigned c = __hip_atomic_load(cnt + 64 * e, __ATOMIC_RELAXED, __HIP_MEMORY_SCOPE_AGENT); acc += (int)((c + 255u) >> 8); }
    tb[8] = acc;
}
__device__ __forceinline__ void moe_gather(const Frame& F) {
    const bf16_t* H = (const bf16_t*)(F.ws + WS_H); bf16_t* H2G = (bf16_t*)(F.ws + WS_H2G);
    const int* ridx = (const int*)(F.ws + WS_RT_IDX); const int* rpos = (const int*)(F.ws + WS_RT_POS); const float* rgate = (const float*)(F.ws + WS_RT_GATE);
    float* rowgate = (float*)(F.ws + WS_RT_ROWGATE);
    const unsigned* cnt = (const unsigned*)(F.ws + WS_CTL) + CW_MOECNT;
    int tb[9]; moe_tile_bases(F, tb);
    const int gw = F.vcu * NWAVES + F.wave, NGW = F.G * NWAVES;
    for (int m = gw; m < L; m += NGW) {
        const u32x4 r0 = *((const u32x4*)(H + (size_t)m * DM) + F.lane), r1 = *((const u32x4*)(H + (size_t)m * DM) + 64 + F.lane);
#pragma unroll
        for (int s = 0; s < 2; ++s) {
            const int e = ridx[2 * m + s]; int base = 0;
#pragma unroll
            for (int k = 0; k < 8; ++k) base = (e == k) ? tb[k] : base;
            const size_t row = (size_t)base * 256 + rpos[2 * m + s];
            *((u32x4*)(H2G + row * DM) + F.lane) = r0; *((u32x4*)(H2G + row * DM) + 64 + F.lane) = r1;
            if (F.lane == 0) rowgate[row] = rgate[2 * m + s];
        }
    }
#pragma unroll
    for (int e = 0; e < 8; ++e) {
        const int c = (int)__hip_atomic_load(cnt + 64 * e, __ATOMIC_RELAXED, __HIP_MEMORY_SCOPE_AGENT);
        const int lo = tb[e] * 256 + c, hi_ = tb[e + 1] * 256;
        for (int row = lo + gw; row < hi_; row += NGW) { *((u32x4*)(H2G + (size_t)row * DM) + F.lane) = (u32x4){0u, 0u, 0u, 0u}; *((u32x4*)(H2G + (size_t)row * DM) + 64 + F.lane) = (u32x4){0u, 0u, 0u, 0u}; if (F.lane == 0) rowgate[row] = 0.f; }
    }
}
__device__ __forceinline__ void moe_combine(const Frame& F, float* out, const float* gt2) {
    const bf16_t* YS = (const bf16_t*)(F.ws + WS_H2G);
    const int* ridx = (const int*)(F.ws + WS_RT_IDX); const int* rpos = (const int*)(F.ws + WS_RT_POS);
    int tb[9]; moe_tile_bases(F, tb);
    const int gw = F.vcu * NWAVES + F.wave, NGW = F.G * NWAVES;
    for (int m = gw; m < L; m += NGW) {
        size_t rows[2];
#pragma unroll
        for (int s = 0; s < 2; ++s) { const int e = ridx[2 * m + s]; int base = 0;
#pragma unroll
            for (int k = 0; k < 8; ++k) base = (e == k) ? tb[k] : base;
            rows[s] = (size_t)base * 256 + rpos[2 * m + s]; }
#pragma unroll
        for (int hf = 0; hf < 2; ++hf) {
            const int c0 = hf * 512 + F.lane * 8;
            const u32x4 a0 = *(const u32x4*)(YS + rows[0] * DM + c0), a1 = *(const u32x4*)(YS + rows[1] * DM + c0);
            float* op = out + (size_t)m * DM + c0;
            const f32x4 g0 = *(const f32x4*)(gt2 + c0), g1 = *(const f32x4*)(gt2 + c0 + 4);
            f32x4 x0 = *(const f32x4*)op, x1 = *(const f32x4*)(op + 4);
            x0 += g0 * (f32x4){lo_bf(a0.x) + lo_bf(a1.x), hi_bf(a0.x) + hi_bf(a1.x), lo_bf(a0.y) + lo_bf(a1.y), hi_bf(a0.y) + hi_bf(a1.y)};
            x1 += g1 * (f32x4){lo_bf(a0.z) + lo_bf(a1.z), hi_bf(a0.z) + hi_bf(a1.z), lo_bf(a0.w) + lo_bf(a1.w), hi_bf(a0.w) + hi_bf(a1.w)};
            *(f32x4*)op = x0; *(f32x4*)(op + 4) = x1;
        }
    }
}

#ifndef PROBE_MOE
#define PROBE_MOE 1
#endif
#ifndef PROBE_NA
#define PROBE_NA 1
#endif
#ifndef PROBE_MLA
#define PROBE_MLA 1
#endif
#ifndef PROBE_GEMM
#define PROBE_GEMM 1
#endif
#ifndef PROBE_P1012
#define PROBE_P1012 1
#endif
#ifndef PROBE_P14
#define PROBE_P14 1
#endif
#ifndef PROBE_RW3
#define PROBE_RW3 1
#endif
#ifndef PROBE_RW1
#define PROBE_RW1 1
#endif
#ifndef REP_MLA
#define REP_MLA 1
#endif
#ifndef REP_NA
#define REP_NA 1
#endif
#ifndef REP_RW1
#define REP_RW1 1
#endif
#ifndef REP_RW3
#define REP_RW3 1
#endif
#ifndef REP_GEMM
#define REP_GEMM 1
#endif
#ifndef REP_ROW
#define REP_ROW 1
#endif
constexpr int PH_PER_LAYER = 24;
constexpr int N_PHASES = 1 + 2 * PH_PER_LAYER;
__global__ void __launch_bounds__(NTHR, 2) mega_fwd(Args args) {
    extern __shared__ __attribute__((aligned(16))) unsigned char lds_raw[];
    Frame F;
    F.lds = (LAS unsigned char*)lds_raw; F.ws = args.ws;
    F.tid = threadIdx.x; F.lane = F.tid & 63; F.wave = __builtin_amdgcn_readfirstlane((int)threadIdx.x >> 6);
    F.G = gridDim.x; F.bid = blockIdx.x; F.vcu = (F.G % 8 == 0) ? (F.bid % 8) * (F.G / 8) + F.bid / 8 : F.bid;
    volatile LAS unsigned* MISC = (volatile LAS unsigned*)(F.lds + LDS_MISC_OFF);
    if (F.tid < 64) MISC[F.tid] = 0u;
    __syncthreads();
    const int lo = args.ph_lo, hi = args.ph_hi;
    const bool multi = (hi - lo) > 1;
    XcdBarrier bar; bar.bar = (unsigned*)(F.ws + WS_CTL) + CW_BAR; bar.x = 0; bar.st = MISC + 8;
    if (multi) bar = xcd_barrier_post((unsigned*)(F.ws + WS_CTL) + CW_BAR, MISC + 8);
#define IN(k) (lo <= (k) && (k) < hi)
    const Frame F0 = F;
#define SEAM(k) do { if (multi) xcd_barrier(bar); } while (0)
    LAS unsigned char* lds = F.lds;
    float* MODV = (float*)(F.ws + WS_MODV);
    float* out = args.out;

    if (IN(0)) { const Frame F = launder(F0); prologue_mod(F, args); prologue_weights(F, args); }
    SEAM(0);

#pragma unroll
    for (int l = 0; l < 2; ++l) {
        const int pb = 1 + l * PH_PER_LAYER;
        const bool need_ctx = (l == 0);
        unsigned char* wb = F.ws + WS_W + (size_t)l * WB_SIZE;
        const float* modL = MODV + (size_t)(l * 2) * 6144; const float* modC = modL + 6144;
        float* X1 = (float*)(F.ws + WS_X1); float* CM = (float*)(F.ws + WS_CM);
        bf16_t* H = (bf16_t*)(F.ws + WS_H);
        const int nMall = R / 256, nMlat = L / 256;

        if (IN(pb + 0)) { const Frame F = launder(F0);
            if (l == 0) { norm_rows(F, args.in[I_X], 0, 0, L, args.in[I_N1G] + l * DM, modL, modL + 1024, H);
                          norm_rows(F, args.in[I_CTX], L, L, R, args.in[I_N1G] + l * DM, modC, modC + 1024, H); }
            else { norm_rows(F, X1, 0, 0, L, args.in[I_N1G] + l * DM, modL, modL + 1024, H);
                   norm_rows(F, X1, 0, L, R, args.in[I_N1G] + l * DM, modC, modC + 1024, H); }
        }
        SEAM(pb + 0);
        for (int rq_ = 0; rq_ < PROBE_P14; ++rq_) {
        if (IN(pb + 1)) { const Frame F = launder(F0);
            pg8::Gemm g{H, DM, (const bf16_t*)(wb + WB_WINM), DM}; pg8::StaticOrder S; S.init(nMall, ZM_N / 256, F.G, F.bid, PROBE_GEMM);
            EpiZ E{(bf16_t*)(F.ws + WS_ZA), (bf16_t*)(F.ws + WS_ZN), (bf16_t*)(F.ws + WS_ZR)};
            pg8::gemm_phase(lds, F.tid, g, S, E);
        }
        SEAM(pb + 1);
        if (IN(pb + 2)) { const Frame F = launder(F0); prepare_rows(F, args, l); }
        SEAM(pb + 2);
        if (IN(pb + 3)) { const Frame F = launder(F0);
            { pg8::Gemm g{(const bf16_t*)(F.ws + WS_CQN), 384, (const bf16_t*)(wb + WB_WUQ), 384}; pg8::StaticOrder S; S.init(nMall, 3, F.G, F.bid, PROBE_GEMM);
              EpiBf E{(bf16_t*)(F.ws + WS_QRAW), 768}; pg8::gemm_phase(lds, F.tid, g, S, E); }
            { pg8::Gemm g{(const bf16_t*)(F.ws + WS_CKVN), 256, (const bf16_t*)(wb + WB_WUKV), 256}; pg8::StaticOrder S; S.init(nMall, 4, F.G, F.bid, PROBE_GEMM);
              EpiBf E{(bf16_t*)(F.ws + WS_KVRAW), 1024}; pg8::gemm_phase(lds, F.tid, g, S, E); }
            { pg8::Gemm g{(const bf16_t*)(F.ws + WS_LA), 384, (const bf16_t*)(wb + WB_WLORA), 384}; pg8::StaticOrder S; S.init(nMall, 10, F.G, F.bid, PROBE_GEMM);
              EpiLora E{(bf16_t*)(F.ws + WS_LO), args.in[I_W0] + (size_t)l * 1024, args.in[I_A0] + (size_t)l * 1024}; pg8::gemm_phase(lds, F.tid, g, S, E); }
        }
        SEAM(pb + 3);
        if (IN(pb + 4)) { const Frame F = launder(F0); mla_fixup(F, args, l, need_ctx); }
        SEAM(pb + 4);
        }
        if (IN(pb + 5)) { const Frame F = launder(F0);
            const int xcd = F.bid % 8, idx = F.bid / 8, per = F.G / 8;
            for (int u0 = idx; u0 < 64 * PROBE_MLA + ((need_ctx && idx == 0) ? per : 0); u0 += per) { const int u = u0 >= 64 * PROBE_MLA ? 64 : u0 % 64;
                const bool cu = u >= 64;
                mla_unit(F, xcd, cu ? L : u * 256, cu ? L : 0, cu ? CT / 64 : R / 64);
            }
        }
        SEAM(pb + 5);
        if (IN(pb + 6)) { const Frame F = launder(F0);
            for (int it = F.bid; it < PROBE_RW1 * 16 * 128; it += F.G) { const int ci = (it >> 4) & 127, dh = it & 15;
                rwmm::pass1_item(F, args, l, dh >> 3, dh & 7, ci);
            }
        }
        SEAM(pb + 6);
        if (IN(pb + 7)) { const Frame F = launder(F0);
            const int nrw = F.G > 64 ? 16 : 0;
            if (F.bid < nrw) { if (F.wave < 2) rwkv_pass2(F, F.bid, F.wave); }
            else {
                if (nrw == 0 && F.bid < 16 && F.wave < 2) rwkv_pass2(F, F.bid, F.wave);
                __syncthreads();
                if (need_ctx && F.bid >= F.G - 32) { const int k = F.bid - (F.G - 32); rwmm::pass3_item(F, args, l, k >> 4, (k >> 1) & 7, k & 1); }
                const float* rpb_l = args.in[I_RPB] + (size_t)l * 8 * 465;
                for (int u0 = F.bid - nrw; u0 < PROBE_NA * 2 * (256 + (need_ctx ? 4 : 0)); u0 += F.G - nrw) { const int u = u0 % (2 * (256 + (need_ctx ? 4 : 0))); const int un = u >> 1; na_unit(F, rpb_l, un < 256 ? un : un - 256, un >= 256, u & 1); }
            }
        }
        SEAM(pb + 7);
        if (IN(pb + 8)) { const Frame F = launder(F0);
            for (int it = F.bid; it < PROBE_RW3 * 16 * 128; it += F.G) { const int dh = it & 15, pc = 2 + ((it >> 4) & 127);
                rwmm::pass3_item(F, args, l, dh >> 3, dh & 7, pc);
            }
        }
        SEAM(pb + 8);
        if (IN(pb + 10)) { const Frame F = launder(F0);
            rwkv_output_rows(F, args, l, need_ctx ? R : L);
            __syncthreads();
            pg8::Gemm g{H, DM, (const bf16_t*)(wb + WB_WING), DM}; pg8::StaticOrder S; S.init(need_ctx ? nMall : nMlat, 12, F.G, F.bid, PROBE_GEMM);
            EpiSig E{(bf16_t*)(F.ws + WS_ZG), ZG_LD}; pg8::gemm_phase(lds, F.tid, g, S, E);
        }
        SEAM(pb + 10);
        for (int rp_ = 0; rp_ < PROBE_P1012; ++rp_) {
        if (IN(pb + 11)) { const Frame F = launder(F0);
            pg8::Gemm g{(const bf16_t*)(F.ws + WS_YA), 512, (const bf16_t*)(wb + WB_WOA), 512, (unsigned)(WS_YB - WS_YA), (unsigned)(WB_WOB - WB_WOA)};
            pg8::SegOrder3 S; S.S.init(need_ctx ? nMall : nMlat, 4, F.G, F.bid);
            EpiMerge3 E{(bf16_t*)(F.ws + WS_U), (const bf16_t*)(F.ws + WS_ZG)}; pg8::gemm_phase(lds, F.tid, g, S, E);
        }
        SEAM(pb + 11);
        if (IN(pb + 12)) { const Frame F = launder(F0);
            pg8::Gemm g{(const bf16_t*)(F.ws + WS_U), DM, (const bf16_t*)(wb + WB_WOUT), DM}; pg8::StaticOrder S; S.init(need_ctx ? nMall : nMlat, 4, F.G, F.bid, PROBE_GEMM);
            EpiRes E{l == 0 ? args.in[I_X] : X1, l == 0 ? args.in[I_CTX] : X1 + (size_t)L * DM, out, CM, modL + 2048, modC + 2048};
            pg8::gemm_phase(lds, F.tid, g, S, E);
        }
        SEAM(pb + 12);
        }
        if (l == 0) {
            if (IN(pb + 13)) { const Frame F = launder(F0); norm_rows(F, out, 0, 0, L, args.in[I_N2G] + l * DM, modL + 3072, modL + 4096, H);
                               norm_rows(F, CM, L, L, R, args.in[I_N2G] + l * DM, modC + 3072, modC + 4096, H); }
            SEAM(pb + 13);
            if (IN(pb + 14)) { const Frame F = launder(F0);
                pg8::Gemm g{H, DM, (const bf16_t*)(F.ws + WS_W13), DM}; pg8::StaticOrder S; S.init(nMall, 22, F.G, F.bid, PROBE_GEMM);
                EpiSwiglu E{(bf16_t*)(F.ws + WS_G), FF, 0, 1 << 20}; pg8::gemm_phase(lds, F.tid, g, S, E);
            }
            SEAM(pb + 14);
            if (IN(pb + 15)) { const Frame F = launder(F0);
                pg8::Gemm g{(const bf16_t*)(F.ws + WS_G), FF, (const bf16_t*)(F.ws + WS_W2), FF}; pg8::StaticOrder S; S.init(nMall, 4, F.G, F.bid, PROBE_GEMM);
                EpiRes E{out, CM, X1, X1 + (size_t)L * DM, modL + 5120, modC + 5120};
                pg8::gemm_phase(lds, F.tid, g, S, E);
            }
            SEAM(pb + 15);
        } else {
            if (IN(pb + 13)) { const Frame F = launder(F0); norm2_route_rows(F, args, l, out, args.in[I_N2G] + l * DM, modL + 3072, modL + 4096); }
            SEAM(pb + 13);
            if (IN(pb + 14)) { const Frame F = launder(F0); moe_gather(F); moe_weights(F, args, 0); }
            SEAM(pb + 14);
            int tb[9]; moe_tile_bases(F, tb);
            if (IN(pb + 15)) { const Frame F = launder(F0);
                moe_weights(F, args, 1);
                __syncthreads();
                MoeOrder S{tb[0], tb[1], tb[2], tb[3], tb[4], tb[5], tb[6], tb[7], tb[8], 28, 0, F.G, F.bid, PROBE_MOE};
                pg8::Gemm g{(const bf16_t*)(F.ws + WS_H2G), DM, (const bf16_t*)(F.ws + WS_W13E), DM};
                EpiSwiglu E{(bf16_t*)(F.ws + WS_HID), FFE, 0, 28}; pg8::gemm_phase(lds, F.tid, g, S, E);
            }
            SEAM(pb + 15);
            if (IN(pb + 17)) { const Frame F = launder(F0);
                MoeOrder S{tb[0], tb[1], tb[2], tb[3], tb[4], tb[5], tb[6], tb[7], tb[8], 4, W2E_HI_TILE_SHIFT, F.G, F.bid, PROBE_MOE};
                pg8::Gemm g{(const bf16_t*)(F.ws + WS_HID), FFE, (const bf16_t*)(F.ws + WS_W2E_LO), FFE};
                EpiMoe2 E{(bf16_t*)(F.ws + WS_H2G), (const float*)(F.ws + WS_RT_ROWGATE)}; pg8::gemm_phase(lds, F.tid, g, S, E);
            }
            SEAM(pb + 17);
            if (IN(pb + 19)) { const Frame F = launder(F0); moe_combine(F, out, modL + 5120); }
        }
    }
#undef IN
#undef SEAM
}

#ifndef MK_PER_PHASE
#define MK_PER_PHASE 0
#endif
extern "C" void kernel_launch(void* const* d_in, const int* in_sizes, int n_in, void* d_out, int out_size, void* d_ws, size_t ws_size, hipStream_t stream) {
    static int grid = 0;
    if (grid == 0) {
        if (n_in != 40 || out_size != L * DM || ws_size < 560 * MiB) { fprintf(stderr, "kernel_launch: unexpected shapes (n_in %d out %d ws %zu)\n", n_in, out_size, ws_size); grid = -1; return; }
        int dev = 0, cus = 0, per_cu = 0;
        if (hipGetDevice(&dev) != hipSuccess || hipDeviceGetAttribute(&cus, hipDeviceAttributeMultiprocessorCount, dev) != hipSuccess) { grid = -1; return; }
        if (hipFuncSetAttribute((const void*)mega_fwd, hipFuncAttributeMaxDynamicSharedMemorySize, LDS_BYTES) != hipSuccess) { fprintf(stderr, "kernel_launch: hipFuncSetAttribute failed\n"); grid = -1; return; }
        if (hipOccupancyMaxActiveBlocksPerMultiprocessor(&per_cu, (const void*)mega_fwd, NTHR, LDS_BYTES) != hipSuccess || per_cu < 1) fprintf(stderr, "kernel_launch: occupancy query says %d\n", per_cu);
        (void)hipGetLastError();
        grid = cus;
    }
    if (grid < 0) return;
    (void)hipMemsetAsync((char*)d_ws + WS_CTL, 0, CTL_ZERO_BYTES, stream);
    Args a{};
    for (int i = 0; i < 40; ++i) a.in[i] = (const float*)d_in[i];
    a.out = (float*)d_out; a.ws = (unsigned char*)d_ws;
#if MK_PER_PHASE
    for (int p = 0; p < N_PHASES; ++p) { a.ph_lo = p; a.ph_hi = p + 1; hipLaunchKernelGGL(mega_fwd, dim3(grid), dim3(NTHR), LDS_BYTES, stream, a); }
#else
    a.ph_lo = 0; a.ph_hi = N_PHASES;
    hipLaunchKernelGGL(mega_fwd, dim3(grid), dim3(NTHR), LDS_BYTES, stream, a);
#endif
    const hipError_t le = hipPeekAtLastError();
    if (le != hipSuccess) fprintf(stderr, "kernel_launch: launch failed: %s\n", hipGetErrorName(le));
}
```

```cpp
#include <hip/hip_runtime.h>
#include <cstdio>
#include <cstdint>

#define LAS __attribute__((address_space(3)))
#define GAS __attribute__((address_space(1)))
typedef unsigned short bf16_t;
typedef short bf16x8 __attribute__((ext_vector_type(8)));
typedef short s16x4 __attribute__((ext_vector_type(4)));
typedef float f32x4 __attribute__((ext_vector_type(4)));
typedef float f32x2 __attribute__((ext_vector_type(2)));
typedef float f32x16 __attribute__((ext_vector_type(16)));
typedef unsigned u32x4 __attribute__((ext_vector_type(4)));
typedef unsigned u32x2 __attribute__((ext_vector_type(2)));
typedef __bf16 bf16x2_t __attribute__((ext_vector_type(2)));

constexpr int L = 16384, CT = 256, R = L + CT, DM = 1024, GW = 64;
constexpr int NWAVES = 8, NTHR = 512;
constexpr int ZA_LD = 768, ZN_LD = 1536, ZR_LD = 2048, ZM_N = 4352, ZG_LD = 3072;
constexpr int LO_LD = 2560, RKV_LD = 1536;
constexpr int FF = 2816, FFE = 3584, NEXP = 8;
constexpr int MOE_ROWS = 2 * L + NEXP * 256;
constexpr float NORM_EPS = 1e-6f;
constexpr float LOG2E = 1.4426950408889634f;
constexpr int TCH = 128, NCH = 129;

constexpr size_t MiB = 1u << 20;
constexpr size_t WS_CTL = 0, CTL_ZERO_BYTES = 1 * MiB;
constexpr size_t WS_W = 1 * MiB;
constexpr size_t WB_WINM = 0;
constexpr size_t WB_WING = WB_WINM + (size_t)ZM_N * DM * 2;
constexpr size_t WB_WUQ = WB_WING + (size_t)ZG_LD * DM * 2;
constexpr size_t WB_WUKV = WB_WUQ + (size_t)768 * 384 * 2;
constexpr size_t WB_WLORA = WB_WUKV + (size_t)1024 * 256 * 2;
constexpr size_t WB_WOA = WB_WLORA + (size_t)2560 * 384 * 2;
constexpr size_t WB_WOB = WB_WOA + (size_t)1024 * 512 * 2;
constexpr size_t WB_WOR = WB_WOB + (size_t)1024 * 512 * 2;
constexpr size_t WB_WOUT = WB_WOR + (size_t)1024 * 512 * 2;
constexpr size_t WB_SIZE = WB_WOUT + (size_t)1024 * 1024 * 2;
constexpr size_t WS_W13 = WS_W + 2 * WB_SIZE;
constexpr size_t WS_W2 = WS_W13 + (size_t)2 * FF * DM * 2;
constexpr size_t WS_W_END = WS_W2 + (size_t)DM * FF * 2;
static_assert(WS_W_END <= 67 * MiB, "weights region");
constexpr size_t WS_X1 = 67 * MiB;
constexpr size_t WS_CM = 132 * MiB;
constexpr size_t WS_H = 135 * MiB;
constexpr size_t WS_MISC = 168 * MiB;
constexpr size_t WS_MODV = WS_MISC;
constexpr size_t WS_RT_IDX = WS_MISC + 128 * 1024;
constexpr size_t WS_RT_POS = WS_RT_IDX + 128 * 1024;
constexpr size_t WS_RT_GATE = WS_RT_POS + 128 * 1024;
constexpr size_t WS_RT_ROWGATE = WS_RT_GATE + 128 * 1024;
constexpr size_t WS_KN = WS_MISC + 1 * MiB;
constexpr size_t WS_BIG = 170 * MiB;
constexpr size_t WS_ZN = WS_BIG;
constexpr size_t WS_Q = 219 * MiB, WS_K = 244 * MiB, WS_V = 269 * MiB;
constexpr size_t WS_RKV = 286 * MiB;
constexpr size_t WS_LO = 335 * MiB;
constexpr size_t WS_CQN = 417 * MiB, WS_CKVN = 430 * MiB, WS_LA = 439 * MiB, WS_KR = 452 * MiB;
constexpr size_t WS_YA = 417 * MiB, WS_YB = 434 * MiB;
constexpr size_t WS_ZA = 453 * MiB, WS_ZR = 478 * MiB;
constexpr size_t WS_QRAW = 453 * MiB, WS_KVRAW = 478 * MiB;
constexpr size_t WS_PST = 219 * MiB, WS_QST = 486 * MiB, WS_YF = 519 * MiB, WS_YBK = 536 * MiB, WS_YR = 451 * MiB;
static_assert(WS_YR - WS_YB == WS_YB - WS_YA && WB_WOR - WB_WOB == WB_WOB - WB_WOA, "merge segments");
constexpr size_t WS_ZG = WS_BIG;
constexpr size_t WS_U32 = 335 * MiB;
constexpr size_t WS_U = 286 * MiB;
constexpr size_t WS_G = WS_BIG;
constexpr size_t WS_H2G = 67 * MiB;
constexpr size_t WS_W13E = 170 * MiB;
constexpr size_t WS_W2E_LO = 135 * MiB;
constexpr size_t WS_W2E_HI = 282 * MiB;
constexpr int W2E_HI_TILE_SHIFT = (int)((WS_W2E_HI - WS_W2E_LO) / ((size_t)256 * FFE * 2)) - 16;
static_assert((WS_W2E_HI - WS_W2E_LO) % ((size_t)256 * FFE * 2) == 0 && (W2E_HI_TILE_SHIFT % 4) == 0, "W2E split");
constexpr size_t WS_HID = 310 * MiB;
constexpr size_t WS_END = 553 * MiB;
static_assert((size_t)16 * NCH * 4096 * 4 <= 33 * MiB, "state slots");
static_assert(WS_ZR + (size_t)R * ZR_LD * 2 <= WS_END, "ws map");
static_assert(WS_HID + (size_t)MOE_ROWS * FFE * 2 <= 549 * MiB, "hid");
constexpr int CW_BAR = 4096;
constexpr int CW_MOECNT = 1024;

#ifndef PROBE_CVT
#define PROBE_CVT 1
#endif
#ifndef PROBE_ROW
#define PROBE_ROW 1
#endif
__device__ __forceinline__ float bf2f(unsigned b) { return __uint_as_float(b << 16); }
__device__ __forceinline__ unsigned cvtpk(float lo, float hi) { f32x2 v = {lo, hi}; bf16x2_t b = __builtin_convertvector(v, bf16x2_t); return __builtin_bit_cast(unsigned, b); }
__device__ __forceinline__ float lo_bf(unsigned w) { return __uint_as_float(w << 16); }
__device__ __forceinline__ float hi_bf(unsigned w) { return __uint_as_float(w & 0xffff0000u); }
__device__ __forceinline__ float wave_sum(float v) {
#pragma unroll
    for (int o = 1; o < 64; o <<= 1) v += __shfl_xor(v, o);
    return v;
}
__device__ __forceinline__ float sigmoidf_(float x) { return 1.f / (1.f + __expf(-x)); }
__device__ __forceinline__ float siluf_(float x) { return x / (1.f + __expf(-x)); }
#define LDS_WAIT() asm volatile("s_waitcnt lgkmcnt(0)" ::: "memory")
#define VM_WAIT() asm volatile("s_waitcnt vmcnt(0)" ::: "memory")

namespace pg8 {
constexpr int BM = 256, BK = 64, HALF = 128, HTB = HALF * BK * 2, STAGE_BYTES = 8 * HTB, NXCD = 8, WGM = 8;
__device__ __forceinline__ int lds_byte(int r, int c) { const int st = (r >> 4) * 2 + (c >> 5), rr = r & 15, cc = c & 31, ob = rr * 64 + cc * 2; return st * 1024 + (ob ^ (((ob >> 9) & 1) << 5)); }
__device__ __forceinline__ void stage_rc(int b, int& R_, int& C_) { const int st = b / 1024, sb = b % 1024, swz = sb ^ (((sb >> 9) & 1) << 5); R_ = (st >> 1) * 16 + swz / 64; C_ = (st & 1) * 32 + (swz % 64) / 2; }
__device__ __forceinline__ int perm32(int rho) { const int n = rho >> 4, i = rho & 15; return 8 * (i >> 2) + 4 * n + (i & 3); }

struct Unit { int pm, pn, seg; };
struct Gemm { const bf16_t* A; int lda; const bf16_t* Bt; int K; unsigned segA = 0, segB = 0; };
template <class E> __device__ __forceinline__ bool epi_done(const E&, const Unit&) { return true; }

struct StaticOrder {
    int nM, nN, nwg, G, c, rep;
    __device__ void init(int nM_, int nN_, int G_, int c_, int rep_ = 1) { nM = nM_; nN = nN_; nwg = nM * nN; G = G_; c = c_; rep = rep_; }
    __device__ bool next(int i, Unit& u) const {
        const long Lx = (long)i * G + c; if (Lx >= (long)nwg * rep) return false;
        int wgid = (int)(Lx % nwg); { const int q = nwg / NXCD, r = nwg % NXCD, xcd = wgid % NXCD, off = wgid / NXCD; wgid = (xcd < r ? xcd * (q + 1) : r * (q + 1) + (xcd - r) * q) + off; }
        const int nig = WGM * nN, gid = wgid / nig, fm = gid * WGM, gsz = (nM - fm) < WGM ? (nM - fm) : WGM;
        u.pm = fm + ((wgid % nig) % gsz); u.pn = (wgid % nig) / gsz; u.seg = 0; return true;
    }
};

struct SegOrder3 { StaticOrder S; __device__ bool next(int i, Unit& u) const { if (!S.next(i / 3, u)) return false; u.seg = i % 3; return true; } };
template <class Epi, class Sched>
__device__ __forceinline__ void gemm_phase(LAS unsigned char* lds, const int tid, const Gemm g, const Sched& S, const Epi& E) {
    const int wid = __builtin_amdgcn_readfirstlane(tid >> 6), lane = tid & 63, wr = wid >> 2, wc = wid & 3, fr = lane & 15, fq = lane >> 4;
    const int K = g.K, nt = K / BK;
    unsigned voffA[2], voffB[2];
#pragma unroll
    for (int i = 0; i < 2; ++i) { int R_, C_; stage_rc(tid * 16 + i * 8192, R_, C_); const int Rb = (R_ & ~31) + perm32(R_ & 31);
        voffA[i] = (unsigned)(R_ * g.lda + C_) * 2u; voffB[i] = (unsigned)(Rb * K + C_) * 2u; }
    const size_t kstep = (size_t)(BK * 2);
    const size_t hstepA = (size_t)HALF * g.lda * 2, hstepB = (size_t)HALF * K * 2;
    const size_t tstepA = 2 * hstepA, tstepB = 2 * hstepB;
    const unsigned ldsw = (unsigned)wid * 1024u;
    const int aoff = lds_byte(wr * 64 + fr, fq * 8), boff = lds_byte(wc * 32 + fr, fq * 8);
#define PG8_SA(b, h) (((b) * 2 + (h)) * HTB)
#define PG8_SB(b, h) ((4 + (b) * 2 + (h)) * HTB)
#define PG8_STAGE(bufoff, gbase, voff) do { _Pragma("unroll") for (int _i = 0; _i < 2; ++_i) \
        __builtin_amdgcn_global_load_lds((const unsigned*)((const char*)(gbase) + (voff)[_i]), (LAS unsigned*)(lds + (bufoff) + ldsw + _i * 8192), 16, 0, 0); } while (0)
#define PG8_LDA(dst, b, h) do { _Pragma("unroll") for (int m = 0; m < 4; ++m) _Pragma("unroll") for (int k = 0; k < 2; ++k) dst[m][k] = *(const LAS bf16x8*)(lds + PG8_SA(b, h) + aoff + m * 2048 + k * 1024); } while (0)
#define PG8_LDB(dst, b, h) do { _Pragma("unroll") for (int n = 0; n < 2; ++n) _Pragma("unroll") for (int k = 0; k < 2; ++k) dst[n][k] = *(const LAS bf16x8*)(lds + PG8_SB(b, h) + boff + n * 2048 + k * 1024); } while (0)
#define PG8_MMA(ai, bj, At, Bt) do { __builtin_amdgcn_s_setprio(1); _Pragma("unroll") for (int m = 0; m < 4; ++m) _Pragma("unroll") for (int n = 0; n < 2; ++n) _Pragma("unroll") for (int k = 0; k < 2; ++k) \
        acc[ai][bj][m][n] = __builtin_amdgcn_mfma_f32_16x16x32_bf16(Bt[n][k], At[m][k], acc[ai][bj][m][n], 0, 0, 0); __builtin_amdgcn_s_setprio(0); } while (0)
#define PG8_WAIT_V(n) asm volatile("s_waitcnt vmcnt(" #n ")" ::: "memory")
#define PG8_WAIT_L(n) asm volatile("s_waitcnt lgkmcnt(" #n ")" ::: "memory")
#define PG8_BAR __builtin_amdgcn_s_barrier()
#define PG8_SCHED __builtin_amdgcn_sched_barrier(0)
    Unit cur, nxt; int ui = 0;
    if (!S.next(0, cur)) return;
    f32x4 acc[2][2][4][2];
#pragma unroll
    for (int a = 0; a < 2; ++a)
#pragma unroll
        for (int b = 0; b < 2; ++b)
#pragma unroll
            for (int m = 0; m < 4; ++m)
#pragma unroll
                for (int n = 0; n < 2; ++n) acc[a][b][m][n] = (f32x4){0.f, 0.f, 0.f, 0.f};
    bf16x8 At[4][2], B0[2][2], B1[2][2];
    const char* cA = (const char*)g.A + (size_t)cur.pm * tstepA + (size_t)cur.seg * g.segA; const char* cB = (const char*)g.Bt + (size_t)cur.pn * tstepB + (size_t)cur.seg * g.segB;
    PG8_STAGE(PG8_SB(0, 0), cB, voffB); PG8_STAGE(PG8_SB(0, 1), cB + hstepB, voffB); PG8_STAGE(PG8_SA(0, 0), cA, voffA); PG8_STAGE(PG8_SA(0, 1), cA + hstepA, voffA);
    if (wr == 1) PG8_BAR;
    PG8_WAIT_V(2); PG8_BAR;
    PG8_STAGE(PG8_SB(1, 0), cB + kstep, voffB); PG8_STAGE(PG8_SA(1, 0), cA + kstep, voffA); PG8_STAGE(PG8_SB(1, 1), cB + hstepB + kstep, voffB);
    PG8_WAIT_V(6); PG8_BAR;
    for (;;) {
        const bool has_next = S.next(ui + 1, nxt);
        const char* nA = has_next ? (const char*)g.A + (size_t)nxt.pm * tstepA + (size_t)nxt.seg * g.segA : cA; const char* nB = has_next ? (const char*)g.Bt + (size_t)nxt.pn * tstepB + (size_t)nxt.seg * g.segB : cB;
        for (int t = 0; t < nt; t += 2) {
            const bool last = (t == nt - 2);
            const char* a1 = cA + (size_t)(t + 1) * kstep;
            const char* a2 = last ? nA : cA + (size_t)(t + 2) * kstep; const char* b2 = last ? nB : cB + (size_t)(t + 2) * kstep;
            const char* a3 = a2 + kstep; const char* b3 = b2 + kstep;
            PG8_LDB(B0, 0, 0); PG8_LDB(B1, 0, 1); PG8_SCHED; PG8_LDA(At, 0, 0); PG8_STAGE(PG8_SA(1, 1), a1 + hstepA, voffA);
            PG8_WAIT_V(8); PG8_WAIT_L(0); PG8_BAR; PG8_MMA(0, 0, At, B0); PG8_MMA(0, 1, At, B1); PG8_BAR; PG8_SCHED;
            PG8_LDA(At, 0, 1); PG8_STAGE(PG8_SB(0, 0), b2, voffB); PG8_STAGE(PG8_SB(0, 1), b2 + hstepB, voffB); PG8_STAGE(PG8_SA(0, 0), a2, voffA);
            PG8_WAIT_V(8); PG8_WAIT_L(0); PG8_BAR; PG8_MMA(1, 0, At, B0); PG8_MMA(1, 1, At, B1); PG8_BAR; PG8_SCHED;
            PG8_LDB(B0, 1, 0); PG8_LDB(B1, 1, 1); PG8_SCHED; PG8_LDA(At, 1, 0); PG8_STAGE(PG8_SA(0, 1), a2 + hstepA, voffA);
            PG8_WAIT_V(8); PG8_WAIT_L(0); PG8_BAR; PG8_MMA(0, 0, At, B0); PG8_MMA(0, 1, At, B1); PG8_BAR; PG8_SCHED;
            PG8_LDA(At, 1, 1); PG8_STAGE(PG8_SB(1, 0), b3, voffB); PG8_STAGE(PG8_SB(1, 1), b3 + hstepB, voffB); PG8_STAGE(PG8_SA(1, 0), a3, voffA);
            PG8_WAIT_V(8); PG8_WAIT_L(0); PG8_BAR; PG8_MMA(1, 0, At, B0); PG8_MMA(1, 1, At, B1); PG8_BAR; PG8_SCHED;
        }
        if (wr == 0) PG8_BAR;
        E(acc, cur, wr, wc, fr, fq);
        if (!has_next) break;
        if (epi_done(E, cur)) {
#pragma unroll
        for (int a = 0; a < 2; ++a)
#pragma unroll
            for (int b = 0; b < 2; ++b)
#pragma unroll
                for (int m = 0; m < 4; ++m)
#pragma unroll
                    for (int n = 0; n < 2; ++n) acc[a][b][m][n] = (f32x4){0.f, 0.f, 0.f, 0.f};
        }
        cur = nxt; cA = nA; cB = nB; ++ui;
        if (wr == 1) PG8_BAR;
    }
    PG8_WAIT_V(0);
    PG8_BAR;
#undef PG8_SA
#undef PG8_SB
#undef PG8_STAGE
#undef PG8_LDA
#undef PG8_LDB
#undef PG8_MMA
#undef PG8_WAIT_V
#undef PG8_WAIT_L
#undef PG8_BAR
#undef PG8_SCHED
}

template <class F> __device__ __forceinline__ void epi_each(const f32x4 (&acc)[2][2][4][2], const Unit& u, int wr, int wc, int fr, int fq, F&& f) {
    const int row0 = u.pm * BM + wr * 64 + fr, col0 = u.pn * BM + wc * 32 + 8 * fq;
#pragma unroll
    for (int ai = 0; ai < 2; ++ai)
#pragma unroll
        for (int m = 0; m < 4; ++m)
#pragma unroll
            for (int bj = 0; bj < 2; ++bj) f(row0 + ai * HALF + m * 16, col0 + bj * HALF, acc[ai][bj][m][0], acc[ai][bj][m][1]);
}
__device__ __forceinline__ void st_bf16x8(bf16_t* p, f32x4 v0, f32x4 v1) {
    u32x4 w; w.x = cvtpk(v0[0], v0[1]); w.y = cvtpk(v0[2], v0[3]); w.z = cvtpk(v1[0], v1[1]); w.w = cvtpk(v1[2], v1[3]); *(u32x4*)p = w;
}
}
#include <hip/hip_runtime.h>
#include <cstdio>
#include <cstdint>
#include <cstdlib>
#include <vector>

#define XB_TMO      128
#define XB_XCNT(j)  (256  + 64 * (j))
#define XB_XSUB(j)  (1280 + 64 * (j))
#define XB_XGEN(j)  (2304 + 64 * (j))
#define XB_TOP      3328
#define XB_TOPGEN   3392
#define XCD_BAR_WORDS 3456
#define XB_SPIN_CAP (1u << 18)

__device__ __forceinline__ unsigned xb_ld(unsigned* p)              { return __hip_atomic_load(p, __ATOMIC_RELAXED, __HIP_MEMORY_SCOPE_AGENT); }
__device__ __forceinline__ unsigned xb_add(unsigned* p, unsigned v) { return __hip_atomic_fetch_add(p, v, __ATOMIC_RELAXED, __HIP_MEMORY_SCOPE_AGENT); }
__device__ __forceinline__ unsigned xb_xcc_id() { return (unsigned)__builtin_amdgcn_s_getreg((3 << 11) | 20) & 0xFu; }
#define XB_SPIN(cond, bar) do { unsigned _sp = 0; while (cond) { __builtin_amdgcn_s_sleep(1); \
    if ((++_sp & 255u) == 0u) { if (xb_ld(&(bar)[XB_TMO])) break; if (_sp > XB_SPIN_CAP) { atomicAdd(&(bar)[XB_TMO], 1u); break; } } } } while (0)

struct XcdBarrier {
    unsigned* bar; unsigned x;
    volatile LAS unsigned* st;
};

__device__ __forceinline__ XcdBarrier xcd_barrier_post(unsigned* bar, volatile LAS unsigned* st) {
    XcdBarrier b; b.bar = bar; b.x = xb_xcc_id(); b.st = st;
    if (threadIdx.x == 0) (void)xb_add(&bar[XB_XCNT(b.x)], 1u);
    return b;
}
__device__ __forceinline__ void xcd_barrier_complete(unsigned* bar, unsigned x, unsigned& nloc, unsigned& nx) {
    const unsigned G = gridDim.x * gridDim.y * gridDim.z;
    unsigned sum, cnt, mine, sp = 0u;
    for (;;) {
        sum = 0u; cnt = 0u; mine = 0u;
#pragma unroll
        for (unsigned j = 0; j < 16; ++j) { const unsigned c = xb_ld(&bar[XB_XCNT(j)]); sum += c; cnt += (c > 0u) ? 1u : 0u; mine = (j == x) ? c : mine; }
        if (sum == G) break;
        __builtin_amdgcn_s_sleep(1);
        if ((++sp & 255u) == 0u) { if (xb_ld(&bar[XB_TMO])) break; if (sp > XB_SPIN_CAP) { atomicAdd(&bar[XB_TMO], 1u); break; } }
    }
    nloc = mine > 0u ? mine : 1u; nx = cnt > 0u ? cnt : 1u;
}

__device__ __forceinline__ void xcd_barrier(const XcdBarrier& b) {
    asm volatile("s_waitcnt vmcnt(0)" ::: "memory");
    __syncthreads();
    if (threadIdx.x == 0) {
        unsigned* bar = b.bar;
        __builtin_amdgcn_s_waitcnt(0);
        unsigned nloc = b.st[0], nx = b.st[1];
        if (nloc == 0u) { xcd_barrier_complete(bar, b.x, nloc, nx); b.st[0] = nloc; b.st[1] = nx; }
        const unsigned old = xb_add(&bar[XB_XSUB(b.x)], 1u);
        const unsigned gen = old / nloc;
        if (old + 1u == (gen + 1u) * nloc) {
            __builtin_amdgcn_fence(__ATOMIC_RELEASE, "agent");
            asm volatile("s_waitcnt vmcnt(0)" ::: "memory");
            const unsigned og = xb_add(&bar[XB_TOP], 1u);
            const unsigned tg = og / nx;
            if (og + 1u == (tg + 1u) * nx) xb_add(&bar[XB_TOPGEN], 1u);
            else XB_SPIN(xb_ld(&bar[XB_TOPGEN]) == tg, bar);
            __builtin_amdgcn_fence(__ATOMIC_ACQUIRE, "agent");
            xb_add(&bar[XB_XGEN(b.x)], 1u);
            asm volatile("s_waitcnt vmcnt(0)" ::: "memory");
        } else {
            XB_SPIN(xb_ld(&bar[XB_XGEN(b.x)]) == gen, bar);
            __builtin_amdgcn_fence(__ATOMIC_ACQUIRE, "agent");
            asm volatile("s_waitcnt vmcnt(0)" ::: "memory");
        }
    }
    __syncthreads();
}


constexpr int LDS_BYTES = 147456;
constexpr int LDS_MISC_OFF = 146432;
struct Args { const float* in[40]; float* out; unsigned char* ws; int ph_lo, ph_hi; };
enum { I_X = 0, I_C, I_CTX, I_CCTX, I_MODW, I_MODB, I_N1G, I_N2G, I_WIN, I_CQG, I_WUQ, I_CKVG, I_WUKV, I_QNG, I_KNG, I_MLAWO,
       I_NAQG, I_NAKG, I_RPB, I_NAWO, I_MU, I_W0, I_W2, I_A0, I_A2, I_G2, I_KK, I_KA, I_RK, I_LNG, I_LNB, I_RWWO, I_WOUT,
       I_F1, I_F3, I_F2, I_ROUTER, I_M1, I_M3, I_M2 };

struct Frame {
    LAS unsigned char* lds;
    unsigned char* ws;
    int tid, lane, wave, G, vcu, bid;
};

__device__ __forceinline__ Frame launder(const Frame& F) {
    Frame P = F; int w = F.wave, v = F.vcu, b = F.bid; unsigned long long wi = (unsigned long long)F.ws;
    asm volatile("" : "+s"(w), "+s"(v), "+s"(b), "+s"(wi));
    int ln = (int)__builtin_amdgcn_mbcnt_hi(~0u, __builtin_amdgcn_mbcnt_lo(~0u, 0u));
    asm volatile("" : "+v"(ln));
    P.tid = w * 64 + ln; P.lane = ln; P.wave = w; P.vcu = v; P.bid = b;
    P.ws = (unsigned char*)(GAS unsigned char*)wi;
    return P;
}
__device__ __forceinline__ void tr_item(const float* src, int lds_, int scol0, bf16_t* dst, int ldd, int drow0, int koff, int nblk, int ileave, int item, LAS float* scr, int lane) {
    const int kb = item / nblk, nb = item - kb * nblk, k0 = 64 * kb, n0 = 32 * nb;
    {
        f32x4 v[8]; const int c4 = (lane & 7) * 4, r8 = lane >> 3;
        const float* sp = src + (size_t)(k0 + r8) * lds_ + scol0 + n0 + c4;
#pragma unroll
        for (int i = 0; i < 8; ++i) v[i] = *(const f32x4*)(sp + (size_t)(8 * i) * lds_);
#pragma unroll
        for (int i = 0; i < 8; ++i) { LAS float* d = scr + (8 * i + r8) * 33 + c4; d[0] = v[i][0]; d[1] = v[i][1]; d[2] = v[i][2]; d[3] = v[i][3]; }
    }
    LDS_WAIT(); asm volatile("" ::: "memory");
    const int c = lane & 7;
#pragma unroll
    for (int j = 0; j < 4; ++j) { const int n = (lane >> 3) + 8 * j; const LAS float* s = scr + (8 * c) * 33 + n;
        u32x4 o; o.x = cvtpk(s[0 * 33], s[1 * 33]); o.y = cvtpk(s[2 * 33], s[3 * 33]); o.z = cvtpk(s[4 * 33], s[5 * 33]); o.w = cvtpk(s[6 * 33], s[7 * 33]);
        const int nn = n0 + n; const int drow = ileave ? drow0 + (nn >> 7) * 256 + (nn & 127) : drow0 + nn;
        *(u32x4*)(dst + (size_t)drow * ldd + koff + k0 + 8 * c) = o; }
    LDS_WAIT(); asm volatile("" ::: "memory");
}
__device__ __forceinline__ void zero_item(bf16_t* dst, int ldd, int drow0, int koff, int nblk, int item, int lane) {
    const int kb = item / nblk, nb = item - kb * nblk, k0 = 64 * kb, n0 = 32 * nb, c = lane & 7;
#pragma unroll
    for (int j = 0; j < 4; ++j) { const int n = (lane >> 3) + 8 * j; *(u32x4*)(dst + (size_t)(drow0 + n0 + n) * ldd + koff + k0 + 8 * c) = (u32x4){0u, 0u, 0u, 0u}; }
}

#define TRJOB(NITEMS, CALL) { const int _n = (NITEMS); if (r < _n) { CALL; continue; } r -= _n; }
__device__ __forceinline__ void prologue_weights(const Frame& F, const Args& a) {
    LAS float* scr = (LAS float*)(F.lds + F.wave * 16384);
    const int gw = F.vcu * NWAVES + F.wave, NGW = F.G * NWAVES;
    constexpr int PER_LAYER = 16 * 21 + 16 * 3   + 16 * 108   + 16 * 4   + 16 * 96
                              + 6 * 24   + 4 * 32   + 6 * 80   + 3 * 8 * 32   + 16 * 32  ;
    constexpr int FFN_ITEMS = 2 * 16 * 88 + 44 * 32;
    constexpr int NITEMS = 2 * PER_LAYER + FFN_ITEMS;
    for (int it0 = gw; it0 < NITEMS * PROBE_CVT; it0 += NGW) { const int it = it0 % NITEMS;
        int r = it;
        bool done = false;
        for (int l = 0; l < 2 && !done; ++l) {
            if (r >= PER_LAYER) { r -= PER_LAYER; continue; }
            done = true;
            unsigned char* wb = F.ws + WS_W + (size_t)l * WB_SIZE;
            bf16_t* WinM = (bf16_t*)(wb + WB_WINM); bf16_t* WinG = (bf16_t*)(wb + WB_WING);
            const float* win = a.in[I_WIN] + (size_t)l * DM * 7200;
            do {
                if (r < 16 * 21) { tr_item(win, 7200, 0, WinM, DM, 0, 0, 21, 0, r, scr, F.lane); break; } r -= 16 * 21;
                if (r < 16 * 3) { zero_item(WinM, DM, 672, 0, 3, r, F.lane); break; } r -= 16 * 3;
                if (r < 16 * 108) { tr_item(win, 7200, 672, WinM, DM, 768, 0, 108, 0, r, scr, F.lane); break; } r -= 16 * 108;
                if (r < 16 * 4) { zero_item(WinM, DM, 4224, 0, 4, r, F.lane); break; } r -= 16 * 4;
                if (r < 16 * 96) { tr_item(win, 7200, 4128, WinG, DM, 0, 0, 96, 0, r, scr, F.lane); break; } r -= 16 * 96;
                if (r < 6 * 24) { tr_item(a.in[I_WUQ] + (size_t)l * 384 * 768, 768, 0, (bf16_t*)(wb + WB_WUQ), 384, 0, 0, 24, 0, r, scr, F.lane); break; } r -= 6 * 24;
                if (r < 4 * 32) { tr_item(a.in[I_WUKV] + (size_t)l * 256 * 1024, 1024, 0, (bf16_t*)(wb + WB_WUKV), 256, 0, 0, 32, 0, r, scr, F.lane); break; } r -= 4 * 32;
                if (r < 6 * 80) {
                    bf16_t* Wl = (bf16_t*)(wb + WB_WLORA);
                    const int kb = r / 80, nb = r % 80, s = nb / 16;
                    const int koff = s < 4 ? 64 * s : 256, Ks = s < 4 ? 64 : 128;
                    const int k0 = 64 * kb;
                    if (k0 >= koff && k0 < koff + Ks) {
                        const float* src = s < 2 ? a.in[I_W2] + ((size_t)l * 2 + s) * 64 * 512 : s < 4 ? a.in[I_A2] + ((size_t)l * 2 + (s - 2)) * 64 * 512 : a.in[I_G2] + (size_t)l * 128 * 512;
                        const int sub = ((k0 - koff) / 64) * 16 + (nb % 16);
                        tr_item(src, 512, 0, Wl, 384, 512 * s, koff, 16, 0, sub, scr, F.lane);
                    } else zero_item(Wl, 384, 0, 0, 80, r, F.lane);
                    break; } r -= 6 * 80;
                if (r < 3 * 8 * 32) { const int b = r / 256, rr = r % 256;
                    const float* src = (b == 0 ? a.in[I_MLAWO] : b == 1 ? a.in[I_NAWO] : a.in[I_RWWO]) + (size_t)l * 512 * 1024;
                    tr_item(src, 1024, 0, (bf16_t*)(wb + (b == 0 ? WB_WOA : b == 1 ? WB_WOB : WB_WOR)), 512, 0, 0, 32, 0, rr, scr, F.lane); break; } r -= 3 * 8 * 32;
                tr_item(a.in[I_WOUT] + (size_t)l * 1024 * 1024, 1024, 0, (bf16_t*)(wb + WB_WOUT), 1024, 0, 0, 32, 0, r, scr, F.lane);
            } while (0);
        }
        if (done) continue;
        if (r < 16 * 88) { tr_item(a.in[I_F1], FF, 0, (bf16_t*)(F.ws + WS_W13), DM, 0, 0, 88, 1, r, scr, F.lane); continue; } r -= 16 * 88;
        if (r < 16 * 88) { tr_item(a.in[I_F3], FF, 0, (bf16_t*)(F.ws + WS_W13), DM, 128, 0, 88, 1, r, scr, F.lane); continue; } r -= 16 * 88;
        tr_item(a.in[I_F2], DM, 0, (bf16_t*)(F.ws + WS_W2), FF, 0, 0, 32, 0, r, scr, F.lane);
    }
}
__device__ __forceinline__ void moe_weights(const Frame& F, const Args& a, int part) {
    LAS float* scr = (LAS float*)(F.lds + F.wave * 16384);
    const int gw = F.vcu * NWAVES + F.wave, NGW = F.G * NWAVES;
    constexpr int I13 = 16 * 112, I2 = 56 * 32;
    if (part == 0) {
        constexpr int NIT = NEXP * 2 * I13 + 4 * I2;
        for (int it0 = gw; it0 < NIT * PROBE_CVT; it0 += NGW) { const int it = it0 % NIT;
            if (it < NEXP * 2 * I13) { const int e = it / (2 * I13); int r = it - e * 2 * I13;
                bf16_t* w13 = (bf16_t*)(F.ws + WS_W13E) + (size_t)e * 2 * FFE * DM;
                if (r < I13) tr_item(a.in[I_M1] + (size_t)e * DM * FFE, FFE, 0, w13, DM, 0, 0, 112, 1, r, scr, F.lane);
                else tr_item(a.in[I_M3] + (size_t)e * DM * FFE, FFE, 0, w13, DM, 128, 0, 112, 1, r - I13, scr, F.lane);
            } else { const int q = it - NEXP * 2 * I13, e = 4 + q / I2, r = q % I2;
                tr_item(a.in[I_M2] + (size_t)e * FFE * DM, DM, 0, (bf16_t*)(F.ws + WS_W2E_HI) + (size_t)(e - 4) * DM * FFE, FFE, 0, 0, 32, 0, r, scr, F.lane); }
        }
    } else {
        for (int it = gw; it < 4 * I2; it += NGW) { const int e = it / I2, r = it % I2;
            tr_item(a.in[I_M2] + (size_t)e * FFE * DM, DM, 0, (bf16_t*)(F.ws + WS_W2E_LO) + (size_t)e * DM * FFE, FFE, 0, 0, 32, 0, r, scr, F.lane); }
    }
}

__device__ __forceinline__ void prologue_mod(const Frame& F, const Args& a) {
    LAS float* sl = (LAS float*)(F.lds);
    LAS float* part = sl + 2048;
    if (F.bid >= 192) return;
    const int l = F.bid / 96, nb = F.bid % 96;
    for (int i = F.tid; i < 2048; i += NTHR) { const float v = i < 1024 ? a.in[I_C][i] : a.in[I_CCTX][i - 1024]; sl[i] = siluf_(v); }
    __syncthreads();
    const int col = F.tid & 63, kg = F.tid >> 6, n = nb * 64 + col;
    const float* W = a.in[I_MODW] + (size_t)l * DM * 6144 + n;
    float aL = 0.f, aC = 0.f;
#pragma unroll 32
    for (int k = kg * 128; k < kg * 128 + 128; ++k) { const float w = W[(size_t)k * 6144]; aL += sl[k] * w; aC += sl[1024 + k] * w; }
    part[(kg * 64 + col) * 2] = aL; part[(kg * 64 + col) * 2 + 1] = aC;
    __syncthreads();
    if (F.tid < 128) { const int c2 = F.tid & 63, which = F.tid >> 6; float s = 0.f;
#pragma unroll
        for (int k = 0; k < 8; ++k) s += part[(k * 64 + c2) * 2 + which];
        const int nn = nb * 64 + c2;
        ((float*)(F.ws + WS_MODV))[(size_t)(l * 2 + which) * 6144 + nn] = s + a.in[I_MODB][(size_t)l * 6144 + nn]; }
    __syncthreads();
}

__device__ __forceinline__ void norm_rows(const Frame& F, const float* src, int src_row0, int m0, int m1, const float* g, const float* sh, const float* sc, bf16_t* dst) {
    f32x4 ca[4], cb[4];
#pragma unroll
    for (int j = 0; j < 4; ++j) { const int d = F.lane * 4 + 256 * j; const f32x4 gg = *(const f32x4*)(g + d), s1 = *(const f32x4*)(sc + d); ca[j] = gg * (s1 + 1.0f); cb[j] = *(const f32x4*)(sh + d); }
    const int gw = F.vcu * NWAVES + F.wave, NGW = F.G * NWAVES;
    for (int mm = gw; mm < (m1 - m0) * PROBE_ROW; mm += NGW) { const int m = m0 + mm % (m1 - m0);
        const f32x4* xr = (const f32x4*)(src + (size_t)(m - src_row0) * DM) + F.lane;
        f32x4 v[4]; float s = 0.f;
#pragma unroll
        for (int j = 0; j < 4; ++j) { v[j] = xr[64 * j]; s += (v[j].x * v[j].x + v[j].y * v[j].y) + (v[j].z * v[j].z + v[j].w * v[j].w); }
        const float rstd = rsqrtf(wave_sum(s) * (1.f / DM) + NORM_EPS);
        u32x2* o8 = (u32x2*)(dst + (size_t)m * DM) + F.lane;
#pragma unroll
        for (int j = 0; j < 4; ++j) { const f32x4 y = v[j] * rstd * ca[j] + cb[j]; u32x2 w; w.x = cvtpk(y.x, y.y); w.y = cvtpk(y.z, y.w); o8[64 * j] = w; }
    }
}

using pg8::Unit;
struct EpiZ {
    bf16_t *za, *zn, *zr;
    __device__ __forceinline__ void operator()(const f32x4 (&acc)[2][2][4][2], const Unit& u, int wr, int wc, int fr, int fq) const {
        bf16_t* base; int ld, ct;
        if (u.pn < 3) { base = za; ld = ZA_LD; ct = u.pn; } else if (u.pn < 9) { base = zn; ld = ZN_LD; ct = u.pn - 3; } else { base = zr; ld = ZR_LD; ct = u.pn - 9; }
        const int cshift = (ct - u.pn) * 256;
        pg8::epi_each(acc, u, wr, wc, fr, fq, [&](int row, int col, f32x4 v0, f32x4 v1) { pg8::st_bf16x8(base + (size_t)row * ld + col + cshift, v0, v1); });
    }
};
struct EpiBf {
    bf16_t* o; int ld;
    __device__ __forceinline__ void operator()(const f32x4 (&acc)[2][2][4][2], const Unit& u, int wr, int wc, int fr, int fq) const {
        pg8::epi_each(acc, u, wr, wc, fr, fq, [&](int row, int col, f32x4 v0, f32x4 v1) { pg8::st_bf16x8(o + (size_t)row * ld + col, v0, v1); });
    }
};
__device__ __forceinline__ f32x4 lora_fn(f32x4 v, const float* bias, int seg) {
    if (seg < 4) { const f32x4 b = *(const f32x4*)bias;
#pragma unroll
        for (int e = 0; e < 4; ++e) { const float x = b[e] + v[e];
            if (seg < 2) { const float y = -x; const float sp = fmaxf(y, 0.f) + __logf(1.f + __expf(-fabsf(y))); v[e] = -__expf(-sp - 0.5f); }
            else v[e] = sigmoidf_(x); } }
    return v;
}
struct EpiLora {
    bf16_t* o; const float* w0; const float* a0;
    __device__ __forceinline__ void operator()(const f32x4 (&acc)[2][2][4][2], const Unit& u, int wr, int wc, int fr, int fq) const {
        const int seg = u.pn >> 1;
        const float* bias = seg < 2 ? w0 : a0 - 1024;
        pg8::epi_each(acc, u, wr, wc, fr, fq, [&](int row, int col, f32x4 v0, f32x4 v1) {
            const f32x4 r0 = lora_fn(v0, bias + col, seg), r1 = lora_fn(v1, bias + col + 4, seg);
            pg8::st_bf16x8(o + (size_t)row * LO_LD + col, r0, r1);
        });
    }
};
struct EpiSig {
    bf16_t* o; int ld;
    __device__ __forceinline__ void operator()(const f32x4 (&acc)[2][2][4][2], const Unit& u, int wr, int wc, int fr, int fq) const {
        pg8::epi_each(acc, u, wr, wc, fr, fq, [&](int row, int col, f32x4 v0, f32x4 v1) {
            f32x4 r0, r1;
#pragma unroll
            for (int e = 0; e < 4; ++e) { r0[e] = fmaxf(sigmoidf_(v0[e]), 1e-13f); r1[e] = fmaxf(sigmoidf_(v1[e]), 1e-13f); }
            pg8::st_bf16x8(o + (size_t)row * ld + col, r0, r1); });
    }
};
struct EpiMerge3 {
    bf16_t* ub; const bf16_t* zg;
    __device__ __forceinline__ void operator()(f32x4 (&acc)[2][2][4][2], const Unit& u, int wr, int wc, int fr, int fq) const {
        const int row0 = u.pm * 256 + wr * 64 + fr, col0 = u.pn * 256 + wc * 32 + 8 * fq;
        if (u.seg < 2) {
            const bf16_t* z = zg + u.seg * 1024 + (size_t)row0 * ZG_LD + col0;
#pragma unroll
            for (int ai = 0; ai < 2; ++ai)
#pragma unroll
                for (int m = 0; m < 4; ++m)
#pragma unroll
                    for (int bj = 0; bj < 2; ++bj) {
                        const bf16_t* p = z + (size_t)(ai * 128 + m * 16) * ZG_LD + bj * 128;
                        const u32x4 ga = *(const u32x4*)p, gb = *(const u32x4*)(p + 1024);
                        const float a_[8] = {lo_bf(ga.x), hi_bf(ga.x), lo_bf(ga.y), hi_bf(ga.y), lo_bf(ga.z), hi_bf(ga.z), lo_bf(ga.w), hi_bf(ga.w)};
                        const float b_[8] = {lo_bf(gb.x), hi_bf(gb.x), lo_bf(gb.y), hi_bf(gb.y), lo_bf(gb.z), hi_bf(gb.z), lo_bf(gb.w), hi_bf(gb.w)};
#pragma unroll
                        for (int e = 0; e < 4; ++e) { acc[ai][bj][m][0][e] *= a_[e] * __builtin_amdgcn_rcpf(b_[e]); acc[ai][bj][m][1][e] *= a_[4 + e] * __builtin_amdgcn_rcpf(b_[4 + e]); }
                    }
        } else {
            const bf16_t* z = zg + 2048;
            pg8::epi_each(acc, u, wr, wc, fr, fq, [&](int row, int col, f32x4 v0, f32x4 v1) {
                const u32x4 gw = *(const u32x4*)(z + (size_t)row * ZG_LD + col);
                const f32x4 g0 = {lo_bf(gw.x), hi_bf(gw.x), lo_bf(gw.y), hi_bf(gw.y)}, g1 = {lo_bf(gw.z), hi_bf(gw.z), lo_bf(gw.w), hi_bf(gw.w)};
                pg8::st_bf16x8(ub + (size_t)row * DM + col, g0 * v0, g1 * v1); });
        }
    }
};
__device__ __forceinline__ bool epi_done(const EpiMerge3&, const Unit& u) { return u.seg == 2; }
struct EpiRes {
    const float* resL; const float* resC; float* outL; float* outC; const float* gateL; const float* gateC;
    __device__ __forceinline__ void operator()(const f32x4 (&acc)[2][2][4][2], const Unit& u, int wr, int wc, int fr, int fq) const {
        const bool isc = u.pm >= L / 256;
        const float* res = isc ? resC - (size_t)L * DM : resL; float* out = isc ? outC - (size_t)L * DM : outL; const float* gate = isc ? gateC : gateL;
        pg8::epi_each(acc, u, wr, wc, fr, fq, [&](int row, int col, f32x4 v0, f32x4 v1) {
            const size_t o = (size_t)row * DM + col;
            const f32x4 g0 = *(const f32x4*)(gate + col), g1 = *(const f32x4*)(gate + col + 4);
            *(f32x4*)(out + o) = *(const f32x4*)(res + o) + g0 * v0; *(f32x4*)(out + o + 4) = *(const f32x4*)(res + o + 4) + g1 * v1;
        });
    }
};
struct EpiSwiglu {
    bf16_t* o; int ld; int row_sub; int ct_mod;
    __device__ __forceinline__ void operator()(const f32x4 (&acc)[2][2][4][2], const Unit& u, int wr, int wc, int fr, int fq) const {
        const int row0 = u.pm * 256 + wr * 64 + fr - row_sub, col0 = (u.pn % ct_mod) * 128 + wc * 32 + 8 * fq;
#pragma unroll
        for (int ai = 0; ai < 2; ++ai)
#pragma unroll
            for (int m = 0; m < 4; ++m) {
                f32x4 r0, r1;
#pragma unroll
                for (int e = 0; e < 4; ++e) { r0[e] = siluf_(acc[ai][0][m][0][e]) * acc[ai][1][m][0][e]; r1[e] = siluf_(acc[ai][0][m][1][e]) * acc[ai][1][m][1][e]; }
                pg8::st_bf16x8(o + (size_t)(row0 + ai * 128 + m * 16) * ld + col0, r0, r1);
            }
    }
};
struct EpiMoe2 {
    bf16_t* ys; const float* rowgate;
    __device__ __forceinline__ void operator()(const f32x4 (&acc)[2][2][4][2], const Unit& u, int wr, int wc, int fr, int fq) const {
        const int cshift = ((u.pn & 3) - u.pn) * 256;
        pg8::epi_each(acc, u, wr, wc, fr, fq, [&](int row, int col, f32x4 v0, f32x4 v1) {
            const float g = rowgate[row];
            pg8::st_bf16x8(ys + (size_t)row * DM + col + cshift, v0 * g, v1 * g);
        });
    }
};
struct MoeOrder {
    int t0, t1, t2, t3, t4, t5, t6, t7, t8, nct, hi_shift, G, c, rep;
    __device__ bool next(int i, Unit& u) const {
        int idx = i * G + c; const int tot = (t8 - t0) * nct; if (idx >= tot * rep) return false; idx %= tot;
#define MOE_E(e, ta, tb_, sh) { const int w = (tb_) - (ta), n = w * nct; if (idx < n) { u.pm = (ta) + idx % w; u.pn = (e) * nct + idx / w + (sh); u.seg = 0; return true; } idx -= n; }
        MOE_E(0, t0, t1, 0) MOE_E(1, t1, t2, 0) MOE_E(2, t2, t3, 0) MOE_E(3, t3, t4, 0)
        MOE_E(4, t4, t5, hi_shift) MOE_E(5, t5, t6, hi_shift) MOE_E(6, t6, t7, hi_shift) MOE_E(7, t7, t8, hi_shift)
#undef MOE_E
        return false;
    }
};

struct PrepIn { unsigned za[3]; u32x2 zk; unsigned kr; u32x4 nq, nk; u32x4 zc[3], zp[3], zn[3]; unsigned tc[3], tp[3], tn[3]; };
__device__ __forceinline__ void prep_row_load(const Frame& F, int m, PrepIn& I) {
    const bf16_t* ZA = (const bf16_t*)(F.ws + WS_ZA); const bf16_t* ZN = (const bf16_t*)(F.ws + WS_ZN); const bf16_t* ZR = (const bf16_t*)(F.ws + WS_ZR);
    const int lane = F.lane;
    { const unsigned* p = (const unsigned*)(ZA + (size_t)m * ZA_LD) + lane * 3; I.za[0] = p[0]; I.za[1] = p[1]; I.za[2] = p[2]; }
    I.zk = *((const u32x2*)(ZA + (size_t)m * ZA_LD + 384) + lane);
    I.kr = ((const unsigned*)(ZA + (size_t)m * ZA_LD + 640))[lane & 15];
    I.nq = *((const u32x4*)(ZN + (size_t)m * ZN_LD) + lane); I.nk = *((const u32x4*)(ZN + (size_t)m * ZN_LD + 512) + lane);
    const bool hasp = (m != 0) && (m != L), hasn = (m != L - 1) && (m != R - 1);
    const bf16_t* zc = ZR + (size_t)m * ZR_LD; const bf16_t* zp = zc - ZR_LD; const bf16_t* zn = zc + ZR_LD;
#pragma unroll
    for (int ch = 0; ch < 3; ++ch) { const int c0 = ch * 512 + lane * 8;
        I.zc[ch] = *(const u32x4*)(zc + c0); I.zp[ch] = (u32x4){0u, 0u, 0u, 0u}; I.zn[ch] = (u32x4){0u, 0u, 0u, 0u};
        if (hasp) I.zp[ch] = *(const u32x4*)(zp + c0); if (hasn) I.zn[ch] = *(const u32x4*)(zn + c0);
        const int c1 = 1536 + ch * 128 + lane * 2;
        I.tc[ch] = *(const unsigned*)(zc + c1); I.tp[ch] = 0u; I.tn[ch] = 0u;
        if (hasp) I.tp[ch] = *(const unsigned*)(zp + c1); if (hasn) I.tn[ch] = *(const unsigned*)(zn + c1); }
}
__device__ __forceinline__ void prep_row_compute(const Frame& F, int m, const PrepIn& I, const float (&cqg)[6], const float (&ckvg)[4], const float (&qng)[8], const float (&kng)[8], const float (&kkv)[8], const float* mu0, const float* mu1) {
    bf16_t* ZN = (bf16_t*)(F.ws + WS_ZN);
    bf16_t* CQN = (bf16_t*)(F.ws + WS_CQN); bf16_t* CKVN = (bf16_t*)(F.ws + WS_CKVN); bf16_t* LA = (bf16_t*)(F.ws + WS_LA); bf16_t* KR = (bf16_t*)(F.ws + WS_KR);
    bf16_t* RKV = (bf16_t*)(F.ws + WS_RKV);
    const int lane = F.lane;
    { float v[6] = {lo_bf(I.za[0]), hi_bf(I.za[0]), lo_bf(I.za[1]), hi_bf(I.za[1]), lo_bf(I.za[2]), hi_bf(I.za[2])}; float s = 0.f;
#pragma unroll
      for (int e = 0; e < 6; ++e) s += v[e] * v[e];
      const float rstd = rsqrtf(wave_sum(s) * (1.f / 384.f) + NORM_EPS);
      unsigned* o = (unsigned*)(CQN + (size_t)m * 384) + lane * 3;
      o[0] = cvtpk(v[0] * rstd * cqg[0], v[1] * rstd * cqg[1]); o[1] = cvtpk(v[2] * rstd * cqg[2], v[3] * rstd * cqg[3]); o[2] = cvtpk(v[4] * rstd * cqg[4], v[5] * rstd * cqg[5]); }
    { float v[4] = {lo_bf(I.zk.x), hi_bf(I.zk.x), lo_bf(I.zk.y), hi_bf(I.zk.y)}; float s = v[0] * v[0] + v[1] * v[1] + v[2] * v[2] + v[3] * v[3];
      const float rstd = rsqrtf(wave_sum(s) * (1.f / 256.f) + NORM_EPS);
      u32x2 o; o.x = cvtpk(v[0] * rstd * ckvg[0], v[1] * rstd * ckvg[1]); o.y = cvtpk(v[2] * rstd * ckvg[2], v[3] * rstd * ckvg[3]);
      *((u32x2*)(CKVN + (size_t)m * 256) + lane) = o; }
    if (lane < 16) ((unsigned*)(KR + (size_t)m * 32))[lane] = I.kr;
#pragma unroll
    for (int qk = 0; qk < 2; ++qk) {
        const u32x4 w = qk == 0 ? I.nq : I.nk;
        float v[8] = {lo_bf(w.x), hi_bf(w.x), lo_bf(w.y), hi_bf(w.y), lo_bf(w.z), hi_bf(w.z), lo_bf(w.w), hi_bf(w.w)}; float s = 0.f;
#pragma unroll
        for (int e = 0; e < 8; ++e) s += v[e] * v[e];
        s += __shfl_xor(s, 1); s += __shfl_xor(s, 2); s += __shfl_xor(s, 4);
        const float rstd = rsqrtf(s * (1.f / 64.f) + NORM_EPS);
        u32x4 o;
        if (qk == 0) { o.x = cvtpk(v[0] * rstd * qng[0], v[1] * rstd * qng[1]); o.y = cvtpk(v[2] * rstd * qng[2], v[3] * rstd * qng[3]); o.z = cvtpk(v[4] * rstd * qng[4], v[5] * rstd * qng[5]); o.w = cvtpk(v[6] * rstd * qng[6], v[7] * rstd * qng[7]); }
        else { o.x = cvtpk(v[0] * rstd * kng[0], v[1] * rstd * kng[1]); o.y = cvtpk(v[2] * rstd * kng[2], v[3] * rstd * kng[3]); o.z = cvtpk(v[4] * rstd * kng[4], v[5] * rstd * kng[5]); o.w = cvtpk(v[6] * rstd * kng[6], v[7] * rstd * kng[7]); }
        *((u32x4*)(ZN + (size_t)m * ZN_LD + qk * 512) + lane) = o;
    }
#pragma unroll
    for (int ch = 0; ch < 3; ++ch) {
        const int c0 = ch * 512 + lane * 8;
        const u32x4 wc_ = I.zc[ch], wp = I.zp[ch], wn = I.zn[ch];
        const float zcv[8] = {lo_bf(wc_.x), hi_bf(wc_.x), lo_bf(wc_.y), hi_bf(wc_.y), lo_bf(wc_.z), hi_bf(wc_.z), lo_bf(wc_.w), hi_bf(wc_.w)};
        const float zpv[8] = {lo_bf(wp.x), hi_bf(wp.x), lo_bf(wp.y), hi_bf(wp.y), lo_bf(wp.z), hi_bf(wp.z), lo_bf(wp.w), hi_bf(wp.w)};
        const float znv[8] = {lo_bf(wn.x), hi_bf(wn.x), lo_bf(wn.y), hi_bf(wn.y), lo_bf(wn.z), hi_bf(wn.z), lo_bf(wn.w), hi_bf(wn.w)};
        float o[8];
        const f32x4 ma = *(const f32x4*)(mu0 + c0), mb = *(const f32x4*)(mu0 + c0 + 4), na = *(const f32x4*)(mu1 + c0), nb = *(const f32x4*)(mu1 + c0 + 4);
        const float m0v[8] = {ma[0], ma[1], ma[2], ma[3], mb[0], mb[1], mb[2], mb[3]}, m1v[8] = {na[0], na[1], na[2], na[3], nb[0], nb[1], nb[2], nb[3]};
#pragma unroll
        for (int e = 0; e < 8; ++e) o[e] = zcv[e] + m0v[e] * (zpv[e] - zcv[e]) + m1v[e] * (znv[e] - zcv[e]);
        u32x4 w; w.x = cvtpk(o[0], o[1]); w.y = cvtpk(o[2], o[3]); w.z = cvtpk(o[4], o[5]); w.w = cvtpk(o[6], o[7]);
        *(u32x4*)(RKV + (size_t)m * RKV_LD + c0) = w;
        if (ch == 1) {
            const float kr_[8] = {lo_bf(w.x), hi_bf(w.x), lo_bf(w.y), hi_bf(w.y), lo_bf(w.z), hi_bf(w.z), lo_bf(w.w), hi_bf(w.w)};
            float s2 = 0.f;
#pragma unroll
            for (int e = 0; e < 8; ++e) { const float kx = kr_[e] * kkv[e]; s2 += kx * kx; }
            s2 += __shfl_xor(s2, 1); s2 += __shfl_xor(s2, 2); s2 += __shfl_xor(s2, 4);
            if ((lane & 7) == 0) ((float*)(F.ws + WS_KN))[(size_t)m * 8 + (lane >> 3)] = 1.f / fmaxf(sqrtf(s2), 1e-12f);
        }
    }
#pragma unroll
    for (int ch = 0; ch < 3; ++ch) {
        const int c0 = 1536 + ch * 128 + lane * 2;
        float o0 = lo_bf(I.tc[ch]), o1 = hi_bf(I.tc[ch]);
        o0 = o0 + mu0[c0] * (lo_bf(I.tp[ch]) - o0) + mu1[c0] * (lo_bf(I.tn[ch]) - o0);
        o1 = o1 + mu0[c0 + 1] * (hi_bf(I.tp[ch]) - o1) + mu1[c0 + 1] * (hi_bf(I.tn[ch]) - o1);
        if (ch == 0) { o0 = tanhf(o0); o1 = tanhf(o1); } else if (ch == 2) { o0 = sigmoidf_(o0); o1 = sigmoidf_(o1); }
        *(unsigned*)(LA + (size_t)m * 384 + ch * 128 + lane * 2) = cvtpk(o0, o1);
    }
}
__device__ __forceinline__ void prepare_rows(const Frame& F, const Args& a, int l) {
    const int lane = F.lane;
    float cqg[6], ckvg[4], qng[8], kng[8];
#pragma unroll
    for (int e = 0; e < 6; ++e) cqg[e] = a.in[I_CQG][l * 384 + lane * 6 + e];
#pragma unroll
    for (int e = 0; e < 4; ++e) ckvg[e] = a.in[I_CKVG][l * 256 + lane * 4 + e];
#pragma unroll
    for (int e = 0; e < 8; ++e) { qng[e] = a.in[I_NAQG][l * 64 + (lane & 7) * 8 + e] * (0.125f * LOG2E); kng[e] = a.in[I_NAKG][l * 64 + (lane & 7) * 8 + e]; }
    const float* mu0 = a.in[I_MU] + (size_t)l * 2 * 1920; const float* mu1 = mu0 + 1920;
    float kkv[8];
#pragma unroll
    for (int e = 0; e < 8; ++e) kkv[e] = a.in[I_KK][l * 512 + lane * 8 + e];
    const int gw = F.vcu * NWAVES + F.wave, NGW = F.G * NWAVES;
    PrepIn cur, nxt;
    if (gw < R) prep_row_load(F, gw, cur);
    for (int m = gw; m < R; m += NGW) {
        if (m + NGW < R) prep_row_load(F, m + NGW, nxt);
        prep_row_compute(F, m, cur, cqg, ckvg, qng, kng, kkv, mu0, mu1);
        cur = nxt;
    }
}

__device__ __forceinline__ void mla_fixup(const Frame& F, const Args& a, int l, bool need_ctx_q) {
    const bf16_t* QRAW = (const bf16_t*)(F.ws + WS_QRAW); const bf16_t* KVRAW = (const bf16_t*)(F.ws + WS_KVRAW); const bf16_t* KR = (const bf16_t*)(F.ws + WS_KR);
    bf16_t* Q = (bf16_t*)(F.ws + WS_Q); bf16_t* K = (bf16_t*)(F.ws + WS_K); bf16_t* V = (bf16_t*)(F.ws + WS_V);
    const int lane = F.lane, h = lane >> 3, sub = lane & 7;
    float qg[12], kg[12];
#pragma unroll
    for (int i = 0; i < 12; ++i) { qg[i] = a.in[I_QNG][l * 96 + sub + 8 * i] * (0.10206207261596575f * LOG2E); kg[i] = a.in[I_KNG][l * 96 + sub + 8 * i]; }
    const float freq = __expf(-9.210340371976184f * (float)sub * 0.125f);
    const int gw = F.vcu * NWAVES + F.wave, NGW = F.G * NWAVES;
    for (int m0 = gw; m0 < R * PROBE_ROW; m0 += NGW) { const int m = m0 % R;
        const bool lat = m < L;
        float cr = 1.f, sr = 0.f, cc = 1.f, sc = 0.f;
        if (lat) { sincosf((float)(m >> 6) * freq, &sr, &cr); sincosf((float)(m & 63) * freq, &sc, &cc); }
        if (lat || need_ctx_q) {
            float v[12]; float s = 0.f;
#pragma unroll
            for (int i = 0; i < 12; ++i) { v[i] = bf2f(QRAW[(size_t)m * 768 + h * 96 + sub + 8 * i]); s += v[i] * v[i]; }
            s += __shfl_xor(s, 1); s += __shfl_xor(s, 2); s += __shfl_xor(s, 4);
            const float rstd = rsqrtf(s * (1.f / 96.f) + NORM_EPS);
#pragma unroll
            for (int i = 0; i < 12; ++i) v[i] *= rstd * qg[i];
            { const float t1 = v[8], t2 = v[9]; v[8] = t1 * cr - t2 * sr; v[9] = t1 * sr + t2 * cr; }
            { const float t1 = v[10], t2 = v[11]; v[10] = t1 * cc - t2 * sc; v[11] = t1 * sc + t2 * cc; }
            bf16_t* qo = Q + ((size_t)h * R + m) * 96 + sub;
#pragma unroll
            for (int i = 0; i < 12; ++i) qo[8 * i] = (bf16_t)(cvtpk(v[i], 0.f) & 0xffffu);
        }
        {
            float v[12]; float s = 0.f;
#pragma unroll
            for (int i = 0; i < 8; ++i) v[i] = bf2f(KVRAW[(size_t)m * 1024 + h * 128 + sub + 8 * i]);
#pragma unroll
            for (int i = 0; i < 4; ++i) v[8 + i] = bf2f(KR[(size_t)m * 32 + sub + 8 * i]);
#pragma unroll
            for (int i = 0; i < 12; ++i) s += v[i] * v[i];
            s += __shfl_xor(s, 1); s += __shfl_xor(s, 2); s += __shfl_xor(s, 4);
            const float rstd = rsqrtf(s * (1.f / 96.f) + NORM_EPS);
#pragma unroll
            for (int i = 0; i < 12; ++i) v[i] *= rstd * kg[i];
            { const float t1 = v[8], t2 = v[9]; v[8] = t1 * cr - t2 * sr; v[9] = t1 * sr + t2 * cr; }
            { const float t1 = v[10], t2 = v[11]; v[10] = t1 * cc - t2 * sc; v[11] = t1 * sc + t2 * cc; }
            bf16_t* ko = K + ((size_t)h * R + m) * 96 + sub;
#pragma unroll
            for (int i = 0; i < 12; ++i) ko[8 * i] = (bf16_t)(cvtpk(v[i], 0.f) & 0xffffu);
            *(u32x4*)(V + ((size_t)h * R + m) * 64 + sub * 8) = *(const u32x4*)(KVRAW + (size_t)m * 1024 + h * 128 + 64 + sub * 8);
        }
    }
}

__device__ __forceinline__ void rwkv_output_rows(const Frame& F, const Args& a, int l, int m_end) {
    const bf16_t* RKV = (const bf16_t*)(F.ws + WS_RKV); const bf16_t* LO = (const bf16_t*)(F.ws + WS_LO);
    const bf16_t* YF = (const bf16_t*)(F.ws + WS_YF); const bf16_t* YBK = (const bf16_t*)(F.ws + WS_YBK); bf16_t* YR = (bf16_t*)(F.ws + WS_YR);
    const int lane = F.lane, c0 = lane * 8;
    float ka[8], rk[8], lg[8], lb[8];
#pragma unroll
    for (int e = 0; e < 8; ++e) { ka[e] = a.in[I_KA][l * 512 + c0 + e]; rk[e] = a.in[I_RK][l * 512 + c0 + e]; lg[e] = a.in[I_LNG][l * 512 + c0 + e]; lb[e] = a.in[I_LNB][l * 512 + c0 + e]; }
    const int gw = F.vcu * NWAVES + F.wave, NGW = F.G * NWAVES;
#define UNPK8(W, V) const float V[8] = {lo_bf(W.x), hi_bf(W.x), lo_bf(W.y), hi_bf(W.y), lo_bf(W.z), hi_bf(W.z), lo_bf(W.w), hi_bf(W.w)}
    for (int m0 = gw; m0 < m_end * PROBE_ROW; m0 += NGW) { const int m = m0 % m_end;
        const u32x4 wr_ = *(const u32x4*)(RKV + (size_t)m * RKV_LD + c0), wk_ = *(const u32x4*)(RKV + (size_t)m * RKV_LD + 512 + c0), wv_ = *(const u32x4*)(RKV + (size_t)m * RKV_LD + 1024 + c0);
        const u32x4 wa0 = *(const u32x4*)(LO + (size_t)m * LO_LD + 1024 + c0), wa1 = *(const u32x4*)(LO + (size_t)m * LO_LD + 1536 + c0), wg_ = *(const u32x4*)(LO + (size_t)m * LO_LD + 2048 + c0);
        const u32x4 wyf = *(const u32x4*)(YF + (size_t)m * 512 + c0), wyb = *(const u32x4*)(YBK + (size_t)m * 512 + c0);
        UNPK8(wr_, r); UNPK8(wk_, k); UNPK8(wv_, v); UNPK8(wa0, a0v); UNPK8(wa1, a1v); UNPK8(wg_, g); UNPK8(wyf, yf); UNPK8(wyb, yb);
        float y[8]; float s = 0.f, bs = 0.f;
#pragma unroll
        for (int e = 0; e < 8; ++e) { y[e] = yf[e] + yb[e]; s += y[e];
            const float kd0 = k[e] * (1.f + (a0v[e] - 1.f) * ka[e]), kd1 = k[e] * (1.f + (a1v[e] - 1.f) * ka[e]);
            bs += r[e] * rk[e] * (kd0 + kd1); }
        s += __shfl_xor(s, 1); s += __shfl_xor(s, 2); s += __shfl_xor(s, 4);
        bs += __shfl_xor(bs, 1); bs += __shfl_xor(bs, 2); bs += __shfl_xor(bs, 4);
        const float mean = s * (1.f / 64.f); float q = 0.f;
#pragma unroll
        for (int e = 0; e < 8; ++e) { const float d = y[e] - mean; q += d * d; }
        q += __shfl_xor(q, 1); q += __shfl_xor(q, 2); q += __shfl_xor(q, 4);
        const float rstd = rsqrtf(q * (1.f / 64.f) + 64e-5f);
        float o[8];
#pragma unroll
        for (int e = 0; e < 8; ++e) o[e] = ((y[e] - mean) * rstd * lg[e] + lb[e] + bs * v[e]) * g[e];
        u32x4 w; w.x = cvtpk(o[0], o[1]); w.y = cvtpk(o[2], o[3]); w.z = cvtpk(o[4], o[5]); w.w = cvtpk(o[6], o[7]);
        *(u32x4*)(YR + (size_t)m * 512 + c0) = w;
    }
#undef UNPK8
}

__device__ __forceinline__ int crow(int r, int hi) { return (r & 3) + 8 * (r >> 2) + 4 * hi; }
#define SBAR() __builtin_amdgcn_sched_barrier(0)
__device__ __forceinline__ s16x4 tr_read_at(unsigned addr) { s16x4 r; asm volatile("ds_read_b64_tr_b16 %0, %1" : "=&v"(r) : "v"(addr) : "memory"); return r; }
__device__ __forceinline__ float rowmax32(const f32x16& p0, const f32x16& p1) {
    float m = p0[0];
#pragma unroll
    for (int r = 1; r < 16; ++r) m = fmaxf(m, p0[r]);
#pragma unroll
    for (int r = 0; r < 16; ++r) m = fmaxf(m, p1[r]);
    auto rr = __builtin_amdgcn_permlane32_swap(__float_as_uint(m), __float_as_uint(m), false, false);
    return fmaxf(__uint_as_float(rr[0]), __uint_as_float(rr[1]));
}
__device__ __forceinline__ float halfsum(float s) {
    auto rr = __builtin_amdgcn_permlane32_swap(__float_as_uint(s), __float_as_uint(s), false, false);
    return __uint_as_float(rr[0]) + __uint_as_float(rr[1]);
}
__device__ __forceinline__ void pack_p(const f32x16& p0, const f32x16& p1, bf16x8 (&pa)[4]) {
#define PK8(P, B, OUT) do { u32x4 w = {cvtpk(P[B + 0], P[B + 1]), cvtpk(P[B + 2], P[B + 3]), cvtpk(P[B + 4], P[B + 5]), cvtpk(P[B + 6], P[B + 7])}; OUT = __builtin_bit_cast(bf16x8, w); } while (0)
    PK8(p0, 0, pa[0]); PK8(p0, 8, pa[1]); PK8(p1, 0, pa[2]); PK8(p1, 8, pa[3]);
#undef PK8
}

constexpr int AK_PITCH = 208, AK_BYTES = 64 * AK_PITCH, AV_BYTES = 8192;
constexpr int ANSLOT = 6;
constexpr int ALDS_K = 0, ALDS_V = ANSLOT * AK_BYTES, ALDS_WS = ALDS_V + ANSLOT * AV_BYTES, ALDS_END = ALDS_WS + 8 * 256;
static_assert(ALDS_END <= 131072, "MLA LDS");
typedef short v4i16_t __attribute__((ext_vector_type(4)));
__device__ __forceinline__ s16x4 vtr(LAS const unsigned char* p) { return __builtin_bit_cast(s16x4, __builtin_amdgcn_ds_read_tr16_b64_v4i16((LAS v4i16_t*)p)); }
__device__ __forceinline__ void mla_unit(const Frame& F, int h, int q0, int k0, int nt) {
    const bf16_t* Q = (const bf16_t*)(F.ws + WS_Q) + (size_t)h * R * 96; const bf16_t* K = (const bf16_t*)(F.ws + WS_K) + (size_t)h * R * 96 + (size_t)k0 * 96;
    const bf16_t* V = (const bf16_t*)(F.ws + WS_V) + (size_t)h * R * 64 + (size_t)k0 * 64; bf16_t* YA = (bf16_t*)(F.ws + WS_YA);
    LAS unsigned char* lds = F.lds;
    const int tid = F.tid, lane = F.lane, wid = F.wave, r32 = lane & 31, hi = lane >> 5;
    LAS float* wsf = (LAS float*)(lds + ALDS_WS) + wid * 64;
    bf16x8 qr[6];
    { const bf16_t* qp = Q + (size_t)(q0 + wid * 32 + r32) * 96 + hi * 8;
#pragma unroll
      for (int s = 0; s < 6; ++s) qr[s] = *(const bf16x8*)(qp + s * 16); }
    const int kc0 = tid, kc1 = 512 + tid; const bool k2 = tid < 256;
    const int kr0 = kc0 / 12, kq0 = kc0 % 12, kr1 = kc1 / 12, kq1 = kc1 % 12;
    const int vkey = tid >> 3, vc8 = tid & 7;
    const unsigned kdst0 = kr0 * AK_PITCH + kq0 * 16, kdst1 = kr1 * AK_PITCH + kq1 * 16;
    const unsigned vdst = (vc8 >> 2) * 4096 + vkey * 64 + (vc8 & 3) * 16;
    u32x4 sk0, sk1, sv, tk0, tk1, tv;
#define A_LOAD(t) do { const bf16_t* kt = K + (size_t)(t) * 64 * 96; sk0 = *(const u32x4*)(kt + kr0 * 96 + kq0 * 8); if (k2) sk1 = *(const u32x4*)(kt + kr1 * 96 + kq1 * 8); \
        sv = *(const u32x4*)(V + (size_t)(t) * 64 * 64 + vkey * 64 + vc8 * 8); } while (0)
#define A_WRITE(sl) do { *(LAS u32x4*)(lds + ALDS_K + (sl) * AK_BYTES + kdst0) = sk0; if (k2) *(LAS u32x4*)(lds + ALDS_K + (sl) * AK_BYTES + kdst1) = sk1; \
        *(LAS u32x4*)(lds + ALDS_V + (sl) * AV_BYTES + vdst) = sv; } while (0)
#define A_LOAD2(t) do { const bf16_t* kt = K + (size_t)(t) * 64 * 96; tk0 = *(const u32x4*)(kt + kr0 * 96 + kq0 * 8); if (k2) tk1 = *(const u32x4*)(kt + kr1 * 96 + kq1 * 8); \
        tv = *(const u32x4*)(V + (size_t)(t) * 64 * 64 + vkey * 64 + vc8 * 8); } while (0)
#define A_WRITE2(sl) do { *(LAS u32x4*)(lds + ALDS_K + (sl) * AK_BYTES + kdst0) = tk0; if (k2) *(LAS u32x4*)(lds + ALDS_K + (sl) * AK_BYTES + kdst1) = tk1; \
        *(LAS u32x4*)(lds + ALDS_V + (sl) * AV_BYTES + vdst) = tv; } while (0)
    f32x16 o[2]; o[0] = f32x16{}; o[1] = f32x16{};
    float mref = 0.f, lsum = 0.f; f32x16 negm = f32x16{};
    LAS const unsigned char* kb_rd = lds + ALDS_K + r32 * AK_PITCH + hi * 16;
    LAS const unsigned char* vb_rd = lds + ALDS_V + ((lane >> 4) & 1) * 32 + (lane & 3) * 8 + (4 * hi + ((lane & 15) >> 2)) * 64;
#define PIN(x) asm volatile("" : "+v"(x))
#define A_QKT(C0, C1, sl) do { LAS const unsigned char* kt_ = kb_rd + (sl) * AK_BYTES; C0 = negm; C1 = negm; \
        _Pragma("unroll") for (int s = 0; s < 6; ++s) { const bf16x8 a0 = *(LAS const bf16x8*)(kt_ + s * 32); const bf16x8 a1 = *(LAS const bf16x8*)(kt_ + 32 * AK_PITCH + s * 32); \
            C0 = __builtin_amdgcn_mfma_f32_32x32x16_bf16(a0, qr[s], C0, 0, 0, 0); C1 = __builtin_amdgcn_mfma_f32_32x32x16_bf16(a1, qr[s], C1, 0, 0, 0); } } while (0)
#define A_MAX(C0, C1, al) do { const float rm_ = rowmax32(C0, C1); al = 1.f; \
        if (__builtin_expect(__any(rm_ > 8.f), 0)) { const float dl_ = fmaxf(rm_, 0.f); mref += dl_; al = __builtin_amdgcn_exp2f(-dl_); \
            _Pragma("unroll") for (int r = 0; r < 16; ++r) { C0[r] -= dl_; C1[r] -= dl_; negm[r] = -mref; } } } while (0)
#define A_RESC(al) do { if (__any((al) < 1.f)) { if (hi == 0) wsf[r32] = (al); LDS_WAIT(); \
        _Pragma("unroll") for (int r = 0; r < 16; ++r) { const float f_ = wsf[crow(r, hi)]; o[0][r] *= f_; o[1][r] *= f_; } } } while (0)
#define A_STEP(C0, C1, P0, P1, sk_, sv_, alP, alC) do { \
        LAS const unsigned char* kt_ = kb_rd + (sk_) * AK_BYTES; LAS const unsigned char* vt_ = vb_rd + (sv_) * AV_BYTES; \
        bf16x8 ka_[2], kb_[2]; u32x4 pw_[4]; float ps0_ = 0.f, ps1_ = 0.f; \
        ka_[0] = *(LAS const bf16x8*)(kt_); kb_[0] = *(LAS const bf16x8*)(kt_ + 32 * AK_PITCH); SBAR(); \
        _Pragma("unroll") for (int s = 0; s < 6; ++s) { const int c_ = s & 1, n_ = c_ ^ 1; \
            if (s + 1 < 6) { ka_[n_] = *(LAS const bf16x8*)(kt_ + (s + 1) * 32); kb_[n_] = *(LAS const bf16x8*)(kt_ + 32 * AK_PITCH + (s + 1) * 32); } \
            if (s == 0) C0 = __builtin_amdgcn_mfma_f32_32x32x16_bf16(ka_[c_], qr[s], negm, 0, 0, 0); else C0 = __builtin_amdgcn_mfma_f32_32x32x16_bf16(ka_[c_], qr[s], C0, 0, 0, 0); \
            if (s < 4) { ps0_ += P0[4 * s] + P0[4 * s + 1]; ps1_ += P0[4 * s + 2] + P0[4 * s + 3]; PIN(ps0_); PIN(ps1_); } \
            else { pw_[2 * (s - 4)][0] = cvtpk(P0[8 * (s - 4)], P0[8 * (s - 4) + 1]); pw_[2 * (s - 4)][1] = cvtpk(P0[8 * (s - 4) + 2], P0[8 * (s - 4) + 3]); pw_[2 * (s - 4)][2] = cvtpk(P0[8 * (s - 4) + 4], P0[8 * (s - 4) + 5]); pw_[2 * (s - 4)][3] = cvtpk(P0[8 * (s - 4) + 6], P0[8 * (s - 4) + 7]); PIN(pw_[2 * (s - 4)]); } \
            SBAR(); \
            if (s == 0) C1 = __builtin_amdgcn_mfma_f32_32x32x16_bf16(kb_[c_], qr[s], negm, 0, 0, 0); else C1 = __builtin_amdgcn_mfma_f32_32x32x16_bf16(kb_[c_], qr[s], C1, 0, 0, 0); \
            if (s < 4) { ps0_ += P1[4 * s] + P1[4 * s + 1]; ps1_ += P1[4 * s + 2] + P1[4 * s + 3]; PIN(ps0_); PIN(ps1_); } \
            else { pw_[2 * (s - 4) + 1][0] = cvtpk(P1[8 * (s - 4)], P1[8 * (s - 4) + 1]); pw_[2 * (s - 4) + 1][1] = cvtpk(P1[8 * (s - 4) + 2], P1[8 * (s - 4) + 3]); pw_[2 * (s - 4) + 1][2] = cvtpk(P1[8 * (s - 4) + 4], P1[8 * (s - 4) + 5]); pw_[2 * (s - 4) + 1][3] = cvtpk(P1[8 * (s - 4) + 6], P1[8 * (s - 4) + 7]); PIN(pw_[2 * (s - 4) + 1]); } \
            SBAR(); } \
        lsum = lsum * (alP) + (ps0_ + ps1_); \
        A_MAX(C0, C1, alC); SBAR(); \
          \
        s16x4 vl_[2], vh_[2]; vl_[0] = vtr(vt_); vh_[0] = vtr(vt_ + 512); SBAR(); \
        _Pragma("unroll") for (int m_ = 0; m_ < 8; ++m_) { const int dt_ = m_ >> 2, s_ = m_ & 3, c_ = m_ & 1, n_ = c_ ^ 1; \
            if (m_ + 1 < 8) { vl_[n_] = vtr(vt_ + ((m_ + 1) >> 2) * 4096 + ((m_ + 1) & 3) * 1024); vh_[n_] = vtr(vt_ + ((m_ + 1) >> 2) * 4096 + ((m_ + 1) & 3) * 1024 + 512); } \
            const bf16x8 vf_ = {vl_[c_][0], vl_[c_][1], vl_[c_][2], vl_[c_][3], vh_[c_][0], vh_[c_][1], vh_[c_][2], vh_[c_][3]}; \
            const int pi_ = (s_ == 0) ? 0 : (s_ == 1) ? 2 : (s_ == 2) ? 1 : 3; \
            o[dt_] = __builtin_amdgcn_mfma_f32_32x32x16_bf16(__builtin_bit_cast(bf16x8, pw_[pi_]), vf_, o[dt_], 0, 0, 0); \
            if (m_ < 4) { C0[4 * m_] = __builtin_amdgcn_exp2f(C0[4 * m_]); C0[4 * m_ + 1] = __builtin_amdgcn_exp2f(C0[4 * m_ + 1]); C0[4 * m_ + 2] = __builtin_amdgcn_exp2f(C0[4 * m_ + 2]); C0[4 * m_ + 3] = __builtin_amdgcn_exp2f(C0[4 * m_ + 3]); PIN(C0); } \
            else { C1[4 * (m_ - 4)] = __builtin_amdgcn_exp2f(C1[4 * (m_ - 4)]); C1[4 * (m_ - 4) + 1] = __builtin_amdgcn_exp2f(C1[4 * (m_ - 4) + 1]); C1[4 * (m_ - 4) + 2] = __builtin_amdgcn_exp2f(C1[4 * (m_ - 4) + 2]); C1[4 * (m_ - 4) + 3] = __builtin_amdgcn_exp2f(C1[4 * (m_ - 4) + 3]); PIN(C1); } \
            SBAR(); } \
    } while (0)
    f32x16 pA0, pA1, pB0, pB1; float alA = 1.f, alB = 1.f;
    A_LOAD(0); A_WRITE(0); A_LOAD(1); A_WRITE(1); A_LOAD(2); A_LOAD2(3); __syncthreads();
    A_QKT(pA0, pA1, 0); A_MAX(pA0, pA1, alA);
#pragma unroll
    for (int r = 0; r < 16; ++r) { pA0[r] = __builtin_amdgcn_exp2f(pA0[r]); pA1[r] = __builtin_amdgcn_exp2f(pA1[r]); }
    A_WRITE(2); A_WRITE2(3);
    if (nt > 4) { A_LOAD(4); A_LOAD2(5); A_WRITE(4); A_WRITE2(5); }
    __syncthreads();
    alA = 1.f;
    int sk = 1, sv_ = 0, sw = 0;
#define A_NEXT(x) ((x) == ANSLOT - 1 ? 0 : (x) + 1)
    for (int t = 1; t + 1 < nt; t += 2) {
        const bool st = t + 6 < nt;
        if (st) { A_LOAD(t + 5); A_LOAD2(t + 6); }
        A_STEP(pB0, pB1, pA0, pA1, sk, sv_, alA, alB);
        A_RESC(alB);
        sv_ = sk; sk = A_NEXT(sk);
        A_STEP(pA0, pA1, pB0, pB1, sk, sv_, alB, alA);
        __syncthreads(); if (st) { A_WRITE(sw); A_WRITE2(A_NEXT(sw)); } A_RESC(alA);
        sv_ = sk; sk = A_NEXT(sk); sw = A_NEXT(A_NEXT(sw));
    }
    A_STEP(pB0, pB1, pA0, pA1, sk, sv_, alA, alB);
    A_RESC(alB);
    { float ps = 0.f;
#pragma unroll
      for (int r = 0; r < 16; ++r) ps += pB0[r] + pB1[r];
      lsum = lsum * alB + ps;
      bf16x8 pa[4]; pack_p(pB0, pB1, pa);
      LAS const unsigned char* vt_ = vb_rd + sk * AV_BYTES;
#pragma unroll
      for (int dt = 0; dt < 2; ++dt)
#pragma unroll
          for (int s = 0; s < 4; ++s) { const s16x4 lo_ = vtr(vt_ + dt * 4096 + s * 1024), hh_ = vtr(vt_ + dt * 4096 + s * 1024 + 512);
              const bf16x8 vf = {lo_[0], lo_[1], lo_[2], lo_[3], hh_[0], hh_[1], hh_[2], hh_[3]};
              o[dt] = __builtin_amdgcn_mfma_f32_32x32x16_bf16(pa[s], vf, o[dt], 0, 0, 0); } }
    lsum = halfsum(lsum);
    if (hi == 0) wsf[r32] = lsum; LDS_WAIT();
#pragma unroll
    for (int r = 0; r < 16; ++r) { const float inv = 1.f / wsf[crow(r, hi)]; const int row = q0 + wid * 32 + crow(r, hi);
        bf16_t* op = YA + (size_t)row * 512 + h * 64 + r32;
        op[0] = (bf16_t)(cvtpk(o[0][r] * inv, 0.f) & 0xffffu); op[32] = (bf16_t)(cvtpk(o[1][r] * inv, 0.f) & 0xffffu); }
    __syncthreads();
#undef A_LOAD
#undef A_WRITE
#undef A_LOAD2
#undef A_WRITE2
#undef A_NEXT
#undef A_QKT
#undef A_MAX
#undef A_RESC
#undef A_STEP
#undef PIN
}

constexpr int NLDS_V = 0, NLDS_RPB = 8 * 8192, NLDS_WS = NLDS_RPB + 8 * 2048, NLDS_END = NLDS_WS + 8 * 256;
__device__ __forceinline__ void na_unit(const Frame& F, const float* rpb_l, int unit, bool ctxq, int qt) {
    const bf16_t* ZN = (const bf16_t*)(F.ws + WS_ZN); bf16_t* YB = (bf16_t*)(F.ws + WS_YB);
    LAS unsigned char* lds = F.lds;
    const int lane = F.lane, h = F.wave, r32 = lane & 31, hi = lane >> 5;
    LAS unsigned char* vlds = lds + NLDS_V + h * 8192; LAS float* rpbs = (LAS float*)(lds + NLDS_RPB + h * 2048); LAS float* wsf = (LAS float*)(lds + NLDS_WS) + h * 64;
    const int qrow0 = ctxq ? L + unit * 64 : unit * 64;
    const int rs = ctxq ? 0 : min(max(unit - 4, 0), 256 - 8);
    for (int i = lane; i < 15 * 31; i += 64) rpbs[i] = rpb_l[h * 465 + i] * LOG2E;
    bf16x8 qr[4];
#pragma unroll
    for (int s = 0; s < 4; ++s) qr[s] = *(const bf16x8*)(ZN + (size_t)(qrow0 + qt * 32 + r32) * ZN_LD + h * 64 + s * 16 + hi * 8);
    f32x16 o[2]; o[0] = f32x16{}; o[1] = f32x16{};
    float mref = -1e30f, lsum = 0.f;
    const unsigned vb_rd = (unsigned)(uintptr_t)vlds + ((lane >> 4) & 1) * 32 + (lane & 3) * 8 + (4 * hi + ((lane & 15) >> 2)) * 64;
    const int ntl = ctxq ? 0 : 8, nt = ntl + 4;
    LDS_WAIT();
    for (int t = 0; t < nt; ++t) {
        const bool local = t < ntl;
        const int krow0 = local ? (rs + t) * 64 : L + (t - ntl) * 64;
        bf16x8 kf[2][4];
#pragma unroll
        for (int hf = 0; hf < 2; ++hf)
#pragma unroll
            for (int s = 0; s < 4; ++s) kf[hf][s] = *(const bf16x8*)(ZN + (size_t)(krow0 + hf * 32 + r32) * ZN_LD + 512 + h * 64 + s * 16 + hi * 8);
        u32x4 sv[8];
#pragma unroll
        for (int i = 0; i < 8; ++i) { const int c = i * 64 + lane; sv[i] = *(const u32x4*)(ZN + (size_t)(krow0 + (c >> 3)) * ZN_LD + 1024 + h * 64 + (c & 7) * 8); }
#pragma unroll
        for (int i = 0; i < 8; ++i) { const int c = i * 64 + lane; const int key = c >> 3, c8 = c & 7; *(LAS u32x4*)(vlds + (c8 >> 2) * 4096 + key * 64 + (c8 & 3) * 16) = sv[i]; }
        LDS_WAIT();
        const int dr = rs + t - unit + 7;
        {
            f32x16 p0 = f32x16{}, p1 = f32x16{};
#pragma unroll
            for (int s = 0; s < 4; ++s) { p0 = __builtin_amdgcn_mfma_f32_32x32x16_bf16(kf[0][s], qr[s], p0, 0, 0, 0); p1 = __builtin_amdgcn_mfma_f32_32x32x16_bf16(kf[1][s], qr[s], p1, 0, 0, 0); }
            if (local) {
                const int qc = qt * 32 + r32, cs = min(max(qc - 8, 0), 48);
#pragma unroll
                for (int r = 0; r < 16; ++r) { const int kc0 = crow(r, hi), kc1 = kc0 + 32;
                    const bool v0 = (kc0 >= cs) && (kc0 < cs + 16), v1 = (kc1 >= cs) && (kc1 < cs + 16);
                    const int d0 = v0 ? kc0 - qc + 15 : 0, d1 = v1 ? kc1 - qc + 15 : 0;
                    const float b0 = rpbs[dr * 31 + d0], b1 = rpbs[dr * 31 + d1];
                    p0[r] = v0 ? p0[r] + b0 : -1e30f; p1[r] = v1 ? p1[r] + b1 : -1e30f; }
            }
            const float rm = rowmax32(p0, p1);
            if (__any(rm > mref + 8.f)) {
                const float mn = fmaxf(mref, rm); const float al = __builtin_amdgcn_exp2f(mref - mn); mref = mn; lsum *= al;
                if (hi == 0) wsf[r32] = al; LDS_WAIT();
#pragma unroll
                for (int r = 0; r < 16; ++r) { const float f = wsf[crow(r, hi)]; o[0][r] *= f; o[1][r] *= f; }
                LDS_WAIT();
            }
            float ps = 0.f;
#pragma unroll
            for (int r = 0; r < 16; ++r) { p0[r] = __builtin_amdgcn_exp2f(p0[r] - mref); p1[r] = __builtin_amdgcn_exp2f(p1[r] - mref); ps += p0[r] + p1[r]; }
            lsum += ps;
            bf16x8 pa[4]; pack_p(p0, p1, pa);
#pragma unroll
            for (int dt = 0; dt < 2; ++dt) {
                s16x4 lo[4], hh[4];
#pragma unroll
                for (int s = 0; s < 4; ++s) { lo[s] = tr_read_at(vb_rd + dt * 4096 + s * 1024); hh[s] = tr_read_at(vb_rd + dt * 4096 + s * 1024 + 512); }
                LDS_WAIT(); SBAR();
#pragma unroll
                for (int s = 0; s < 4; ++s) { const bf16x8 vf = {lo[s][0], lo[s][1], lo[s][2], lo[s][3], hh[s][0], hh[s][1], hh[s][2], hh[s][3]};
                    o[dt] = __builtin_amdgcn_mfma_f32_32x32x16_bf16(pa[s], vf, o[dt], 0, 0, 0); }
            }
        }
        LDS_WAIT(); SBAR();
    }
    {
        const float ls = halfsum(lsum);
        if (hi == 0) wsf[r32] = ls; LDS_WAIT();
#pragma unroll
        for (int r = 0; r < 16; ++r) { const float inv = 1.f / wsf[crow(r, hi)]; const int row = qrow0 + qt * 32 + crow(r, hi);
            bf16_t* op = YB + (size_t)row * 512 + h * 64 + r32;
            op[0] = (bf16_t)(cvtpk(o[0][r] * inv, 0.f) & 0xffffu); op[32] = (bf16_t)(cvtpk(o[1][r] * inv, 0.f) & 0xffffu); }
        LDS_WAIT();
    }
}

__device__ __forceinline__ int rw_row2(int d, int seq, int t) {
    if (seq == 0) return d == 0 ? L + t : L + (CT - 1) - t;
    return d == 0 ? t : (L - 1) - t;
}
__device__ __forceinline__ void rwkv_pass2(const Frame& F, int dh, int it) {
    const int lane = F.lane, r32 = lane & 31, hi = lane >> 5;
    float* Qb = (float*)(F.ws + WS_QST) + (size_t)dh * NCH * 4096;
    f32x16 X[2];
#pragma unroll
    for (int jt = 0; jt < 2; ++jt)
#pragma unroll
        for (int r = 0; r < 16; ++r) X[jt][r] = Qb[(size_t)(32 * it + r32) * 64 + 32 * jt + crow(r, hi)];
    bf16x8 pnx[2][2][2]; f32x4 qn[2][4];
    const bf16_t* PTb = (const bf16_t*)(F.ws + WS_PST) + (size_t)dh * NCH * 4096;
#define P2_LOAD(ci_) do { const bf16_t* P_ = PTb + (size_t)(ci_) * 4096; const float* Q_ = Qb + (size_t)(ci_) * 4096 + (size_t)(32 * it + r32) * 64 + 4 * hi; \
        _Pragma("unroll") for (int jn = 0; jn < 2; ++jn) _Pragma("unroll") for (int jt = 0; jt < 2; ++jt) _Pragma("unroll") for (int s = 0; s < 2; ++s) pnx[jn][jt][s] = *(const bf16x8*)(P_ + (size_t)(32 * jn + r32) * 64 + jt * 32 + s * 16 + hi * 8); \
        _Pragma("unroll") for (int jt = 0; jt < 2; ++jt) _Pragma("unroll") for (int g = 0; g < 4; ++g) qn[jt][g] = *(const f32x4*)(Q_ + 32 * jt + 8 * g); } while (0)
    P2_LOAD(1);
    for (int ci = 1; ci < NCH - 1; ++ci) {
        float* Qc = Qb + (size_t)ci * 4096;
        bf16x8 pa[2][2][2]; f32x16 N[2];
#pragma unroll
        for (int jn = 0; jn < 2; ++jn)
#pragma unroll
            for (int jt = 0; jt < 2; ++jt)
#pragma unroll
                for (int s = 0; s < 2; ++s) pa[jn][jt][s] = pnx[jn][jt][s];
#pragma unroll
        for (int jt = 0; jt < 2; ++jt)
#pragma unroll
            for (int r = 0; r < 16; ++r) N[jt][r] = qn[jt][r >> 2][r & 3];
        if (ci + 1 < NCH - 1) P2_LOAD(ci + 1);
        bf16x8 bh[2][2], bl[2][2];
#pragma unroll
        for (int jt = 0; jt < 2; ++jt)
#pragma unroll
            for (int s = 0; s < 2; ++s) {
                unsigned wh[4], wl[4];
#pragma unroll
                for (int e2 = 0; e2 < 4; ++e2) { const float x0 = X[jt][8 * s + 2 * e2], x1 = X[jt][8 * s + 2 * e2 + 1]; const unsigned h = cvtpk(x0, x1); wh[e2] = h; wl[e2] = cvtpk(x0 - lo_bf(h), x1 - hi_bf(h)); }
                u32x4 a = {wh[0], wh[1], wh[2], wh[3]}, b = {wl[0], wl[1], wl[2], wl[3]}; bh[jt][s] = __builtin_bit_cast(bf16x8, a); bl[jt][s] = __builtin_bit_cast(bf16x8, b);
            }
#pragma unroll
        for (int jn = 0; jn < 2; ++jn)
#pragma unroll
            for (int jt = 0; jt < 2; ++jt)
#pragma unroll
                for (int s = 0; s < 2; ++s) { N[jn] = __builtin_amdgcn_mfma_f32_32x32x16_bf16(pa[jn][jt][s], bh[jt][s], N[jn], 0, 0, 0); N[jn] = __builtin_amdgcn_mfma_f32_32x32x16_bf16(pa[jn][jt][s], bl[jt][s], N[jn], 0, 0, 0); }
        X[0] = N[0]; X[1] = N[1];
#pragma unroll
        for (int jt = 0; jt < 2; ++jt)
#pragma unroll
            for (int r = 0; r < 16; ++r) Qc[(size_t)(32 * it + r32) * 64 + 32 * jt + crow(r, hi)] = X[jt][r];
    }
#undef P2_LOAD
}


namespace rwmm {
#define RW_BAR() asm volatile("s_waitcnt lgkmcnt(0)\n\ts_barrier" ::: "memory")
constexpr int PITCH = 144, MB = 64 * PITCH;
enum { B_PR = 0, B_PT, B_QR, B_QT, B_KR, B_KT, B_VR, B_RT, B_W0, B_W1, B_W2, B_W3, B_W4, B_W5, B_SB, B_NBUF };
constexpr int OFF_GC = B_NBUF * MB, OFF_TOT = OFF_GC + 256, LDS_END = OFF_TOT + 8 * 64 * 4;
static_assert(LDS_END <= 146432, "rwmm LDS");
__device__ __forceinline__ LAS unsigned char* buf(LAS unsigned char* lds, int b) { return lds + b * MB; }
__device__ __forceinline__ f32x16 mm_acc(LAS const unsigned char* A, LAS const unsigned char* B, int mt, int nt, int r32, int hi, f32x16 acc) {
    LAS const unsigned char* ap = A + (32 * mt + r32) * PITCH + hi * 16; LAS const unsigned char* bp = B + (32 * nt + r32) * PITCH + hi * 16;
#pragma unroll
    for (int ks = 0; ks < 4; ++ks) acc = __builtin_amdgcn_mfma_f32_32x32x16_bf16(*(LAS const bf16x8*)(ap + ks * 32), *(LAS const bf16x8*)(bp + ks * 32), acc, 0, 0, 0);
    return acc;
}
__device__ __forceinline__ void store_T(const f32x16& c, LAS unsigned char* b, int mt, int nt, int r32, int hi) {
#pragma unroll
    for (int g = 0; g < 4; ++g) { u32x2 w = {cvtpk(c[4 * g], c[4 * g + 1]), cvtpk(c[4 * g + 2], c[4 * g + 3])}; *(LAS u32x2*)(b + (32 * nt + r32) * PITCH + (32 * mt + 8 * g + 4 * hi) * 2) = w; }
}
__device__ __forceinline__ void store_N(const f32x16& c, LAS unsigned char* b, int mt, int nt, int r32, int hi) {
#pragma unroll
    for (int r = 0; r < 16; ++r) *(LAS bf16_t*)(b + (32 * mt + crow(r, hi)) * PITCH + (32 * nt + r32) * 2) = (bf16_t)(cvtpk(c[r], 0.f) & 0xffffu);
}
__device__ __forceinline__ f32x16 load_T(LAS const unsigned char* b, int mt, int nt, int r32, int hi) {
    f32x16 c;
#pragma unroll
    for (int g = 0; g < 4; ++g) { const u32x2 w = *(LAS const u32x2*)(b + (32 * nt + r32) * PITCH + (32 * mt + 8 * g + 4 * hi) * 2); c[4 * g] = lo_bf(w.x); c[4 * g + 1] = hi_bf(w.x); c[4 * g + 2] = lo_bf(w.y); c[4 * g + 3] = hi_bf(w.y); }
    return c;
}
template <bool STRICT> __device__ __forceinline__ void mask_upper(f32x16& c, int mt, int nt, int r32, int hi) {
#pragma unroll
    for (int r = 0; r < 16; ++r) { const int s = 32 * mt + crow(r, hi), t = 32 * nt + r32; const bool keep = STRICT ? (s < t) : (s <= t); c[r] = keep ? c[r] : 0.f; }
}

struct Raw { unsigned ka[8], lr[8], vv[4]; float kn[8]; };
__device__ __forceinline__ void prep_load(const Frame& F, int d, int h, int seq, int t0, Raw& R_) {
    const bf16_t* RKV = (const bf16_t*)(F.ws + WS_RKV); const bf16_t* LO = (const bf16_t*)(F.ws + WS_LO); const float* KN = (const float*)(F.ws + WS_KN);
    const int c = h * 64 + F.lane;
    const unsigned cu = (unsigned)c;
#pragma unroll
    for (int e = 0; e < 8; ++e) { const int row = __builtin_amdgcn_readfirstlane(rw_row2(d, seq, t0 + 8 * F.wave + e));
        const bf16_t* rb = RKV + (size_t)row * RKV_LD; const bf16_t* lb = LO + (size_t)row * LO_LD + d * 512;
        R_.ka[e] = (unsigned)rb[512u + cu] | ((unsigned)lb[1024u + cu] << 16);
        R_.lr[e] = (unsigned)lb[cu] | ((unsigned)rb[cu] << 16);
        const unsigned v = rb[1024u + cu]; if (e & 1) R_.vv[e >> 1] |= v << 16; else R_.vv[e >> 1] = v;
        R_.kn[e] = KN[row * 8 + h]; }
}
template <bool PASS3> __device__ __forceinline__ void prep(const Frame& F, const Args& a, int l, int h, const Raw& R_) {
    LAS unsigned char* lds = F.lds; const int lane = F.lane, w = F.wave, c = h * 64 + lane;
    const float kkp = a.in[I_KK][l * 512 + c], kap = a.in[I_KA][l * 512 + c];
    float G[8]; float run = 0.f;
#pragma unroll
    for (int e = 0; e < 8; ++e) { run += lo_bf(R_.lr[e]); G[e] = run; }
    LAS float* tot = (LAS float*)(lds + OFF_TOT);
    tot[w * 64 + lane] = run;
    RW_BAR();
    float off = 0.f;
#pragma unroll
    for (int ww = 0; ww < 7; ++ww) off += (ww < w) ? tot[ww * 64 + lane] : 0.f;
    unsigned pr[4], qr_[4], kr_[4];
#pragma unroll
    for (int e2 = 0; e2 < 4; ++e2) {
        float Pv[2], Qv[2], Kv[2];
#pragma unroll
        for (int u = 0; u < 2; ++u) { const int e = 2 * e2 + u, t = 8 * w + e;
            const float k = lo_bf(R_.ka[e]), av = hi_bf(R_.ka[e]), lw = lo_bf(R_.lr[e]), rr = hi_bf(R_.lr[e]);
            const float kx = k * kkp * R_.kn[e], kd = k * (1.f + (av - 1.f) * kap);
            const float g = G[e] + off; const float gam = __expf(g), inv = __expf(-g), gprev = __expf(g - lw);
            Pv[u] = -kx * gprev; Qv[u] = kx * av * inv; Kv[u] = kd * inv; const float Rv = rr * gam;
            *(LAS bf16_t*)(buf(lds, B_PT) + t * PITCH + lane * 2) = (bf16_t)(cvtpk(Pv[u], 0.f) & 0xffffu);
            *(LAS bf16_t*)(buf(lds, B_QT) + t * PITCH + lane * 2) = (bf16_t)(cvtpk(Qv[u], 0.f) & 0xffffu);
            *(LAS bf16_t*)(buf(lds, B_KT) + t * PITCH + lane * 2) = (bf16_t)(cvtpk(Kv[u], 0.f) & 0xffffu);
            if (PASS3) *(LAS bf16_t*)(buf(lds, B_RT) + t * PITCH + lane * 2) = (bf16_t)(cvtpk(Rv, 0.f) & 0xffffu);
            if (t == 63) ((LAS float*)(lds + OFF_GC))[lane] = gam; }
        pr[e2] = cvtpk(Pv[0], Pv[1]); qr_[e2] = cvtpk(Qv[0], Qv[1]); kr_[e2] = cvtpk(Kv[0], Kv[1]);
    }
    *(LAS u32x4*)(buf(lds, B_PR) + lane * PITCH + w * 16) = (u32x4){pr[0], pr[1], pr[2], pr[3]};
    *(LAS u32x4*)(buf(lds, B_QR) + lane * PITCH + w * 16) = (u32x4){qr_[0], qr_[1], qr_[2], qr_[3]};
    *(LAS u32x4*)(buf(lds, B_KR) + lane * PITCH + w * 16) = (u32x4){kr_[0], kr_[1], kr_[2], kr_[3]};
    *(LAS u32x4*)(buf(lds, B_VR) + lane * PITCH + w * 16) = (u32x4){R_.vv[0], R_.vv[1], R_.vv[2], R_.vv[3]};
    RW_BAR();
}

__device__ __forceinline__ f32x16 mm_accT(LAS const unsigned char* At, LAS const unsigned char* B, int mt, int nt, int lane, f32x16 acc) {
    const int r32 = lane & 31, hi = lane >> 5;
    LAS const unsigned char* ap = At + (8 * hi + ((lane & 15) >> 2)) * PITCH + (32 * mt + 16 * ((lane >> 4) & 1) + 4 * (lane & 3)) * 2;
    LAS const unsigned char* bp = B + (32 * nt + r32) * PITCH + hi * 16;
#pragma unroll
    for (int ks = 0; ks < 4; ++ks) { const s16x4 lo = vtr(ap + ks * 16 * PITCH), hh = vtr(ap + ks * 16 * PITCH + 4 * PITCH);
        const bf16x8 af = {lo[0], lo[1], lo[2], lo[3], hh[0], hh[1], hh[2], hh[3]};
        acc = __builtin_amdgcn_mfma_f32_32x32x16_bf16(af, *(LAS const bf16x8*)(bp + ks * 32), acc, 0, 0, 0); }
    return acc;
}
template <bool PASS3> __device__ __forceinline__ void core(const Frame& F, bool sT  , f32x16& vk, f32x16& ye) {
    LAS unsigned char* lds = F.lds; const int lane = F.lane, r32 = lane & 31, hi = lane >> 5, q = F.wave & 3, mt = q >> 1, nt = q & 1; const bool g0 = F.wave < 4;
    const f32x16 Z16 = f32x16{};
    f32x16 Tacc = Z16, a1 = Z16;
    if (g0) { f32x16 n = mm_acc(buf(lds, B_QT), buf(lds, B_PT), mt, nt, r32, hi, Z16); mask_upper<true>(n, mt, nt, r32, hi); store_T(n, buf(lds, B_W0), mt, nt, r32, hi);
        Tacc = n;
#pragma unroll
        for (int r = 0; r < 16; ++r) Tacc[r] += (mt == nt && crow(r, hi) == r32) ? 1.f : 0.f;
        store_T(Tacc, buf(lds, B_W2), mt, nt, r32, hi);
    } else { f32x16 m = mm_acc(buf(lds, B_KT), buf(lds, B_PT), mt, nt, r32, hi, Z16); mask_upper<true>(m, mt, nt, r32, hi); store_T(m, buf(lds, B_W3), mt, nt, r32, hi); }
    RW_BAR();
    if (!g0) { const f32x16 n2 = mm_accT(buf(lds, B_W0), buf(lds, B_W0), mt, nt, lane, Z16); store_T(n2, buf(lds, B_W1), mt, nt, r32, hi); }
    else if (PASS3) { f32x16 g3 = mm_acc(buf(lds, B_QT), buf(lds, B_RT), mt, nt, r32, hi, Z16); mask_upper<false>(g3, mt, nt, r32, hi); store_T(g3, buf(lds, B_W4), mt, nt, r32, hi); }
    else { const f32x16 vm = mm_acc(buf(lds, B_VR), buf(lds, B_W3), mt, nt, r32, hi, Z16); store_T(vm, buf(lds, B_W4), mt, nt, r32, hi); }
    RW_BAR();
#pragma unroll
    for (int k = 0; k < 4; ++k) {
        const int cP = (k & 1) ? B_W0 : B_W1, nP = (k & 1) ? B_W1 : B_W0, tIn = (k & 1) ? B_W5 : B_W2, tOut = (k & 1) ? B_W2 : B_W5;
        if (!g0) { const f32x16 p2 = mm_accT(buf(lds, cP), buf(lds, cP), mt, nt, lane, Z16); store_T(p2, buf(lds, nP), mt, nt, r32, hi);
            if (PASS3) {
                if (k == 0) { f32x16 g4 = mm_acc(buf(lds, B_KT), buf(lds, B_RT), mt, nt, r32, hi, Z16); mask_upper<false>(g4, mt, nt, r32, hi); store_T(g4, buf(lds, B_QT), mt, nt, r32, hi); }
                if (k == 1) ye = sT ? mm_accT(buf(lds, B_SB), buf(lds, B_RT), mt, nt, lane, Z16) : mm_acc(buf(lds, B_SB), buf(lds, B_RT), mt, nt, r32, hi, Z16);
                if (k == 2) ye = mm_acc(buf(lds, B_VR), buf(lds, B_QT), mt, nt, r32, hi, ye);
            }
        } else { Tacc = mm_accT(buf(lds, tIn), buf(lds, cP), mt, nt, lane, Tacc); store_T(Tacc, buf(lds, tOut), mt, nt, r32, hi);
            if (PASS3) {
                if (k == 0) a1 = sT ? mm_accT(buf(lds, B_SB), buf(lds, B_PT), mt, nt, lane, Z16) : mm_acc(buf(lds, B_SB), buf(lds, B_PT), mt, nt, r32, hi, Z16);
                if (k == 1) { a1 = mm_acc(buf(lds, B_VR), buf(lds, B_W3), mt, nt, r32, hi, a1); store_T(a1, buf(lds, B_KT), mt, nt, r32, hi); }
                if (k == 2) vk = mm_acc(buf(lds, B_VR), buf(lds, B_KR), mt, nt, r32, hi, Z16);
            }
        }
        RW_BAR();
    }
    if (g0) { Tacc = mm_accT(buf(lds, B_W2), buf(lds, B_W1), mt, nt, lane, Tacc); store_T(Tacc, buf(lds, B_W5), mt, nt, r32, hi); }
    else if (!PASS3) vk = mm_acc(buf(lds, B_VR), buf(lds, B_KR), mt, nt, r32, hi, Z16);
    RW_BAR();
    if (g0) { const f32x16 e = mm_accT(buf(lds, B_W5), buf(lds, B_QR), mt, nt, lane, Z16); store_T(e, buf(lds, B_W0), mt, nt, r32, hi); }
    else if (PASS3) { const f32x16 f = mm_accT(buf(lds, B_W5), buf(lds, B_W4), mt, nt, lane, Z16); store_T(f, buf(lds, B_W1), mt, nt, r32, hi); }
    RW_BAR();
}

__device__ __forceinline__ void pass1_item(const Frame& F, const Args& a, int l, int d, int h, int ci) {
    LAS unsigned char* lds = F.lds; const int lane = F.lane, r32 = lane & 31, hi = lane >> 5, q = F.wave & 3, mt = q >> 1, nt = q & 1; const bool g0 = F.wave < 4;
    const bool ctx = ci == 0; const int nsub = ctx ? 4 : 2, seq = ctx ? 0 : 1, tb = ctx ? 0 : (ci - 1) * TCH;
    float* Qs = (float*)(F.ws + WS_QST) + (size_t)(d * 8 + h) * NCH * 4096; bf16_t* PTg = (bf16_t*)(F.ws + WS_PST) + ((size_t)(d * 8 + h) * NCH + ci) * 4096;
    const f32x16 Z16 = f32x16{};
    for (int sb = 0; sb < nsub; ++sb) {
        { Raw raw; prep_load(F, d, h, seq, tb + 64 * sb, raw); prep<false>(F, a, l, h, raw); }
        f32x16 vk = Z16, ye = Z16;
        core<false>(F, false, vk, ye);
        const float gc = ((LAS const float*)(lds + OFF_GC))[32 * nt + r32];
        f32x16 pq = Z16;
        if (g0) { if (!ctx) { pq = mm_acc(buf(lds, B_PR), buf(lds, B_W0), mt, nt, r32, hi, Z16);
#pragma unroll
                for (int r = 0; r < 16; ++r) pq[r] = (pq[r] + ((mt == nt && crow(r, hi) == r32) ? 1.f : 0.f)) * gc;
                store_T(pq, buf(lds, B_W2), mt, nt, r32, hi); if (sb == 0) store_T(pq, buf(lds, B_SB), mt, nt, r32, hi); }
            else if (sb > 0) { pq = mm_acc(buf(lds, B_PR), buf(lds, B_W0), mt, nt, r32, hi, Z16);
#pragma unroll
                for (int r = 0; r < 16; ++r) pq[r] = (pq[r] + ((mt == nt && crow(r, hi) == r32) ? 1.f : 0.f)) * gc;
                store_T(pq, buf(lds, B_W2), mt, nt, r32, hi); }
        } else { pq = mm_accT(buf(lds, B_W4), buf(lds, B_W0), mt, nt, lane, vk);
#pragma unroll
            for (int r = 0; r < 16; ++r) pq[r] *= gc;
            if (sb == 0) store_T(pq, buf(lds, B_RT), mt, nt, r32, hi); }
        RW_BAR();
        if (sb > 0) {
            if (g0) { if (!ctx) pq = mm_accT(buf(lds, B_SB), buf(lds, B_W2), mt, nt, lane, Z16); }
            else pq = mm_accT(buf(lds, B_RT), buf(lds, B_W2), mt, nt, lane, pq);
            RW_BAR();
            const bool last = sb == nsub - 1;
            if (!g0) {
                if (!last) store_T(pq, buf(lds, B_RT), mt, nt, r32, hi);
                if (last || (ctx && sb == 1)) {
                    float* o = Qs + (size_t)((ctx && sb == 1) ? NCH - 1 : ci) * 4096;
#pragma unroll
                    for (int r = 0; r < 16; ++r) o[(32 * mt + crow(r, hi)) * 64 + 32 * nt + r32] = pq[r];
                }
            } else if (!ctx) {
                if (!last) store_T(pq, buf(lds, B_SB), mt, nt, r32, hi);
                else {
#pragma unroll
                    for (int g = 0; g < 4; ++g) { const int pos = (mt << 5) | ((g >> 1) << 4) | (hi << 3) | ((g & 1) << 2);
                        u32x2 wv = {cvtpk(pq[4 * g], pq[4 * g + 1]), cvtpk(pq[4 * g + 2], pq[4 * g + 3])}; *(u32x2*)(PTg + (32 * nt + r32) * 64 + pos) = wv; }
                }
            }
            RW_BAR();
        }
    }
}
__device__ __forceinline__ void pass3_item(const Frame& F, const Args& a, int l, int d, int h, int pc) {
    LAS unsigned char* lds = F.lds; const int lane = F.lane, r32 = lane & 31, hi = lane >> 5, q = F.wave & 3, mt = q >> 1, nt = q & 1; const bool g0 = F.wave < 4;
    const int seq = pc < 2 ? 0 : 1, tb = pc < 2 ? pc * TCH : (pc - 2) * TCH, slot = pc == 1 ? NCH - 1 : pc - 2;
    bf16_t* Y = (bf16_t*)(F.ws + (d == 0 ? WS_YF : WS_YBK));
    const float* S0g = (const float*)(F.ws + WS_QST) + ((size_t)(d * 8 + h) * NCH + slot) * 4096;
    { const int i = F.tid >> 3, c8 = (F.tid & 7) * 8; u32x4 wv = {0u, 0u, 0u, 0u};
      if (pc != 0) { const float* S0 = S0g + i * 64 + c8; const f32x4 x0 = *(const f32x4*)S0, x1 = *(const f32x4*)(S0 + 4);
          wv = (u32x4){cvtpk(x0[0], x0[1]), cvtpk(x0[2], x0[3]), cvtpk(x1[0], x1[1]), cvtpk(x1[2], x1[3])}; }
      *(LAS u32x4*)(buf(lds, B_SB) + i * PITCH + c8 * 2) = wv; }
    const f32x16 Z16 = f32x16{};
    for (int sb = 0; sb < 2; ++sb) {
        { Raw raw; prep_load(F, d, h, seq, tb + 64 * sb, raw); prep<true>(F, a, l, h, raw); }
        f32x16 vk = Z16, ye = Z16;
        core<true>(F, sb == 1, vk, ye);
        f32x16 s1 = Z16;
        if (!g0) {
            const f32x16 y = mm_accT(buf(lds, B_KT), buf(lds, B_W1), mt, nt, lane, ye);
            const size_t row = (size_t)rw_row2(d, seq, tb + 64 * sb + 32 * nt + r32);
#pragma unroll
            for (int g = 0; g < 4; ++g) { u32x2 wv = {cvtpk(y[4 * g], y[4 * g + 1]), cvtpk(y[4 * g + 2], y[4 * g + 3])}; *(u32x2*)(Y + row * 512 + h * 64 + 32 * mt + 8 * g + 4 * hi) = wv; }
        } else if (sb == 0) {
            const float gc = ((LAS const float*)(lds + OFF_GC))[32 * nt + r32];
            s1 = vk;
            if (pc != 0) {
#pragma unroll
                for (int r = 0; r < 16; ++r) s1[r] += S0g[(32 * mt + crow(r, hi)) * 64 + 32 * nt + r32]; }
            s1 = mm_accT(buf(lds, B_KT), buf(lds, B_W0), mt, nt, lane, s1);
#pragma unroll
            for (int r = 0; r < 16; ++r) s1[r] *= gc;
        }
        RW_BAR();
        if (g0 && sb == 0) store_T(s1, buf(lds, B_SB), mt, nt, r32, hi);
        RW_BAR();
    }
}
#undef RW_BAR
}

__device__ __forceinline__ void norm2_route_rows(const Frame& F, const Args& a, int l, const float* src, const float* g, const float* sh, const float* sc) {
    bf16_t* H = (bf16_t*)(F.ws + WS_H);
    int* ridx = (int*)(F.ws + WS_RT_IDX); int* rpos = (int*)(F.ws + WS_RT_POS); float* rgate = (float*)(F.ws + WS_RT_GATE);
    unsigned* cnt = (unsigned*)(F.ws + WS_CTL) + CW_MOECNT;
    const float* rw = a.in[I_ROUTER];
    f32x4 ca[4], cb[4];
#pragma unroll
    for (int j = 0; j < 4; ++j) { const int d = F.lane * 4 + 256 * j; const f32x4 gg = *(const f32x4*)(g + d), s1 = *(const f32x4*)(sc + d); ca[j] = gg * (s1 + 1.0f); cb[j] = *(const f32x4*)(sh + d); }
    const int gw = F.vcu * NWAVES + F.wave, NGW = F.G * NWAVES;
    for (int m = gw; m < L; m += NGW) {
        const f32x4* xr = (const f32x4*)(src + (size_t)m * DM) + F.lane;
        f32x4 v[4]; float s = 0.f;
#pragma unroll
        for (int j = 0; j < 4; ++j) { v[j] = xr[64 * j]; s += (v[j].x * v[j].x + v[j].y * v[j].y) + (v[j].z * v[j].z + v[j].w * v[j].w); }
        const float rstd = rsqrtf(wave_sum(s) * (1.f / DM) + NORM_EPS);
        u32x2* o8 = (u32x2*)(H + (size_t)m * DM) + F.lane;
        float lg[8] = {0.f, 0.f, 0.f, 0.f, 0.f, 0.f, 0.f, 0.f};
#pragma unroll
        for (int j = 0; j < 4; ++j) { const f32x4 y = v[j] * rstd * ca[j] + cb[j]; u32x2 w; w.x = cvtpk(y.x, y.y); w.y = cvtpk(y.z, y.w); o8[64 * j] = w;
            const float* rp = rw + (size_t)(F.lane * 4 + 256 * j) * 8;
#pragma unroll
            for (int e4 = 0; e4 < 4; ++e4) { const f32x4 w0 = *(const f32x4*)(rp + e4 * 8), w1 = *(const f32x4*)(rp + e4 * 8 + 4);
                const float yy = y[e4];
                lg[0] += yy * w0[0]; lg[1] += yy * w0[1]; lg[2] += yy * w0[2]; lg[3] += yy * w0[3]; lg[4] += yy * w1[0]; lg[5] += yy * w1[1]; lg[6] += yy * w1[2]; lg[7] += yy * w1[3]; } }
#pragma unroll
        for (int e = 0; e < 8; ++e) lg[e] = wave_sum(lg[e]);
        if (F.lane == 0) {
            int i1 = 0; float l1 = lg[0];
#pragma unroll
            for (int e = 1; e < 8; ++e) if (lg[e] > l1) { l1 = lg[e]; i1 = e; }
            int i2 = -1; float l2 = -3.0e38f;
#pragma unroll
            for (int e = 0; e < 8; ++e) if (e != i1 && lg[e] > l2) { l2 = lg[e]; i2 = e; }
            const float g2v = 1.f / (1.f + __expf(l1 - l2)), g1v = 1.f - g2v;
            const unsigned p1 = __hip_atomic_fetch_add(cnt + 64 * i1, 1u, __ATOMIC_RELAXED, __HIP_MEMORY_SCOPE_AGENT);
            const unsigned p2 = __hip_atomic_fetch_add(cnt + 64 * i2, 1u, __ATOMIC_RELAXED, __HIP_MEMORY_SCOPE_AGENT);
            ridx[2 * m] = i1; ridx[2 * m + 1] = i2; rpos[2 * m] = (int)p1; rpos[2 * m + 1] = (int)p2; rgate[2 * m] = g1v; rgate[2 * m + 1] = g2v;
        }
    }
}
__device__ __forceinline__ void moe_tile_bases(const Frame& F, int (&tb)[9]) {
    const unsigned* cnt = (const unsigned*)(F.ws + WS_CTL) + CW_MOECNT;
    int acc = 0;
#pragma unroll
    for (int e = 0; e < 8; ++e) { tb[e] = acc; const unsigned c = __hip_atomic_load(cnt + 64 * e, __ATOMIC_RELAXED, __HIP_MEMORY_SCOPE_AGENT); acc += (int)((c + 255u) >> 8); }
    tb[8] = acc;
}
__device__ __forceinline__ void moe_gather(const Frame& F) {
    const bf16_t* H = (const bf16_t*)(F.ws + WS_H); bf16_t* H2G = (bf16_t*)(F.ws + WS_H2G);
    const int* ridx = (const int*)(F.ws + WS_RT_IDX); const int* rpos = (const int*)(F.ws + WS_RT_POS); const float* rgate = (const float*)(F.ws + WS_RT_GATE);
    float* rowgate = (float*)(F.ws + WS_RT_ROWGATE);
    const unsigned* cnt = (const unsigned*)(F.ws + WS_CTL) + CW_MOECNT;
    int tb[9]; moe_tile_bases(F, tb);
    const int gw = F.vcu * NWAVES + F.wave, NGW = F.G * NWAVES;
    for (int m = gw; m < L; m += NGW) {
        const u32x4 r0 = *((const u32x4*)(H + (size_t)m * DM) + F.lane), r1 = *((const u32x4*)(H + (size_t)m * DM) + 64 + F.lane);
#pragma unroll
        for (int s = 0; s < 2; ++s) {
            const int e = ridx[2 * m + s]; int base = 0;
#pragma unroll
            for (int k = 0; k < 8; ++k) base = (e == k) ? tb[k] : base;
            const size_t row = (size_t)base * 256 + rpos[2 * m + s];
            *((u32x4*)(H2G + row * DM) + F.lane) = r0; *((u32x4*)(H2G + row * DM) + 64 + F.lane) = r1;
            if (F.lane == 0) rowgate[row] = rgate[2 * m + s];
        }
    }
#pragma unroll
    for (int e = 0; e < 8; ++e) {
        const int c = (int)__hip_atomic_load(cnt + 64 * e, __ATOMIC_RELAXED, __HIP_MEMORY_SCOPE_AGENT);
        const int lo = tb[e] * 256 + c, hi_ = tb[e + 1] * 256;
        for (int row = lo + gw; row < hi_; row += NGW) { *((u32x4*)(H2G + (size_t)row * DM) + F.lane) = (u32x4){0u, 0u, 0u, 0u}; *((u32x4*)(H2G + (size_t)row * DM) + 64 + F.lane) = (u32x4){0u, 0u, 0u, 0u}; if (F.lane == 0) rowgate[row] = 0.f; }
    }
}
__device__ __forceinline__ void moe_combine(const Frame& F, float* out, const float* gt2) {
    const bf16_t* YS = (const bf16_t*)(F.ws + WS_H2G);
    const int* ridx = (const int*)(F.ws + WS_RT_IDX); const int* rpos = (const int*)(F.ws + WS_RT_POS);
    int tb[9]; moe_tile_bases(F, tb);
    const int gw = F.vcu * NWAVES + F.wave, NGW = F.G * NWAVES;
    for (int m = gw; m < L; m += NGW) {
        size_t rows[2];
#pragma unroll
        for (int s = 0; s < 2; ++s) { const int e = ridx[2 * m + s]; int base = 0;
#pragma unroll
            for (int k = 0; k < 8; ++k) base = (e == k) ? tb[k] : base;
            rows[s] = (size_t)base * 256 + rpos[2 * m + s]; }
#pragma unroll
        for (int hf = 0; hf < 2; ++hf) {
            const int c0 = hf * 512 + F.lane * 8;
            const u32x4 a0 = *(const u32x4*)(YS + rows[0] * DM + c0), a1 = *(const u32x4*)(YS + rows[1] * DM + c0);
            float* op = out + (size_t)m * DM + c0;
            const f32x4 g0 = *(const f32x4*)(gt2 + c0), g1 = *(const f32x4*)(gt2 + c0 + 4);
            f32x4 x0 = *(const f32x4*)op, x1 = *(const f32x4*)(op + 4);
            x0 += g0 * (f32x4){lo_bf(a0.x) + lo_bf(a1.x), hi_bf(a0.x) + hi_bf(a1.x), lo_bf(a0.y) + lo_bf(a1.y), hi_bf(a0.y) + hi_bf(a1.y)};
            x1 += g1 * (f32x4){lo_bf(a0.z) + lo_bf(a1.z), hi_bf(a0.z) + hi_bf(a1.z), lo_bf(a0.w) + lo_bf(a1.w), hi_bf(a0.w) + hi_bf(a1.w)};
            *(f32x4*)op = x0; *(f32x4*)(op + 4) = x1;
        }
    }
}

#ifndef PROBE_MOE
#define PROBE_MOE 1
#endif
#ifndef PROBE_NA
#define PROBE_NA 1
#endif
#ifndef PROBE_MLA
#define PROBE_MLA 1
#endif
#ifndef PROBE_GEMM
#define PROBE_GEMM 1
#endif
#ifndef PROBE_P1012
#define PROBE_P1012 1
#endif
#ifndef PROBE_P14
#define PROBE_P14 1
#endif
#ifndef PROBE_RW3
#define PROBE_RW3 1
#endif
#ifndef PROBE_RW1
#define PROBE_RW1 1
#endif
#ifndef REP_MLA
#define REP_MLA 1
#endif
#ifndef REP_NA
#define REP_NA 1
#endif
#ifndef REP_RW1
#define REP_RW1 1
#endif
#ifndef REP_RW3
#define REP_RW3 1
#endif
#ifndef REP_GEMM
#define REP_GEMM 1
#endif
#ifndef REP_ROW
#define REP_ROW 1
#endif
#ifndef PROBE_PREFIX
#define PROBE_PREFIX 0
#endif
constexpr int PH_PER_LAYER = 24;
constexpr int N_PHASES = 1 + 2 * PH_PER_LAYER;
__global__ void __launch_bounds__(NTHR, 2) mega_fwd(Args args) {
    extern __shared__ __attribute__((aligned(16))) unsigned char lds_raw[];
    Frame F;
    F.lds = (LAS unsigned char*)lds_raw; F.ws = args.ws;
    F.tid = threadIdx.x; F.lane = F.tid & 63; F.wave = __builtin_amdgcn_readfirstlane((int)threadIdx.x >> 6);
    F.G = gridDim.x; F.bid = blockIdx.x; F.vcu = (F.G % 8 == 0) ? (F.bid % 8) * (F.G / 8) + F.bid / 8 : F.bid;
    volatile LAS unsigned* MISC = (volatile LAS unsigned*)(F.lds + LDS_MISC_OFF);
    if (F.tid < 64) MISC[F.tid] = 0u;
    __syncthreads();
    const int lo = args.ph_lo, hi_full = args.ph_hi;
    const bool multi = (hi_full - lo) > 1;
    XcdBarrier bar; bar.bar = (unsigned*)(F.ws + WS_CTL) + CW_BAR; bar.x = 0; bar.st = MISC + 8;
    if (multi) bar = xcd_barrier_post((unsigned*)(F.ws + WS_CTL) + CW_BAR, MISC + 8);
#define IN(k) (lo <= (k) && (k) < hi)
    const Frame F0 = F;
#define SEAM(k) do { if (multi && (k) < hi) xcd_barrier(bar); } while (0)
    LAS unsigned char* lds = F.lds;
    float* MODV = (float*)(F.ws + WS_MODV);
    float* out = args.out;

    for (int pass_ = 0; pass_ < (PROBE_PREFIX > 0 ? 2 : 1); ++pass_) {
    const int hi = (PROBE_PREFIX > 0 && pass_ == 0) ? PROBE_PREFIX : hi_full;
    if (IN(0)) { const Frame F = launder(F0); prologue_mod(F, args); prologue_weights(F, args); }
    SEAM(0);

#pragma unroll
    for (int l = 0; l < 2; ++l) {
        const int pb = 1 + l * PH_PER_LAYER;
        const bool need_ctx = (l == 0);
        unsigned char* wb = F.ws + WS_W + (size_t)l * WB_SIZE;
        const float* modL = MODV + (size_t)(l * 2) * 6144; const float* modC = modL + 6144;
        float* X1 = (float*)(F.ws + WS_X1); float* CM = (float*)(F.ws + WS_CM);
        bf16_t* H = (bf16_t*)(F.ws + WS_H);
        const int nMall = R / 256, nMlat = L / 256;

        if (IN(pb + 0)) { const Frame F = launder(F0);
            if (l == 0) { norm_rows(F, args.in[I_X], 0, 0, L, args.in[I_N1G] + l * DM, modL, modL + 1024, H);
                          norm_rows(F, args.in[I_CTX], L, L, R, args.in[I_N1G] + l * DM, modC, modC + 1024, H); }
            else { norm_rows(F, X1, 0, 0, L, args.in[I_N1G] + l * DM, modL, modL + 1024, H);
                   norm_rows(F, X1, 0, L, R, args.in[I_N1G] + l * DM, modC, modC + 1024, H); }
        }
        SEAM(pb + 0);
        for (int rq_ = 0; rq_ < PROBE_P14; ++rq_) {
        if (IN(pb + 1)) { const Frame F = launder(F0);
            pg8::Gemm g{H, DM, (const bf16_t*)(wb + WB_WINM), DM}; pg8::StaticOrder S; S.init(nMall, ZM_N / 256, F.G, F.bid, PROBE_GEMM);
            EpiZ E{(bf16_t*)(F.ws + WS_ZA), (bf16_t*)(F.ws + WS_ZN), (bf16_t*)(F.ws + WS_ZR)};
            pg8::gemm_phase(lds, F.tid, g, S, E);
        }
        SEAM(pb + 1);
        if (IN(pb + 2)) { const Frame F = launder(F0); prepare_rows(F, args, l); }
        SEAM(pb + 2);
        if (IN(pb + 3)) { const Frame F = launder(F0);
            { pg8::Gemm g{(const bf16_t*)(F.ws + WS_CQN), 384, (const bf16_t*)(wb + WB_WUQ), 384}; pg8::StaticOrder S; S.init(nMall, 3, F.G, F.bid, PROBE_GEMM);
              EpiBf E{(bf16_t*)(F.ws + WS_QRAW), 768}; pg8::gemm_phase(lds, F.tid, g, S, E); }
            { pg8::Gemm g{(const bf16_t*)(F.ws + WS_CKVN), 256, (const bf16_t*)(wb + WB_WUKV), 256}; pg8::StaticOrder S; S.init(nMall, 4, F.G, F.bid, PROBE_GEMM);
              EpiBf E{(bf16_t*)(F.ws + WS_KVRAW), 1024}; pg8::gemm_phase(lds, F.tid, g, S, E); }
            { pg8::Gemm g{(const bf16_t*)(F.ws + WS_LA), 384, (const bf16_t*)(wb + WB_WLORA), 384}; pg8::StaticOrder S; S.init(nMall, 10, F.G, F.bid, PROBE_GEMM);
              EpiLora E{(bf16_t*)(F.ws + WS_LO), args.in[I_W0] + (size_t)l * 1024, args.in[I_A0] + (size_t)l * 1024}; pg8::gemm_phase(lds, F.tid, g, S, E); }
        }
        SEAM(pb + 3);
        if (IN(pb + 4)) { const Frame F = launder(F0); mla_fixup(F, args, l, need_ctx); }
        SEAM(pb + 4);
        }
        if (IN(pb + 5)) { const Frame F = launder(F0);
            const int xcd = F.bid % 8, idx = F.bid / 8, per = F.G / 8;
            for (int u0 = idx; u0 < 64 * PROBE_MLA + ((need_ctx && idx == 0) ? per : 0); u0 += per) { const int u = u0 >= 64 * PROBE_MLA ? 64 : u0 % 64;
                const bool cu = u >= 64;
                mla_unit(F, xcd, cu ? L : u * 256, cu ? L : 0, cu ? CT / 64 : R / 64);
            }
        }
        SEAM(pb + 5);
        if (IN(pb + 6)) { const Frame F = launder(F0);
            for (int it = F.bid; it < PROBE_RW1 * 16 * 128; it += F.G) { const int ci = (it >> 4) & 127, dh = it & 15;
                rwmm::pass1_item(F, args, l, dh >> 3, dh & 7, ci);
            }
        }
        SEAM(pb + 6);
        if (IN(pb + 7)) { const Frame F = launder(F0);
            const int nrw = F.G > 64 ? 16 : 0;
            if (F.bid < nrw) { if (F.wave < 2) rwkv_pass2(F, F.bid, F.wave); }
            else {
                if (nrw == 0 && F.bid < 16 && F.wave < 2) rwkv_pass2(F, F.bid, F.wave);
                __syncthreads();
                if (need_ctx && F.bid >= F.G - 32) { const int k = F.bid - (F.G - 32); rwmm::pass3_item(F, args, l, k >> 4, (k >> 1) & 7, k & 1); }
                const float* rpb_l = args.in[I_RPB] + (size_t)l * 8 * 465;
                for (int u0 = F.bid - nrw; u0 < PROBE_NA * 2 * (256 + (need_ctx ? 4 : 0)); u0 += F.G - nrw) { const int u = u0 % (2 * (256 + (need_ctx ? 4 : 0))); const int un = u >> 1; na_unit(F, rpb_l, un < 256 ? un : un - 256, un >= 256, u & 1); }
            }
        }
        SEAM(pb + 7);
        if (IN(pb + 8)) { const Frame F = launder(F0);
            for (int it = F.bid; it < PROBE_RW3 * 16 * 128; it += F.G) { const int dh = it & 15, pc = 2 + ((it >> 4) & 127);
                rwmm::pass3_item(F, args, l, dh >> 3, dh & 7, pc);
            }
        }
        SEAM(pb + 8);
        if (IN(pb + 10)) { const Frame F = launder(F0);
            rwkv_output_rows(F, args, l, need_ctx ? R : L);
            __syncthreads();
            pg8::Gemm g{H, DM, (const bf16_t*)(wb + WB_WING), DM}; pg8::StaticOrder S; S.init(need_ctx ? nMall : nMlat, 12, F.G, F.bid, PROBE_GEMM);
            EpiSig E{(bf16_t*)(F.ws + WS_ZG), ZG_LD}; pg8::gemm_phase(lds, F.tid, g, S, E);
        }
        SEAM(pb + 10);
        for (int rp_ = 0; rp_ < PROBE_P1012; ++rp_) {
        if (IN(pb + 11)) { const Frame F = launder(F0);
            pg8::Gemm g{(const bf16_t*)(F.ws + WS_YA), 512, (const bf16_t*)(wb + WB_WOA), 512, (unsigned)(WS_YB - WS_YA), (unsigned)(WB_WOB - WB_WOA)};
            pg8::SegOrder3 S; S.S.init(need_ctx ? nMall : nMlat, 4, F.G, F.bid);
            EpiMerge3 E{(bf16_t*)(F.ws + WS_U), (const bf16_t*)(F.ws + WS_ZG)}; pg8::gemm_phase(lds, F.tid, g, S, E);
        }
        SEAM(pb + 11);
        if (IN(pb + 12)) { const Frame F = launder(F0);
            pg8::Gemm g{(const bf16_t*)(F.ws + WS_U), DM, (const bf16_t*)(wb + WB_WOUT), DM}; pg8::StaticOrder S; S.init(need_ctx ? nMall : nMlat, 4, F.G, F.bid, PROBE_GEMM);
            EpiRes E{l == 0 ? args.in[I_X] : X1, l == 0 ? args.in[I_CTX] : X1 + (size_t)L * DM, out, CM, modL + 2048, modC + 2048};
            pg8::gemm_phase(lds, F.tid, g, S, E);
        }
        SEAM(pb + 12);
        }
        if (l == 0) {
            if (IN(pb + 13)) { const Frame F = launder(F0); norm_rows(F, out, 0, 0, L, args.in[I_N2G] + l * DM, modL + 3072, modL + 4096, H);
                               norm_rows(F, CM, L, L, R, args.in[I_N2G] + l * DM, modC + 3072, modC + 4096, H); }
            SEAM(pb + 13);
            if (IN(pb + 14)) { const Frame F = launder(F0);
                pg8::Gemm g{H, DM, (const bf16_t*)(F.ws + WS_W13), DM}; pg8::StaticOrder S; S.init(nMall, 22, F.G, F.bid, PROBE_GEMM);
                EpiSwiglu E{(bf16_t*)(F.ws + WS_G), FF, 0, 1 << 20}; pg8::gemm_phase(lds, F.tid, g, S, E);
            }
            SEAM(pb + 14);
            if (IN(pb + 15)) { const Frame F = launder(F0);
                pg8::Gemm g{(const bf16_t*)(F.ws + WS_G), FF, (const bf16_t*)(F.ws + WS_W2), FF}; pg8::StaticOrder S; S.init(nMall, 4, F.G, F.bid, PROBE_GEMM);
                EpiRes E{out, CM, X1, X1 + (size_t)L * DM, modL + 5120, modC + 5120};
                pg8::gemm_phase(lds, F.tid, g, S, E);
            }
            SEAM(pb + 15);
        } else {
            if (IN(pb + 13)) { const Frame F = launder(F0); norm2_route_rows(F, args, l, out, args.in[I_N2G] + l * DM, modL + 3072, modL + 4096); }
            SEAM(pb + 13);
            if (IN(pb + 14)) { const Frame F = launder(F0); moe_gather(F); moe_weights(F, args, 0); }
            SEAM(pb + 14);
            int tb[9]; moe_tile_bases(F, tb);
            if (IN(pb + 15)) { const Frame F = launder(F0);
                moe_weights(F, args, 1);
                __syncthreads();
                MoeOrder S{tb[0], tb[1], tb[2], tb[3], tb[4], tb[5], tb[6], tb[7], tb[8], 28, 0, F.G, F.bid, PROBE_MOE};
                pg8::Gemm g{(const bf16_t*)(F.ws + WS_H2G), DM, (const bf16_t*)(F.ws + WS_W13E), DM};
                EpiSwiglu E{(bf16_t*)(F.ws + WS_HID), FFE, 0, 28}; pg8::gemm_phase(lds, F.tid, g, S, E);
            }
            SEAM(pb + 15);
            if (IN(pb + 17)) { const Frame F = launder(F0);
                MoeOrder S{tb[0], tb[1], tb[2], tb[3], tb[4], tb[5], tb[6], tb[7], tb[8], 4, W2E_HI_TILE_SHIFT, F.G, F.bid, PROBE_MOE};
                pg8::Gemm g{(const bf16_t*)(F.ws + WS_HID), FFE, (const bf16_t*)(F.ws + WS_W2E_LO), FFE};
                EpiMoe2 E{(bf16_t*)(F.ws + WS_H2G), (const float*)(F.ws + WS_RT_ROWGATE)}; pg8::gemm_phase(lds, F.tid, g, S, E);
            }
            SEAM(pb + 17);
            if (IN(pb + 19)) { const Frame F = launder(F0); moe_combine(F, out, modL + 5120); }
        }
    }
    }
#undef IN
#undef SEAM
}

#ifndef MK_PER_PHASE
#define MK_PER_PHASE 0
#endif
extern "C" void kernel_launch(void* const* d_in, const int* in_sizes, int n_in, void* d_out, int out_size, void* d_ws, size_t ws_size, hipStream_t stream) {
    static int grid = 0;
    if (grid == 0) {
        if (n_in != 40 || out_size != L * DM || ws_size < 560 * MiB) { fprintf(stderr, "kernel_launch: unexpected shapes (n_in %d out %d ws %zu)\n", n_in, out_size, ws_size); grid = -1; return; }
        int dev = 0, cus = 0, per_cu = 0;
        if (hipGetDevice(&dev) != hipSuccess || hipDeviceGetAttribute(&cus, hipDeviceAttributeMultiprocessorCount, dev) != hipSuccess) { grid = -1; return; }
        if (hipFuncSetAttribute((const void*)mega_fwd, hipFuncAttributeMaxDynamicSharedMemorySize, LDS_BYTES) != hipSuccess) { fprintf(stderr, "kernel_launch: hipFuncSetAttribute failed\n"); grid = -1; return; }
        if (hipOccupancyMaxActiveBlocksPerMultiprocessor(&per_cu, (const void*)mega_fwd, NTHR, LDS_BYTES) != hipSuccess || per_cu < 1) fprintf(stderr, "kernel_launch: occupancy query says %d\n", per_cu);
        (void)hipGetLastError();
        grid = cus;
    }
    if (grid < 0) return;
    (void)hipMemsetAsync((char*)d_ws + WS_CTL, 0, CTL_ZERO_BYTES, stream);
    Args a{};
    for (int i = 0; i < 40; ++i) a.in[i] = (const float*)d_in[i];
    a.out = (float*)d_out; a.ws = (unsigned char*)d_ws;
#if MK_PER_PHASE
    for (int p = 0; p < N_PHASES; ++p) { a.ph_lo = p; a.ph_hi = p + 1; hipLaunchKernelGGL(mega_fwd, dim3(grid), dim3(NTHR), LDS_BYTES, stream, a); }
#else
    a.ph_lo = 0; a.ph_hi = N_PHASES;
    hipLaunchKernelGGL(mega_fwd, dim3(grid), dim3(NTHR), LDS_BYTES, stream, a);
#endif
    const hipError_t le = hipPeekAtLastError();
    if (le != hipSuccess) fprintf(stderr, "kernel_launch: launch failed: %s\n", hipGetErrorName(le));
}
```

```cpp
#include <hip/hip_runtime.h>
#include <cstdio>
#include <cstdint>

#define LAS __attribute__((address_space(3)))
#define GAS __attribute__((address_space(1)))
typedef unsigned short bf16_t;
typedef short bf16x8 __attribute__((ext_vector_type(8)));
typedef short s16x4 __attribute__((ext_vector_type(4)));
typedef float f32x4 __attribute__((ext_vector_type(4)));
typedef float f32x2 __attribute__((ext_vector_type(2)));
typedef float f32x16 __attribute__((ext_vector_type(16)));
typedef unsigned u32x4 __attribute__((ext_vector_type(4)));
typedef unsigned u32x2 __attribute__((ext_vector_type(2)));
typedef __bf16 bf16x2_t __attribute__((ext_vector_type(2)));

constexpr int L = 16384, CT = 256, R = L + CT, DM = 1024, GW = 64;
constexpr int NWAVES = 8, NTHR = 512;
constexpr int ZA_LD = 768, ZN_LD = 1536, ZR_LD = 2048, ZM_N = 4352, ZG_LD = 3072;
constexpr int LO_LD = 2560, RKV_LD = 1536;
constexpr int FF = 2816, FFE = 3584, NEXP = 8;
constexpr int MOE_ROWS = 2 * L + NEXP * 256;
constexpr float NORM_EPS = 1e-6f;
constexpr float LOG2E = 1.4426950408889634f;
constexpr int TCH = 128, NCH = 129;

constexpr size_t MiB = 1u << 20;
constexpr size_t WS_CTL = 0, CTL_ZERO_BYTES = 1 * MiB;
constexpr size_t WS_W = 1 * MiB;
constexpr size_t WB_WINM = 0;
constexpr size_t WB_WING = WB_WINM + (size_t)ZM_N * DM * 2;
constexpr size_t WB_WUQ = WB_WING + (size_t)ZG_LD * DM * 2;
constexpr size_t WB_WUKV = WB_WUQ + (size_t)768 * 384 * 2;
constexpr size_t WB_WLORA = WB_WUKV + (size_t)1024 * 256 * 2;
constexpr size_t WB_WOA = WB_WLORA + (size_t)2560 * 384 * 2;
constexpr size_t WB_WOB = WB_WOA + (size_t)1024 * 512 * 2;
constexpr size_t WB_WOR = WB_WOB + (size_t)1024 * 512 * 2;
constexpr size_t WB_WOUT = WB_WOR + (size_t)1024 * 512 * 2;
constexpr size_t WB_SIZE = WB_WOUT + (size_t)1024 * 1024 * 2;
constexpr size_t WS_W13 = WS_W + 2 * WB_SIZE;
constexpr size_t WS_W2 = WS_W13 + (size_t)2 * FF * DM * 2;
constexpr size_t WS_W_END = WS_W2 + (size_t)DM * FF * 2;
static_assert(WS_W_END <= 67 * MiB, "weights region");
constexpr size_t WS_X1 = 67 * MiB;
constexpr size_t WS_CM = 132 * MiB;
constexpr size_t WS_H = 135 * MiB;
constexpr size_t WS_MISC = 168 * MiB;
constexpr size_t WS_MODV = WS_MISC;
constexpr size_t WS_RT_IDX = WS_MISC + 128 * 1024;
constexpr size_t WS_RT_POS = WS_RT_IDX + 128 * 1024;
constexpr size_t WS_RT_GATE = WS_RT_POS + 128 * 1024;
constexpr size_t WS_RT_ROWGATE = WS_RT_GATE + 128 * 1024;
constexpr size_t WS_KN = WS_MISC + 1 * MiB;
constexpr size_t WS_BIG = 170 * MiB;
constexpr size_t WS_ZN = WS_BIG;
constexpr size_t WS_Q = 219 * MiB, WS_K = 244 * MiB, WS_V = 269 * MiB;
constexpr size_t WS_RKV = 286 * MiB;
constexpr size_t WS_LO = 335 * MiB;
constexpr size_t WS_CQN = 417 * MiB, WS_CKVN = 430 * MiB, WS_LA = 439 * MiB, WS_KR = 452 * MiB;
constexpr size_t WS_YA = 417 * MiB, WS_YB = 434 * MiB;
constexpr size_t WS_ZA = 453 * MiB, WS_ZR = 478 * MiB;
constexpr size_t WS_QRAW = 453 * MiB, WS_KVRAW = 478 * MiB;
constexpr size_t WS_PST = 219 * MiB, WS_QST = 486 * MiB, WS_YF = 519 * MiB, WS_YBK = 536 * MiB, WS_YR = 451 * MiB;
static_assert(WS_YR - WS_YB == WS_YB - WS_YA && WB_WOR - WB_WOB == WB_WOB - WB_WOA, "merge segments");
constexpr size_t WS_ZG = WS_BIG;
constexpr size_t WS_U32 = 335 * MiB;
constexpr size_t WS_U = 286 * MiB;
constexpr size_t WS_G = WS_BIG;
constexpr size_t WS_H2G = 67 * MiB;
constexpr size_t WS_W13E = 170 * MiB;
constexpr size_t WS_W2E_LO = 135 * MiB;
constexpr size_t WS_W2E_HI = 282 * MiB;
constexpr int W2E_HI_TILE_SHIFT = (int)((WS_W2E_HI - WS_W2E_LO) / ((size_t)256 * FFE * 2)) - 16;
static_assert((WS_W2E_HI - WS_W2E_LO) % ((size_t)256 * FFE * 2) == 0 && (W2E_HI_TILE_SHIFT % 4) == 0, "W2E split");
constexpr int MOE_TAIL_ROWS = MOE_ROWS - 2 * L;
constexpr size_t WS_YSP = 170 * MiB;
constexpr size_t WS_HID = 310 * MiB;
constexpr size_t WS_END = 553 * MiB;
static_assert((size_t)16 * NCH * 4096 * 4 <= 33 * MiB, "state slots");
static_assert(WS_ZR + (size_t)R * ZR_LD * 2 <= WS_END, "ws map");
static_assert(WS_HID + (size_t)MOE_ROWS * FFE * 2 <= 549 * MiB, "hid");
constexpr int CW_BAR = 4096;
constexpr int CW_MOECNT = 1024;

#ifndef PROBE_CVT
#define PROBE_CVT 1
#endif
#ifndef PROBE_ROW
#define PROBE_ROW 1
#endif
__device__ __forceinline__ float bf2f(unsigned b) { return __uint_as_float(b << 16); }
__device__ __forceinline__ unsigned cvtpk(float lo, float hi) { f32x2 v = {lo, hi}; bf16x2_t b = __builtin_convertvector(v, bf16x2_t); return __builtin_bit_cast(unsigned, b); }
__device__ __forceinline__ float lo_bf(unsigned w) { return __uint_as_float(w << 16); }
__device__ __forceinline__ float hi_bf(unsigned w) { return __uint_as_float(w & 0xffff0000u); }
__device__ __forceinline__ float wave_sum(float v) {
#pragma unroll
    for (int o = 1; o < 64; o <<= 1) v += __shfl_xor(v, o);
    return v;
}
__device__ __forceinline__ float sigmoidf_(float x) { return 1.f / (1.f + __expf(-x)); }
__device__ __forceinline__ float siluf_(float x) { return x / (1.f + __expf(-x)); }
#define LDS_WAIT() asm volatile("s_waitcnt lgkmcnt(0)" ::: "memory")
#define VM_WAIT() asm volatile("s_waitcnt vmcnt(0)" ::: "memory")

namespace pg8 {
constexpr int BM = 256, BK = 64, HALF = 128, HTB = HALF * BK * 2, STAGE_BYTES = 8 * HTB, NXCD = 8, WGM = 8;
__device__ __forceinline__ int lds_byte(int r, int c) { const int st = (r >> 4) * 2 + (c >> 5), rr = r & 15, cc = c & 31, ob = rr * 64 + cc * 2; return st * 1024 + (ob ^ (((ob >> 9) & 1) << 5)); }
__device__ __forceinline__ void stage_rc(int b, int& R_, int& C_) { const int st = b / 1024, sb = b % 1024, swz = sb ^ (((sb >> 9) & 1) << 5); R_ = (st >> 1) * 16 + swz / 64; C_ = (st & 1) * 32 + (swz % 64) / 2; }
__device__ __forceinline__ int perm32(int rho) { const int n = rho >> 4, i = rho & 15; return 8 * (i >> 2) + 4 * n + (i & 3); }

struct Unit { int pm, pn, seg; };
struct Gemm { const bf16_t* A; int lda; const bf16_t* Bt; int K; unsigned segA = 0, segB = 0; int ldb = 0; };
template <class E> __device__ __forceinline__ bool epi_done(const E&, const Unit&) { return true; }

struct StaticOrder {
    int nM, nN, nwg, G, c, rep;
    __device__ void init(int nM_, int nN_, int G_, int c_, int rep_ = 1) { nM = nM_; nN = nN_; nwg = nM * nN; G = G_; c = c_; rep = rep_; }
    __device__ bool next(int i, Unit& u) const {
        const long Lx = (long)i * G + c; if (Lx >= (long)nwg * rep) return false;
        int wgid = (int)(Lx % nwg); { const int q = nwg / NXCD, r = nwg % NXCD, xcd = wgid % NXCD, off = wgid / NXCD; wgid = (xcd < r ? xcd * (q + 1) : r * (q + 1) + (xcd - r) * q) + off; }
        const int nig = WGM * nN, gid = wgid / nig, fm = gid * WGM, gsz = (nM - fm) < WGM ? (nM - fm) : WGM;
        u.pm = fm + ((wgid % nig) % gsz); u.pn = (wgid % nig) / gsz; u.seg = 0; return true;
    }
};

struct SegOrder3 { StaticOrder S; __device__ bool next(int i, Unit& u) const { if (!S.next(i / 3, u)) return false; u.seg = i % 3; return true; } };
template <class Epi, class Sched>
__device__ __forceinline__ void gemm_phase(LAS unsigned char* lds, const int tid, const Gemm g, const Sched& S, const Epi& E) {
    const int wid = __builtin_amdgcn_readfirstlane(tid >> 6), lane = tid & 63, wr = wid >> 2, wc = wid & 3, fr = lane & 15, fq = lane >> 4;
    const int K = g.K, nt = K / BK, ldb = g.ldb ? g.ldb : K;
    unsigned voffA[2], voffB[2];
#pragma unroll
    for (int i = 0; i < 2; ++i) { int R_, C_; stage_rc(tid * 16 + i * 8192, R_, C_); const int Rb = (R_ & ~31) + perm32(R_ & 31);
        voffA[i] = (unsigned)(R_ * g.lda + C_) * 2u; voffB[i] = (unsigned)(Rb * ldb + C_) * 2u; }
    const size_t kstep = (size_t)(BK * 2);
    const size_t hstepA = (size_t)HALF * g.lda * 2, hstepB = (size_t)HALF * ldb * 2;
    const size_t tstepA = 2 * hstepA, tstepB = 2 * hstepB;
    const unsigned ldsw = (unsigned)wid * 1024u;
    const int aoff = lds_byte(wr * 64 + fr, fq * 8), boff = lds_byte(wc * 32 + fr, fq * 8);
#define PG8_SA(b, h) (((b) * 2 + (h)) * HTB)
#define PG8_SB(b, h) ((4 + (b) * 2 + (h)) * HTB)
#define PG8_STAGE(bufoff, gbase, voff) do { _Pragma("unroll") for (int _i = 0; _i < 2; ++_i) \
        __builtin_amdgcn_global_load_lds((const unsigned*)((const char*)(gbase) + (voff)[_i]), (LAS unsigned*)(lds + (bufoff) + ldsw + _i * 8192), 16, 0, 0); } while (0)
#define PG8_LDA(dst, b, h) do { _Pragma("unroll") for (int m = 0; m < 4; ++m) _Pragma("unroll") for (int k = 0; k < 2; ++k) dst[m][k] = *(const LAS bf16x8*)(lds + PG8_SA(b, h) + aoff + m * 2048 + k * 1024); } while (0)
#define PG8_LDB(dst, b, h) do { _Pragma("unroll") for (int n = 0; n < 2; ++n) _Pragma("unroll") for (int k = 0; k < 2; ++k) dst[n][k] = *(const LAS bf16x8*)(lds + PG8_SB(b, h) + boff + n * 2048 + k * 1024); } while (0)
#define PG8_MMA(ai, bj, At, Bt) do { __builtin_amdgcn_s_setprio(1); _Pragma("unroll") for (int m = 0; m < 4; ++m) _Pragma("unroll") for (int n = 0; n < 2; ++n) _Pragma("unroll") for (int k = 0; k < 2; ++k) \
        acc[ai][bj][m][n] = __builtin_amdgcn_mfma_f32_16x16x32_bf16(Bt[n][k], At[m][k], acc[ai][bj][m][n], 0, 0, 0); __builtin_amdgcn_s_setprio(0); } while (0)
#define PG8_WAIT_V(n) asm volatile("s_waitcnt vmcnt(" #n ")" ::: "memory")
#define PG8_WAIT_L(n) asm volatile("s_waitcnt lgkmcnt(" #n ")" ::: "memory")
#define PG8_BAR __builtin_amdgcn_s_barrier()
#define PG8_SCHED __builtin_amdgcn_sched_barrier(0)
    Unit cur, nxt; int ui = 0;
    if (!S.next(0, cur)) return;
    f32x4 acc[2][2][4][2];
#pragma unroll
    for (int a = 0; a < 2; ++a)
#pragma unroll
        for (int b = 0; b < 2; ++b)
#pragma unroll
            for (int m = 0; m < 4; ++m)
#pragma unroll
                for (int n = 0; n < 2; ++n) acc[a][b][m][n] = (f32x4){0.f, 0.f, 0.f, 0.f};
    bf16x8 At[4][2], B0[2][2], B1[2][2];
    const char* cA = (const char*)g.A + (size_t)cur.pm * tstepA + (size_t)cur.seg * g.segA; const char* cB = (const char*)g.Bt + (size_t)cur.pn * tstepB + (size_t)cur.seg * g.segB;
    PG8_STAGE(PG8_SB(0, 0), cB, voffB); PG8_STAGE(PG8_SB(0, 1), cB + hstepB, voffB); PG8_STAGE(PG8_SA(0, 0), cA, voffA); PG8_STAGE(PG8_SA(0, 1), cA + hstepA, voffA);
    if (wr == 1) PG8_BAR;
    PG8_WAIT_V(2); PG8_BAR;
    PG8_STAGE(PG8_SB(1, 0), cB + kstep, voffB); PG8_STAGE(PG8_SA(1, 0), cA + kstep, voffA); PG8_STAGE(PG8_SB(1, 1), cB + hstepB + kstep, voffB);
    PG8_WAIT_V(6); PG8_BAR;
    for (;;) {
        const bool has_next = S.next(ui + 1, nxt);
        const char* nA = has_next ? (const char*)g.A + (size_t)nxt.pm * tstepA + (size_t)nxt.seg * g.segA : cA; const char* nB = has_next ? (const char*)g.Bt + (size_t)nxt.pn * tstepB + (size_t)nxt.seg * g.segB : cB;
        for (int t = 0; t < nt; t += 2) {
            const bool last = (t == nt - 2);
            const char* a1 = cA + (size_t)(t + 1) * kstep;
            const char* a2 = last ? nA : cA + (size_t)(t + 2) * kstep; const char* b2 = last ? nB : cB + (size_t)(t + 2) * kstep;
            const char* a3 = a2 + kstep; const char* b3 = b2 + kstep;
            PG8_LDB(B0, 0, 0); PG8_LDB(B1, 0, 1); PG8_SCHED; PG8_LDA(At, 0, 0); PG8_STAGE(PG8_SA(1, 1), a1 + hstepA, voffA);
            PG8_WAIT_V(8); PG8_WAIT_L(0); PG8_BAR; PG8_MMA(0, 0, At, B0); PG8_MMA(0, 1, At, B1); PG8_BAR; PG8_SCHED;
            PG8_LDA(At, 0, 1); PG8_STAGE(PG8_SB(0, 0), b2, voffB); PG8_STAGE(PG8_SB(0, 1), b2 + hstepB, voffB); PG8_STAGE(PG8_SA(0, 0), a2, voffA);
            PG8_WAIT_V(8); PG8_WAIT_L(0); PG8_BAR; PG8_MMA(1, 0, At, B0); PG8_MMA(1, 1, At, B1); PG8_BAR; PG8_SCHED;
            PG8_LDB(B0, 1, 0); PG8_LDB(B1, 1, 1); PG8_SCHED; PG8_LDA(At, 1, 0); PG8_STAGE(PG8_SA(0, 1), a2 + hstepA, voffA);
            PG8_WAIT_V(8); PG8_WAIT_L(0); PG8_BAR; PG8_MMA(0, 0, At, B0); PG8_MMA(0, 1, At, B1); PG8_BAR; PG8_SCHED;
            PG8_LDA(At, 1, 1); PG8_STAGE(PG8_SB(1, 0), b3, voffB); PG8_STAGE(PG8_SB(1, 1), b3 + hstepB, voffB); PG8_STAGE(PG8_SA(1, 0), a3, voffA);
            PG8_WAIT_V(8); PG8_WAIT_L(0); PG8_BAR; PG8_MMA(1, 0, At, B0); PG8_MMA(1, 1, At, B1); PG8_BAR; PG8_SCHED;
        }
        if (wr == 0) PG8_BAR;
        E(acc, cur, wr, wc, fr, fq);
        if (!has_next) break;
        if (epi_done(E, cur)) {
#pragma unroll
        for (int a = 0; a < 2; ++a)
#pragma unroll
            for (int b = 0; b < 2; ++b)
#pragma unroll
                for (int m = 0; m < 4; ++m)
#pragma unroll
                    for (int n = 0; n < 2; ++n) acc[a][b][m][n] = (f32x4){0.f, 0.f, 0.f, 0.f};
        }
        cur = nxt; cA = nA; cB = nB; ++ui;
        if (wr == 1) PG8_BAR;
    }
    PG8_WAIT_V(0);
    PG8_BAR;
#undef PG8_SA
#undef PG8_SB
#undef PG8_STAGE
#undef PG8_LDA
#undef PG8_LDB
#undef PG8_MMA
#undef PG8_WAIT_V
#undef PG8_WAIT_L
#undef PG8_BAR
#undef PG8_SCHED
}

template <class F> __device__ __forceinline__ void epi_each(const f32x4 (&acc)[2][2][4][2], const Unit& u, int wr, int wc, int fr, int fq, F&& f) {
    const int row0 = u.pm * BM + wr * 64 + fr, col0 = u.pn * BM + wc * 32 + 8 * fq;
#pragma unroll
    for (int ai = 0; ai < 2; ++ai)
#pragma unroll
        for (int m = 0; m < 4; ++m)
#pragma unroll
            for (int bj = 0; bj < 2; ++bj) f(row0 + ai * HALF + m * 16, col0 + bj * HALF, acc[ai][bj][m][0], acc[ai][bj][m][1]);
}
__device__ __forceinline__ void st_bf16x8(bf16_t* p, f32x4 v0, f32x4 v1) {
    u32x4 w; w.x = cvtpk(v0[0], v0[1]); w.y = cvtpk(v0[2], v0[3]); w.z = cvtpk(v1[0], v1[1]); w.w = cvtpk(v1[2], v1[3]); *(u32x4*)p = w;
}
}
#include <hip/hip_runtime.h>
#include <cstdio>
#include <cstdint>
#include <cstdlib>
#include <vector>

#define XB_TMO      128
#define XB_XCNT(j)  (256  + 64 * (j))
#define XB_XSUB(j)  (1280 + 64 * (j))
#define XB_XGEN(j)  (2304 + 64 * (j))
#define XB_TOP      3328
#define XB_TOPGEN   3392
#define XCD_BAR_WORDS 3456
#define XB_SPIN_CAP (1u << 18)

__device__ __forceinline__ unsigned xb_ld(unsigned* p)              { return __hip_atomic_load(p, __ATOMIC_RELAXED, __HIP_MEMORY_SCOPE_AGENT); }
__device__ __forceinline__ unsigned xb_add(unsigned* p, unsigned v) { return __hip_atomic_fetch_add(p, v, __ATOMIC_RELAXED, __HIP_MEMORY_SCOPE_AGENT); }
__device__ __forceinline__ unsigned xb_xcc_id() { return (unsigned)__builtin_amdgcn_s_getreg((3 << 11) | 20) & 0xFu; }
#define XB_SPIN(cond, bar) do { unsigned _sp = 0; while (cond) { __builtin_amdgcn_s_sleep(1); \
    if ((++_sp & 255u) == 0u) { if (xb_ld(&(bar)[XB_TMO])) break; if (_sp > XB_SPIN_CAP) { atomicAdd(&(bar)[XB_TMO], 1u); break; } } } } while (0)

struct XcdBarrier {
    unsigned* bar; unsigned x;
    volatile LAS unsigned* st;
};

__device__ __forceinline__ XcdBarrier xcd_barrier_post(unsigned* bar, volatile LAS unsigned* st) {
    XcdBarrier b; b.bar = bar; b.x = xb_xcc_id(); b.st = st;
    if (threadIdx.x == 0) (void)xb_add(&bar[XB_XCNT(b.x)], 1u);
    return b;
}
__device__ __forceinline__ void xcd_barrier_complete(unsigned* bar, unsigned x, unsigned& nloc, unsigned& nx) {
    const unsigned G = gridDim.x * gridDim.y * gridDim.z;
    unsigned sum, cnt, mine, sp = 0u;
    for (;;) {
        sum = 0u; cnt = 0u; mine = 0u;
#pragma unroll
        for (unsigned j = 0; j < 16; ++j) { const unsigned c = xb_ld(&bar[XB_XCNT(j)]); sum += c; cnt += (c > 0u) ? 1u : 0u; mine = (j == x) ? c : mine; }
        if (sum == G) break;
        __builtin_amdgcn_s_sleep(1);
        if ((++sp & 255u) == 0u) { if (xb_ld(&bar[XB_TMO])) break; if (sp > XB_SPIN_CAP) { atomicAdd(&bar[XB_TMO], 1u); break; } }
    }
    nloc = mine > 0u ? mine : 1u; nx = cnt > 0u ? cnt : 1u;
}

__device__ __forceinline__ void xcd_barrier(const XcdBarrier& b) {
    asm volatile("s_waitcnt vmcnt(0)" ::: "memory");
    __syncthreads();
    if (threadIdx.x == 0) {
        unsigned* bar = b.bar;
        __builtin_amdgcn_s_waitcnt(0);
        unsigned nloc = b.st[0], nx = b.st[1];
        if (nloc == 0u) { xcd_barrier_complete(bar, b.x, nloc, nx); b.st[0] = nloc; b.st[1] = nx; }
        const unsigned old = xb_add(&bar[XB_XSUB(b.x)], 1u);
        const unsigned gen = old / nloc;
        if (old + 1u == (gen + 1u) * nloc) {
            __builtin_amdgcn_fence(__ATOMIC_RELEASE, "agent");
            asm volatile("s_waitcnt vmcnt(0)" ::: "memory");
            const unsigned og = xb_add(&bar[XB_TOP], 1u);
            const unsigned tg = og / nx;
            if (og + 1u == (tg + 1u) * nx) xb_add(&bar[XB_TOPGEN], 1u);
            else XB_SPIN(xb_ld(&bar[XB_TOPGEN]) == tg, bar);
            __builtin_amdgcn_fence(__ATOMIC_ACQUIRE, "agent");
            xb_add(&bar[XB_XGEN(b.x)], 1u);
            asm volatile("s_waitcnt vmcnt(0)" ::: "memory");
        } else {
            XB_SPIN(xb_ld(&bar[XB_XGEN(b.x)]) == gen, bar);
            __builtin_amdgcn_fence(__ATOMIC_ACQUIRE, "agent");
            asm volatile("s_waitcnt vmcnt(0)" ::: "memory");
        }
    }
    __syncthreads();
}


constexpr int LDS_BYTES = 147456;
constexpr int LDS_MISC_OFF = 146432;
struct Args { const float* in[40]; float* out; unsigned char* ws; int ph_lo, ph_hi; };
enum { I_X = 0, I_C, I_CTX, I_CCTX, I_MODW, I_MODB, I_N1G, I_N2G, I_WIN, I_CQG, I_WUQ, I_CKVG, I_WUKV, I_QNG, I_KNG, I_MLAWO,
       I_NAQG, I_NAKG, I_RPB, I_NAWO, I_MU, I_W0, I_W2, I_A0, I_A2, I_G2, I_KK, I_KA, I_RK, I_LNG, I_LNB, I_RWWO, I_WOUT,
       I_F1, I_F3, I_F2, I_ROUTER, I_M1, I_M3, I_M2 };

struct Frame {
    LAS unsigned char* lds;
    unsigned char* ws;
    int tid, lane, wave, G, vcu, bid;
};

__device__ __forceinline__ Frame launder(const Frame& F) {
    Frame P = F; int w = F.wave, v = F.vcu, b = F.bid; unsigned long long wi = (unsigned long long)F.ws;
    asm volatile("" : "+s"(w), "+s"(v), "+s"(b), "+s"(wi));
    int ln = (int)__builtin_amdgcn_mbcnt_hi(~0u, __builtin_amdgcn_mbcnt_lo(~0u, 0u));
    asm volatile("" : "+v"(ln));
    P.tid = w * 64 + ln; P.lane = ln; P.wave = w; P.vcu = v; P.bid = b;
    P.ws = (unsigned char*)(GAS unsigned char*)wi;
    return P;
}
__device__ __forceinline__ void tr_item(const float* src, int lds_, int scol0, bf16_t* dst, int ldd, int drow0, int koff, int nblk, int ileave, int item, LAS float* scr, int lane) {
    const int kb = item / nblk, nb = item - kb * nblk, k0 = 64 * kb, n0 = 32 * nb;
    {
        f32x4 v[8]; const int c4 = (lane & 7) * 4, r8 = lane >> 3;
        const float* sp = src + (size_t)(k0 + r8) * lds_ + scol0 + n0 + c4;
#pragma unroll
        for (int i = 0; i < 8; ++i) v[i] = *(const f32x4*)(sp + (size_t)(8 * i) * lds_);
#pragma unroll
        for (int i = 0; i < 8; ++i) { LAS float* d = scr + (8 * i + r8) * 33 + c4; d[0] = v[i][0]; d[1] = v[i][1]; d[2] = v[i][2]; d[3] = v[i][3]; }
    }
    LDS_WAIT(); asm volatile("" ::: "memory");
    const int c = lane & 7;
#pragma unroll
    for (int j = 0; j < 4; ++j) { const int n = (lane >> 3) + 8 * j; const LAS float* s = scr + (8 * c) * 33 + n;
        u32x4 o; o.x = cvtpk(s[0 * 33], s[1 * 33]); o.y = cvtpk(s[2 * 33], s[3 * 33]); o.z = cvtpk(s[4 * 33], s[5 * 33]); o.w = cvtpk(s[6 * 33], s[7 * 33]);
        const int nn = n0 + n; const int drow = ileave ? drow0 + (nn >> 7) * 256 + (nn & 127) : drow0 + nn;
        *(u32x4*)(dst + (size_t)drow * ldd + koff + k0 + 8 * c) = o; }
    LDS_WAIT(); asm volatile("" ::: "memory");
}
__device__ __forceinline__ void zero_item(bf16_t* dst, int ldd, int drow0, int koff, int nblk, int item, int lane) {
    const int kb = item / nblk, nb = item - kb * nblk, k0 = 64 * kb, n0 = 32 * nb, c = lane & 7;
#pragma unroll
    for (int j = 0; j < 4; ++j) { const int n = (lane >> 3) + 8 * j; *(u32x4*)(dst + (size_t)(drow0 + n0 + n) * ldd + koff + k0 + 8 * c) = (u32x4){0u, 0u, 0u, 0u}; }
}

#define TRJOB(NITEMS, CALL) { const int _n = (NITEMS); if (r < _n) { CALL; continue; } r -= _n; }
__device__ __forceinline__ void prologue_weights(const Frame& F, const Args& a) {
    LAS float* scr = (LAS float*)(F.lds + F.wave * 16384);
    const int gw = F.vcu * NWAVES + F.wave, NGW = F.G * NWAVES;
    constexpr int PER_LAYER = 16 * 21 + 16 * 3   + 16 * 108   + 16 * 4   + 16 * 96
                              + 6 * 24   + 4 * 32   + 6 * 80   + 3 * 8 * 32   + 16 * 32  ;
    constexpr int FFN_ITEMS = 2 * 16 * 88 + 44 * 32;
    constexpr int NITEMS = 2 * PER_LAYER + FFN_ITEMS;
    for (int it0 = gw; it0 < NITEMS * PROBE_CVT; it0 += NGW) { const int it = it0 % NITEMS;
        int r = it;
        bool done = false;
        for (int l = 0; l < 2 && !done; ++l) {
            if (r >= PER_LAYER) { r -= PER_LAYER; continue; }
            done = true;
            unsigned char* wb = F.ws + WS_W + (size_t)l * WB_SIZE;
            bf16_t* WinM = (bf16_t*)(wb + WB_WINM); bf16_t* WinG = (bf16_t*)(wb + WB_WING);
            const float* win = a.in[I_WIN] + (size_t)l * DM * 7200;
            do {
                if (r < 16 * 21) { tr_item(win, 7200, 0, WinM, DM, 0, 0, 21, 0, r, scr, F.lane); break; } r -= 16 * 21;
                if (r < 16 * 3) { zero_item(WinM, DM, 672, 0, 3, r, F.lane); break; } r -= 16 * 3;
                if (r < 16 * 108) { tr_item(win, 7200, 672, WinM, DM, 768, 0, 108, 0, r, scr, F.lane); break; } r -= 16 * 108;
                if (r < 16 * 4) { zero_item(WinM, DM, 4224, 0, 4, r, F.lane); break; } r -= 16 * 4;
                if (r < 16 * 96) { tr_item(win, 7200, 4128, WinG, DM, 0, 0, 96, 0, r, scr, F.lane); break; } r -= 16 * 96;
                if (r < 6 * 24) { tr_item(a.in[I_WUQ] + (size_t)l * 384 * 768, 768, 0, (bf16_t*)(wb + WB_WUQ), 384, 0, 0, 24, 0, r, scr, F.lane); break; } r -= 6 * 24;
                if (r < 4 * 32) { tr_item(a.in[I_WUKV] + (size_t)l * 256 * 1024, 1024, 0, (bf16_t*)(wb + WB_WUKV), 256, 0, 0, 32, 0, r, scr, F.lane); break; } r -= 4 * 32;
                if (r < 6 * 80) {
                    bf16_t* Wl = (bf16_t*)(wb + WB_WLORA);
                    const int kb = r / 80, nb = r % 80, s = nb / 16;
                    const int koff = s < 4 ? 64 * s : 256, Ks = s < 4 ? 64 : 128;
                    const int k0 = 64 * kb;
                    if (k0 >= koff && k0 < koff + Ks) {
                        const float* src = s < 2 ? a.in[I_W2] + ((size_t)l * 2 + s) * 64 * 512 : s < 4 ? a.in[I_A2] + ((size_t)l * 2 + (s - 2)) * 64 * 512 : a.in[I_G2] + (size_t)l * 128 * 512;
                        const int sub = ((k0 - koff) / 64) * 16 + (nb % 16);
                        tr_item(src, 512, 0, Wl, 384, 512 * s, koff, 16, 0, sub, scr, F.lane);
                    } else zero_item(Wl, 384, 0, 0, 80, r, F.lane);
                    break; } r -= 6 * 80;
                if (r < 3 * 8 * 32) { const int b = r / 256, rr = r % 256;
                    const float* src = (b == 0 ? a.in[I_MLAWO] : b == 1 ? a.in[I_NAWO] : a.in[I_RWWO]) + (size_t)l * 512 * 1024;
                    tr_item(src, 1024, 0, (bf16_t*)(wb + (b == 0 ? WB_WOA : b == 1 ? WB_WOB : WB_WOR)), 512, 0, 0, 32, 0, rr, scr, F.lane); break; } r -= 3 * 8 * 32;
                tr_item(a.in[I_WOUT] + (size_t)l * 1024 * 1024, 1024, 0, (bf16_t*)(wb + WB_WOUT), 1024, 0, 0, 32, 0, r, scr, F.lane);
            } while (0);
        }
        if (done) continue;
        if (r < 16 * 88) { tr_item(a.in[I_F1], FF, 0, (bf16_t*)(F.ws + WS_W13), DM, 0, 0, 88, 1, r, scr, F.lane); continue; } r -= 16 * 88;
        if (r < 16 * 88) { tr_item(a.in[I_F3], FF, 0, (bf16_t*)(F.ws + WS_W13), DM, 128, 0, 88, 1, r, scr, F.lane); continue; } r -= 16 * 88;
        tr_item(a.in[I_F2], DM, 0, (bf16_t*)(F.ws + WS_W2), FF, 0, 0, 32, 0, r, scr, F.lane);
    }
}
__device__ __forceinline__ void moe_weights(const Frame& F, const Args& a, int part) {
    LAS float* scr = (LAS float*)(F.lds + F.wave * 16384);
    const int gw = F.vcu * NWAVES + F.wave, NGW = F.G * NWAVES;
    constexpr int I13 = 16 * 112, I2 = 56 * 32;
    if (part == 0) {
        constexpr int NIT = NEXP * 2 * I13 + 4 * I2;
        for (int it0 = gw; it0 < NIT * PROBE_CVT; it0 += NGW) { const int it = it0 % NIT;
            if (it < NEXP * 2 * I13) { const int e = it / (2 * I13); int r = it - e * 2 * I13;
                bf16_t* w13 = (bf16_t*)(F.ws + WS_W13E) + (size_t)e * 2 * FFE * DM;
                if (r < I13) tr_item(a.in[I_M1] + (size_t)e * DM * FFE, FFE, 0, w13, DM, 0, 0, 112, 1, r, scr, F.lane);
                else tr_item(a.in[I_M3] + (size_t)e * DM * FFE, FFE, 0, w13, DM, 128, 0, 112, 1, r - I13, scr, F.lane);
            } else { const int q = it - NEXP * 2 * I13, e = 4 + q / I2, r = q % I2;
                tr_item(a.in[I_M2] + (size_t)e * FFE * DM, DM, 0, (bf16_t*)(F.ws + WS_W2E_HI) + (size_t)(e - 4) * DM * FFE, FFE, 0, 0, 32, 0, r, scr, F.lane); }
        }
    } else {
        for (int it = gw; it < 4 * I2; it += NGW) { const int e = it / I2, r = it % I2;
            tr_item(a.in[I_M2] + (size_t)e * FFE * DM, DM, 0, (bf16_t*)(F.ws + WS_W2E_LO) + (size_t)e * DM * FFE, FFE, 0, 0, 32, 0, r, scr, F.lane); }
    }
}

__device__ __forceinline__ void prologue_mod(const Frame& F, const Args& a) {
    LAS float* sl = (LAS float*)(F.lds);
    LAS float* part = sl + 2048;
    if (F.bid >= 192) return;
    const int l = F.bid / 96, nb = F.bid % 96;
    for (int i = F.tid; i < 2048; i += NTHR) { const float v = i < 1024 ? a.in[I_C][i] : a.in[I_CCTX][i - 1024]; sl[i] = siluf_(v); }
    __syncthreads();
    const int col = F.tid & 63, kg = F.tid >> 6, n = nb * 64 + col;
    const float* W = a.in[I_MODW] + (size_t)l * DM * 6144 + n;
    float aL = 0.f, aC = 0.f;
#pragma unroll 32
    for (int k = kg * 128; k < kg * 128 + 128; ++k) { const float w = W[(size_t)k * 6144]; aL += sl[k] * w; aC += sl[1024 + k] * w; }
    part[(kg * 64 + col) * 2] = aL; part[(kg * 64 + col) * 2 + 1] = aC;
    __syncthreads();
    if (F.tid < 128) { const int c2 = F.tid & 63, which = F.tid >> 6; float s = 0.f;
#pragma unroll
        for (int k = 0; k < 8; ++k) s += part[(k * 64 + c2) * 2 + which];
        const int nn = nb * 64 + c2;
        ((float*)(F.ws + WS_MODV))[(size_t)(l * 2 + which) * 6144 + nn] = s + a.in[I_MODB][(size_t)l * 6144 + nn]; }
    __syncthreads();
}

__device__ __forceinline__ void norm_rows(const Frame& F, const float* src, int src_row0, int m0, int m1, const float* g, const float* sh, const float* sc, bf16_t* dst) {
    f32x4 ca[4], cb[4];
#pragma unroll
    for (int j = 0; j < 4; ++j) { const int d = F.lane * 4 + 256 * j; const f32x4 gg = *(const f32x4*)(g + d), s1 = *(const f32x4*)(sc + d); ca[j] = gg * (s1 + 1.0f); cb[j] = *(const f32x4*)(sh + d); }
    const int gw = F.vcu * NWAVES + F.wave, NGW = F.G * NWAVES;
    for (int mm = gw; mm < (m1 - m0) * PROBE_ROW; mm += NGW) { const int m = m0 + mm % (m1 - m0);
        const f32x4* xr = (const f32x4*)(src + (size_t)(m - src_row0) * DM) + F.lane;
        f32x4 v[4]; float s = 0.f;
#pragma unroll
        for (int j = 0; j < 4; ++j) { v[j] = xr[64 * j]; s += (v[j].x * v[j].x + v[j].y * v[j].y) + (v[j].z * v[j].z + v[j].w * v[j].w); }
        const float rstd = rsqrtf(wave_sum(s) * (1.f / DM) + NORM_EPS);
        u32x2* o8 = (u32x2*)(dst + (size_t)m * DM) + F.lane;
#pragma unroll
        for (int j = 0; j < 4; ++j) { const f32x4 y = v[j] * rstd * ca[j] + cb[j]; u32x2 w; w.x = cvtpk(y.x, y.y); w.y = cvtpk(y.z, y.w); o8[64 * j] = w; }
    }
}

using pg8::Unit;
struct EpiZ {
    bf16_t *za, *zn, *zr;
    __device__ __forceinline__ void operator()(const f32x4 (&acc)[2][2][4][2], const Unit& u, int wr, int wc, int fr, int fq) const {
        bf16_t* base; int ld, ct;
        if (u.pn < 3) { base = za; ld = ZA_LD; ct = u.pn; } else if (u.pn < 9) { base = zn; ld = ZN_LD; ct = u.pn - 3; } else { base = zr; ld = ZR_LD; ct = u.pn - 9; }
        const int cshift = (ct - u.pn) * 256;
        pg8::epi_each(acc, u, wr, wc, fr, fq, [&](int row, int col, f32x4 v0, f32x4 v1) { pg8::st_bf16x8(base + (size_t)row * ld + col + cshift, v0, v1); });
    }
};
struct EpiBf {
    bf16_t* o; int ld;
    __device__ __forceinline__ void operator()(const f32x4 (&acc)[2][2][4][2], const Unit& u, int wr, int wc, int fr, int fq) const {
        pg8::epi_each(acc, u, wr, wc, fr, fq, [&](int row, int col, f32x4 v0, f32x4 v1) { pg8::st_bf16x8(o + (size_t)row * ld + col, v0, v1); });
    }
};
__device__ __forceinline__ f32x4 lora_fn(f32x4 v, const float* bias, int seg) {
    if (seg < 4) { const f32x4 b = *(const f32x4*)bias;
#pragma unroll
        for (int e = 0; e < 4; ++e) { const float x = b[e] + v[e];
            if (seg < 2) { const float y = -x; const float sp = fmaxf(y, 0.f) + __logf(1.f + __expf(-fabsf(y))); v[e] = -__expf(-sp - 0.5f); }
            else v[e] = sigmoidf_(x); } }
    return v;
}
struct EpiLora {
    bf16_t* o; const float* w0; const float* a0;
    __device__ __forceinline__ void operator()(const f32x4 (&acc)[2][2][4][2], const Unit& u, int wr, int wc, int fr, int fq) const {
        const int seg = u.pn >> 1;
        const float* bias = seg < 2 ? w0 : a0 - 1024;
        pg8::epi_each(acc, u, wr, wc, fr, fq, [&](int row, int col, f32x4 v0, f32x4 v1) {
            const f32x4 r0 = lora_fn(v0, bias + col, seg), r1 = lora_fn(v1, bias + col + 4, seg);
            pg8::st_bf16x8(o + (size_t)row * LO_LD + col, r0, r1);
        });
    }
};
struct EpiSig {
    bf16_t* o; int ld;
    __device__ __forceinline__ void operator()(const f32x4 (&acc)[2][2][4][2], const Unit& u, int wr, int wc, int fr, int fq) const {
        pg8::epi_each(acc, u, wr, wc, fr, fq, [&](int row, int col, f32x4 v0, f32x4 v1) {
            f32x4 r0, r1;
#pragma unroll
            for (int e = 0; e < 4; ++e) { r0[e] = fmaxf(sigmoidf_(v0[e]), 1e-13f); r1[e] = fmaxf(sigmoidf_(v1[e]), 1e-13f); }
            pg8::st_bf16x8(o + (size_t)row * ld + col, r0, r1); });
    }
};
struct EpiMerge3 {
    bf16_t* ub; const bf16_t* zg;
    __device__ __forceinline__ void operator()(f32x4 (&acc)[2][2][4][2], const Unit& u, int wr, int wc, int fr, int fq) const {
        const int row0 = u.pm * 256 + wr * 64 + fr, col0 = u.pn * 256 + wc * 32 + 8 * fq;
        if (u.seg < 2) {
            const bf16_t* z = zg + u.seg * 1024 + (size_t)row0 * ZG_LD + col0;
#pragma unroll
            for (int ai = 0; ai < 2; ++ai)
#pragma unroll
                for (int m = 0; m < 4; ++m)
#pragma unroll
                    for (int bj = 0; bj < 2; ++bj) {
                        const bf16_t* p = z + (size_t)(ai * 128 + m * 16) * ZG_LD + bj * 128;
                        const u32x4 ga = *(const u32x4*)p, gb = *(const u32x4*)(p + 1024);
                        const float a_[8] = {lo_bf(ga.x), hi_bf(ga.x), lo_bf(ga.y), hi_bf(ga.y), lo_bf(ga.z), hi_bf(ga.z), lo_bf(ga.w), hi_bf(ga.w)};
                        const float b_[8] = {lo_bf(gb.x), hi_bf(gb.x), lo_bf(gb.y), hi_bf(gb.y), lo_bf(gb.z), hi_bf(gb.z), lo_bf(gb.w), hi_bf(gb.w)};
#pragma unroll
                        for (int e = 0; e < 4; ++e) { acc[ai][bj][m][0][e] *= a_[e] * __builtin_amdgcn_rcpf(b_[e]); acc[ai][bj][m][1][e] *= a_[4 + e] * __builtin_amdgcn_rcpf(b_[4 + e]); }
                    }
        } else {
            const bf16_t* z = zg + 2048;
            pg8::epi_each(acc, u, wr, wc, fr, fq, [&](int row, int col, f32x4 v0, f32x4 v1) {
                const u32x4 gw = *(const u32x4*)(z + (size_t)row * ZG_LD + col);
                const f32x4 g0 = {lo_bf(gw.x), hi_bf(gw.x), lo_bf(gw.y), hi_bf(gw.y)}, g1 = {lo_bf(gw.z), hi_bf(gw.z), lo_bf(gw.w), hi_bf(gw.w)};
                pg8::st_bf16x8(ub + (size_t)row * DM + col, g0 * v0, g1 * v1); });
        }
    }
};
__device__ __forceinline__ bool epi_done(const EpiMerge3&, const Unit& u) { return u.seg == 2; }
struct EpiRes {
    const float* resL; const float* resC; float* outL; float* outC; const float* gateL; const float* gateC;
    __device__ __forceinline__ void operator()(const f32x4 (&acc)[2][2][4][2], const Unit& u, int wr, int wc, int fr, int fq) const {
        const bool isc = u.pm >= L / 256;
        const float* res = isc ? resC - (size_t)L * DM : resL; float* out = isc ? outC - (size_t)L * DM : outL; const float* gate = isc ? gateC : gateL;
        pg8::epi_each(acc, u, wr, wc, fr, fq, [&](int row, int col, f32x4 v0, f32x4 v1) {
            const size_t o = (size_t)row * DM + col;
            const f32x4 g0 = *(const f32x4*)(gate + col), g1 = *(const f32x4*)(gate + col + 4);
            *(f32x4*)(out + o) = *(const f32x4*)(res + o) + g0 * v0; *(f32x4*)(out + o + 4) = *(const f32x4*)(res + o + 4) + g1 * v1;
        });
    }
};
struct EpiSwiglu {
    bf16_t* o; int ld; int row_sub; int ct_mod;
    __device__ __forceinline__ void operator()(const f32x4 (&acc)[2][2][4][2], const Unit& u, int wr, int wc, int fr, int fq) const {
        const int row0 = u.pm * 256 + wr * 64 + fr - row_sub, col0 = (u.pn % ct_mod) * 128 + wc * 32 + 8 * fq;
#pragma unroll
        for (int ai = 0; ai < 2; ++ai)
#pragma unroll
            for (int m = 0; m < 4; ++m) {
                f32x4 r0, r1;
#pragma unroll
                for (int e = 0; e < 4; ++e) { r0[e] = siluf_(acc[ai][0][m][0][e]) * acc[ai][1][m][0][e]; r1[e] = siluf_(acc[ai][0][m][1][e]) * acc[ai][1][m][1][e]; }
                pg8::st_bf16x8(o + (size_t)(row0 + ai * 128 + m * 16) * ld + col0, r0, r1);
            }
    }
};
struct EpiMoe2 {
    bf16_t* ys; const float* rowgate;
    __device__ __forceinline__ void operator()(const f32x4 (&acc)[2][2][4][2], const Unit& u, int wr, int wc, int fr, int fq) const {
        const int cshift = ((u.pn & 3) - u.pn) * 256;
        pg8::epi_each(acc, u, wr, wc, fr, fq, [&](int row, int col, f32x4 v0, f32x4 v1) {
            const float g = rowgate[row];
            pg8::st_bf16x8(ys + (size_t)row * DM + col + cshift, v0 * g, v1 * g);
        });
    }
};
struct MoeOrder {
    int t0, t1, t2, t3, t4, t5, t6, t7, t8, nct, hi_shift, G, c, rep, tm;
    __device__ bool next(int i, Unit& u) const {
        int idx = i * G + c; const int tot = (tm - t0) * nct; if (idx >= tot * rep) return false; idx %= tot;
#define MOE_E(e, ta, tb_, sh) { const int a_ = (ta) < tm ? (ta) : tm, b_ = (tb_) < tm ? (tb_) : tm; const int w = b_ - a_, n = w * nct; if (idx < n) { u.pm = a_ + idx % w; u.pn = (e) * nct + idx / w + (sh); u.seg = 0; return true; } idx -= n; }
        MOE_E(0, t0, t1, 0) MOE_E(1, t1, t2, 0) MOE_E(2, t2, t3, 0) MOE_E(3, t3, t4, 0)
        MOE_E(4, t4, t5, hi_shift) MOE_E(5, t5, t6, hi_shift) MOE_E(6, t6, t7, hi_shift) MOE_E(7, t7, t8, hi_shift)
#undef MOE_E
        return false;
    }
};
struct MoeTailOrder {
    int t1, t2, t3, t4, t5, t6, t7, t8, tm, hi_shift, G, c;
    __device__ bool next(int i, Unit& u) const {
        const int idx = i * G + c; if (idx >= (t8 - tm) * 16) return false;
        const int tile = tm + idx / 16, r = idx % 16;
        const int e = (tile >= t1) + (tile >= t2) + (tile >= t3) + (tile >= t4) + (tile >= t5) + (tile >= t6) + (tile >= t7);
        u.pm = tile; u.pn = e * 4 + (r >> 2) + (e >= 4 ? hi_shift : 0); u.seg = r & 3; return true;
    }
};
struct EpiMoe2P {
    bf16_t* ys; bf16_t* part; const float* rowgate; int row0;
    __device__ __forceinline__ void operator()(const f32x4 (&acc)[2][2][4][2], const Unit& u, int wr, int wc, int fr, int fq) const {
        const int cshift = ((u.pn & 3) - u.pn) * 256;
        bf16_t* dst = u.seg == 0 ? ys : part + ((size_t)(u.seg - 1) * MOE_TAIL_ROWS - row0) * DM;
        pg8::epi_each(acc, u, wr, wc, fr, fq, [&](int row, int col, f32x4 v0, f32x4 v1) {
            const float g = rowgate[row];
            pg8::st_bf16x8(dst + (size_t)row * DM + col + cshift, v0 * g, v1 * g);
        });
    }
};

struct PrepIn { unsigned za[3]; u32x2 zk; unsigned kr; u32x4 nq, nk; u32x4 zc[3], zp[3], zn[3]; unsigned tc[3], tp[3], tn[3]; };
__device__ __forceinline__ void prep_row_load(const Frame& F, int m, PrepIn& I) {
    const bf16_t* ZA = (const bf16_t*)(F.ws + WS_ZA); const bf16_t* ZN = (const bf16_t*)(F.ws + WS_ZN); const bf16_t* ZR = (const bf16_t*)(F.ws + WS_ZR);
    const int lane = F.lane;
    { const unsigned* p = (const unsigned*)(ZA + (size_t)m * ZA_LD) + lane * 3; I.za[0] = p[0]; I.za[1] = p[1]; I.za[2] = p[2]; }
    I.zk = *((const u32x2*)(ZA + (size_t)m * ZA_LD + 384) + lane);
    I.kr = ((const unsigned*)(ZA + (size_t)m * ZA_LD + 640))[lane & 15];
    I.nq = *((const u32x4*)(ZN + (size_t)m * ZN_LD) + lane); I.nk = *((const u32x4*)(ZN + (size_t)m * ZN_LD + 512) + lane);
    const bool hasp = (m != 0) && (m != L), hasn = (m != L - 1) && (m != R - 1);
    const bf16_t* zc = ZR + (size_t)m * ZR_LD; const bf16_t* zp = zc - ZR_LD; const bf16_t* zn = zc + ZR_LD;
#pragma unroll
    for (int ch = 0; ch < 3; ++ch) { const int c0 = ch * 512 + lane * 8;
        I.zc[ch] = *(const u32x4*)(zc + c0); I.zp[ch] = (u32x4){0u, 0u, 0u, 0u}; I.zn[ch] = (u32x4){0u, 0u, 0u, 0u};
        if (hasp) I.zp[ch] = *(const u32x4*)(zp + c0); if (hasn) I.zn[ch] = *(const u32x4*)(zn + c0);
        const int c1 = 1536 + ch * 128 + lane * 2;
        I.tc[ch] = *(const unsigned*)(zc + c1); I.tp[ch] = 0u; I.tn[ch] = 0u;
        if (hasp) I.tp[ch] = *(const unsigned*)(zp + c1); if (hasn) I.tn[ch] = *(const unsigned*)(zn + c1); }
}
__device__ __forceinline__ void prep_row_compute(const Frame& F, int m, const PrepIn& I, const float (&cqg)[6], const float (&ckvg)[4], const float (&qng)[8], const float (&kng)[8], const float (&kkv)[8], const float* mu0, const float* mu1) {
    bf16_t* ZN = (bf16_t*)(F.ws + WS_ZN);
    bf16_t* CQN = (bf16_t*)(F.ws + WS_CQN); bf16_t* CKVN = (bf16_t*)(F.ws + WS_CKVN); bf16_t* LA = (bf16_t*)(F.ws + WS_LA); bf16_t* KR = (bf16_t*)(F.ws + WS_KR);
    bf16_t* RKV = (bf16_t*)(F.ws + WS_RKV);
    const int lane = F.lane;
    { float v[6] = {lo_bf(I.za[0]), hi_bf(I.za[0]), lo_bf(I.za[1]), hi_bf(I.za[1]), lo_bf(I.za[2]), hi_bf(I.za[2])}; float s = 0.f;
#pragma unroll
      for (int e = 0; e < 6; ++e) s += v[e] * v[e];
      const float rstd = rsqrtf(wave_sum(s) * (1.f / 384.f) + NORM_EPS);
      unsigned* o = (unsigned*)(CQN + (size_t)m * 384) + lane * 3;
      o[0] = cvtpk(v[0] * rstd * cqg[0], v[1] * rstd * cqg[1]); o[1] = cvtpk(v[2] * rstd * cqg[2], v[3] * rstd * cqg[3]); o[2] = cvtpk(v[4] * rstd * cqg[4], v[5] * rstd * cqg[5]); }
    { float v[4] = {lo_bf(I.zk.x), hi_bf(I.zk.x), lo_bf(I.zk.y), hi_bf(I.zk.y)}; float s = v[0] * v[0] + v[1] * v[1] + v[2] * v[2] + v[3] * v[3];
      const float rstd = rsqrtf(wave_sum(s) * (1.f / 256.f) + NORM_EPS);
      u32x2 o; o.x = cvtpk(v[0] * rstd * ckvg[0], v[1] * rstd * ckvg[1]); o.y = cvtpk(v[2] * rstd * ckvg[2], v[3] * rstd * ckvg[3]);
      *((u32x2*)(CKVN + (size_t)m * 256) + lane) = o; }
    if (lane < 16) ((unsigned*)(KR + (size_t)m * 32))[lane] = I.kr;
#pragma unroll
    for (int qk = 0; qk < 2; ++qk) {
        const u32x4 w = qk == 0 ? I.nq : I.nk;
        float v[8] = {lo_bf(w.x), hi_bf(w.x), lo_bf(w.y), hi_bf(w.y), lo_bf(w.z), hi_bf(w.z), lo_bf(w.w), hi_bf(w.w)}; float s = 0.f;
#pragma unroll
        for (int e = 0; e < 8; ++e) s += v[e] * v[e];
        s += __shfl_xor(s, 1); s += __shfl_xor(s, 2); s += __shfl_xor(s, 4);
        const float rstd = rsqrtf(s * (1.f / 64.f) + NORM_EPS);
        u32x4 o;
        if (qk == 0) { o.x = cvtpk(v[0] * rstd * qng[0], v[1] * rstd * qng[1]); o.y = cvtpk(v[2] * rstd * qng[2], v[3] * rstd * qng[3]); o.z = cvtpk(v[4] * rstd * qng[4], v[5] * rstd * qng[5]); o.w = cvtpk(v[6] * rstd * qng[6], v[7] * rstd * qng[7]); }
        else { o.x = cvtpk(v[0] * rstd * kng[0], v[1] * rstd * kng[1]); o.y = cvtpk(v[2] * rstd * kng[2], v[3] * rstd * kng[3]); o.z = cvtpk(v[4] * rstd * kng[4], v[5] * rstd * kng[5]); o.w = cvtpk(v[6] * rstd * kng[6], v[7] * rstd * kng[7]); }
        *((u32x4*)(ZN + (size_t)m * ZN_LD + qk * 512) + lane) = o;
    }
#pragma unroll
    for (int ch = 0; ch < 3; ++ch) {
        const int c0 = ch * 512 + lane * 8;
        const u32x4 wc_ = I.zc[ch], wp = I.zp[ch], wn = I.zn[ch];
        const float zcv[8] = {lo_bf(wc_.x), hi_bf(wc_.x), lo_bf(wc_.y), hi_bf(wc_.y), lo_bf(wc_.z), hi_bf(wc_.z), lo_bf(wc_.w), hi_bf(wc_.w)};
        const float zpv[8] = {lo_bf(wp.x), hi_bf(wp.x), lo_bf(wp.y), hi_bf(wp.y), lo_bf(wp.z), hi_bf(wp.z), lo_bf(wp.w), hi_bf(wp.w)};
        const float znv[8] = {lo_bf(wn.x), hi_bf(wn.x), lo_bf(wn.y), hi_bf(wn.y), lo_bf(wn.z), hi_bf(wn.z), lo_bf(wn.w), hi_bf(wn.w)};
        float o[8];
        const f32x4 ma = *(const f32x4*)(mu0 + c0), mb = *(const f32x4*)(mu0 + c0 + 4), na = *(const f32x4*)(mu1 + c0), nb = *(const f32x4*)(mu1 + c0 + 4);
        const float m0v[8] = {ma[0], ma[1], ma[2], ma[3], mb[0], mb[1], mb[2], mb[3]}, m1v[8] = {na[0], na[1], na[2], na[3], nb[0], nb[1], nb[2], nb[3]};
#pragma unroll
        for (int e = 0; e < 8; ++e) o[e] = zcv[e] + m0v[e] * (zpv[e] - zcv[e]) + m1v[e] * (znv[e] - zcv[e]);
        u32x4 w; w.x = cvtpk(o[0], o[1]); w.y = cvtpk(o[2], o[3]); w.z = cvtpk(o[4], o[5]); w.w = cvtpk(o[6], o[7]);
        *(u32x4*)(RKV + (size_t)m * RKV_LD + c0) = w;
        if (ch == 1) {
            const float kr_[8] = {lo_bf(w.x), hi_bf(w.x), lo_bf(w.y), hi_bf(w.y), lo_bf(w.z), hi_bf(w.z), lo_bf(w.w), hi_bf(w.w)};
            float s2 = 0.f;
#pragma unroll
            for (int e = 0; e < 8; ++e) { const float kx = kr_[e] * kkv[e]; s2 += kx * kx; }
            s2 += __shfl_xor(s2, 1); s2 += __shfl_xor(s2, 2); s2 += __shfl_xor(s2, 4);
            if ((lane & 7) == 0) ((float*)(F.ws + WS_KN))[(size_t)m * 8 + (lane >> 3)] = 1.f / fmaxf(sqrtf(s2), 1e-12f);
        }
    }
#pragma unroll
    for (int ch = 0; ch < 3; ++ch) {
        const int c0 = 1536 + ch * 128 + lane * 2;
        float o0 = lo_bf(I.tc[ch]), o1 = hi_bf(I.tc[ch]);
        o0 = o0 + mu0[c0] * (lo_bf(I.tp[ch]) - o0) + mu1[c0] * (lo_bf(I.tn[ch]) - o0);
        o1 = o1 + mu0[c0 + 1] * (hi_bf(I.tp[ch]) - o1) + mu1[c0 + 1] * (hi_bf(I.tn[ch]) - o1);
        if (ch == 0) { o0 = tanhf(o0); o1 = tanhf(o1); } else if (ch == 2) { o0 = sigmoidf_(o0); o1 = sigmoidf_(o1); }
        *(unsigned*)(LA + (size_t)m * 384 + ch * 128 + lane * 2) = cvtpk(o0, o1);
    }
}
__device__ __forceinline__ void prepare_rows(const Frame& F, const Args& a, int l) {
    const int lane = F.lane;
    float cqg[6], ckvg[4], qng[8], kng[8];
#pragma unroll
    for (int e = 0; e < 6; ++e) cqg[e] = a.in[I_CQG][l * 384 + lane * 6 + e];
#pragma unroll
    for (int e = 0; e < 4; ++e) ckvg[e] = a.in[I_CKVG][l * 256 + lane * 4 + e];
#pragma unroll
    for (int e = 0; e < 8; ++e) { qng[e] = a.in[I_NAQG][l * 64 + (lane & 7) * 8 + e] * (0.125f * LOG2E); kng[e] = a.in[I_NAKG][l * 64 + (lane & 7) * 8 + e]; }
    const float* mu0 = a.in[I_MU] + (size_t)l * 2 * 1920; const float* mu1 = mu0 + 1920;
    float kkv[8];
#pragma unroll
    for (int e = 0; e < 8; ++e) kkv[e] = a.in[I_KK][l * 512 + lane * 8 + e];
    const int gw = F.vcu * NWAVES + F.wave, NGW = F.G * NWAVES;
    PrepIn cur, nxt;
    if (gw < R) prep_row_load(F, gw, cur);
    for (int m = gw; m < R; m += NGW) {
        if (m + NGW < R) prep_row_load(F, m + NGW, nxt);
        prep_row_compute(F, m, cur, cqg, ckvg, qng, kng, kkv, mu0, mu1);
        cur = nxt;
    }
}

struct FixIn { u32x4 qn, kn, vv; unsigned short qr[4], kr[4]; };
__device__ __forceinline__ void fix_load(const Frame& F, int m, bool need_q, FixIn& I) {
    const bf16_t* QRAW = (const bf16_t*)(F.ws + WS_QRAW); const bf16_t* KVRAW = (const bf16_t*)(F.ws + WS_KVRAW); const bf16_t* KR = (const bf16_t*)(F.ws + WS_KR);
    const int h = F.lane >> 3, sub = F.lane & 7;
    if (need_q) { const bf16_t* q = QRAW + (size_t)m * 768 + h * 96; I.qn = *(const u32x4*)(q + 8 * sub);
#pragma unroll
        for (int i = 0; i < 4; ++i) I.qr[i] = q[64 + sub + 8 * i]; }
    const bf16_t* kv = KVRAW + (size_t)m * 1024 + h * 128; I.kn = *(const u32x4*)(kv + 8 * sub); I.vv = *(const u32x4*)(kv + 64 + 8 * sub);
#pragma unroll
    for (int i = 0; i < 4; ++i) I.kr[i] = KR[(size_t)m * 32 + sub + 8 * i];
}
__device__ __forceinline__ void fix_head(u32x4 nw, const unsigned short (&rw)[4], const float (&gn)[8], const float (&gr)[4], float cr, float sr, float cc, float sc, bf16_t* o, int sub) {
    float v[8] = {lo_bf(nw.x), hi_bf(nw.x), lo_bf(nw.y), hi_bf(nw.y), lo_bf(nw.z), hi_bf(nw.z), lo_bf(nw.w), hi_bf(nw.w)};
    float r[4] = {bf2f(rw[0]), bf2f(rw[1]), bf2f(rw[2]), bf2f(rw[3])};
    float s = 0.f;
#pragma unroll
    for (int e = 0; e < 8; ++e) s += v[e] * v[e];
#pragma unroll
    for (int e = 0; e < 4; ++e) s += r[e] * r[e];
    s += __shfl_xor(s, 1); s += __shfl_xor(s, 2); s += __shfl_xor(s, 4);
    const float rstd = rsqrtf(s * (1.f / 96.f) + NORM_EPS);
#pragma unroll
    for (int e = 0; e < 8; ++e) v[e] *= rstd * gn[e];
#pragma unroll
    for (int e = 0; e < 4; ++e) r[e] *= rstd * gr[e];
    u32x4 w; w.x = cvtpk(v[0], v[1]); w.y = cvtpk(v[2], v[3]); w.z = cvtpk(v[4], v[5]); w.w = cvtpk(v[6], v[7]);
    *(u32x4*)(o + 8 * sub) = w;
    const float t0 = r[0] * cr - r[1] * sr, t1 = r[0] * sr + r[1] * cr, t2 = r[2] * cc - r[3] * sc, t3 = r[2] * sc + r[3] * cc;
    o[64 + sub] = (bf16_t)(cvtpk(t0, 0.f) & 0xffffu); o[72 + sub] = (bf16_t)(cvtpk(t1, 0.f) & 0xffffu); o[80 + sub] = (bf16_t)(cvtpk(t2, 0.f) & 0xffffu); o[88 + sub] = (bf16_t)(cvtpk(t3, 0.f) & 0xffffu);
}
__device__ __forceinline__ void mla_fixup(const Frame& F, const Args& a, int l, bool need_ctx_q) {
    bf16_t* Q = (bf16_t*)(F.ws + WS_Q); bf16_t* K = (bf16_t*)(F.ws + WS_K); bf16_t* V = (bf16_t*)(F.ws + WS_V);
    const int lane = F.lane, h = lane >> 3, sub = lane & 7;
    float qgn[8], kgn[8], qgr[4], kgr[4];
#pragma unroll
    for (int e = 0; e < 8; ++e) { qgn[e] = a.in[I_QNG][l * 96 + 8 * sub + e] * (0.10206207261596575f * LOG2E); kgn[e] = a.in[I_KNG][l * 96 + 8 * sub + e]; }
#pragma unroll
    for (int i = 0; i < 4; ++i) { qgr[i] = a.in[I_QNG][l * 96 + 64 + sub + 8 * i] * (0.10206207261596575f * LOG2E); kgr[i] = a.in[I_KNG][l * 96 + 64 + sub + 8 * i]; }
    const float freq = __expf(-9.210340371976184f * (float)sub * 0.125f);
    const int gw = F.vcu * NWAVES + F.wave, NGW = F.G * NWAVES;
    FixIn cur, nxt;
    if (gw < R) fix_load(F, gw, gw < L || need_ctx_q, cur);
    for (int m = gw; m < R; m += NGW) {
        if (m + NGW < R) fix_load(F, m + NGW, (m + NGW) < L || need_ctx_q, nxt);
        const bool lat = m < L;
        float cr = 1.f, sr = 0.f, cc = 1.f, sc = 0.f;
        if (lat) { sincosf((float)(m >> 6) * freq, &sr, &cr); sincosf((float)(m & 63) * freq, &sc, &cc); }
        if (lat || need_ctx_q) fix_head(cur.qn, cur.qr, qgn, qgr, cr, sr, cc, sc, Q + ((size_t)h * R + m) * 96, sub);
        fix_head(cur.kn, cur.kr, kgn, kgr, cr, sr, cc, sc, K + ((size_t)h * R + m) * 96, sub);
        *(u32x4*)(V + ((size_t)h * R + m) * 64 + sub * 8) = cur.vv;
        cur = nxt;
    }
}

__device__ __forceinline__ void rwkv_output_rows(const Frame& F, const Args& a, int l, int m_end) {
    const bf16_t* RKV = (const bf16_t*)(F.ws + WS_RKV); const bf16_t* LO = (const bf16_t*)(F.ws + WS_LO);
    const bf16_t* YF = (const bf16_t*)(F.ws + WS_YF); const bf16_t* YBK = (const bf16_t*)(F.ws + WS_YBK); bf16_t* YR = (bf16_t*)(F.ws + WS_YR);
    const int lane = F.lane, c0 = lane * 8;
    float ka[8], rk[8], lg[8], lb[8];
#pragma unroll
    for (int e = 0; e < 8; ++e) { ka[e] = a.in[I_KA][l * 512 + c0 + e]; rk[e] = a.in[I_RK][l * 512 + c0 + e]; lg[e] = a.in[I_LNG][l * 512 + c0 + e]; lb[e] = a.in[I_LNB][l * 512 + c0 + e]; }
    const int gw = F.vcu * NWAVES + F.wave, NGW = F.G * NWAVES;
#define UNPK8(W, V) const float V[8] = {lo_bf(W.x), hi_bf(W.x), lo_bf(W.y), hi_bf(W.y), lo_bf(W.z), hi_bf(W.z), lo_bf(W.w), hi_bf(W.w)}
    u32x4 cw[8], nw[8];
#define RWO_LOAD(W, m_) do { const int mm_ = (m_); W[0] = *(const u32x4*)(RKV + (size_t)mm_ * RKV_LD + c0); W[1] = *(const u32x4*)(RKV + (size_t)mm_ * RKV_LD + 512 + c0); W[2] = *(const u32x4*)(RKV + (size_t)mm_ * RKV_LD + 1024 + c0); \
        W[3] = *(const u32x4*)(LO + (size_t)mm_ * LO_LD + 1024 + c0); W[4] = *(const u32x4*)(LO + (size_t)mm_ * LO_LD + 1536 + c0); W[5] = *(const u32x4*)(LO + (size_t)mm_ * LO_LD + 2048 + c0); \
        W[6] = *(const u32x4*)(YF + (size_t)mm_ * 512 + c0); W[7] = *(const u32x4*)(YBK + (size_t)mm_ * 512 + c0); } while (0)
    if (gw < m_end) RWO_LOAD(cw, gw);
    for (int m = gw; m < m_end; m += NGW) {
        if (m + NGW < m_end) RWO_LOAD(nw, m + NGW);
        const u32x4 wr_ = cw[0], wk_ = cw[1], wv_ = cw[2], wa0 = cw[3], wa1 = cw[4], wg_ = cw[5], wyf = cw[6], wyb = cw[7];
        UNPK8(wr_, r); UNPK8(wk_, k); UNPK8(wv_, v); UNPK8(wa0, a0v); UNPK8(wa1, a1v); UNPK8(wg_, g); UNPK8(wyf, yf); UNPK8(wyb, yb);
        float y[8]; float s = 0.f, bs = 0.f;
#pragma unroll
        for (int e = 0; e < 8; ++e) { y[e] = yf[e] + yb[e]; s += y[e];
            const float kd0 = k[e] * (1.f + (a0v[e] - 1.f) * ka[e]), kd1 = k[e] * (1.f + (a1v[e] - 1.f) * ka[e]);
            bs += r[e] * rk[e] * (kd0 + kd1); }
        s += __shfl_xor(s, 1); s += __shfl_xor(s, 2); s += __shfl_xor(s, 4);
        bs += __shfl_xor(bs, 1); bs += __shfl_xor(bs, 2); bs += __shfl_xor(bs, 4);
        const float mean = s * (1.f / 64.f); float q = 0.f;
#pragma unroll
        for (int e = 0; e < 8; ++e) { const float d = y[e] - mean; q += d * d; }
        q += __shfl_xor(q, 1); q += __shfl_xor(q, 2); q += __shfl_xor(q, 4);
        const float rstd = rsqrtf(q * (1.f / 64.f) + 64e-5f);
        float o[8];
#pragma unroll
        for (int e = 0; e < 8; ++e) o[e] = ((y[e] - mean) * rstd * lg[e] + lb[e] + bs * v[e]) * g[e];
        u32x4 w; w.x = cvtpk(o[0], o[1]); w.y = cvtpk(o[2], o[3]); w.z = cvtpk(o[4], o[5]); w.w = cvtpk(o[6], o[7]);
        *(u32x4*)(YR + (size_t)m * 512 + c0) = w;
#pragma unroll
        for (int i = 0; i < 8; ++i) cw[i] = nw[i];
    }
#undef RWO_LOAD
#undef UNPK8
}

__device__ __forceinline__ int crow(int r, int hi) { return (r & 3) + 8 * (r >> 2) + 4 * hi; }
#define SBAR() __builtin_amdgcn_sched_barrier(0)
__device__ __forceinline__ s16x4 tr_read_at(unsigned addr) { s16x4 r; asm volatile("ds_read_b64_tr_b16 %0, %1" : "=&v"(r) : "v"(addr) : "memory"); return r; }
__device__ __forceinline__ float rowmax32(const f32x16& p0, const f32x16& p1) {
    float m = p0[0];
#pragma unroll
    for (int r = 1; r < 16; ++r) m = fmaxf(m, p0[r]);
#pragma unroll
    for (int r = 0; r < 16; ++r) m = fmaxf(m, p1[r]);
    auto rr = __builtin_amdgcn_permlane32_swap(__float_as_uint(m), __float_as_uint(m), false, false);
    return fmaxf(__uint_as_float(rr[0]), __uint_as_float(rr[1]));
}
__device__ __forceinline__ float halfsum(float s) {
    auto rr = __builtin_amdgcn_permlane32_swap(__float_as_uint(s), __float_as_uint(s), false, false);
    return __uint_as_float(rr[0]) + __uint_as_float(rr[1]);
}
__device__ __forceinline__ void pack_p(const f32x16& p0, const f32x16& p1, bf16x8 (&pa)[4]) {
#define PK8(P, B, OUT) do { u32x4 w = {cvtpk(P[B + 0], P[B + 1]), cvtpk(P[B + 2], P[B + 3]), cvtpk(P[B + 4], P[B + 5]), cvtpk(P[B + 6], P[B + 7])}; OUT = __builtin_bit_cast(bf16x8, w); } while (0)
    PK8(p0, 0, pa[0]); PK8(p0, 8, pa[1]); PK8(p1, 0, pa[2]); PK8(p1, 8, pa[3]);
#undef PK8
}

constexpr int AK_PITCH = 208, AK_BYTES = 64 * AK_PITCH, AV_BYTES = 8192;
constexpr int ANSLOT = 6;
constexpr int ALDS_K = 0, ALDS_V = ANSLOT * AK_BYTES, ALDS_WS = ALDS_V + ANSLOT * AV_BYTES, ALDS_END = ALDS_WS + 8 * 256;
static_assert(ALDS_END <= 131072, "MLA LDS");
typedef short v4i16_t __attribute__((ext_vector_type(4)));
__device__ __forceinline__ s16x4 vtr(LAS const unsigned char* p) { return __builtin_bit_cast(s16x4, __builtin_amdgcn_ds_read_tr16_b64_v4i16((LAS v4i16_t*)p)); }
__device__ __forceinline__ void mla_unit(const Frame& F, int h, int q0, int k0, int nt) {
    const bf16_t* Q = (const bf16_t*)(F.ws + WS_Q) + (size_t)h * R * 96; const bf16_t* K = (const bf16_t*)(F.ws + WS_K) + (size_t)h * R * 96 + (size_t)k0 * 96;
    const bf16_t* V = (const bf16_t*)(F.ws + WS_V) + (size_t)h * R * 64 + (size_t)k0 * 64; bf16_t* YA = (bf16_t*)(F.ws + WS_YA);
    LAS unsigned char* lds = F.lds;
    const int tid = F.tid, lane = F.lane, wid = F.wave, r32 = lane & 31, hi = lane >> 5;
    LAS float* wsf = (LAS float*)(lds + ALDS_WS) + wid * 64;
    bf16x8 qr[6];
    { const bf16_t* qp = Q + (size_t)(q0 + wid * 32 + r32) * 96 + hi * 8;
#pragma unroll
      for (int s = 0; s < 6; ++s) qr[s] = *(const bf16x8*)(qp + s * 16); }
    const int kc0 = tid, kc1 = 512 + tid; const bool k2 = tid < 256;
    const int kr0 = kc0 / 12, kq0 = kc0 % 12, kr1 = kc1 / 12, kq1 = kc1 % 12;
    const int vkey = tid >> 3, vc8 = tid & 7;
    const unsigned kdst0 = kr0 * AK_PITCH + kq0 * 16, kdst1 = kr1 * AK_PITCH + kq1 * 16;
    const unsigned vdst = (vc8 >> 2) * 4096 + vkey * 64 + (vc8 & 3) * 16;
    u32x4 sk0, sk1, sv, tk0, tk1, tv;
#define A_LOAD(t) do { const bf16_t* kt = K + (size_t)(t) * 64 * 96; sk0 = *(const u32x4*)(kt + kr0 * 96 + kq0 * 8); if (k2) sk1 = *(const u32x4*)(kt + kr1 * 96 + kq1 * 8); \
        sv = *(const u32x4*)(V + (size_t)(t) * 64 * 64 + vkey * 64 + vc8 * 8); } while (0)
#define A_WRITE(sl) do { *(LAS u32x4*)(lds + ALDS_K + (sl) * AK_BYTES + kdst0) = sk0; if (k2) *(LAS u32x4*)(lds + ALDS_K + (sl) * AK_BYTES + kdst1) = sk1; \
        *(LAS u32x4*)(lds + ALDS_V + (sl) * AV_BYTES + vdst) = sv; } while (0)
#define A_LOAD2(t) do { const bf16_t* kt = K + (size_t)(t) * 64 * 96; tk0 = *(const u32x4*)(kt + kr0 * 96 + kq0 * 8); if (k2) tk1 = *(const u32x4*)(kt + kr1 * 96 + kq1 * 8); \
        tv = *(const u32x4*)(V + (size_t)(t) * 64 * 64 + vkey * 64 + vc8 * 8); } while (0)
#define A_WRITE2(sl) do { *(LAS u32x4*)(lds + ALDS_K + (sl) * AK_BYTES + kdst0) = tk0; if (k2) *(LAS u32x4*)(lds + ALDS_K + (sl) * AK_BYTES + kdst1) = tk1; \
        *(LAS u32x4*)(lds + ALDS_V + (sl) * AV_BYTES + vdst) = tv; } while (0)
    f32x16 o[2]; o[0] = f32x16{}; o[1] = f32x16{};
    float mref = 0.f, lsum = 0.f; f32x16 negm = f32x16{};
    LAS const unsigned char* kb_rd = lds + ALDS_K + r32 * AK_PITCH + hi * 16;
    LAS const unsigned char* vb_rd = lds + ALDS_V + ((lane >> 4) & 1) * 32 + (lane & 3) * 8 + (4 * hi + ((lane & 15) >> 2)) * 64;
#define PIN(x) asm volatile("" : "+v"(x))
#define A_QKT(C0, C1, sl) do { LAS const unsigned char* kt_ = kb_rd + (sl) * AK_BYTES; C0 = negm; C1 = negm; \
        _Pragma("unroll") for (int s = 0; s < 6; ++s) { const bf16x8 a0 = *(LAS const bf16x8*)(kt_ + s * 32); const bf16x8 a1 = *(LAS const bf16x8*)(kt_ + 32 * AK_PITCH + s * 32); \
            C0 = __builtin_amdgcn_mfma_f32_32x32x16_bf16(a0, qr[s], C0, 0, 0, 0); C1 = __builtin_amdgcn_mfma_f32_32x32x16_bf16(a1, qr[s], C1, 0, 0, 0); } } while (0)
#define A_MAX(C0, C1, al) do { const float rm_ = rowmax32(C0, C1); al = 1.f; \
        if (__builtin_expect(__any(rm_ > 8.f), 0)) { const float dl_ = fmaxf(rm_, 0.f); mref += dl_; al = __builtin_amdgcn_exp2f(-dl_); \
            _Pragma("unroll") for (int r = 0; r < 16; ++r) { C0[r] -= dl_; C1[r] -= dl_; negm[r] = -mref; } } } while (0)
#define A_RESC(al) do { if (__any((al) < 1.f)) { if (hi == 0) wsf[r32] = (al); LDS_WAIT(); \
        _Pragma("unroll") for (int r = 0; r < 16; ++r) { const float f_ = wsf[crow(r, hi)]; o[0][r] *= f_; o[1][r] *= f_; } } } while (0)
#define A_STEP(C0, C1, P0, P1, sk_, sv_, alP, alC) do { \
        LAS const unsigned char* kt_ = kb_rd + (sk_) * AK_BYTES; LAS const unsigned char* vt_ = vb_rd + (sv_) * AV_BYTES; \
        bf16x8 ka_[2], kb_[2]; u32x4 pw_[4]; float ps0_ = 0.f, ps1_ = 0.f; \
        ka_[0] = *(LAS const bf16x8*)(kt_); kb_[0] = *(LAS const bf16x8*)(kt_ + 32 * AK_PITCH); SBAR(); \
        _Pragma("unroll") for (int s = 0; s < 6; ++s) { const int c_ = s & 1, n_ = c_ ^ 1; \
            if (s + 1 < 6) { ka_[n_] = *(LAS const bf16x8*)(kt_ + (s + 1) * 32); kb_[n_] = *(LAS const bf16x8*)(kt_ + 32 * AK_PITCH + (s + 1) * 32); } \
            if (s == 0) C0 = __builtin_amdgcn_mfma_f32_32x32x16_bf16(ka_[c_], qr[s], negm, 0, 0, 0); else C0 = __builtin_amdgcn_mfma_f32_32x32x16_bf16(ka_[c_], qr[s], C0, 0, 0, 0); \
            if (s < 4) { ps0_ += P0[4 * s] + P0[4 * s + 1]; ps1_ += P0[4 * s + 2] + P0[4 * s + 3]; PIN(ps0_); PIN(ps1_); } \
            else { pw_[2 * (s - 4)][0] = cvtpk(P0[8 * (s - 4)], P0[8 * (s - 4) + 1]); pw_[2 * (s - 4)][1] = cvtpk(P0[8 * (s - 4) + 2], P0[8 * (s - 4) + 3]); pw_[2 * (s - 4)][2] = cvtpk(P0[8 * (s - 4) + 4], P0[8 * (s - 4) + 5]); pw_[2 * (s - 4)][3] = cvtpk(P0[8 * (s - 4) + 6], P0[8 * (s - 4) + 7]); PIN(pw_[2 * (s - 4)]); } \
            SBAR(); \
            if (s == 0) C1 = __builtin_amdgcn_mfma_f32_32x32x16_bf16(kb_[c_], qr[s], negm, 0, 0, 0); else C1 = __builtin_amdgcn_mfma_f32_32x32x16_bf16(kb_[c_], qr[s], C1, 0, 0, 0); \
            if (s < 4) { ps0_ += P1[4 * s] + P1[4 * s + 1]; ps1_ += P1[4 * s + 2] + P1[4 * s + 3]; PIN(ps0_); PIN(ps1_); } \
            else { pw_[2 * (s - 4) + 1][0] = cvtpk(P1[8 * (s - 4)], P1[8 * (s - 4) + 1]); pw_[2 * (s - 4) + 1][1] = cvtpk(P1[8 * (s - 4) + 2], P1[8 * (s - 4) + 3]); pw_[2 * (s - 4) + 1][2] = cvtpk(P1[8 * (s - 4) + 4], P1[8 * (s - 4) + 5]); pw_[2 * (s - 4) + 1][3] = cvtpk(P1[8 * (s - 4) + 6], P1[8 * (s - 4) + 7]); PIN(pw_[2 * (s - 4) + 1]); } \
            SBAR(); } \
        lsum = lsum * (alP) + (ps0_ + ps1_); \
        A_MAX(C0, C1, alC); SBAR(); \
          \
        s16x4 vl_[2], vh_[2]; vl_[0] = vtr(vt_); vh_[0] = vtr(vt_ + 512); SBAR(); \
        _Pragma("unroll") for (int m_ = 0; m_ < 8; ++m_) { const int dt_ = m_ >> 2, s_ = m_ & 3, c_ = m_ & 1, n_ = c_ ^ 1; \
            if (m_ + 1 < 8) { vl_[n_] = vtr(vt_ + ((m_ + 1) >> 2) * 4096 + ((m_ + 1) & 3) * 1024); vh_[n_] = vtr(vt_ + ((m_ + 1) >> 2) * 4096 + ((m_ + 1) & 3) * 1024 + 512); } \
            const bf16x8 vf_ = {vl_[c_][0], vl_[c_][1], vl_[c_][2], vl_[c_][3], vh_[c_][0], vh_[c_][1], vh_[c_][2], vh_[c_][3]}; \
            const int pi_ = (s_ == 0) ? 0 : (s_ == 1) ? 2 : (s_ == 2) ? 1 : 3; \
            o[dt_] = __builtin_amdgcn_mfma_f32_32x32x16_bf16(__builtin_bit_cast(bf16x8, pw_[pi_]), vf_, o[dt_], 0, 0, 0); \
            if (m_ < 4) { C0[4 * m_] = __builtin_amdgcn_exp2f(C0[4 * m_]); C0[4 * m_ + 1] = __builtin_amdgcn_exp2f(C0[4 * m_ + 1]); C0[4 * m_ + 2] = __builtin_amdgcn_exp2f(C0[4 * m_ + 2]); C0[4 * m_ + 3] = __builtin_amdgcn_exp2f(C0[4 * m_ + 3]); PIN(C0); } \
            else { C1[4 * (m_ - 4)] = __builtin_amdgcn_exp2f(C1[4 * (m_ - 4)]); C1[4 * (m_ - 4) + 1] = __builtin_amdgcn_exp2f(C1[4 * (m_ - 4) + 1]); C1[4 * (m_ - 4) + 2] = __builtin_amdgcn_exp2f(C1[4 * (m_ - 4) + 2]); C1[4 * (m_ - 4) + 3] = __builtin_amdgcn_exp2f(C1[4 * (m_ - 4) + 3]); PIN(C1); } \
            SBAR(); } \
    } while (0)
    f32x16 pA0, pA1, pB0, pB1; float alA = 1.f, alB = 1.f;
    A_LOAD(0); A_WRITE(0); A_LOAD(1); A_WRITE(1); A_LOAD(2); A_LOAD2(3); __syncthreads();
    A_QKT(pA0, pA1, 0); A_MAX(pA0, pA1, alA);
#pragma unroll
    for (int r = 0; r < 16; ++r) { pA0[r] = __builtin_amdgcn_exp2f(pA0[r]); pA1[r] = __builtin_amdgcn_exp2f(pA1[r]); }
    A_WRITE(2); A_WRITE2(3);
    if (nt > 4) { A_LOAD(4); A_LOAD2(5); A_WRITE(4); A_WRITE2(5); }
    __syncthreads();
    alA = 1.f;
    int sk = 1, sv_ = 0, sw = 0;
#define A_NEXT(x) ((x) == ANSLOT - 1 ? 0 : (x) + 1)
    for (int t = 1; t + 1 < nt; t += 2) {
        const bool st = t + 6 < nt;
        if (st) { A_LOAD(t + 5); A_LOAD2(t + 6); }
        A_STEP(pB0, pB1, pA0, pA1, sk, sv_, alA, alB);
        A_RESC(alB);
        sv_ = sk; sk = A_NEXT(sk);
        A_STEP(pA0, pA1, pB0, pB1, sk, sv_, alB, alA);
        __syncthreads(); if (st) { A_WRITE(sw); A_WRITE2(A_NEXT(sw)); } A_RESC(alA);
        sv_ = sk; sk = A_NEXT(sk); sw = A_NEXT(A_NEXT(sw));
    }
    A_STEP(pB0, pB1, pA0, pA1, sk, sv_, alA, alB);
    A_RESC(alB);
    { float ps = 0.f;
#pragma unroll
      for (int r = 0; r < 16; ++r) ps += pB0[r] + pB1[r];
      lsum = lsum * alB + ps;
      bf16x8 pa[4]; pack_p(pB0, pB1, pa);
      LAS const unsigned char* vt_ = vb_rd + sk * AV_BYTES;
#pragma unroll
      for (int dt = 0; dt < 2; ++dt)
#pragma unroll
          for (int s = 0; s < 4; ++s) { const s16x4 lo_ = vtr(vt_ + dt * 4096 + s * 1024), hh_ = vtr(vt_ + dt * 4096 + s * 1024 + 512);
              const bf16x8 vf = {lo_[0], lo_[1], lo_[2], lo_[3], hh_[0], hh_[1], hh_[2], hh_[3]};
              o[dt] = __builtin_amdgcn_mfma_f32_32x32x16_bf16(pa[s], vf, o[dt], 0, 0, 0); } }
    lsum = halfsum(lsum);
    if (hi == 0) wsf[r32] = lsum; LDS_WAIT();
#pragma unroll
    for (int r = 0; r < 16; ++r) { const float inv = 1.f / wsf[crow(r, hi)]; const int row = q0 + wid * 32 + crow(r, hi);
        bf16_t* op = YA + (size_t)row * 512 + h * 64 + r32;
        op[0] = (bf16_t)(cvtpk(o[0][r] * inv, 0.f) & 0xffffu); op[32] = (bf16_t)(cvtpk(o[1][r] * inv, 0.f) & 0xffffu); }
    __syncthreads();
#undef A_LOAD
#undef A_WRITE
#undef A_LOAD2
#undef A_WRITE2
#undef A_NEXT
#undef A_QKT
#undef A_MAX
#undef A_RESC
#undef A_STEP
#undef PIN
}

constexpr int NLDS_V = 0, NLDS_RPB = 8 * 16384, NRPB_SLOT = 1152, NRPB_PAD = 48, NLDS_WS = NLDS_RPB + 8 * NRPB_SLOT, NLDS_END = NLDS_WS + 8 * 256;
static_assert(NLDS_END <= 146432, "NA LDS");
__device__ __forceinline__ void na_table(const Frame& F, const float* rpb_l) {
    const int lane = F.lane, h = F.wave;
    LAS _Float16* rpbs = (LAS _Float16*)(F.lds + NLDS_RPB + h * NRPB_SLOT) + NRPB_PAD;
    float v[9];
#pragma unroll
    for (int j = 0; j < 9; ++j) { const int i = lane - NRPB_PAD + 64 * j; v[j] = (i >= 0 && i < 15 * 31) ? rpb_l[h * 465 + i] * LOG2E : 0.f; }
#pragma unroll
    for (int j = 0; j < 9; ++j) rpbs[lane - NRPB_PAD + 64 * j] = (_Float16)v[j];
    LDS_WAIT();
}
__device__ __forceinline__ void na_unit(const Frame& F, int unit, bool ctxq, int qt) {
    const bf16_t* ZN = (const bf16_t*)(F.ws + WS_ZN); bf16_t* YB = (bf16_t*)(F.ws + WS_YB);
    LAS unsigned char* lds = F.lds;
    const int lane = F.lane, h = F.wave, r32 = lane & 31, hi = lane >> 5;
    LAS unsigned char* vlds = lds + NLDS_V + h * 16384; LAS _Float16* rpbs = (LAS _Float16*)(lds + NLDS_RPB + h * NRPB_SLOT) + NRPB_PAD; LAS float* wsf = (LAS float*)(lds + NLDS_WS) + h * 64;
    const int qrow0 = ctxq ? L + unit * 64 : unit * 64;
    const int rs = ctxq ? 0 : min(max(unit - 4, 0), 256 - 8);
    bf16x8 qr[4];
#pragma unroll
    for (int s = 0; s < 4; ++s) qr[s] = *(const bf16x8*)(ZN + (size_t)(qrow0 + qt * 32 + r32) * ZN_LD + h * 64 + s * 16 + hi * 8);
    f32x16 o[2]; o[0] = f32x16{}; o[1] = f32x16{};
    float mref = -1e30f, lsum = 0.f;
    const unsigned vb_rd = (unsigned)(uintptr_t)vlds + ((lane >> 4) & 1) * 32 + (lane & 3) * 8 + (4 * hi + ((lane & 15) >> 2)) * 64;
    const int ntl = ctxq ? 0 : 8, nt = ntl + 4;
    LDS_WAIT();
    const int qc = qt * 32 + r32, cs = min(max(qc - 8, 0), 48), dbase = 4 * hi - qc + 15;
    f32x16 mk0, mk1;
#pragma unroll
    for (int r = 0; r < 16; ++r) { const int kc0 = crow(r, hi), kc1 = kc0 + 32; mk0[r] = ((kc0 >= cs) && (kc0 < cs + 16)) ? 0.f : -1e30f; mk1[r] = ((kc1 >= cs) && (kc1 < cs + 16)) ? 0.f : -1e30f; }
    bf16x8 kf[2][4];
    const int vkey = lane >> 2, vc16 = lane & 3;
#define NA_REQ(t_) do { const int t__ = (t_); const int kr0_ = t__ < ntl ? (rs + t__) * 64 : L + (t__ - ntl) * 64; \
        LAS unsigned char* img_ = vlds + (t__ & 1) * 8192; \
        _Pragma("unroll") for (int j = 0; j < 8; ++j) __builtin_amdgcn_global_load_lds((const unsigned*)(ZN + (size_t)(kr0_ + (j & 3) * 16 + vkey) * ZN_LD + 1024 + h * 64 + (j >> 2) * 32 + vc16 * 8), (LAS unsigned*)(img_ + j * 1024), 16, 0, 0); \
        _Pragma("unroll") for (int hf = 0; hf < 2; ++hf) _Pragma("unroll") for (int s = 0; s < 4; ++s) kf[hf][s] = *(const bf16x8*)(ZN + (size_t)(kr0_ + hf * 32 + r32) * ZN_LD + 512 + h * 64 + s * 16 + hi * 8); } while (0)
    NA_REQ(0);
    for (int t = 0; t < nt; ++t) {
        const bool local = t < ntl;
        f32x16 p0, p1;
        asm volatile("s_waitcnt vmcnt(0)" ::: "memory");
        if (local) { p0 = __builtin_amdgcn_mfma_f32_32x32x16_bf16(kf[0][0], qr[0], mk0, 0, 0, 0); p1 = __builtin_amdgcn_mfma_f32_32x32x16_bf16(kf[1][0], qr[0], mk1, 0, 0, 0); }
        else { p0 = __builtin_amdgcn_mfma_f32_32x32x16_bf16(kf[0][0], qr[0], f32x16{}, 0, 0, 0); p1 = __builtin_amdgcn_mfma_f32_32x32x16_bf16(kf[1][0], qr[0], f32x16{}, 0, 0, 0); }
#pragma unroll
        for (int s = 1; s < 4; ++s) { p0 = __builtin_amdgcn_mfma_f32_32x32x16_bf16(kf[0][s], qr[s], p0, 0, 0, 0); p1 = __builtin_amdgcn_mfma_f32_32x32x16_bf16(kf[1][s], qr[s], p1, 0, 0, 0); }
        SBAR();
        if (t + 1 < nt) NA_REQ(t + 1);
        SBAR();
        const unsigned vb_t = vb_rd + (t & 1) * 8192;
        const int dr = rs + t - unit + 7;
        {
            if (local) {
                const LAS _Float16* tb = rpbs + dr * 31 + dbase;
#pragma unroll
                for (int r = 0; r < 16; ++r) { const int cr_ = (r & 3) + 8 * (r >> 2); p0[r] += (float)tb[cr_]; p1[r] += (float)tb[cr_ + 32]; }
            }
            const float rm = rowmax32(p0, p1);
            if (__any(rm > mref + 8.f)) {
                const float mn = fmaxf(mref, rm); const float al = __builtin_amdgcn_exp2f(mref - mn); mref = mn; lsum *= al;
                if (hi == 0) wsf[r32] = al; LDS_WAIT();
#pragma unroll
                for (int r = 0; r < 16; ++r) { const float f = wsf[crow(r, hi)]; o[0][r] *= f; o[1][r] *= f; }
                LDS_WAIT();
            }
            float ps = 0.f;
#pragma unroll
            for (int r = 0; r < 16; ++r) { p0[r] = __builtin_amdgcn_exp2f(p0[r] - mref); p1[r] = __builtin_amdgcn_exp2f(p1[r] - mref); ps += p0[r] + p1[r]; }
            lsum += ps;
            bf16x8 pa[4]; pack_p(p0, p1, pa);
#pragma unroll
            for (int dt = 0; dt < 2; ++dt) {
                s16x4 lo[4], hh[4];
#pragma unroll
                for (int s = 0; s < 4; ++s) { lo[s] = tr_read_at(vb_t + dt * 4096 + s * 1024); hh[s] = tr_read_at(vb_t + dt * 4096 + s * 1024 + 512); }
                LDS_WAIT(); SBAR();
#pragma unroll
                for (int s = 0; s < 4; ++s) { const bf16x8 vf = {lo[s][0], lo[s][1], lo[s][2], lo[s][3], hh[s][0], hh[s][1], hh[s][2], hh[s][3]};
                    o[dt] = __builtin_amdgcn_mfma_f32_32x32x16_bf16(pa[s], vf, o[dt], 0, 0, 0); }
            }
        }
        LDS_WAIT(); SBAR();
    }
#undef NA_REQ
    {
        const float ls = halfsum(lsum);
        if (hi == 0) wsf[r32] = ls; LDS_WAIT();
#pragma unroll
        for (int r = 0; r < 16; ++r) { const float inv = 1.f / wsf[crow(r, hi)]; const int row = qrow0 + qt * 32 + crow(r, hi);
            bf16_t* op = YB + (size_t)row * 512 + h * 64 + r32;
            op[0] = (bf16_t)(cvtpk(o[0][r] * inv, 0.f) & 0xffffu); op[32] = (bf16_t)(cvtpk(o[1][r] * inv, 0.f) & 0xffffu); }
        LDS_WAIT();
    }
}

__device__ __forceinline__ int rw_row2(int d, int seq, int t) {
    if (seq == 0) return d == 0 ? L + t : L + (CT - 1) - t;
    return d == 0 ? t : (L - 1) - t;
}
constexpr int P2_D = 4, P2_NS = 5, P2_SLOT = 24576, P2_STEPS = NCH - 2;
static_assert(P2_NS * P2_SLOT <= 131072, "pass-2 ring");
__device__ __forceinline__ void rwkv_pass2(const Frame& F, int dh) {
    const int lane = F.lane, wave = F.wave, r32 = lane & 31, hi = lane >> 5;
    float* Qb = (float*)(F.ws + WS_QST) + (size_t)dh * NCH * 4096;
    const bf16_t* PTb = (const bf16_t*)(F.ws + WS_PST) + (size_t)dh * NCH * 4096;
    LAS unsigned char* lds = F.lds;
    const bool ldP = wave < 4;
    const int lrow = ldP ? (lane >> 3) : (lane >> 4), lc = ldP ? (lane & 7) : (lane & 15);
#define P2_ISSUE(k_) do { const int k__ = (k_); const int ci_ = k__ + 1; LAS unsigned char* sb_ = lds + (k__ % P2_NS) * P2_SLOT; \
        if (ldP) { _Pragma("unroll") for (int q = 0; q < 4; ++q) { const int j = 4 * (wave - 2) + q, row = 8 * j + lrow; \
            __builtin_amdgcn_global_load_lds((const unsigned*)(PTb + (size_t)ci_ * 4096 + row * 64 + ((lc ^ (row & 7)) * 8)), (LAS unsigned*)(sb_ + j * 1024), 16, 0, 0); } } \
        else { _Pragma("unroll") for (int q = 0; q < 4; ++q) { const int j = 4 * (wave - 4) + q, row = 4 * j + lrow; \
            __builtin_amdgcn_global_load_lds((const unsigned*)(Qb + (size_t)ci_ * 4096 + row * 64 + ((lc ^ (row & 15)) * 4)), (LAS unsigned*)(sb_ + 8192 + j * 1024), 16, 0, 0); } } } while (0)
    f32x16 X[2];
    if (wave < 2) {
#pragma unroll
        for (int jt = 0; jt < 2; ++jt)
#pragma unroll
            for (int g = 0; g < 4; ++g) { const f32x4 q4 = *(const f32x4*)(Qb + (size_t)(32 * wave + r32) * 64 + 32 * jt + 8 * g + 4 * hi); X[jt][4 * g] = q4[0]; X[jt][4 * g + 1] = q4[1]; X[jt][4 * g + 2] = q4[2]; X[jt][4 * g + 3] = q4[3]; }
    } else {
#pragma unroll
        for (int k = 0; k < P2_D; ++k) P2_ISSUE(k);
    }
    for (int k = 0; k < P2_STEPS; ++k) {
        if (wave >= 2) {
            const int rem = P2_STEPS - 1 - k;
            if (rem >= 3) asm volatile("s_waitcnt vmcnt(12)" ::: "memory"); else if (rem == 2) asm volatile("s_waitcnt vmcnt(8)" ::: "memory");
            else if (rem == 1) asm volatile("s_waitcnt vmcnt(4)" ::: "memory"); else asm volatile("s_waitcnt vmcnt(0)" ::: "memory");
        } else asm volatile("s_waitcnt lgkmcnt(0)" ::: "memory");
        __builtin_amdgcn_s_barrier();
        if (wave >= 2) { if (k + P2_D < P2_STEPS) P2_ISSUE(k + P2_D); }
        else {
            LAS const unsigned char* sb = lds + (k % P2_NS) * P2_SLOT;
            float* Qc = Qb + (size_t)(k + 1) * 4096;
            bf16x8 pa[2][2][2]; f32x16 N[2];
#pragma unroll
            for (int jn = 0; jn < 2; ++jn)
#pragma unroll
                for (int jt = 0; jt < 2; ++jt)
#pragma unroll
                    for (int s_ = 0; s_ < 2; ++s_) pa[jn][jt][s_] = *(LAS const bf16x8*)(sb + (32 * jn + r32) * 128 + (((4 * jt + 2 * s_ + hi) ^ (r32 & 7)) * 16));
#pragma unroll
            for (int jt = 0; jt < 2; ++jt)
#pragma unroll
                for (int g = 0; g < 4; ++g) { const f32x4 q4 = *(LAS const f32x4*)(sb + 8192 + (32 * wave + r32) * 256 + (((8 * jt + 2 * g + hi) ^ (r32 & 15)) * 16));
                    N[jt][4 * g] = q4[0]; N[jt][4 * g + 1] = q4[1]; N[jt][4 * g + 2] = q4[2]; N[jt][4 * g + 3] = q4[3]; }
            bf16x8 bh[2][2], bl[2][2];
#pragma unroll
            for (int jt = 0; jt < 2; ++jt)
#pragma unroll
                for (int s_ = 0; s_ < 2; ++s_) {
                    unsigned wh[4], wl[4];
#pragma unroll
                    for (int e2 = 0; e2 < 4; ++e2) { const float x0 = X[jt][8 * s_ + 2 * e2], x1 = X[jt][8 * s_ + 2 * e2 + 1]; const unsigned h = cvtpk(x0, x1); wh[e2] = h; wl[e2] = cvtpk(x0 - lo_bf(h), x1 - hi_bf(h)); }
                    u32x4 a = {wh[0], wh[1], wh[2], wh[3]}, b = {wl[0], wl[1], wl[2], wl[3]}; bh[jt][s_] = __builtin_bit_cast(bf16x8, a); bl[jt][s_] = __builtin_bit_cast(bf16x8, b);
                }
#pragma unroll
            for (int jt = 0; jt < 2; ++jt)
#pragma unroll
                for (int s_ = 0; s_ < 2; ++s_)
#pragma unroll
                    for (int jn = 0; jn < 2; ++jn) { N[jn] = __builtin_amdgcn_mfma_f32_32x32x16_bf16(pa[jn][jt][s_], bh[jt][s_], N[jn], 0, 0, 0); N[jn] = __builtin_amdgcn_mfma_f32_32x32x16_bf16(pa[jn][jt][s_], bl[jt][s_], N[jn], 0, 0, 0); }
            X[0] = N[0]; X[1] = N[1];
#pragma unroll
            for (int jt = 0; jt < 2; ++jt)
#pragma unroll
                for (int g = 0; g < 4; ++g) *(f32x4*)(Qc + (size_t)(32 * wave + r32) * 64 + 32 * jt + 8 * g + 4 * hi) = (f32x4){X[jt][4 * g], X[jt][4 * g + 1], X[jt][4 * g + 2], X[jt][4 * g + 3]};
        }
    }
#undef P2_ISSUE
    asm volatile("s_waitcnt vmcnt(0) lgkmcnt(0)" ::: "memory");
    __builtin_amdgcn_s_barrier();
}


namespace rwmm {
#define RW_BAR() asm volatile("s_waitcnt lgkmcnt(0)\n\ts_barrier" ::: "memory")
constexpr int PITCH = 144, MB = 64 * PITCH;
enum { B_PR = 0, B_PT, B_QR, B_QT, B_KR, B_KT, B_VR, B_RT, B_W0, B_W1, B_W2, B_W3, B_W4, B_W5, B_SB, B_NBUF };
constexpr int OFF_GC = B_NBUF * MB, OFF_TOT = OFF_GC + 256, LDS_END = OFF_TOT + 8 * 64 * 4;
static_assert(LDS_END <= 146432, "rwmm LDS");
__device__ __forceinline__ LAS unsigned char* buf(LAS unsigned char* lds, int b) { return lds + b * MB; }
__device__ __forceinline__ f32x16 mm_acc(LAS const unsigned char* A, LAS const unsigned char* B, int mt, int nt, int r32, int hi, f32x16 acc) {
    LAS const unsigned char* ap = A + (32 * mt + r32) * PITCH + hi * 16; LAS const unsigned char* bp = B + (32 * nt + r32) * PITCH + hi * 16;
#pragma unroll
    for (int ks = 0; ks < 4; ++ks) acc = __builtin_amdgcn_mfma_f32_32x32x16_bf16(*(LAS const bf16x8*)(ap + ks * 32), *(LAS const bf16x8*)(bp + ks * 32), acc, 0, 0, 0);
    return acc;
}
__device__ __forceinline__ void store_T(const f32x16& c, LAS unsigned char* b, int mt, int nt, int r32, int hi) {
#pragma unroll
    for (int g = 0; g < 4; ++g) { u32x2 w = {cvtpk(c[4 * g], c[4 * g + 1]), cvtpk(c[4 * g + 2], c[4 * g + 3])}; *(LAS u32x2*)(b + (32 * nt + r32) * PITCH + (32 * mt + 8 * g + 4 * hi) * 2) = w; }
}
__device__ __forceinline__ void store_N(const f32x16& c, LAS unsigned char* b, int mt, int nt, int r32, int hi) {
#pragma unroll
    for (int r = 0; r < 16; ++r) *(LAS bf16_t*)(b + (32 * mt + crow(r, hi)) * PITCH + (32 * nt + r32) * 2) = (bf16_t)(cvtpk(c[r], 0.f) & 0xffffu);
}
__device__ __forceinline__ f32x16 load_T(LAS const unsigned char* b, int mt, int nt, int r32, int hi) {
    f32x16 c;
#pragma unroll
    for (int g = 0; g < 4; ++g) { const u32x2 w = *(LAS const u32x2*)(b + (32 * nt + r32) * PITCH + (32 * mt + 8 * g + 4 * hi) * 2); c[4 * g] = lo_bf(w.x); c[4 * g + 1] = hi_bf(w.x); c[4 * g + 2] = lo_bf(w.y); c[4 * g + 3] = hi_bf(w.y); }
    return c;
}
template <bool STRICT> __device__ __forceinline__ void mask_upper(f32x16& c, int mt, int nt, int r32, int hi) {
#pragma unroll
    for (int r = 0; r < 16; ++r) { const int s = 32 * mt + crow(r, hi), t = 32 * nt + r32; const bool keep = STRICT ? (s < t) : (s <= t); c[r] = keep ? c[r] : 0.f; }
}

struct Raw { unsigned ka[8], lr[8], vv[4]; float kn[8]; };
__device__ __forceinline__ void prep_load(const Frame& F, int d, int h, int seq, int t0, Raw& R_) {
    const bf16_t* RKV = (const bf16_t*)(F.ws + WS_RKV); const bf16_t* LO = (const bf16_t*)(F.ws + WS_LO); const float* KN = (const float*)(F.ws + WS_KN);
    const int c = h * 64 + F.lane;
    const unsigned cu = (unsigned)c;
#pragma unroll
    for (int e = 0; e < 8; ++e) { const int row = __builtin_amdgcn_readfirstlane(rw_row2(d, seq, t0 + 8 * F.wave + e));
        const bf16_t* rb = RKV + (size_t)row * RKV_LD; const bf16_t* lb = LO + (size_t)row * LO_LD + d * 512;
        R_.ka[e] = (unsigned)rb[512u + cu] | ((unsigned)lb[1024u + cu] << 16);
        R_.lr[e] = (unsigned)lb[cu] | ((unsigned)rb[cu] << 16);
        const unsigned v = rb[1024u + cu]; if (e & 1) R_.vv[e >> 1] |= v << 16; else R_.vv[e >> 1] = v;
        R_.kn[e] = KN[row * 8 + h]; }
}
template <bool PASS3> __device__ __forceinline__ void prep(const Frame& F, const Args& a, int l, int h, const Raw& R_) {
    LAS unsigned char* lds = F.lds; const int lane = F.lane, w = F.wave, c = h * 64 + lane;
    const float kkp = a.in[I_KK][l * 512 + c], kap = a.in[I_KA][l * 512 + c];
    float G[8]; float run = 0.f;
#pragma unroll
    for (int e = 0; e < 8; ++e) { run += lo_bf(R_.lr[e]); G[e] = run; }
    LAS float* tot = (LAS float*)(lds + OFF_TOT);
    tot[w * 64 + lane] = run;
    RW_BAR();
    float off = 0.f;
#pragma unroll
    for (int ww = 0; ww < 7; ++ww) off += (ww < w) ? tot[ww * 64 + lane] : 0.f;
    unsigned pr[4], qr_[4], kr_[4];
#pragma unroll
    for (int e2 = 0; e2 < 4; ++e2) {
        float Pv[2], Qv[2], Kv[2];
#pragma unroll
        for (int u = 0; u < 2; ++u) { const int e = 2 * e2 + u, t = 8 * w + e;
            const float k = lo_bf(R_.ka[e]), av = hi_bf(R_.ka[e]), lw = lo_bf(R_.lr[e]), rr = hi_bf(R_.lr[e]);
            const float kx = k * kkp * R_.kn[e], kd = k * (1.f + (av - 1.f) * kap);
            const float g = G[e] + off; const float gam = __expf(g), inv = __expf(-g), gprev = __expf(g - lw);
            Pv[u] = -kx * gprev; Qv[u] = kx * av * inv; Kv[u] = kd * inv; const float Rv = rr * gam;
            *(LAS bf16_t*)(buf(lds, B_PT) + t * PITCH + lane * 2) = (bf16_t)(cvtpk(Pv[u], 0.f) & 0xffffu);
            *(LAS bf16_t*)(buf(lds, B_QT) + t * PITCH + lane * 2) = (bf16_t)(cvtpk(Qv[u], 0.f) & 0xffffu);
            *(LAS bf16_t*)(buf(lds, B_KT) + t * PITCH + lane * 2) = (bf16_t)(cvtpk(Kv[u], 0.f) & 0xffffu);
            if (PASS3) *(LAS bf16_t*)(buf(lds, B_RT) + t * PITCH + lane * 2) = (bf16_t)(cvtpk(Rv, 0.f) & 0xffffu);
            if (t == 63) ((LAS float*)(lds + OFF_GC))[lane] = gam; }
        pr[e2] = cvtpk(Pv[0], Pv[1]); qr_[e2] = cvtpk(Qv[0], Qv[1]); kr_[e2] = cvtpk(Kv[0], Kv[1]);
    }
    *(LAS u32x4*)(buf(lds, B_PR) + lane * PITCH + w * 16) = (u32x4){pr[0], pr[1], pr[2], pr[3]};
    *(LAS u32x4*)(buf(lds, B_QR) + lane * PITCH + w * 16) = (u32x4){qr_[0], qr_[1], qr_[2], qr_[3]};
    *(LAS u32x4*)(buf(lds, B_KR) + lane * PITCH + w * 16) = (u32x4){kr_[0], kr_[1], kr_[2], kr_[3]};
    *(LAS u32x4*)(buf(lds, B_VR) + lane * PITCH + w * 16) = (u32x4){R_.vv[0], R_.vv[1], R_.vv[2], R_.vv[3]};
    RW_BAR();
}

__device__ __forceinline__ f32x16 mm_accT(LAS const unsigned char* At, LAS const unsigned char* B, int mt, int nt, int lane, f32x16 acc) {
    const int r32 = lane & 31, hi = lane >> 5;
    LAS const unsigned char* ap = At + (8 * hi + ((lane & 15) >> 2)) * PITCH + (32 * mt + 16 * ((lane >> 4) & 1) + 4 * (lane & 3)) * 2;
    LAS const unsigned char* bp = B + (32 * nt + r32) * PITCH + hi * 16;
#pragma unroll
    for (int ks = 0; ks < 4; ++ks) { const s16x4 lo = vtr(ap + ks * 16 * PITCH), hh = vtr(ap + ks * 16 * PITCH + 4 * PITCH);
        const bf16x8 af = {lo[0], lo[1], lo[2], lo[3], hh[0], hh[1], hh[2], hh[3]};
        acc = __builtin_amdgcn_mfma_f32_32x32x16_bf16(af, *(LAS const bf16x8*)(bp + ks * 32), acc, 0, 0, 0); }
    return acc;
}
template <bool PASS3> __device__ __forceinline__ void core(const Frame& F, bool sT  , f32x16& vk, f32x16& ye) {
    LAS unsigned char* lds = F.lds; const int lane = F.lane, r32 = lane & 31, hi = lane >> 5, q = F.wave & 3, mt = q >> 1, nt = q & 1; const bool g0 = F.wave < 4;
    const f32x16 Z16 = f32x16{};
    f32x16 Tacc = Z16, a1 = Z16;
    if (g0) { f32x16 n = mm_acc(buf(lds, B_QT), buf(lds, B_PT), mt, nt, r32, hi, Z16); mask_upper<true>(n, mt, nt, r32, hi); store_T(n, buf(lds, B_W0), mt, nt, r32, hi);
        Tacc = n;
#pragma unroll
        for (int r = 0; r < 16; ++r) Tacc[r] += (mt == nt && crow(r, hi) == r32) ? 1.f : 0.f;
        store_T(Tacc, buf(lds, B_W2), mt, nt, r32, hi);
    } else { f32x16 m = mm_acc(buf(lds, B_KT), buf(lds, B_PT), mt, nt, r32, hi, Z16); mask_upper<true>(m, mt, nt, r32, hi); store_T(m, buf(lds, B_W3), mt, nt, r32, hi); }
    RW_BAR();
    if (!g0) { const f32x16 n2 = mm_accT(buf(lds, B_W0), buf(lds, B_W0), mt, nt, lane, Z16); store_T(n2, buf(lds, B_W1), mt, nt, r32, hi); }
    else if (PASS3) { f32x16 g3 = mm_acc(buf(lds, B_QT), buf(lds, B_RT), mt, nt, r32, hi, Z16); mask_upper<false>(g3, mt, nt, r32, hi); store_T(g3, buf(lds, B_W4), mt, nt, r32, hi); }
    else { const f32x16 vm = mm_acc(buf(lds, B_VR), buf(lds, B_W3), mt, nt, r32, hi, Z16); store_T(vm, buf(lds, B_W4), mt, nt, r32, hi); }
    RW_BAR();
#pragma unroll
    for (int k = 0; k < 4; ++k) {
        const int cP = (k & 1) ? B_W0 : B_W1, nP = (k & 1) ? B_W1 : B_W0, tIn = (k & 1) ? B_W5 : B_W2, tOut = (k & 1) ? B_W2 : B_W5;
        if (!g0) { const f32x16 p2 = mm_accT(buf(lds, cP), buf(lds, cP), mt, nt, lane, Z16); store_T(p2, buf(lds, nP), mt, nt, r32, hi);
            if (PASS3) {
                if (k == 0) { f32x16 g4 = mm_acc(buf(lds, B_KT), buf(lds, B_RT), mt, nt, r32, hi, Z16); mask_upper<false>(g4, mt, nt, r32, hi); store_T(g4, buf(lds, B_QT), mt, nt, r32, hi); }
                if (k == 1) ye = sT ? mm_accT(buf(lds, B_SB), buf(lds, B_RT), mt, nt, lane, Z16) : mm_acc(buf(lds, B_SB), buf(lds, B_RT), mt, nt, r32, hi, Z16);
                if (k == 2) ye = mm_acc(buf(lds, B_VR), buf(lds, B_QT), mt, nt, r32, hi, ye);
            }
        } else { Tacc = mm_accT(buf(lds, tIn), buf(lds, cP), mt, nt, lane, Tacc); store_T(Tacc, buf(lds, tOut), mt, nt, r32, hi);
            if (PASS3) {
                if (k == 0) a1 = sT ? mm_accT(buf(lds, B_SB), buf(lds, B_PT), mt, nt, lane, Z16) : mm_acc(buf(lds, B_SB), buf(lds, B_PT), mt, nt, r32, hi, Z16);
                if (k == 1) { a1 = mm_acc(buf(lds, B_VR), buf(lds, B_W3), mt, nt, r32, hi, a1); store_T(a1, buf(lds, B_KT), mt, nt, r32, hi); }
                if (k == 2) vk = mm_acc(buf(lds, B_VR), buf(lds, B_KR), mt, nt, r32, hi, Z16);
            }
        }
        RW_BAR();
    }
    if (g0) { Tacc = mm_accT(buf(lds, B_W2), buf(lds, B_W1), mt, nt, lane, Tacc); store_T(Tacc, buf(lds, B_W5), mt, nt, r32, hi); }
    else if (!PASS3) vk = mm_acc(buf(lds, B_VR), buf(lds, B_KR), mt, nt, r32, hi, Z16);
    RW_BAR();
    if (g0) { const f32x16 e = mm_accT(buf(lds, B_W5), buf(lds, B_QR), mt, nt, lane, Z16); store_T(e, buf(lds, B_W0), mt, nt, r32, hi); }
    else if (PASS3) { const f32x16 f = mm_accT(buf(lds, B_W5), buf(lds, B_W4), mt, nt, lane, Z16); store_T(f, buf(lds, B_W1), mt, nt, r32, hi); }
    RW_BAR();
}

__device__ __forceinline__ void pass1_item(const Frame& F, const Args& a, int l, int d, int h, int ci) {
    LAS unsigned char* lds = F.lds; const int lane = F.lane, r32 = lane & 31, hi = lane >> 5, q = F.wave & 3, mt = q >> 1, nt = q & 1; const bool g0 = F.wave < 4;
    const bool ctx = ci == 0; const int nsub = ctx ? 4 : 2, seq = ctx ? 0 : 1, tb = ctx ? 0 : (ci - 1) * TCH;
    float* Qs = (float*)(F.ws + WS_QST) + (size_t)(d * 8 + h) * NCH * 4096; bf16_t* PTg = (bf16_t*)(F.ws + WS_PST) + ((size_t)(d * 8 + h) * NCH + ci) * 4096;
    const f32x16 Z16 = f32x16{};
    for (int sb = 0; sb < nsub; ++sb) {
        { Raw raw; prep_load(F, d, h, seq, tb + 64 * sb, raw); prep<false>(F, a, l, h, raw); }
        f32x16 vk = Z16, ye = Z16;
        core<false>(F, false, vk, ye);
        const float gc = ((LAS const float*)(lds + OFF_GC))[32 * nt + r32];
        f32x16 pq = Z16;
        if (g0) { if (!ctx) { pq = mm_acc(buf(lds, B_PR), buf(lds, B_W0), mt, nt, r32, hi, Z16);
#pragma unroll
                for (int r = 0; r < 16; ++r) pq[r] = (pq[r] + ((mt == nt && crow(r, hi) == r32) ? 1.f : 0.f)) * gc;
                store_T(pq, buf(lds, B_W2), mt, nt, r32, hi); if (sb == 0) store_T(pq, buf(lds, B_SB), mt, nt, r32, hi); }
            else if (sb > 0) { pq = mm_acc(buf(lds, B_PR), buf(lds, B_W0), mt, nt, r32, hi, Z16);
#pragma unroll
                for (int r = 0; r < 16; ++r) pq[r] = (pq[r] + ((mt == nt && crow(r, hi) == r32) ? 1.f : 0.f)) * gc;
                store_T(pq, buf(lds, B_W2), mt, nt, r32, hi); }
        } else { pq = mm_accT(buf(lds, B_W4), buf(lds, B_W0), mt, nt, lane, vk);
#pragma unroll
            for (int r = 0; r < 16; ++r) pq[r] *= gc;
            if (sb == 0) store_T(pq, buf(lds, B_RT), mt, nt, r32, hi); }
        RW_BAR();
        if (sb > 0) {
            if (g0) { if (!ctx) pq = mm_accT(buf(lds, B_SB), buf(lds, B_W2), mt, nt, lane, Z16); }
            else pq = mm_accT(buf(lds, B_RT), buf(lds, B_W2), mt, nt, lane, pq);
            RW_BAR();
            const bool last = sb == nsub - 1;
            if (!g0) {
                if (!last) store_T(pq, buf(lds, B_RT), mt, nt, r32, hi);
                if (last || (ctx && sb == 1)) {
                    float* o = Qs + (size_t)((ctx && sb == 1) ? NCH - 1 : ci) * 4096;
#pragma unroll
                    for (int r = 0; r < 16; ++r) o[(32 * mt + crow(r, hi)) * 64 + 32 * nt + r32] = pq[r];
                }
            } else if (!ctx) {
                if (!last) store_T(pq, buf(lds, B_SB), mt, nt, r32, hi);
                else {
#pragma unroll
                    for (int g = 0; g < 4; ++g) { const int pos = (mt << 5) | ((g >> 1) << 4) | (hi << 3) | ((g & 1) << 2);
                        u32x2 wv = {cvtpk(pq[4 * g], pq[4 * g + 1]), cvtpk(pq[4 * g + 2], pq[4 * g + 3])}; *(u32x2*)(PTg + (32 * nt + r32) * 64 + pos) = wv; }
                }
            }
            RW_BAR();
        }
    }
}
__device__ __forceinline__ void pass3_item(const Frame& F, const Args& a, int l, int d, int h, int pc) {
    LAS unsigned char* lds = F.lds; const int lane = F.lane, r32 = lane & 31, hi = lane >> 5, q = F.wave & 3, mt = q >> 1, nt = q & 1; const bool g0 = F.wave < 4;
    const int seq = pc < 2 ? 0 : 1, tb = pc < 2 ? pc * TCH : (pc - 2) * TCH, slot = pc == 1 ? NCH - 1 : pc - 2;
    bf16_t* Y = (bf16_t*)(F.ws + (d == 0 ? WS_YF : WS_YBK));
    const float* S0g = (const float*)(F.ws + WS_QST) + ((size_t)(d * 8 + h) * NCH + slot) * 4096;
    { const int i = F.tid >> 3, c8 = (F.tid & 7) * 8; u32x4 wv = {0u, 0u, 0u, 0u};
      if (pc != 0) { const float* S0 = S0g + i * 64 + c8; const f32x4 x0 = *(const f32x4*)S0, x1 = *(const f32x4*)(S0 + 4);
          wv = (u32x4){cvtpk(x0[0], x0[1]), cvtpk(x0[2], x0[3]), cvtpk(x1[0], x1[1]), cvtpk(x1[2], x1[3])}; }
      *(LAS u32x4*)(buf(lds, B_SB) + i * PITCH + c8 * 2) = wv; }
    const f32x16 Z16 = f32x16{};
    for (int sb = 0; sb < 2; ++sb) {
        { Raw raw; prep_load(F, d, h, seq, tb + 64 * sb, raw); prep<true>(F, a, l, h, raw); }
        f32x16 vk = Z16, ye = Z16;
        core<true>(F, sb == 1, vk, ye);
        f32x16 s1 = Z16;
        if (!g0) {
            const f32x16 y = mm_accT(buf(lds, B_KT), buf(lds, B_W1), mt, nt, lane, ye);
            const size_t row = (size_t)rw_row2(d, seq, tb + 64 * sb + 32 * nt + r32);
#pragma unroll
            for (int g = 0; g < 4; ++g) { u32x2 wv = {cvtpk(y[4 * g], y[4 * g + 1]), cvtpk(y[4 * g + 2], y[4 * g + 3])}; *(u32x2*)(Y + row * 512 + h * 64 + 32 * mt + 8 * g + 4 * hi) = wv; }
        } else if (sb == 0) {
            const float gc = ((LAS const float*)(lds + OFF_GC))[32 * nt + r32];
            s1 = vk;
            if (pc != 0) {
#pragma unroll
                for (int r = 0; r < 16; ++r) s1[r] += S0g[(32 * mt + crow(r, hi)) * 64 + 32 * nt + r32]; }
            s1 = mm_accT(buf(lds, B_KT), buf(lds, B_W0), mt, nt, lane, s1);
#pragma unroll
            for (int r = 0; r < 16; ++r) s1[r] *= gc;
        }
        RW_BAR();
        if (g0 && sb == 0) store_T(s1, buf(lds, B_SB), mt, nt, r32, hi);
        RW_BAR();
    }
}
#undef RW_BAR
}

__device__ __forceinline__ void norm2_route_rows(const Frame& F, const Args& a, int l, const float* src, const float* g, const float* sh, const float* sc) {
    bf16_t* H = (bf16_t*)(F.ws + WS_H);
    int* ridx = (int*)(F.ws + WS_RT_IDX); int* rpos = (int*)(F.ws + WS_RT_POS); float* rgate = (float*)(F.ws + WS_RT_GATE);
    unsigned* cnt = (unsigned*)(F.ws + WS_CTL) + CW_MOECNT;
    const float* rw = a.in[I_ROUTER];
    f32x4 ca[4], cb[4];
#pragma unroll
    for (int j = 0; j < 4; ++j) { const int d = F.lane * 4 + 256 * j; const f32x4 gg = *(const f32x4*)(g + d), s1 = *(const f32x4*)(sc + d); ca[j] = gg * (s1 + 1.0f); cb[j] = *(const f32x4*)(sh + d); }
    const int gw = F.vcu * NWAVES + F.wave, NGW = F.G * NWAVES;
    for (int m = gw; m < L; m += NGW) {
        const f32x4* xr = (const f32x4*)(src + (size_t)m * DM) + F.lane;
        f32x4 v[4]; float s = 0.f;
#pragma unroll
        for (int j = 0; j < 4; ++j) { v[j] = xr[64 * j]; s += (v[j].x * v[j].x + v[j].y * v[j].y) + (v[j].z * v[j].z + v[j].w * v[j].w); }
        const float rstd = rsqrtf(wave_sum(s) * (1.f / DM) + NORM_EPS);
        u32x2* o8 = (u32x2*)(H + (size_t)m * DM) + F.lane;
        float lg[8] = {0.f, 0.f, 0.f, 0.f, 0.f, 0.f, 0.f, 0.f};
#pragma unroll
        for (int j = 0; j < 4; ++j) { const f32x4 y = v[j] * rstd * ca[j] + cb[j]; u32x2 w; w.x = cvtpk(y.x, y.y); w.y = cvtpk(y.z, y.w); o8[64 * j] = w;
            const float* rp = rw + (size_t)(F.lane * 4 + 256 * j) * 8;
#pragma unroll
            for (int e4 = 0; e4 < 4; ++e4) { const f32x4 w0 = *(const f32x4*)(rp + e4 * 8), w1 = *(const f32x4*)(rp + e4 * 8 + 4);
                const float yy = y[e4];
                lg[0] += yy * w0[0]; lg[1] += yy * w0[1]; lg[2] += yy * w0[2]; lg[3] += yy * w0[3]; lg[4] += yy * w1[0]; lg[5] += yy * w1[1]; lg[6] += yy * w1[2]; lg[7] += yy * w1[3]; } }
#pragma unroll
        for (int e = 0; e < 8; ++e) lg[e] = wave_sum(lg[e]);
        if (F.lane == 0) {
            int i1 = 0; float l1 = lg[0];
#pragma unroll
            for (int e = 1; e < 8; ++e) if (lg[e] > l1) { l1 = lg[e]; i1 = e; }
            int i2 = -1; float l2 = -3.0e38f;
#pragma unroll
            for (int e = 0; e < 8; ++e) if (e != i1 && lg[e] > l2) { l2 = lg[e]; i2 = e; }
            const float g2v = 1.f / (1.f + __expf(l1 - l2)), g1v = 1.f - g2v;
            const unsigned p1 = __hip_atomic_fetch_add(cnt + 64 * i1, 1u, __ATOMIC_RELAXED, __HIP_MEMORY_SCOPE_AGENT);
            const unsigned p2 = __hip_atomic_fetch_add(cnt + 64 * i2, 1u, __ATOMIC_RELAXED, __HIP_MEMORY_SCOPE_AGENT);
            ridx[2 * m] = i1; ridx[2 * m + 1] = i2; rpos[2 * m] = (int)p1; rpos[2 * m + 1] = (int)p2; rgate[2 * m] = g1v; rgate[2 * m + 1] = g2v;
        }
    }
}
__device__ __forceinline__ void moe_tile_bases(const Frame& F, int (&tb)[9]) {
    const unsigned* cnt = (const unsigned*)(F.ws + WS_CTL) + CW_MOECNT;
    int acc = 0;
#pragma unroll
    for (int e = 0; e < 8; ++e) { tb[e] = acc; const unsigned c = __hip_atomic_load(cnt + 64 * e, __ATOMIC_RELAXED, __HIP_MEMORY_SCOPE_AGENT); acc += (int)((c + 255u) >> 8); }
    tb[8] = acc;
}
__device__ __forceinline__ void moe_gather(const Frame& F) {
    const bf16_t* H = (const bf16_t*)(F.ws + WS_H); bf16_t* H2G = (bf16_t*)(F.ws + WS_H2G);
    const int* ridx = (const int*)(F.ws + WS_RT_IDX); const int* rpos = (const int*)(F.ws + WS_RT_POS); const float* rgate = (const float*)(F.ws + WS_RT_GATE);
    float* rowgate = (float*)(F.ws + WS_RT_ROWGATE);
    const unsigned* cnt = (const unsigned*)(F.ws + WS_CTL) + CW_MOECNT;
    int tb[9]; moe_tile_bases(F, tb);
    const int gw = F.vcu * NWAVES + F.wave, NGW = F.G * NWAVES;
    for (int m = gw; m < L; m += NGW) {
        const u32x4 r0 = *((const u32x4*)(H + (size_t)m * DM) + F.lane), r1 = *((const u32x4*)(H + (size_t)m * DM) + 64 + F.lane);
#pragma unroll
        for (int s = 0; s < 2; ++s) {
            const int e = ridx[2 * m + s]; int base = 0;
#pragma unroll
            for (int k = 0; k < 8; ++k) base = (e == k) ? tb[k] : base;
            const size_t row = (size_t)base * 256 + rpos[2 * m + s];
            *((u32x4*)(H2G + row * DM) + F.lane) = r0; *((u32x4*)(H2G + row * DM) + 64 + F.lane) = r1;
            if (F.lane == 0) rowgate[row] = rgate[2 * m + s];
        }
    }
#pragma unroll
    for (int e = 0; e < 8; ++e) {
        const int c = (int)__hip_atomic_load(cnt + 64 * e, __ATOMIC_RELAXED, __HIP_MEMORY_SCOPE_AGENT);
        const int lo = tb[e] * 256 + c, hi_ = tb[e + 1] * 256;
        for (int row = lo + gw; row < hi_; row += NGW) { *((u32x4*)(H2G + (size_t)row * DM) + F.lane) = (u32x4){0u, 0u, 0u, 0u}; *((u32x4*)(H2G + (size_t)row * DM) + 64 + F.lane) = (u32x4){0u, 0u, 0u, 0u}; if (F.lane == 0) rowgate[row] = 0.f; }
    }
}
__device__ __forceinline__ void moe_combine(const Frame& F, float* out, const float* gt2) {
    const bf16_t* YS = (const bf16_t*)(F.ws + WS_H2G);
    const int* ridx = (const int*)(F.ws + WS_RT_IDX); const int* rpos = (const int*)(F.ws + WS_RT_POS);
    const bf16_t* YSP = (const bf16_t*)(F.ws + WS_YSP);
    int tb[9]; moe_tile_bases(F, tb);
    const size_t tail0 = (size_t)(tb[8] < 128 ? tb[8] : 128) * 256;
    const int gw = F.vcu * NWAVES + F.wave, NGW = F.G * NWAVES;
    for (int m = gw; m < L; m += NGW) {
        size_t rows[2];
#pragma unroll
        for (int s = 0; s < 2; ++s) { const int e = ridx[2 * m + s]; int base = 0;
#pragma unroll
            for (int k = 0; k < 8; ++k) base = (e == k) ? tb[k] : base;
            rows[s] = (size_t)base * 256 + rpos[2 * m + s]; }
#pragma unroll
        for (int hf = 0; hf < 2; ++hf) {
            const int c0 = hf * 512 + F.lane * 8;
            const u32x4 a0 = *(const u32x4*)(YS + rows[0] * DM + c0), a1 = *(const u32x4*)(YS + rows[1] * DM + c0);
            float* op = out + (size_t)m * DM + c0;
            const f32x4 g0 = *(const f32x4*)(gt2 + c0), g1 = *(const f32x4*)(gt2 + c0 + 4);
            f32x4 x0 = *(const f32x4*)op, x1 = *(const f32x4*)(op + 4);
            f32x4 s0 = {lo_bf(a0.x) + lo_bf(a1.x), hi_bf(a0.x) + hi_bf(a1.x), lo_bf(a0.y) + lo_bf(a1.y), hi_bf(a0.y) + hi_bf(a1.y)};
            f32x4 s1 = {lo_bf(a0.z) + lo_bf(a1.z), hi_bf(a0.z) + hi_bf(a1.z), lo_bf(a0.w) + lo_bf(a1.w), hi_bf(a0.w) + hi_bf(a1.w)};
#pragma unroll
            for (int s = 0; s < 2; ++s) if (rows[s] >= tail0) {
#pragma unroll
                for (int q = 0; q < 3; ++q) { const u32x4 p = *(const u32x4*)(YSP + ((size_t)q * MOE_TAIL_ROWS + (rows[s] - tail0)) * DM + c0);
                    s0 += (f32x4){lo_bf(p.x), hi_bf(p.x), lo_bf(p.y), hi_bf(p.y)}; s1 += (f32x4){lo_bf(p.z), hi_bf(p.z), lo_bf(p.w), hi_bf(p.w)}; } }
            x0 += g0 * s0; x1 += g1 * s1;
            *(f32x4*)op = x0; *(f32x4*)(op + 4) = x1;
        }
    }
}

#ifndef PROBE_MOE
#define PROBE_MOE 1
#endif
#ifndef PROBE_LATONLY
#define PROBE_LATONLY 0
#endif
#ifndef PROBE_SKIPNA
#define PROBE_SKIPNA 0
#endif
#ifndef PROBE_NA
#define PROBE_NA 1
#endif
#ifndef PROBE_MLA
#define PROBE_MLA 1
#endif
#ifndef PROBE_GEMM
#define PROBE_GEMM 1
#endif
#ifndef PROBE_P1012
#define PROBE_P1012 1
#endif
#ifndef PROBE_P14
#define PROBE_P14 1
#endif
#ifndef PROBE_RW3
#define PROBE_RW3 1
#endif
#ifndef PROBE_RW1
#define PROBE_RW1 1
#endif
#ifndef REP_MLA
#define REP_MLA 1
#endif
#ifndef REP_NA
#define REP_NA 1
#endif
#ifndef REP_RW1
#define REP_RW1 1
#endif
#ifndef REP_RW3
#define REP_RW3 1
#endif
#ifndef REP_GEMM
#define REP_GEMM 1
#endif
#ifndef REP_ROW
#define REP_ROW 1
#endif
#ifndef PROBE_PREFIX
#define PROBE_PREFIX 0
#endif
constexpr int PH_PER_LAYER = 24;
constexpr int N_PHASES = 1 + 2 * PH_PER_LAYER;
__global__ void __launch_bounds__(NTHR, 2) mega_fwd(Args args) {
    extern __shared__ __attribute__((aligned(16))) unsigned char lds_raw[];
    Frame F;
    F.lds = (LAS unsigned char*)lds_raw; F.ws = args.ws;
    F.tid = threadIdx.x; F.lane = F.tid & 63; F.wave = __builtin_amdgcn_readfirstlane((int)threadIdx.x >> 6);
    F.G = gridDim.x; F.bid = blockIdx.x; F.vcu = (F.G % 8 == 0) ? (F.bid % 8) * (F.G / 8) + F.bid / 8 : F.bid;
    volatile LAS unsigned* MISC = (volatile LAS unsigned*)(F.lds + LDS_MISC_OFF);
    if (F.tid < 64) MISC[F.tid] = 0u;
    __syncthreads();
    const int lo = args.ph_lo, hi_full = args.ph_hi;
    const bool multi = (hi_full - lo) > 1;
    XcdBarrier bar; bar.bar = (unsigned*)(F.ws + WS_CTL) + CW_BAR; bar.x = 0; bar.st = MISC + 8;
    if (multi) bar = xcd_barrier_post((unsigned*)(F.ws + WS_CTL) + CW_BAR, MISC + 8);
#define IN(k) (lo <= (k) && (k) < hi)
    const Frame F0 = F;
#define SEAM(k) do { if (multi && (k) < hi) xcd_barrier(bar); } while (0)
    LAS unsigned char* lds = F.lds;
    float* MODV = (float*)(F.ws + WS_MODV);
    float* out = args.out;

    for (int pass_ = 0; pass_ < (PROBE_PREFIX > 0 ? 2 : 1); ++pass_) {
    const int hi = (PROBE_PREFIX > 0 && pass_ == 0) ? PROBE_PREFIX : hi_full;
    if (IN(0)) { const Frame F = launder(F0);
        if (PROBE_PREFIX > 0 && F.bid == 0 && F.tid < 8) ((unsigned*)(F.ws + WS_CTL) + CW_MOECNT)[F.tid * 64] = 0u;
        prologue_mod(F, args); prologue_weights(F, args); }
    SEAM(0);

#pragma unroll
    for (int l = 0; l < 2; ++l) {
        const int pb = 1 + l * PH_PER_LAYER;
        const bool need_ctx = (l == 0);
        unsigned char* wb = F.ws + WS_W + (size_t)l * WB_SIZE;
        const float* modL = MODV + (size_t)(l * 2) * 6144; const float* modC = modL + 6144;
        float* X1 = (float*)(F.ws + WS_X1); float* CM = (float*)(F.ws + WS_CM);
        bf16_t* H = (bf16_t*)(F.ws + WS_H);
        const int nMall = R / 256, nMlat = L / 256;

        if (IN(pb + 0)) { const Frame F = launder(F0);
            if (l == 0) { norm_rows(F, args.in[I_X], 0, 0, L, args.in[I_N1G] + l * DM, modL, modL + 1024, H);
                          norm_rows(F, args.in[I_CTX], L, L, R, args.in[I_N1G] + l * DM, modC, modC + 1024, H); }
            else { norm_rows(F, X1, 0, 0, L, args.in[I_N1G] + l * DM, modL, modL + 1024, H);
                   norm_rows(F, X1, 0, L, R, args.in[I_N1G] + l * DM, modC, modC + 1024, H); }
        }
        SEAM(pb + 0);
        for (int rq_ = 0; rq_ < PROBE_P14; ++rq_) {
        if (IN(pb + 1)) { const Frame F = launder(F0);
            pg8::Gemm g{H, DM, (const bf16_t*)(wb + WB_WINM), DM}; pg8::StaticOrder S; S.init(nMall, ZM_N / 256, F.G, F.bid, PROBE_GEMM);
            EpiZ E{(bf16_t*)(F.ws + WS_ZA), (bf16_t*)(F.ws + WS_ZN), (bf16_t*)(F.ws + WS_ZR)};
            pg8::gemm_phase(lds, F.tid, g, S, E);
        }
        SEAM(pb + 1);
        if (IN(pb + 2)) { const Frame F = launder(F0); prepare_rows(F, args, l); }
        SEAM(pb + 2);
        if (IN(pb + 3)) { const Frame F = launder(F0);
            { pg8::Gemm g{(const bf16_t*)(F.ws + WS_CQN), 384, (const bf16_t*)(wb + WB_WUQ), 384}; pg8::StaticOrder S; S.init(nMall, 3, F.G, F.bid, PROBE_GEMM);
              EpiBf E{(bf16_t*)(F.ws + WS_QRAW), 768}; pg8::gemm_phase(lds, F.tid, g, S, E); }
            { pg8::Gemm g{(const bf16_t*)(F.ws + WS_CKVN), 256, (const bf16_t*)(wb + WB_WUKV), 256}; pg8::StaticOrder S; S.init(nMall, 4, F.G, (F.bid + F.G - (nMall * 3) % F.G) % F.G, PROBE_GEMM);
              EpiBf E{(bf16_t*)(F.ws + WS_KVRAW), 1024}; pg8::gemm_phase(lds, F.tid, g, S, E); }
            { pg8::Gemm g{(const bf16_t*)(F.ws + WS_LA), 384, (const bf16_t*)(wb + WB_WLORA), 384}; pg8::StaticOrder S; S.init(nMall, 10, F.G, (F.bid + F.G - (nMall * 7) % F.G) % F.G, PROBE_GEMM);
              EpiLora E{(bf16_t*)(F.ws + WS_LO), args.in[I_W0] + (size_t)l * 1024, args.in[I_A0] + (size_t)l * 1024}; pg8::gemm_phase(lds, F.tid, g, S, E); }
        }
        SEAM(pb + 3);
        if (IN(pb + 4)) { const Frame F = launder(F0); mla_fixup(F, args, l, need_ctx); }
        SEAM(pb + 4);
        }
        if (IN(pb + 5)) { const Frame F = launder(F0);
            const int xcd = F.bid % 8, idx = F.bid / 8, per = F.G / 8;
            for (int u0 = idx; u0 < 64 * PROBE_MLA + ((need_ctx && idx == 0) ? per : 0); u0 += per) { const int u = u0 >= 64 * PROBE_MLA ? 64 : u0 % 64;
                const bool cu = u >= 64;
                mla_unit(F, xcd, cu ? L : u * 256, cu ? L : 0, cu ? CT / 64 : R / 64);
            }
        }
        SEAM(pb + 5);
        if (IN(pb + 6)) { const Frame F = launder(F0);
            for (int it = F.bid; it < PROBE_RW1 * 16 * 128; it += F.G) { const int ci = (it >> 4) & 127, dh = it & 15;
                rwmm::pass1_item(F, args, l, dh >> 3, dh & 7, ci);
            }
        }
        SEAM(pb + 6);
        if (IN(pb + 7)) { const Frame F = launder(F0);
            const int nrw = F.G > 64 ? 16 : 0;
            if (F.bid < nrw) rwkv_pass2(F, F.bid);
            else {
                if (nrw == 0 && F.bid < 16) rwkv_pass2(F, F.bid);
                __syncthreads();
                if (need_ctx && F.bid >= F.G - 32) { const int k = F.bid - (F.G - 32); rwmm::pass3_item(F, args, l, k >> 4, (k >> 1) & 7, k & 1); }
                const float* rpb_l = args.in[I_RPB] + (size_t)l * 8 * 465;
                const bool band = F.G == 256; const int x = F.bid & 7, nall = 2 * (256 + (need_ctx ? 4 : 0));
                const int k0 = band ? (F.bid >> 3) - 2 : F.bid - nrw, kstep = band ? 30 : F.G - nrw, kend = (PROBE_SKIPNA && pass_ == 0) ? 0 : band ? 64 + (need_ctx ? 1 : 0) : nall;
                na_table(F, rpb_l);
                for (int k = k0; k < kend; k += kstep) {
                    const bool cq = band ? k >= 64 : (k >> 1) >= 256;
                    const int un = band ? (cq ? x >> 1 : 32 * x + (k >> 1)) : (cq ? (k >> 1) - 256 : k >> 1), qt = band ? (cq ? x & 1 : k & 1) : k & 1;
                    na_unit(F, un, cq, qt);
                }
            }
        }
        SEAM(pb + 7);
        if (IN(pb + 8)) { const Frame F = launder(F0);
            for (int it = F.bid; it < PROBE_RW3 * 16 * 128; it += F.G) { const int dh = it & 15, pc = 2 + ((it >> 4) & 127);
                rwmm::pass3_item(F, args, l, dh >> 3, dh & 7, pc);
            }
        }
        SEAM(pb + 8);
        if (IN(pb + 10)) { const Frame F = launder(F0);
            rwkv_output_rows(F, args, l, need_ctx ? R : L);
            __syncthreads();
            pg8::Gemm g{H, DM, (const bf16_t*)(wb + WB_WING), DM}; pg8::StaticOrder S; S.init(need_ctx ? nMall : nMlat, 12, F.G, F.bid, PROBE_GEMM);
            EpiSig E{(bf16_t*)(F.ws + WS_ZG), ZG_LD}; pg8::gemm_phase(lds, F.tid, g, S, E);
        }
        SEAM(pb + 10);
        for (int rp_ = 0; rp_ < PROBE_P1012; ++rp_) {
        if (IN(pb + 11)) { const Frame F = launder(F0);
            pg8::Gemm g{(const bf16_t*)(F.ws + WS_YA), 512, (const bf16_t*)(wb + WB_WOA), 512, (unsigned)(WS_YB - WS_YA), (unsigned)(WB_WOB - WB_WOA)};
            pg8::SegOrder3 S; S.S.init(need_ctx ? nMall : nMlat, 4, F.G, F.bid);
            EpiMerge3 E{(bf16_t*)(F.ws + WS_U), (const bf16_t*)(F.ws + WS_ZG)}; pg8::gemm_phase(lds, F.tid, g, S, E);
        }
        SEAM(pb + 11);
        if (IN(pb + 12)) { const Frame F = launder(F0);
            pg8::Gemm g{(const bf16_t*)(F.ws + WS_U), DM, (const bf16_t*)(wb + WB_WOUT), DM}; pg8::StaticOrder S; S.init(need_ctx ? nMall : nMlat, 4, F.G, F.bid, PROBE_GEMM);
            EpiRes E{l == 0 ? args.in[I_X] : X1, l == 0 ? args.in[I_CTX] : X1 + (size_t)L * DM, out, CM, modL + 2048, modC + 2048};
            pg8::gemm_phase(lds, F.tid, g, S, E);
        }
        SEAM(pb + 12);
        }
        if (l == 0) {
            if (IN(pb + 13)) { const Frame F = launder(F0); norm_rows(F, out, 0, 0, L, args.in[I_N2G] + l * DM, modL + 3072, modL + 4096, H);
                               norm_rows(F, CM, L, L, R, args.in[I_N2G] + l * DM, modC + 3072, modC + 4096, H); }
            SEAM(pb + 13);
            if (IN(pb + 14)) { const Frame F = launder(F0);
                pg8::Gemm g{H, DM, (const bf16_t*)(F.ws + WS_W13), DM}; pg8::StaticOrder S; S.init(nMall, 22, F.G, F.bid, PROBE_GEMM);
                EpiSwiglu E{(bf16_t*)(F.ws + WS_G), FF, 0, 1 << 20}; pg8::gemm_phase(lds, F.tid, g, S, E);
            }
            SEAM(pb + 14);
            if (IN(pb + 15)) { const Frame F = launder(F0);
                pg8::Gemm g{(const bf16_t*)(F.ws + WS_G), FF, (const bf16_t*)(F.ws + WS_W2), FF}; pg8::StaticOrder S; S.init((PROBE_LATONLY && pass_ == 0) ? nMlat : nMall, 4, F.G, F.bid, PROBE_GEMM);
                EpiRes E{out, CM, X1, X1 + (size_t)L * DM, modL + 5120, modC + 5120};
                pg8::gemm_phase(lds, F.tid, g, S, E);
            }
            SEAM(pb + 15);
        } else {
            if (IN(pb + 13)) { const Frame F = launder(F0); norm2_route_rows(F, args, l, out, args.in[I_N2G] + l * DM, modL + 3072, modL + 4096); }
            SEAM(pb + 13);
            if (IN(pb + 14)) { const Frame F = launder(F0); moe_gather(F); moe_weights(F, args, 0); }
            SEAM(pb + 14);
            int tb[9]; moe_tile_bases(F, tb);
            if (IN(pb + 15)) { const Frame F = launder(F0);
                moe_weights(F, args, 1);
                __syncthreads();
                MoeOrder S{tb[0], tb[1], tb[2], tb[3], tb[4], tb[5], tb[6], tb[7], tb[8], 28, 0, F.G, F.bid, PROBE_MOE, tb[8]};
                pg8::Gemm g{(const bf16_t*)(F.ws + WS_H2G), DM, (const bf16_t*)(F.ws + WS_W13E), DM};
                EpiSwiglu E{(bf16_t*)(F.ws + WS_HID), FFE, 0, 28}; pg8::gemm_phase(lds, F.tid, g, S, E);
            }
            SEAM(pb + 15);
            if (IN(pb + 17)) { const Frame F = launder(F0);
                const int tm = tb[8] < 128 ? tb[8] : 128;
                { MoeOrder S{tb[0], tb[1], tb[2], tb[3], tb[4], tb[5], tb[6], tb[7], tb[8], 4, W2E_HI_TILE_SHIFT, F.G, F.bid, PROBE_MOE, tm};
                  pg8::Gemm g{(const bf16_t*)(F.ws + WS_HID), FFE, (const bf16_t*)(F.ws + WS_W2E_LO), FFE};
                  EpiMoe2 E{(bf16_t*)(F.ws + WS_H2G), (const float*)(F.ws + WS_RT_ROWGATE)}; pg8::gemm_phase(lds, F.tid, g, S, E); }
                { int ksl = FFE / 4; asm volatile("" : "+s"(ksl));
                  MoeTailOrder S{tb[1], tb[2], tb[3], tb[4], tb[5], tb[6], tb[7], tb[8], tm, W2E_HI_TILE_SHIFT, F.G, F.bid};
                  pg8::Gemm g{(const bf16_t*)(F.ws + WS_HID), FFE, (const bf16_t*)(F.ws + WS_W2E_LO), ksl, (unsigned)(FFE / 4 * 2), (unsigned)(FFE / 4 * 2), FFE};
                  EpiMoe2P E{(bf16_t*)(F.ws + WS_H2G), (bf16_t*)(F.ws + WS_YSP), (const float*)(F.ws + WS_RT_ROWGATE), tm * 256}; pg8::gemm_phase(lds, F.tid, g, S, E); }
            }
            SEAM(pb + 17);
            if (IN(pb + 19)) { const Frame F = launder(F0); moe_combine(F, out, modL + 5120); }
        }
    }
    }
#undef IN
#undef SEAM
}

#ifndef MK_PER_PHASE
#define MK_PER_PHASE 0
#endif
extern "C" void kernel_launch(void* const* d_in, const int* in_sizes, int n_in, void* d_out, int out_size, void* d_ws, size_t ws_size, hipStream_t stream) {
    static int grid = 0;
    if (grid == 0) {
        if (n_in != 40 || out_size != L * DM || ws_size < 560 * MiB) { fprintf(stderr, "kernel_launch: unexpected shapes (n_in %d out %d ws %zu)\n", n_in, out_size, ws_size); grid = -1; return; }
        int dev = 0, cus = 0, per_cu = 0;
        if (hipGetDevice(&dev) != hipSuccess || hipDeviceGetAttribute(&cus, hipDeviceAttributeMultiprocessorCount, dev) != hipSuccess) { grid = -1; return; }
        if (hipFuncSetAttribute((const void*)mega_fwd, hipFuncAttributeMaxDynamicSharedMemorySize, LDS_BYTES) != hipSuccess) { fprintf(stderr, "kernel_launch: hipFuncSetAttribute failed\n"); grid = -1; return; }
        if (hipOccupancyMaxActiveBlocksPerMultiprocessor(&per_cu, (const void*)mega_fwd, NTHR, LDS_BYTES) != hipSuccess || per_cu < 1) fprintf(stderr, "kernel_launch: occupancy query says %d\n", per_cu);
        (void)hipGetLastError();
        grid = cus;
    }
    if (grid < 0) return;
    (void)hipMemsetAsync((char*)d_ws + WS_CTL, 0, CTL_ZERO_BYTES, stream);
    Args a{};
    for (int i = 0; i < 40; ++i) a.in[i] = (const float*)d_in[i];
    a.out = (float*)d_out; a.ws = (unsigned char*)d_ws;
#if MK_PER_PHASE
    for (int p = 0; p < N_PHASES; ++p) { a.ph_lo = p; a.ph_hi = p + 1; hipLaunchKernelGGL(mega_fwd, dim3(grid), dim3(NTHR), LDS_BYTES, stream, a); }
#else
    a.ph_lo = 0; a.ph_hi = N_PHASES;
    hipLaunchKernelGGL(mega_fwd, dim3(grid), dim3(NTHR), LDS_BYTES, stream, a);
#endif
    const hipError_t le = hipPeekAtLastError();
    if (le != hipSuccess) fprintf(stderr, "kernel_launch: launch failed: %s\n", hipGetErrorName(le));
}
```

```cpp
#include <hip/hip_runtime.h>
#include <cstdio>
#include <cstdint>

#define LAS __attribute__((address_space(3)))
#define GAS __attribute__((address_space(1)))
typedef unsigned short bf16_t;
typedef short bf16x8 __attribute__((ext_vector_type(8)));
typedef short s16x4 __attribute__((ext_vector_type(4)));
typedef float f32x4 __attribute__((ext_vector_type(4)));
typedef float f32x2 __attribute__((ext_vector_type(2)));
typedef float f32x16 __attribute__((ext_vector_type(16)));
typedef unsigned u32x4 __attribute__((ext_vector_type(4)));
typedef unsigned u32x2 __attribute__((ext_vector_type(2)));
typedef __bf16 bf16x2_t __attribute__((ext_vector_type(2)));

constexpr int L = 16384, CT = 256, R = L + CT, DM = 1024, GW = 64;
constexpr int NWAVES = 8, NTHR = 512;
constexpr int ZA_LD = 768, ZN_LD = 1536, ZR_LD = 2048, ZM_N = 4352, ZG_LD = 3072;
constexpr int LO_LD = 2560, RKV_LD = 1536;
constexpr int FF = 2816, FFE = 3584, NEXP = 8;
constexpr int MOE_ROWS = 2 * L + NEXP * 256;
constexpr float NORM_EPS = 1e-6f;
constexpr float LOG2E = 1.4426950408889634f;
constexpr int TCH = 128, NCH = 129;

constexpr size_t MiB = 1u << 20;
constexpr size_t WS_CTL = 0, CTL_ZERO_BYTES = 1 * MiB;
constexpr size_t WS_W = 1 * MiB;
constexpr size_t WB_WINM = 0;
constexpr size_t WB_WING = WB_WINM + (size_t)ZM_N * DM * 2;
constexpr size_t WB_WUQ = WB_WING + (size_t)ZG_LD * DM * 2;
constexpr size_t WB_WUKV = WB_WUQ + (size_t)768 * 384 * 2;
constexpr size_t WB_WLORA = WB_WUKV + (size_t)1024 * 256 * 2;
constexpr size_t WB_WOA = WB_WLORA + (size_t)2560 * 384 * 2;
constexpr size_t WB_WOB = WB_WOA + (size_t)1024 * 512 * 2;
constexpr size_t WB_WOR = WB_WOB + (size_t)1024 * 512 * 2;
constexpr size_t WB_WOUT = WB_WOR + (size_t)1024 * 512 * 2;
constexpr size_t WB_SIZE = WB_WOUT + (size_t)1024 * 1024 * 2;
constexpr size_t WS_W13 = WS_W + 2 * WB_SIZE;
constexpr size_t WS_W2 = WS_W13 + (size_t)2 * FF * DM * 2;
constexpr size_t WS_W_END = WS_W2 + (size_t)DM * FF * 2;
static_assert(WS_W_END <= 67 * MiB, "weights region");
constexpr size_t WS_X1 = 67 * MiB;
constexpr size_t WS_CM = 132 * MiB;
constexpr size_t WS_H = 135 * MiB;
constexpr size_t WS_MISC = 168 * MiB;
constexpr size_t WS_MODV = WS_MISC;
constexpr size_t WS_RT_IDX = WS_MISC + 128 * 1024;
constexpr size_t WS_RT_POS = WS_RT_IDX + 128 * 1024;
constexpr size_t WS_RT_GATE = WS_RT_POS + 128 * 1024;
constexpr size_t WS_RT_ROWGATE = WS_RT_GATE + 128 * 1024;
constexpr size_t WS_KN = WS_MISC + 1 * MiB;
constexpr size_t WS_BIG = 170 * MiB;
constexpr size_t WS_ZN = WS_BIG;
constexpr size_t WS_Q = 219 * MiB, WS_K = 244 * MiB, WS_V = 269 * MiB;
constexpr size_t WS_RKV = 286 * MiB;
constexpr size_t WS_LO = 335 * MiB;
constexpr size_t WS_CQN = 417 * MiB, WS_CKVN = 430 * MiB, WS_LA = 439 * MiB, WS_KR = 452 * MiB;
constexpr size_t WS_YA = 417 * MiB, WS_YB = 434 * MiB;
constexpr size_t WS_ZA = 453 * MiB, WS_ZR = 478 * MiB;
constexpr size_t WS_QRAW = 453 * MiB, WS_KVRAW = 478 * MiB;
constexpr size_t WS_PST = 219 * MiB, WS_QST = 486 * MiB, WS_YF = 519 * MiB, WS_YBK = 536 * MiB, WS_YR = 451 * MiB;
static_assert(WS_YR - WS_YB == WS_YB - WS_YA && WB_WOR - WB_WOB == WB_WOB - WB_WOA, "merge segments");
constexpr size_t WS_ZG = WS_BIG;
constexpr size_t WS_U32 = 335 * MiB;
constexpr size_t WS_U = 286 * MiB;
constexpr size_t WS_G = WS_BIG;
constexpr size_t WS_H2G = 67 * MiB;
constexpr size_t WS_W13E = 170 * MiB;
constexpr size_t WS_W2E_LO = 135 * MiB;
constexpr size_t WS_W2E_HI = 282 * MiB;
constexpr int W2E_HI_TILE_SHIFT = (int)((WS_W2E_HI - WS_W2E_LO) / ((size_t)256 * FFE * 2)) - 16;
static_assert((WS_W2E_HI - WS_W2E_LO) % ((size_t)256 * FFE * 2) == 0 && (W2E_HI_TILE_SHIFT % 4) == 0, "W2E split");
constexpr int MOE_TAIL_ROWS = MOE_ROWS - 2 * L;
constexpr size_t WS_YSP = 170 * MiB;
constexpr size_t WS_PART = 300 * MiB;
constexpr size_t WS_HID = 310 * MiB;
constexpr size_t WS_END = 553 * MiB;
static_assert((size_t)16 * NCH * 4096 * 4 <= 33 * MiB, "state slots");
static_assert(WS_ZR + (size_t)R * ZR_LD * 2 <= WS_END, "ws map");
static_assert(WS_HID + (size_t)MOE_ROWS * FFE * 2 <= 549 * MiB, "hid");
constexpr int CW_BAR = 4096;
constexpr int CW_MOECNT = 1024;

#ifndef PROBE_CVT
#define PROBE_CVT 1
#endif
#ifndef PROBE_ROW
#define PROBE_ROW 1
#endif
__device__ __forceinline__ float bf2f(unsigned b) { return __uint_as_float(b << 16); }
__device__ __forceinline__ unsigned cvtpk(float lo, float hi) { f32x2 v = {lo, hi}; bf16x2_t b = __builtin_convertvector(v, bf16x2_t); return __builtin_bit_cast(unsigned, b); }
__device__ __forceinline__ float lo_bf(unsigned w) { return __uint_as_float(w << 16); }
__device__ __forceinline__ float hi_bf(unsigned w) { return __uint_as_float(w & 0xffff0000u); }
__device__ __forceinline__ float wave_sum(float v) {
#pragma unroll
    for (int o = 1; o < 64; o <<= 1) v += __shfl_xor(v, o);
    return v;
}
__device__ __forceinline__ float sigmoidf_(float x) { return __builtin_amdgcn_rcpf(1.f + __expf(-x)); }
__device__ __forceinline__ float siluf_(float x) { return x * __builtin_amdgcn_rcpf(1.f + __expf(-x)); }
#define LDS_WAIT() asm volatile("s_waitcnt lgkmcnt(0)" ::: "memory")
#define VM_WAIT() asm volatile("s_waitcnt vmcnt(0)" ::: "memory")

namespace pg8 {
constexpr int BM = 256, BK = 64, HALF = 128, HTB = HALF * BK * 2, STAGE_BYTES = 8 * HTB, NXCD = 8, WGM = 8;
__device__ __forceinline__ int lds_byte(int r, int c) { const int st = (r >> 4) * 2 + (c >> 5), rr = r & 15, cc = c & 31, ob = rr * 64 + cc * 2; return st * 1024 + (ob ^ (((ob >> 9) & 1) << 5)); }
__device__ __forceinline__ void stage_rc(int b, int& R_, int& C_) { const int st = b / 1024, sb = b % 1024, swz = sb ^ (((sb >> 9) & 1) << 5); R_ = (st >> 1) * 16 + swz / 64; C_ = (st & 1) * 32 + (swz % 64) / 2; }
__device__ __forceinline__ int perm32(int rho) { const int n = rho >> 4, i = rho & 15; return 8 * (i >> 2) + 4 * n + (i & 3); }

struct Unit { int pm, pn, seg; };
struct Gemm { const bf16_t* A; int lda; const bf16_t* Bt; int K; unsigned segA = 0, segB = 0; int ldb = 0; };
template <class E> __device__ __forceinline__ bool epi_done(const E&, const Unit&) { return true; }

struct StaticOrder {
    int nM, nN, nwg, G, c, rep;
    __device__ void init(int nM_, int nN_, int G_, int c_, int rep_ = 1) { nM = nM_; nN = nN_; nwg = nM * nN; G = G_; c = c_; rep = rep_; }
    __device__ bool next(int i, Unit& u) const {
        const long Lx = (long)i * G + c; if (Lx >= (long)nwg * rep) return false;
        int wgid = (int)(Lx % nwg); { const int q = nwg / NXCD, r = nwg % NXCD, xcd = wgid % NXCD, off = wgid / NXCD; wgid = (xcd < r ? xcd * (q + 1) : r * (q + 1) + (xcd - r) * q) + off; }
        const int nig = WGM * nN, gid = wgid / nig, fm = gid * WGM, gsz = (nM - fm) < WGM ? (nM - fm) : WGM;
        u.pm = fm + ((wgid % nig) % gsz); u.pn = (wgid % nig) / gsz; u.seg = 0; return true;
    }
};

struct SegOrder3 { StaticOrder S; __device__ bool next(int i, Unit& u) const { if (!S.next(i / 3, u)) return false; u.seg = i % 3; return true; } };
struct PairSegOrder { StaticOrder S; __device__ bool next(int i, Unit& u) const { if (!S.next(i, u)) return false; u.seg = u.pn >> 1; return true; } };
template <class Epi, class Sched>
__device__ __forceinline__ void gemm_phase(LAS unsigned char* lds, const int tid, const Gemm g, const Sched& S, const Epi& E) {
    const int wid = __builtin_amdgcn_readfirstlane(tid >> 6), lane = tid & 63, wr = wid >> 2, wc = wid & 3, fr = lane & 15, fq = lane >> 4;
    const int K = g.K, nt = K / BK, ldb = g.ldb ? g.ldb : K;
    unsigned voffA[2], voffB[2];
#pragma unroll
    for (int i = 0; i < 2; ++i) { int R_, C_; stage_rc(tid * 16 + i * 8192, R_, C_); const int Rb = (R_ & ~31) + perm32(R_ & 31);
        voffA[i] = (unsigned)(R_ * g.lda + C_) * 2u; voffB[i] = (unsigned)(Rb * ldb + C_) * 2u; }
    const size_t kstep = (size_t)(BK * 2);
    const size_t hstepA = (size_t)HALF * g.lda * 2, hstepB = (size_t)HALF * ldb * 2;
    const size_t tstepA = 2 * hstepA, tstepB = 2 * hstepB;
    const unsigned ldsw = (unsigned)wid * 1024u;
    const int aoff = lds_byte(wr * 64 + fr, fq * 8), boff = lds_byte(wc * 32 + fr, fq * 8);
#define PG8_SA(b, h) (((b) * 2 + (h)) * HTB)
#define PG8_SB(b, h) ((4 + (b) * 2 + (h)) * HTB)
#define PG8_STAGE(bufoff, gbase, voff) do { _Pragma("unroll") for (int _i = 0; _i < 2; ++_i) \
        __builtin_amdgcn_global_load_lds((const unsigned*)((const char*)(gbase) + (voff)[_i]), (LAS unsigned*)(lds + (bufoff) + ldsw + _i * 8192), 16, 0, 0); } while (0)
#define PG8_LDA(dst, b, h) do { _Pragma("unroll") for (int m = 0; m < 4; ++m) _Pragma("unroll") for (int k = 0; k < 2; ++k) dst[m][k] = *(const LAS bf16x8*)(lds + PG8_SA(b, h) + aoff + m * 2048 + k * 1024); } while (0)
#define PG8_LDB(dst, b, h) do { _Pragma("unroll") for (int n = 0; n < 2; ++n) _Pragma("unroll") for (int k = 0; k < 2; ++k) dst[n][k] = *(const LAS bf16x8*)(lds + PG8_SB(b, h) + boff + n * 2048 + k * 1024); } while (0)
#define PG8_MMA(ai, bj, At, Bt) do { __builtin_amdgcn_s_setprio(1); _Pragma("unroll") for (int m = 0; m < 4; ++m) _Pragma("unroll") for (int n = 0; n < 2; ++n) _Pragma("unroll") for (int k = 0; k < 2; ++k) \
        acc[ai][bj][m][n] = __builtin_amdgcn_mfma_f32_16x16x32_bf16(Bt[n][k], At[m][k], acc[ai][bj][m][n], 0, 0, 0); __builtin_amdgcn_s_setprio(0); } while (0)
#define PG8_WAIT_V(n) asm volatile("s_waitcnt vmcnt(" #n ")" ::: "memory")
#define PG8_WAIT_L(n) asm volatile("s_waitcnt lgkmcnt(" #n ")" ::: "memory")
#define PG8_BAR __builtin_amdgcn_s_barrier()
#define PG8_SCHED __builtin_amdgcn_sched_barrier(0)
    Unit cur, nxt; int ui = 0;
    if (!S.next(0, cur)) return;
    f32x4 acc[2][2][4][2];
#pragma unroll
    for (int a = 0; a < 2; ++a)
#pragma unroll
        for (int b = 0; b < 2; ++b)
#pragma unroll
            for (int m = 0; m < 4; ++m)
#pragma unroll
                for (int n = 0; n < 2; ++n) acc[a][b][m][n] = (f32x4){0.f, 0.f, 0.f, 0.f};
    bf16x8 At[4][2], B0[2][2], B1[2][2];
    const char* cA = (const char*)g.A + (size_t)cur.pm * tstepA + (size_t)cur.seg * g.segA; const char* cB = (const char*)g.Bt + (size_t)cur.pn * tstepB + (size_t)cur.seg * g.segB;
    PG8_STAGE(PG8_SB(0, 0), cB, voffB); PG8_STAGE(PG8_SB(0, 1), cB + hstepB, voffB); PG8_STAGE(PG8_SA(0, 0), cA, voffA); PG8_STAGE(PG8_SA(0, 1), cA + hstepA, voffA);
    if (wr == 1) PG8_BAR;
    PG8_WAIT_V(2); PG8_BAR;
    PG8_STAGE(PG8_SB(1, 0), cB + kstep, voffB); PG8_STAGE(PG8_SA(1, 0), cA + kstep, voffA); PG8_STAGE(PG8_SB(1, 1), cB + hstepB + kstep, voffB);
    PG8_WAIT_V(6); PG8_BAR;
    for (;;) {
        const bool has_next = S.next(ui + 1, nxt);
        const char* nA = has_next ? (const char*)g.A + (size_t)nxt.pm * tstepA + (size_t)nxt.seg * g.segA : cA; const char* nB = has_next ? (const char*)g.Bt + (size_t)nxt.pn * tstepB + (size_t)nxt.seg * g.segB : cB;
        for (int t = 0; t < nt; t += 2) {
            const bool last = (t == nt - 2);
            const char* a1 = cA + (size_t)(t + 1) * kstep;
            const char* a2 = last ? nA : cA + (size_t)(t + 2) * kstep; const char* b2 = last ? nB : cB + (size_t)(t + 2) * kstep;
            const char* a3 = a2 + kstep; const char* b3 = b2 + kstep;
            PG8_LDB(B0, 0, 0); PG8_LDB(B1, 0, 1); PG8_SCHED; PG8_LDA(At, 0, 0); PG8_STAGE(PG8_SA(1, 1), a1 + hstepA, voffA);
            PG8_WAIT_V(8); PG8_WAIT_L(0); PG8_BAR; PG8_MMA(0, 0, At, B0); PG8_MMA(0, 1, At, B1); PG8_BAR; PG8_SCHED;
            PG8_LDA(At, 0, 1); PG8_STAGE(PG8_SB(0, 0), b2, voffB); PG8_STAGE(PG8_SB(0, 1), b2 + hstepB, voffB); PG8_STAGE(PG8_SA(0, 0), a2, voffA);
            PG8_WAIT_V(8); PG8_WAIT_L(0); PG8_BAR; PG8_MMA(1, 0, At, B0); PG8_MMA(1, 1, At, B1); PG8_BAR; PG8_SCHED;
            PG8_LDB(B0, 1, 0); PG8_LDB(B1, 1, 1); PG8_SCHED; PG8_LDA(At, 1, 0); PG8_STAGE(PG8_SA(0, 1), a2 + hstepA, voffA);
            PG8_WAIT_V(8); PG8_WAIT_L(0); PG8_BAR; PG8_MMA(0, 0, At, B0); PG8_MMA(0, 1, At, B1); PG8_BAR; PG8_SCHED;
            PG8_LDA(At, 1, 1); PG8_STAGE(PG8_SB(1, 0), b3, voffB); PG8_STAGE(PG8_SB(1, 1), b3 + hstepB, voffB); PG8_STAGE(PG8_SA(1, 0), a3, voffA);
            PG8_WAIT_V(8); PG8_WAIT_L(0); PG8_BAR; PG8_MMA(1, 0, At, B0); PG8_MMA(1, 1, At, B1); PG8_BAR; PG8_SCHED;
        }
        if (wr == 0) PG8_BAR;
        E(acc, cur, wr, wc, fr, fq);
        if (!has_next) break;
        if (epi_done(E, cur)) {
#pragma unroll
        for (int a = 0; a < 2; ++a)
#pragma unroll
            for (int b = 0; b < 2; ++b)
#pragma unroll
                for (int m = 0; m < 4; ++m)
#pragma unroll
                    for (int n = 0; n < 2; ++n) acc[a][b][m][n] = (f32x4){0.f, 0.f, 0.f, 0.f};
        }
        cur = nxt; cA = nA; cB = nB; ++ui;
        if (wr == 1) PG8_BAR;
    }
    PG8_WAIT_V(0);
    PG8_BAR;
#undef PG8_SA
#undef PG8_SB
#undef PG8_STAGE
#undef PG8_LDA
#undef PG8_LDB
#undef PG8_MMA
#undef PG8_WAIT_V
#undef PG8_WAIT_L
#undef PG8_BAR
#undef PG8_SCHED
}

template <class F> __device__ __forceinline__ void epi_each(const f32x4 (&acc)[2][2][4][2], const Unit& u, int wr, int wc, int fr, int fq, F&& f) {
    const int row0 = u.pm * BM + wr * 64 + fr, col0 = u.pn * BM + wc * 32 + 8 * fq;
#pragma unroll
    for (int ai = 0; ai < 2; ++ai)
#pragma unroll
        for (int m = 0; m < 4; ++m)
#pragma unroll
            for (int bj = 0; bj < 2; ++bj) f(row0 + ai * HALF + m * 16, col0 + bj * HALF, acc[ai][bj][m][0], acc[ai][bj][m][1]);
}
__device__ __forceinline__ void st_bf16x8(bf16_t* p, f32x4 v0, f32x4 v1) {
    u32x4 w; w.x = cvtpk(v0[0], v0[1]); w.y = cvtpk(v0[2], v0[3]); w.z = cvtpk(v1[0], v1[1]); w.w = cvtpk(v1[2], v1[3]); *(u32x4*)p = w;
}
}
#include <hip/hip_runtime.h>
#include <cstdio>
#include <cstdint>
#include <cstdlib>
#include <vector>

#define XB_TMO      128
#define XB_XCNT(j)  (256  + 64 * (j))
#define XB_XSUB(j)  (1280 + 64 * (j))
#define XB_XGEN(j)  (2304 + 64 * (j))
#define XB_TOP      3328
#define XB_TOPGEN   3392
#define XCD_BAR_WORDS 3456
#define XB_SPIN_CAP (1u << 18)

__device__ __forceinline__ unsigned xb_ld(unsigned* p)              { return __hip_atomic_load(p, __ATOMIC_RELAXED, __HIP_MEMORY_SCOPE_AGENT); }
__device__ __forceinline__ unsigned xb_add(unsigned* p, unsigned v) { return __hip_atomic_fetch_add(p, v, __ATOMIC_RELAXED, __HIP_MEMORY_SCOPE_AGENT); }
__device__ __forceinline__ unsigned xb_xcc_id() { return (unsigned)__builtin_amdgcn_s_getreg((3 << 11) | 20) & 0xFu; }
#define XB_SPIN(cond, bar) do { unsigned _sp = 0; while (cond) { __builtin_amdgcn_s_sleep(1); \
    if ((++_sp & 255u) == 0u) { if (xb_ld(&(bar)[XB_TMO])) break; if (_sp > XB_SPIN_CAP) { atomicAdd(&(bar)[XB_TMO], 1u); break; } } } } while (0)

struct XcdBarrier {
    unsigned* bar; unsigned x;
    volatile LAS unsigned* st;
};

__device__ __forceinline__ XcdBarrier xcd_barrier_post(unsigned* bar, volatile LAS unsigned* st) {
    XcdBarrier b; b.bar = bar; b.x = xb_xcc_id(); b.st = st;
    if (threadIdx.x == 0) (void)xb_add(&bar[XB_XCNT(b.x)], 1u);
    return b;
}
__device__ __forceinline__ void xcd_barrier_complete(unsigned* bar, unsigned x, unsigned& nloc, unsigned& nx) {
    const unsigned G = gridDim.x * gridDim.y * gridDim.z;
    unsigned sum, cnt, mine, sp = 0u;
    for (;;) {
        sum = 0u; cnt = 0u; mine = 0u;
#pragma unroll
        for (unsigned j = 0; j < 16; ++j) { const unsigned c = xb_ld(&bar[XB_XCNT(j)]); sum += c; cnt += (c > 0u) ? 1u : 0u; mine = (j == x) ? c : mine; }
        if (sum == G) break;
        __builtin_amdgcn_s_sleep(1);
        if ((++sp & 255u) == 0u) { if (xb_ld(&bar[XB_TMO])) break; if (sp > XB_SPIN_CAP) { atomicAdd(&bar[XB_TMO], 1u); break; } }
    }
    nloc = mine > 0u ? mine : 1u; nx = cnt > 0u ? cnt : 1u;
}

__device__ __forceinline__ void xcd_barrier(const XcdBarrier& b) {
    asm volatile("s_waitcnt vmcnt(0)" ::: "memory");
    __syncthreads();
    if (threadIdx.x == 0) {
        unsigned* bar = b.bar;
        __builtin_amdgcn_s_waitcnt(0);
        unsigned nloc = b.st[0], nx = b.st[1];
        if (nloc == 0u) { xcd_barrier_complete(bar, b.x, nloc, nx); b.st[0] = nloc; b.st[1] = nx; }
        const unsigned old = xb_add(&bar[XB_XSUB(b.x)], 1u);
        const unsigned gen = old / nloc;
        if (old + 1u == (gen + 1u) * nloc) {
            __builtin_amdgcn_fence(__ATOMIC_RELEASE, "agent");
            asm volatile("s_waitcnt vmcnt(0)" ::: "memory");
            const unsigned og = xb_add(&bar[XB_TOP], 1u);
            const unsigned tg = og / nx;
            if (og + 1u == (tg + 1u) * nx) xb_add(&bar[XB_TOPGEN], 1u);
            else XB_SPIN(xb_ld(&bar[XB_TOPGEN]) == tg, bar);
            __builtin_amdgcn_fence(__ATOMIC_ACQUIRE, "agent");
            xb_add(&bar[XB_XGEN(b.x)], 1u);
            asm volatile("s_waitcnt vmcnt(0)" ::: "memory");
        } else {
            XB_SPIN(xb_ld(&bar[XB_XGEN(b.x)]) == gen, bar);
            __builtin_amdgcn_fence(__ATOMIC_ACQUIRE, "agent");
            asm volatile("s_waitcnt vmcnt(0)" ::: "memory");
        }
    }
    __syncthreads();
}


constexpr int LDS_BYTES = 147456;
constexpr int LDS_MISC_OFF = 146432;
struct Args { const float* in[40]; float* out; unsigned char* ws; int ph_lo, ph_hi; };
enum { I_X = 0, I_C, I_CTX, I_CCTX, I_MODW, I_MODB, I_N1G, I_N2G, I_WIN, I_CQG, I_WUQ, I_CKVG, I_WUKV, I_QNG, I_KNG, I_MLAWO,
       I_NAQG, I_NAKG, I_RPB, I_NAWO, I_MU, I_W0, I_W2, I_A0, I_A2, I_G2, I_KK, I_KA, I_RK, I_LNG, I_LNB, I_RWWO, I_WOUT,
       I_F1, I_F3, I_F2, I_ROUTER, I_M1, I_M3, I_M2 };

struct Frame {
    LAS unsigned char* lds;
    unsigned char* ws;
    int tid, lane, wave, G, vcu, bid;
};

__device__ __forceinline__ Frame launder(const Frame& F) {
    Frame P = F; int w = F.wave, v = F.vcu, b = F.bid; unsigned long long wi = (unsigned long long)F.ws;
    asm volatile("" : "+s"(w), "+s"(v), "+s"(b), "+s"(wi));
    int ln = (int)__builtin_amdgcn_mbcnt_hi(~0u, __builtin_amdgcn_mbcnt_lo(~0u, 0u));
    asm volatile("" : "+v"(ln));
    P.tid = w * 64 + ln; P.lane = ln; P.wave = w; P.vcu = v; P.bid = b;
    P.ws = (unsigned char*)(GAS unsigned char*)wi;
    return P;
}
__device__ __forceinline__ void tr_item(const float* src, int lds_, int scol0, bf16_t* dst, int ldd, int drow0, int koff, int nblk, int ileave, int item, LAS float* scr, int lane) {
    const int kb = item / nblk, nb = item - kb * nblk, k0 = 64 * kb, n0 = 32 * nb;
    {
        f32x4 v[8]; const int c4 = (lane & 7) * 4, r8 = lane >> 3;
        const float* sp = src + (size_t)(k0 + r8) * lds_ + scol0 + n0 + c4;
#pragma unroll
        for (int i = 0; i < 8; ++i) v[i] = *(const f32x4*)(sp + (size_t)(8 * i) * lds_);
#pragma unroll
        for (int i = 0; i < 8; ++i) { LAS float* d = scr + (8 * i + r8) * 33 + c4; d[0] = v[i][0]; d[1] = v[i][1]; d[2] = v[i][2]; d[3] = v[i][3]; }
    }
    LDS_WAIT(); asm volatile("" ::: "memory");
    const int c = lane & 7;
#pragma unroll
    for (int j = 0; j < 4; ++j) { const int n = (lane >> 3) + 8 * j; const LAS float* s = scr + (8 * c) * 33 + n;
        u32x4 o; o.x = cvtpk(s[0 * 33], s[1 * 33]); o.y = cvtpk(s[2 * 33], s[3 * 33]); o.z = cvtpk(s[4 * 33], s[5 * 33]); o.w = cvtpk(s[6 * 33], s[7 * 33]);
        const int nn = n0 + n; const int drow = ileave ? drow0 + (nn >> 7) * 256 + (nn & 127) : drow0 + nn;
        *(u32x4*)(dst + (size_t)drow * ldd + koff + k0 + 8 * c) = o; }
    LDS_WAIT(); asm volatile("" ::: "memory");
}
__device__ __forceinline__ void zero_item(bf16_t* dst, int ldd, int drow0, int koff, int nblk, int item, int lane) {
    const int kb = item / nblk, nb = item - kb * nblk, k0 = 64 * kb, n0 = 32 * nb, c = lane & 7;
#pragma unroll
    for (int j = 0; j < 4; ++j) { const int n = (lane >> 3) + 8 * j; *(u32x4*)(dst + (size_t)(drow0 + n0 + n) * ldd + koff + k0 + 8 * c) = (u32x4){0u, 0u, 0u, 0u}; }
}

#define TRJOB(NITEMS, CALL) { const int _n = (NITEMS); if (r < _n) { CALL; continue; } r -= _n; }
__device__ __forceinline__ void prologue_weights(const Frame& F, const Args& a) {
    LAS float* scr = (LAS float*)(F.lds + F.wave * 16384);
    const int gw = F.vcu * NWAVES + F.wave, NGW = F.G * NWAVES;
    constexpr int PER_LAYER = 16 * 21 + 16 * 3   + 16 * 108   + 16 * 4   + 16 * 96
                              + 6 * 24   + 4 * 32   + 2 * 80   + 3 * 8 * 32   + 16 * 32  ;
    constexpr int FFN_ITEMS = 2 * 16 * 88 + 44 * 32;
    constexpr int NITEMS = 2 * PER_LAYER + FFN_ITEMS;
    for (int it0 = gw; it0 < NITEMS * PROBE_CVT; it0 += NGW) { const int it = it0 % NITEMS;
        int r = it;
        bool done = false;
        for (int l = 0; l < 2 && !done; ++l) {
            if (r >= PER_LAYER) { r -= PER_LAYER; continue; }
            done = true;
            unsigned char* wb = F.ws + WS_W + (size_t)l * WB_SIZE;
            bf16_t* WinM = (bf16_t*)(wb + WB_WINM); bf16_t* WinG = (bf16_t*)(wb + WB_WING);
            const float* win = a.in[I_WIN] + (size_t)l * DM * 7200;
            do {
                if (r < 16 * 21) { tr_item(win, 7200, 0, WinM, DM, 0, 0, 21, 0, r, scr, F.lane); break; } r -= 16 * 21;
                if (r < 16 * 3) { zero_item(WinM, DM, 672, 0, 3, r, F.lane); break; } r -= 16 * 3;
                if (r < 16 * 108) { tr_item(win, 7200, 672, WinM, DM, 768, 0, 108, 0, r, scr, F.lane); break; } r -= 16 * 108;
                if (r < 16 * 4) { zero_item(WinM, DM, 4224, 0, 4, r, F.lane); break; } r -= 16 * 4;
                if (r < 16 * 96) { tr_item(win, 7200, 4128, WinG, DM, 0, 0, 96, 0, r, scr, F.lane); break; } r -= 16 * 96;
                if (r < 6 * 24) { tr_item(a.in[I_WUQ] + (size_t)l * 384 * 768, 768, 0, (bf16_t*)(wb + WB_WUQ), 384, 0, 0, 24, 0, r, scr, F.lane); break; } r -= 6 * 24;
                if (r < 4 * 32) { tr_item(a.in[I_WUKV] + (size_t)l * 256 * 1024, 1024, 0, (bf16_t*)(wb + WB_WUKV), 256, 0, 0, 32, 0, r, scr, F.lane); break; } r -= 4 * 32;
                if (r < 2 * 80) {
                    bf16_t* Wl = (bf16_t*)(wb + WB_WLORA);
                    const int kb = r / 80, nb = r % 80, s = nb / 16;
                    if (64 * kb < (s < 4 ? 64 : 128)) {
                        const float* src = s < 2 ? a.in[I_W2] + ((size_t)l * 2 + s) * 64 * 512 : s < 4 ? a.in[I_A2] + ((size_t)l * 2 + (s - 2)) * 64 * 512 : a.in[I_G2] + (size_t)l * 128 * 512;
                        tr_item(src, 512, 0, Wl, 128, 512 * s, 0, 16, 0, kb * 16 + (nb % 16), scr, F.lane);
                    } else zero_item(Wl, 128, 0, 0, 80, r, F.lane);
                    break; } r -= 2 * 80;
                if (r < 3 * 8 * 32) { const int b = r / 256, rr = r % 256;
                    const float* src = (b == 0 ? a.in[I_MLAWO] : b == 1 ? a.in[I_NAWO] : a.in[I_RWWO]) + (size_t)l * 512 * 1024;
                    tr_item(src, 1024, 0, (bf16_t*)(wb + (b == 0 ? WB_WOA : b == 1 ? WB_WOB : WB_WOR)), 512, 0, 0, 32, 0, rr, scr, F.lane); break; } r -= 3 * 8 * 32;
                tr_item(a.in[I_WOUT] + (size_t)l * 1024 * 1024, 1024, 0, (bf16_t*)(wb + WB_WOUT), 1024, 0, 0, 32, 0, r, scr, F.lane);
            } while (0);
        }
        if (done) continue;
        if (r < 16 * 88) { tr_item(a.in[I_F1], FF, 0, (bf16_t*)(F.ws + WS_W13), DM, 0, 0, 88, 1, r, scr, F.lane); continue; } r -= 16 * 88;
        if (r < 16 * 88) { tr_item(a.in[I_F3], FF, 0, (bf16_t*)(F.ws + WS_W13), DM, 128, 0, 88, 1, r, scr, F.lane); continue; } r -= 16 * 88;
        tr_item(a.in[I_F2], DM, 0, (bf16_t*)(F.ws + WS_W2), FF, 0, 0, 32, 0, r, scr, F.lane);
    }
}
__device__ __forceinline__ void moe_weights(const Frame& F, const Args& a, int part) {
    LAS float* scr = (LAS float*)(F.lds + F.wave * 16384);
    const int gw = F.vcu * NWAVES + F.wave, NGW = F.G * NWAVES;
    constexpr int I13 = 16 * 112, I2 = 56 * 32;
    if (part == 0) {
        constexpr int NIT = NEXP * 2 * I13 + 4 * I2;
        for (int it0 = gw; it0 < NIT * PROBE_CVT; it0 += NGW) { const int it = it0 % NIT;
            if (it < NEXP * 2 * I13) { const int e = it / (2 * I13); int r = it - e * 2 * I13;
                bf16_t* w13 = (bf16_t*)(F.ws + WS_W13E) + (size_t)e * 2 * FFE * DM;
                if (r < I13) tr_item(a.in[I_M1] + (size_t)e * DM * FFE, FFE, 0, w13, DM, 0, 0, 112, 1, r, scr, F.lane);
                else tr_item(a.in[I_M3] + (size_t)e * DM * FFE, FFE, 0, w13, DM, 128, 0, 112, 1, r - I13, scr, F.lane);
            } else { const int q = it - NEXP * 2 * I13, e = 4 + q / I2, r = q % I2;
                tr_item(a.in[I_M2] + (size_t)e * FFE * DM, DM, 0, (bf16_t*)(F.ws + WS_W2E_HI) + (size_t)(e - 4) * DM * FFE, FFE, 0, 0, 32, 0, r, scr, F.lane); }
        }
    } else {
        for (int it = gw; it < 4 * I2; it += NGW) { const int e = it / I2, r = it % I2;
            tr_item(a.in[I_M2] + (size_t)e * FFE * DM, DM, 0, (bf16_t*)(F.ws + WS_W2E_LO) + (size_t)e * DM * FFE, FFE, 0, 0, 32, 0, r, scr, F.lane); }
    }
}

__device__ __forceinline__ void prologue_mod(const Frame& F, const Args& a) {
    LAS float* sl = (LAS float*)(F.lds);
    LAS float* part = sl + 2048;
    if (F.bid >= 192) return;
    const int l = F.bid / 96, nb = F.bid % 96;
    for (int i = F.tid; i < 2048; i += NTHR) { const float v = i < 1024 ? a.in[I_C][i] : a.in[I_CCTX][i - 1024]; sl[i] = siluf_(v); }
    __syncthreads();
    const int col = F.tid & 63, kg = F.tid >> 6, n = nb * 64 + col;
    const float* W = a.in[I_MODW] + (size_t)l * DM * 6144 + n;
    float aL = 0.f, aC = 0.f;
#pragma unroll 32
    for (int k = kg * 128; k < kg * 128 + 128; ++k) { const float w = W[(size_t)k * 6144]; aL += sl[k] * w; aC += sl[1024 + k] * w; }
    part[(kg * 64 + col) * 2] = aL; part[(kg * 64 + col) * 2 + 1] = aC;
    __syncthreads();
    if (F.tid < 128) { const int c2 = F.tid & 63, which = F.tid >> 6; float s = 0.f;
#pragma unroll
        for (int k = 0; k < 8; ++k) s += part[(k * 64 + c2) * 2 + which];
        const int nn = nb * 64 + c2;
        ((float*)(F.ws + WS_MODV))[(size_t)(l * 2 + which) * 6144 + nn] = s + a.in[I_MODB][(size_t)l * 6144 + nn]; }
    __syncthreads();
}

__device__ __forceinline__ void norm_ctx_rows_from_parts(const Frame& F, const float* cm, const float* part, const float* gate, const float* g, const float* sh, const float* sc, bf16_t* dst) {
    const int gw = F.vcu * NWAVES + F.wave, NGW = F.G * NWAVES;
    for (int m = gw; m < CT; m += NGW) {
        f32x4 v[4]; float s = 0.f;
#pragma unroll
        for (int j = 0; j < 4; ++j) { const int d = F.lane * 4 + 256 * j; f32x4 a = {0.f, 0.f, 0.f, 0.f};
#pragma unroll
            for (int k = 0; k < FF / 256; ++k) a += *(const f32x4*)(part + ((size_t)k * CT + m) * DM + d);
            v[j] = *(const f32x4*)(cm + (size_t)m * DM + d) + *(const f32x4*)(gate + d) * a;
            s += (v[j].x * v[j].x + v[j].y * v[j].y) + (v[j].z * v[j].z + v[j].w * v[j].w); }
        const float rstd = rsqrtf(wave_sum(s) * (1.f / DM) + NORM_EPS);
        u32x2* o8 = (u32x2*)(dst + (size_t)(L + m) * DM) + F.lane;
#pragma unroll
        for (int j = 0; j < 4; ++j) { const int d = F.lane * 4 + 256 * j; const f32x4 y = v[j] * rstd * (*(const f32x4*)(g + d)) * (*(const f32x4*)(sc + d) + 1.0f) + *(const f32x4*)(sh + d);
            u32x2 w; w.x = cvtpk(y.x, y.y); w.y = cvtpk(y.z, y.w); o8[64 * j] = w; }
    }
}
__device__ __forceinline__ void norm_rows(const Frame& F, const float* src, int src_row0, int m0, int m1, const float* g, const float* sh, const float* sc, bf16_t* dst) {
    f32x4 ca[4], cb[4];
#pragma unroll
    for (int j = 0; j < 4; ++j) { const int d = F.lane * 4 + 256 * j; const f32x4 gg = *(const f32x4*)(g + d), s1 = *(const f32x4*)(sc + d); ca[j] = gg * (s1 + 1.0f); cb[j] = *(const f32x4*)(sh + d); }
    const int gw = F.vcu * NWAVES + F.wave, NGW = F.G * NWAVES;
    for (int mm = gw; mm < (m1 - m0) * PROBE_ROW; mm += NGW) { const int m = m0 + mm % (m1 - m0);
        const f32x4* xr = (const f32x4*)(src + (size_t)(m - src_row0) * DM) + F.lane;
        f32x4 v[4]; float s = 0.f;
#pragma unroll
        for (int j = 0; j < 4; ++j) { v[j] = xr[64 * j]; s += (v[j].x * v[j].x + v[j].y * v[j].y) + (v[j].z * v[j].z + v[j].w * v[j].w); }
        const float rstd = rsqrtf(wave_sum(s) * (1.f / DM) + NORM_EPS);
        u32x2* o8 = (u32x2*)(dst + (size_t)m * DM) + F.lane;
#pragma unroll
        for (int j = 0; j < 4; ++j) { const f32x4 y = v[j] * rstd * ca[j] + cb[j]; u32x2 w; w.x = cvtpk(y.x, y.y); w.y = cvtpk(y.z, y.w); o8[64 * j] = w; }
    }
}

using pg8::Unit;
struct EpiZ {
    bf16_t *za, *zn, *zr;
    __device__ __forceinline__ void operator()(const f32x4 (&acc)[2][2][4][2], const Unit& u, int wr, int wc, int fr, int fq) const {
        bf16_t* base; int ld, ct;
        if (u.pn < 3) { base = za; ld = ZA_LD; ct = u.pn; } else if (u.pn < 9) { base = zn; ld = ZN_LD; ct = u.pn - 3; } else { base = zr; ld = ZR_LD; ct = u.pn - 9; }
        const int cshift = (ct - u.pn) * 256;
        pg8::epi_each(acc, u, wr, wc, fr, fq, [&](int row, int col, f32x4 v0, f32x4 v1) { pg8::st_bf16x8(base + (size_t)row * ld + col + cshift, v0, v1); });
    }
};
struct EpiBf {
    bf16_t* o; int ld;
    __device__ __forceinline__ void operator()(const f32x4 (&acc)[2][2][4][2], const Unit& u, int wr, int wc, int fr, int fq) const {
        pg8::epi_each(acc, u, wr, wc, fr, fq, [&](int row, int col, f32x4 v0, f32x4 v1) { pg8::st_bf16x8(o + (size_t)row * ld + col, v0, v1); });
    }
};
__device__ __forceinline__ f32x4 lora_fn(f32x4 v, const float* bias, int seg) {
    if (seg < 4) { const f32x4 b = *(const f32x4*)bias;
#pragma unroll
        for (int e = 0; e < 4; ++e) { const float x = b[e] + v[e];
            if (seg < 2) v[e] = -0.6065306597126334f * sigmoidf_(x);
            else v[e] = sigmoidf_(x); } }
    return v;
}
struct EpiLora {
    bf16_t* o; const float* w0; const float* a0;
    __device__ __forceinline__ void operator()(const f32x4 (&acc)[2][2][4][2], const Unit& u, int wr, int wc, int fr, int fq) const {
        const int seg = u.pn >> 1;
        const float* bias = seg < 2 ? w0 : a0 - 1024;
        pg8::epi_each(acc, u, wr, wc, fr, fq, [&](int row, int col, f32x4 v0, f32x4 v1) {
            const f32x4 r0 = lora_fn(v0, bias + col, seg), r1 = lora_fn(v1, bias + col + 4, seg);
            pg8::st_bf16x8(o + (size_t)row * LO_LD + col, r0, r1);
        });
    }
};
struct EpiSig {
    bf16_t* o; int ld;
    __device__ __forceinline__ void operator()(const f32x4 (&acc)[2][2][4][2], const Unit& u, int wr, int wc, int fr, int fq) const {
        pg8::epi_each(acc, u, wr, wc, fr, fq, [&](int row, int col, f32x4 v0, f32x4 v1) {
            f32x4 r0, r1;
#pragma unroll
            for (int e = 0; e < 4; ++e) { r0[e] = fmaxf(sigmoidf_(v0[e]), 1e-13f); r1[e] = fmaxf(sigmoidf_(v1[e]), 1e-13f); }
            pg8::st_bf16x8(o + (size_t)row * ld + col, r0, r1); });
    }
};
struct EpiMerge3 {
    bf16_t* ub; const bf16_t* zg;
    __device__ __forceinline__ void operator()(f32x4 (&acc)[2][2][4][2], const Unit& u, int wr, int wc, int fr, int fq) const {
        const int row0 = u.pm * 256 + wr * 64 + fr, col0 = u.pn * 256 + wc * 32 + 8 * fq;
        if (u.seg < 2) {
            const bf16_t* z = zg + u.seg * 1024 + (size_t)row0 * ZG_LD + col0;
#pragma unroll
            for (int ai = 0; ai < 2; ++ai)
#pragma unroll
                for (int m = 0; m < 4; ++m)
#pragma unroll
                    for (int bj = 0; bj < 2; ++bj) {
                        const bf16_t* p = z + (size_t)(ai * 128 + m * 16) * ZG_LD + bj * 128;
                        const u32x4 ga = *(const u32x4*)p, gb = *(const u32x4*)(p + 1024);
                        const float a_[8] = {lo_bf(ga.x), hi_bf(ga.x), lo_bf(ga.y), hi_bf(ga.y), lo_bf(ga.z), hi_bf(ga.z), lo_bf(ga.w), hi_bf(ga.w)};
                        const float b_[8] = {lo_bf(gb.x), hi_bf(gb.x), lo_bf(gb.y), hi_bf(gb.y), lo_bf(gb.z), hi_bf(gb.z), lo_bf(gb.w), hi_bf(gb.w)};
#pragma unroll
                        for (int e = 0; e < 4; ++e) { acc[ai][bj][m][0][e] *= a_[e] * __builtin_amdgcn_rcpf(b_[e]); acc[ai][bj][m][1][e] *= a_[4 + e] * __builtin_amdgcn_rcpf(b_[4 + e]); }
                    }
        } else {
            const bf16_t* z = zg + 2048;
            pg8::epi_each(acc, u, wr, wc, fr, fq, [&](int row, int col, f32x4 v0, f32x4 v1) {
                const u32x4 gw = *(const u32x4*)(z + (size_t)row * ZG_LD + col);
                const f32x4 g0 = {lo_bf(gw.x), hi_bf(gw.x), lo_bf(gw.y), hi_bf(gw.y)}, g1 = {lo_bf(gw.z), hi_bf(gw.z), lo_bf(gw.w), hi_bf(gw.w)};
                pg8::st_bf16x8(ub + (size_t)row * DM + col, g0 * v0, g1 * v1); });
        }
    }
};
__device__ __forceinline__ bool epi_done(const EpiMerge3&, const Unit& u) { return u.seg == 2; }
struct EpiRes {
    const float* resL; const float* resC; float* outL; float* outC; const float* gateL; const float* gateC;
    __device__ __forceinline__ void operator()(const f32x4 (&acc)[2][2][4][2], const Unit& u, int wr, int wc, int fr, int fq) const {
        const bool isc = u.pm >= L / 256;
        const float* res = isc ? resC - (size_t)L * DM : resL; float* out = isc ? outC - (size_t)L * DM : outL; const float* gate = isc ? gateC : gateL;
        pg8::epi_each(acc, u, wr, wc, fr, fq, [&](int row, int col, f32x4 v0, f32x4 v1) {
            const size_t o = (size_t)row * DM + col;
            const f32x4 g0 = *(const f32x4*)(gate + col), g1 = *(const f32x4*)(gate + col + 4);
            *(f32x4*)(out + o) = *(const f32x4*)(res + o) + g0 * v0; *(f32x4*)(out + o + 4) = *(const f32x4*)(res + o + 4) + g1 * v1;
        });
    }
};
struct EpiSwiglu {
    bf16_t* o; int ld; int row_sub; int ct_mod;
    __device__ __forceinline__ void operator()(const f32x4 (&acc)[2][2][4][2], const Unit& u, int wr, int wc, int fr, int fq) const {
        const int row0 = u.pm * 256 + wr * 64 + fr - row_sub, col0 = (u.pn % ct_mod) * 128 + wc * 32 + 8 * fq;
#pragma unroll
        for (int ai = 0; ai < 2; ++ai)
#pragma unroll
            for (int m = 0; m < 4; ++m) {
                f32x4 r0, r1;
#pragma unroll
                for (int e = 0; e < 4; ++e) { r0[e] = siluf_(acc[ai][0][m][0][e]) * acc[ai][1][m][0][e]; r1[e] = siluf_(acc[ai][0][m][1][e]) * acc[ai][1][m][1][e]; }
                pg8::st_bf16x8(o + (size_t)(row0 + ai * 128 + m * 16) * ld + col0, r0, r1);
            }
    }
};
struct EpiMoe2 {
    bf16_t* ys; const float* rowgate;
    __device__ __forceinline__ void operator()(const f32x4 (&acc)[2][2][4][2], const Unit& u, int wr, int wc, int fr, int fq) const {
        const int cshift = ((u.pn & 3) - u.pn) * 256;
        pg8::epi_each(acc, u, wr, wc, fr, fq, [&](int row, int col, f32x4 v0, f32x4 v1) {
            const float g = rowgate[row];
            pg8::st_bf16x8(ys + (size_t)row * DM + col + cshift, v0 * g, v1 * g);
        });
    }
};
struct CtxSplitOrder {
    int pm, nct, nks, G, c;
    __device__ bool next(int i, Unit& u) const { const int idx = i * G + c; if (idx >= nct * nks) return false; u.pm = pm; u.pn = idx % nct; u.seg = idx / nct; return true; }
};
struct EpiCtxPart {
    float* part;
    __device__ __forceinline__ void operator()(const f32x4 (&acc)[2][2][4][2], const Unit& u, int wr, int wc, int fr, int fq) const {
        float* base = part + (size_t)u.seg * CT * DM - (size_t)L * DM;
        pg8::epi_each(acc, u, wr, wc, fr, fq, [&](int row, int col, f32x4 v0, f32x4 v1) { float* o = base + (size_t)row * DM + col; *(f32x4*)o = v0; *(f32x4*)(o + 4) = v1; });
    }
};
struct MoeOrder {
    int t0, t1, t2, t3, t4, t5, t6, t7, t8, nct, hi_shift, G, c, rep, tm;
    __device__ bool next(int i, Unit& u) const {
        int idx = i * G + c; const int tot = (tm - t0) * nct; if (idx >= tot * rep) return false; idx %= tot;
#define MOE_E(e, ta, tb_, sh) { const int a_ = (ta) < tm ? (ta) : tm, b_ = (tb_) < tm ? (tb_) : tm; const int w = b_ - a_, n = w * nct; if (idx < n) { u.pm = a_ + idx % w; u.pn = (e) * nct + idx / w + (sh); u.seg = 0; return true; } idx -= n; }
        MOE_E(0, t0, t1, 0) MOE_E(1, t1, t2, 0) MOE_E(2, t2, t3, 0) MOE_E(3, t3, t4, 0)
        MOE_E(4, t4, t5, hi_shift) MOE_E(5, t5, t6, hi_shift) MOE_E(6, t6, t7, hi_shift) MOE_E(7, t7, t8, hi_shift)
#undef MOE_E
        return false;
    }
};
struct MoeTailOrder {
    int t1, t2, t3, t4, t5, t6, t7, t8, tm, hi_shift, G, c;
    __device__ bool next(int i, Unit& u) const {
        const int idx = i * G + c; if (idx >= (t8 - tm) * 16) return false;
        const int tile = tm + idx / 16, r = idx % 16;
        const int e = (tile >= t1) + (tile >= t2) + (tile >= t3) + (tile >= t4) + (tile >= t5) + (tile >= t6) + (tile >= t7);
        u.pm = tile; u.pn = e * 4 + (r >> 2) + (e >= 4 ? hi_shift : 0); u.seg = r & 3; return true;
    }
};
struct EpiMoe2P {
    bf16_t* ys; bf16_t* part; const float* rowgate; int row0;
    __device__ __forceinline__ void operator()(const f32x4 (&acc)[2][2][4][2], const Unit& u, int wr, int wc, int fr, int fq) const {
        const int cshift = ((u.pn & 3) - u.pn) * 256;
        bf16_t* dst = u.seg == 0 ? ys : part + ((size_t)(u.seg - 1) * MOE_TAIL_ROWS - row0) * DM;
        pg8::epi_each(acc, u, wr, wc, fr, fq, [&](int row, int col, f32x4 v0, f32x4 v1) {
            const float g = rowgate[row];
            pg8::st_bf16x8(dst + (size_t)row * DM + col + cshift, v0 * g, v1 * g);
        });
    }
};

struct PrepIn { unsigned za[3]; u32x2 zk; unsigned kr; u32x4 nq, nk; u32x4 zc[3], zp[3], zn[3]; unsigned tc[3], tp[3], tn[3]; };
__device__ __forceinline__ void prep_row_load(const Frame& F, int m, PrepIn& I) {
    const bf16_t* ZA = (const bf16_t*)(F.ws + WS_ZA); const bf16_t* ZN = (const bf16_t*)(F.ws + WS_ZN); const bf16_t* ZR = (const bf16_t*)(F.ws + WS_ZR);
    const int lane = F.lane;
    { const unsigned* p = (const unsigned*)(ZA + (size_t)m * ZA_LD) + lane * 3; I.za[0] = p[0]; I.za[1] = p[1]; I.za[2] = p[2]; }
    I.zk = *((const u32x2*)(ZA + (size_t)m * ZA_LD + 384) + lane);
    I.kr = ((const unsigned*)(ZA + (size_t)m * ZA_LD + 640))[lane & 15];
    I.nq = *((const u32x4*)(ZN + (size_t)m * ZN_LD) + lane); I.nk = *((const u32x4*)(ZN + (size_t)m * ZN_LD + 512) + lane);
    const bool hasp = (m != 0) && (m != L), hasn = (m != L - 1) && (m != R - 1);
    const bf16_t* zc = ZR + (size_t)m * ZR_LD; const bf16_t* zp = zc - ZR_LD; const bf16_t* zn = zc + ZR_LD;
#pragma unroll
    for (int ch = 0; ch < 3; ++ch) { const int c0 = ch * 512 + lane * 8;
        I.zc[ch] = *(const u32x4*)(zc + c0); I.zp[ch] = (u32x4){0u, 0u, 0u, 0u}; I.zn[ch] = (u32x4){0u, 0u, 0u, 0u};
        if (hasp) I.zp[ch] = *(const u32x4*)(zp + c0); if (hasn) I.zn[ch] = *(const u32x4*)(zn + c0);
        const int c1 = 1536 + ch * 128 + lane * 2;
        I.tc[ch] = *(const unsigned*)(zc + c1); I.tp[ch] = 0u; I.tn[ch] = 0u;
        if (hasp) I.tp[ch] = *(const unsigned*)(zp + c1); if (hasn) I.tn[ch] = *(const unsigned*)(zn + c1); }
}
__device__ __forceinline__ void prep_row_compute(const Frame& F, int m, const PrepIn& I, const float (&cqg)[6], const float (&ckvg)[4], const float (&qng)[8], const float (&kng)[8], const float (&kkv)[8], const float* mu0, const float* mu1) {
    bf16_t* ZN = (bf16_t*)(F.ws + WS_ZN);
    bf16_t* CQN = (bf16_t*)(F.ws + WS_CQN); bf16_t* CKVN = (bf16_t*)(F.ws + WS_CKVN); bf16_t* LA = (bf16_t*)(F.ws + WS_LA); bf16_t* KR = (bf16_t*)(F.ws + WS_KR);
    bf16_t* RKV = (bf16_t*)(F.ws + WS_RKV);
    const int lane = F.lane;
    { float v[6] = {lo_bf(I.za[0]), hi_bf(I.za[0]), lo_bf(I.za[1]), hi_bf(I.za[1]), lo_bf(I.za[2]), hi_bf(I.za[2])}; float s = 0.f;
#pragma unroll
      for (int e = 0; e < 6; ++e) s += v[e] * v[e];
      const float rstd = rsqrtf(wave_sum(s) * (1.f / 384.f) + NORM_EPS);
      unsigned* o = (unsigned*)(CQN + (size_t)m * 384) + lane * 3;
      o[0] = cvtpk(v[0] * rstd * cqg[0], v[1] * rstd * cqg[1]); o[1] = cvtpk(v[2] * rstd * cqg[2], v[3] * rstd * cqg[3]); o[2] = cvtpk(v[4] * rstd * cqg[4], v[5] * rstd * cqg[5]); }
    { float v[4] = {lo_bf(I.zk.x), hi_bf(I.zk.x), lo_bf(I.zk.y), hi_bf(I.zk.y)}; float s = v[0] * v[0] + v[1] * v[1] + v[2] * v[2] + v[3] * v[3];
      const float rstd = rsqrtf(wave_sum(s) * (1.f / 256.f) + NORM_EPS);
      u32x2 o; o.x = cvtpk(v[0] * rstd * ckvg[0], v[1] * rstd * ckvg[1]); o.y = cvtpk(v[2] * rstd * ckvg[2], v[3] * rstd * ckvg[3]);
      *((u32x2*)(CKVN + (size_t)m * 256) + lane) = o; }
    if (lane < 16) ((unsigned*)(KR + (size_t)m * 32))[lane] = I.kr;
#pragma unroll
    for (int qk = 0; qk < 2; ++qk) {
        const u32x4 w = qk == 0 ? I.nq : I.nk;
        float v[8] = {lo_bf(w.x), hi_bf(w.x), lo_bf(w.y), hi_bf(w.y), lo_bf(w.z), hi_bf(w.z), lo_bf(w.w), hi_bf(w.w)}; float s = 0.f;
#pragma unroll
        for (int e = 0; e < 8; ++e) s += v[e] * v[e];
        s += __shfl_xor(s, 1); s += __shfl_xor(s, 2); s += __shfl_xor(s, 4);
        const float rstd = rsqrtf(s * (1.f / 64.f) + NORM_EPS);
        u32x4 o;
        if (qk == 0) { o.x = cvtpk(v[0] * rstd * qng[0], v[1] * rstd * qng[1]); o.y = cvtpk(v[2] * rstd * qng[2], v[3] * rstd * qng[3]); o.z = cvtpk(v[4] * rstd * qng[4], v[5] * rstd * qng[5]); o.w = cvtpk(v[6] * rstd * qng[6], v[7] * rstd * qng[7]); }
        else { o.x = cvtpk(v[0] * rstd * kng[0], v[1] * rstd * kng[1]); o.y = cvtpk(v[2] * rstd * kng[2], v[3] * rstd * kng[3]); o.z = cvtpk(v[4] * rstd * kng[4], v[5] * rstd * kng[5]); o.w = cvtpk(v[6] * rstd * kng[6], v[7] * rstd * kng[7]); }
        *((u32x4*)(ZN + (size_t)m * ZN_LD + qk * 512) + lane) = o;
    }
#pragma unroll
    for (int ch = 0; ch < 3; ++ch) {
        const int c0 = ch * 512 + lane * 8;
        const u32x4 wc_ = I.zc[ch], wp = I.zp[ch], wn = I.zn[ch];
        const float zcv[8] = {lo_bf(wc_.x), hi_bf(wc_.x), lo_bf(wc_.y), hi_bf(wc_.y), lo_bf(wc_.z), hi_bf(wc_.z), lo_bf(wc_.w), hi_bf(wc_.w)};
        const float zpv[8] = {lo_bf(wp.x), hi_bf(wp.x), lo_bf(wp.y), hi_bf(wp.y), lo_bf(wp.z), hi_bf(wp.z), lo_bf(wp.w), hi_bf(wp.w)};
        const float znv[8] = {lo_bf(wn.x), hi_bf(wn.x), lo_bf(wn.y), hi_bf(wn.y), lo_bf(wn.z), hi_bf(wn.z), lo_bf(wn.w), hi_bf(wn.w)};
        float o[8];
        const f32x4 ma = *(const f32x4*)(mu0 + c0), mb = *(const f32x4*)(mu0 + c0 + 4), na = *(const f32x4*)(mu1 + c0), nb = *(const f32x4*)(mu1 + c0 + 4);
        const float m0v[8] = {ma[0], ma[1], ma[2], ma[3], mb[0], mb[1], mb[2], mb[3]}, m1v[8] = {na[0], na[1], na[2], na[3], nb[0], nb[1], nb[2], nb[3]};
#pragma unroll
        for (int e = 0; e < 8; ++e) o[e] = zcv[e] + m0v[e] * (zpv[e] - zcv[e]) + m1v[e] * (znv[e] - zcv[e]);
        u32x4 w; w.x = cvtpk(o[0], o[1]); w.y = cvtpk(o[2], o[3]); w.z = cvtpk(o[4], o[5]); w.w = cvtpk(o[6], o[7]);
        *(u32x4*)(RKV + (size_t)m * RKV_LD + c0) = w;
        if (ch == 1) {
            const float kr_[8] = {lo_bf(w.x), hi_bf(w.x), lo_bf(w.y), hi_bf(w.y), lo_bf(w.z), hi_bf(w.z), lo_bf(w.w), hi_bf(w.w)};
            float s2 = 0.f;
#pragma unroll
            for (int e = 0; e < 8; ++e) { const float kx = kr_[e] * kkv[e]; s2 += kx * kx; }
            s2 += __shfl_xor(s2, 1); s2 += __shfl_xor(s2, 2); s2 += __shfl_xor(s2, 4);
            if ((lane & 7) == 0) ((float*)(F.ws + WS_KN))[(size_t)m * 8 + (lane >> 3)] = 1.f / fmaxf(sqrtf(s2), 1e-12f);
        }
    }
#pragma unroll
    for (int ch = 0; ch < 3; ++ch) {
        const int c0 = 1536 + ch * 128 + lane * 2;
        float o0 = lo_bf(I.tc[ch]), o1 = hi_bf(I.tc[ch]);
        o0 = o0 + mu0[c0] * (lo_bf(I.tp[ch]) - o0) + mu1[c0] * (lo_bf(I.tn[ch]) - o0);
        o1 = o1 + mu0[c0 + 1] * (hi_bf(I.tp[ch]) - o1) + mu1[c0 + 1] * (hi_bf(I.tn[ch]) - o1);
        if (ch == 0) { o0 = tanhf(o0); o1 = tanhf(o1); } else if (ch == 2) { o0 = sigmoidf_(o0); o1 = sigmoidf_(o1); }
        *(unsigned*)(LA + (size_t)m * 384 + ch * 128 + lane * 2) = cvtpk(o0, o1);
    }
}
__device__ __forceinline__ void prepare_rows(const Frame& F, const Args& a, int l) {
    const int lane = F.lane;
    float cqg[6], ckvg[4], qng[8], kng[8];
#pragma unroll
    for (int e = 0; e < 6; ++e) cqg[e] = a.in[I_CQG][l * 384 + lane * 6 + e];
#pragma unroll
    for (int e = 0; e < 4; ++e) ckvg[e] = a.in[I_CKVG][l * 256 + lane * 4 + e];
#pragma unroll
    for (int e = 0; e < 8; ++e) { qng[e] = a.in[I_NAQG][l * 64 + (lane & 7) * 8 + e] * (0.125f * LOG2E); kng[e] = a.in[I_NAKG][l * 64 + (lane & 7) * 8 + e]; }
    const float* mu0 = a.in[I_MU] + (size_t)l * 2 * 1920; const float* mu1 = mu0 + 1920;
    float kkv[8];
#pragma unroll
    for (int e = 0; e < 8; ++e) kkv[e] = a.in[I_KK][l * 512 + lane * 8 + e];
    const int gw = F.vcu * NWAVES + F.wave, NGW = F.G * NWAVES;
    PrepIn cur, nxt;
    if (gw < R) prep_row_load(F, gw, cur);
    for (int m = gw; m < R; m += NGW) {
        if (m + NGW < R) prep_row_load(F, m + NGW, nxt);
        prep_row_compute(F, m, cur, cqg, ckvg, qng, kng, kkv, mu0, mu1);
        cur = nxt;
    }
}

struct FixIn { u32x4 qn, kn, vv; unsigned short qr[4], kr[4]; };
__device__ __forceinline__ void fix_load(const Frame& F, int m, bool need_q, FixIn& I) {
    const bf16_t* QRAW = (const bf16_t*)(F.ws + WS_QRAW); const bf16_t* KVRAW = (const bf16_t*)(F.ws + WS_KVRAW); const bf16_t* KR = (const bf16_t*)(F.ws + WS_KR);
    const int h = F.lane >> 3, sub = F.lane & 7;
    if (need_q) { const bf16_t* q = QRAW + (size_t)m * 768 + h * 96; I.qn = *(const u32x4*)(q + 8 * sub);
#pragma unroll
        for (int i = 0; i < 4; ++i) I.qr[i] = q[64 + sub + 8 * i]; }
    const bf16_t* kv = KVRAW + (size_t)m * 1024 + h * 128; I.kn = *(const u32x4*)(kv + 8 * sub); I.vv = *(const u32x4*)(kv + 64 + 8 * sub);
#pragma unroll
    for (int i = 0; i < 4; ++i) I.kr[i] = KR[(size_t)m * 32 + sub + 8 * i];
}
__device__ __forceinline__ void fix_head(u32x4 nw, const unsigned short (&rw)[4], const float (&gn)[8], const float (&gr)[4], float cr, float sr, float cc, float sc, bf16_t* o, int sub) {
    float v[8] = {lo_bf(nw.x), hi_bf(nw.x), lo_bf(nw.y), hi_bf(nw.y), lo_bf(nw.z), hi_bf(nw.z), lo_bf(nw.w), hi_bf(nw.w)};
    float r[4] = {bf2f(rw[0]), bf2f(rw[1]), bf2f(rw[2]), bf2f(rw[3])};
    float s = 0.f;
#pragma unroll
    for (int e = 0; e < 8; ++e) s += v[e] * v[e];
#pragma unroll
    for (int e = 0; e < 4; ++e) s += r[e] * r[e];
    s += __shfl_xor(s, 1); s += __shfl_xor(s, 2); s += __shfl_xor(s, 4);
    const float rstd = rsqrtf(s * (1.f / 96.f) + NORM_EPS);
#pragma unroll
    for (int e = 0; e < 8; ++e) v[e] *= rstd * gn[e];
#pragma unroll
    for (int e = 0; e < 4; ++e) r[e] *= rstd * gr[e];
    u32x4 w; w.x = cvtpk(v[0], v[1]); w.y = cvtpk(v[2], v[3]); w.z = cvtpk(v[4], v[5]); w.w = cvtpk(v[6], v[7]);
    *(u32x4*)(o + 8 * sub) = w;
    const float t0 = r[0] * cr - r[1] * sr, t1 = r[0] * sr + r[1] * cr, t2 = r[2] * cc - r[3] * sc, t3 = r[2] * sc + r[3] * cc;
    o[64 + sub] = (bf16_t)(cvtpk(t0, 0.f) & 0xffffu); o[72 + sub] = (bf16_t)(cvtpk(t1, 0.f) & 0xffffu); o[80 + sub] = (bf16_t)(cvtpk(t2, 0.f) & 0xffffu); o[88 + sub] = (bf16_t)(cvtpk(t3, 0.f) & 0xffffu);
}
__device__ __forceinline__ void mla_fixup(const Frame& F, const Args& a, int l, bool need_ctx_q) {
    bf16_t* Q = (bf16_t*)(F.ws + WS_Q); bf16_t* K = (bf16_t*)(F.ws + WS_K); bf16_t* V = (bf16_t*)(F.ws + WS_V);
    const int lane = F.lane, h = lane >> 3, sub = lane & 7;
    float qgn[8], kgn[8], qgr[4], kgr[4];
#pragma unroll
    for (int e = 0; e < 8; ++e) { qgn[e] = a.in[I_QNG][l * 96 + 8 * sub + e] * (0.10206207261596575f * LOG2E); kgn[e] = a.in[I_KNG][l * 96 + 8 * sub + e]; }
#pragma unroll
    for (int i = 0; i < 4; ++i) { qgr[i] = a.in[I_QNG][l * 96 + 64 + sub + 8 * i] * (0.10206207261596575f * LOG2E); kgr[i] = a.in[I_KNG][l * 96 + 64 + sub + 8 * i]; }
    const float freq = __expf(-9.210340371976184f * (float)sub * 0.125f);
    const int gw = F.vcu * NWAVES + F.wave, NGW = F.G * NWAVES;
    FixIn cur, nxt;
    if (gw < R) fix_load(F, gw, gw < L || need_ctx_q, cur);
    for (int m = gw; m < R; m += NGW) {
        if (m + NGW < R) fix_load(F, m + NGW, (m + NGW) < L || need_ctx_q, nxt);
        const bool lat = m < L;
        float cr = 1.f, sr = 0.f, cc = 1.f, sc = 0.f;
        if (lat) { __sincosf((float)(m >> 6) * freq, &sr, &cr); __sincosf((float)(m & 63) * freq, &sc, &cc); }
        if (lat || need_ctx_q) fix_head(cur.qn, cur.qr, qgn, qgr, cr, sr, cc, sc, Q + ((size_t)h * R + m) * 96, sub);
        fix_head(cur.kn, cur.kr, kgn, kgr, cr, sr, cc, sc, K + ((size_t)h * R + m) * 96, sub);
        *(u32x4*)(V + ((size_t)h * R + m) * 64 + sub * 8) = cur.vv;
        cur = nxt;
    }
}

__device__ __forceinline__ void rwkv_output_rows(const Frame& F, const Args& a, int l, int m_end) {
    const bf16_t* RKV = (const bf16_t*)(F.ws + WS_RKV); const bf16_t* LO = (const bf16_t*)(F.ws + WS_LO);
    const bf16_t* YF = (const bf16_t*)(F.ws + WS_YF); const bf16_t* YBK = (const bf16_t*)(F.ws + WS_YBK); bf16_t* YR = (bf16_t*)(F.ws + WS_YR);
    const int lane = F.lane, c0 = lane * 8;
    float ka[8], rk[8], lg[8], lb[8];
#pragma unroll
    for (int e = 0; e < 8; ++e) { ka[e] = a.in[I_KA][l * 512 + c0 + e]; rk[e] = a.in[I_RK][l * 512 + c0 + e]; lg[e] = a.in[I_LNG][l * 512 + c0 + e]; lb[e] = a.in[I_LNB][l * 512 + c0 + e]; }
    const int gw = F.vcu * NWAVES + F.wave, NGW = F.G * NWAVES;
#define UNPK8(W, V) const float V[8] = {lo_bf(W.x), hi_bf(W.x), lo_bf(W.y), hi_bf(W.y), lo_bf(W.z), hi_bf(W.z), lo_bf(W.w), hi_bf(W.w)}
    u32x4 cw[8], nw[8];
#define RWO_LOAD(W, m_) do { const int mm_ = (m_); W[0] = *(const u32x4*)(RKV + (size_t)mm_ * RKV_LD + c0); W[1] = *(const u32x4*)(RKV + (size_t)mm_ * RKV_LD + 512 + c0); W[2] = *(const u32x4*)(RKV + (size_t)mm_ * RKV_LD + 1024 + c0); \
        W[3] = *(const u32x4*)(LO + (size_t)mm_ * LO_LD + 1024 + c0); W[4] = *(const u32x4*)(LO + (size_t)mm_ * LO_LD + 1536 + c0); W[5] = *(const u32x4*)(LO + (size_t)mm_ * LO_LD + 2048 + c0); \
        W[6] = *(const u32x4*)(YF + (size_t)mm_ * 512 + c0); W[7] = *(const u32x4*)(YBK + (size_t)mm_ * 512 + c0); } while (0)
    if (gw < m_end) RWO_LOAD(cw, gw);
    for (int m = gw; m < m_end; m += NGW) {
        if (m + NGW < m_end) RWO_LOAD(nw, m + NGW);
        const u32x4 wr_ = cw[0], wk_ = cw[1], wv_ = cw[2], wa0 = cw[3], wa1 = cw[4], wg_ = cw[5], wyf = cw[6], wyb = cw[7];
        UNPK8(wr_, r); UNPK8(wk_, k); UNPK8(wv_, v); UNPK8(wa0, a0v); UNPK8(wa1, a1v); UNPK8(wg_, g); UNPK8(wyf, yf); UNPK8(wyb, yb);
        float y[8]; float s = 0.f, bs = 0.f;
#pragma unroll
        for (int e = 0; e < 8; ++e) { y[e] = yf[e] + yb[e]; s += y[e];
            const float kd0 = k[e] * (1.f + (a0v[e] - 1.f) * ka[e]), kd1 = k[e] * (1.f + (a1v[e] - 1.f) * ka[e]);
            bs += r[e] * rk[e] * (kd0 + kd1); }
        s += __shfl_xor(s, 1); s += __shfl_xor(s, 2); s += __shfl_xor(s, 4);
        bs += __shfl_xor(bs, 1); bs += __shfl_xor(bs, 2); bs += __shfl_xor(bs, 4);
        const float mean = s * (1.f / 64.f); float q = 0.f;
#pragma unroll
        for (int e = 0; e < 8; ++e) { const float d = y[e] - mean; q += d * d; }
        q += __shfl_xor(q, 1); q += __shfl_xor(q, 2); q += __shfl_xor(q, 4);
        const float rstd = rsqrtf(q * (1.f / 64.f) + 64e-5f);
        float o[8];
#pragma unroll
        for (int e = 0; e < 8; ++e) o[e] = ((y[e] - mean) * rstd * lg[e] + lb[e] + bs * v[e]) * g[e];
        u32x4 w; w.x = cvtpk(o[0], o[1]); w.y = cvtpk(o[2], o[3]); w.z = cvtpk(o[4], o[5]); w.w = cvtpk(o[6], o[7]);
        *(u32x4*)(YR + (size_t)m * 512 + c0) = w;
#pragma unroll
        for (int i = 0; i < 8; ++i) cw[i] = nw[i];
    }
#undef RWO_LOAD
#undef UNPK8
}

__device__ __forceinline__ int crow(int r, int hi) { return (r & 3) + 8 * (r >> 2) + 4 * hi; }
#define SBAR() __builtin_amdgcn_sched_barrier(0)
__device__ __forceinline__ s16x4 tr_read_at(unsigned addr) { s16x4 r; asm volatile("ds_read_b64_tr_b16 %0, %1" : "=&v"(r) : "v"(addr) : "memory"); return r; }
__device__ __forceinline__ float rowmax32(const f32x16& p0, const f32x16& p1) {
    float m = p0[0];
#pragma unroll
    for (int r = 1; r < 16; ++r) m = fmaxf(m, p0[r]);
#pragma unroll
    for (int r = 0; r < 16; ++r) m = fmaxf(m, p1[r]);
    auto rr = __builtin_amdgcn_permlane32_swap(__float_as_uint(m), __float_as_uint(m), false, false);
    return fmaxf(__uint_as_float(rr[0]), __uint_as_float(rr[1]));
}
__device__ __forceinline__ float halfsum(float s) {
    auto rr = __builtin_amdgcn_permlane32_swap(__float_as_uint(s), __float_as_uint(s), false, false);
    return __uint_as_float(rr[0]) + __uint_as_float(rr[1]);
}
__device__ __forceinline__ void pack_p(const f32x16& p0, const f32x16& p1, bf16x8 (&pa)[4]) {
#define PK8(P, B, OUT) do { u32x4 w = {cvtpk(P[B + 0], P[B + 1]), cvtpk(P[B + 2], P[B + 3]), cvtpk(P[B + 4], P[B + 5]), cvtpk(P[B + 6], P[B + 7])}; OUT = __builtin_bit_cast(bf16x8, w); } while (0)
    PK8(p0, 0, pa[0]); PK8(p0, 8, pa[1]); PK8(p1, 0, pa[2]); PK8(p1, 8, pa[3]);
#undef PK8
}

constexpr int AK_PITCH = 208, AK_BYTES = 64 * AK_PITCH, AV_BYTES = 8192;
constexpr int ANSLOT = 6;
constexpr int ALDS_K = 0, ALDS_V = ANSLOT * AK_BYTES, ALDS_WS = ALDS_V + ANSLOT * AV_BYTES, ALDS_END = ALDS_WS + 8 * 256;
static_assert(ALDS_END <= 131072, "MLA LDS");
typedef short v4i16_t __attribute__((ext_vector_type(4)));
__device__ __forceinline__ s16x4 vtr(LAS const unsigned char* p) { return __builtin_bit_cast(s16x4, __builtin_amdgcn_ds_read_tr16_b64_v4i16((LAS v4i16_t*)p)); }
__device__ __forceinline__ void mla_unit(const Frame& F, int h, int q0, int k0, int nt) {
    const bf16_t* Q = (const bf16_t*)(F.ws + WS_Q) + (size_t)h * R * 96; const bf16_t* K = (const bf16_t*)(F.ws + WS_K) + (size_t)h * R * 96 + (size_t)k0 * 96;
    const bf16_t* V = (const bf16_t*)(F.ws + WS_V) + (size_t)h * R * 64 + (size_t)k0 * 64; bf16_t* YA = (bf16_t*)(F.ws + WS_YA);
    LAS unsigned char* lds = F.lds;
    const int tid = F.tid, lane = F.lane, wid = F.wave, r32 = lane & 31, hi = lane >> 5;
    LAS float* wsf = (LAS float*)(lds + ALDS_WS) + wid * 64;
    bf16x8 qr[6];
    { const bf16_t* qp = Q + (size_t)(q0 + wid * 32 + r32) * 96 + hi * 8;
#pragma unroll
      for (int s = 0; s < 6; ++s) qr[s] = *(const bf16x8*)(qp + s * 16); }
    const int kc0 = tid, kc1 = 512 + tid; const bool k2 = tid < 256;
    const int kr0 = kc0 / 12, kq0 = kc0 % 12, kr1 = kc1 / 12, kq1 = kc1 % 12;
    const int vkey = tid >> 3, vc8 = tid & 7;
    const unsigned kdst0 = kr0 * AK_PITCH + kq0 * 16, kdst1 = kr1 * AK_PITCH + kq1 * 16;
    const unsigned vdst = (vc8 >> 2) * 4096 + vkey * 64 + (vc8 & 3) * 16;
    u32x4 sk0, sk1, sv, tk0, tk1, tv;
#define A_LOAD(t) do { const bf16_t* kt = K + (size_t)(t) * 64 * 96; sk0 = *(const u32x4*)(kt + kr0 * 96 + kq0 * 8); if (k2) sk1 = *(const u32x4*)(kt + kr1 * 96 + kq1 * 8); \
        sv = *(const u32x4*)(V + (size_t)(t) * 64 * 64 + vkey * 64 + vc8 * 8); } while (0)
#define A_WRITE(sl) do { *(LAS u32x4*)(lds + ALDS_K + (sl) * AK_BYTES + kdst0) = sk0; if (k2) *(LAS u32x4*)(lds + ALDS_K + (sl) * AK_BYTES + kdst1) = sk1; \
        *(LAS u32x4*)(lds + ALDS_V + (sl) * AV_BYTES + vdst) = sv; } while (0)
#define A_LOAD2(t) do { const bf16_t* kt = K + (size_t)(t) * 64 * 96; tk0 = *(const u32x4*)(kt + kr0 * 96 + kq0 * 8); if (k2) tk1 = *(const u32x4*)(kt + kr1 * 96 + kq1 * 8); \
        tv = *(const u32x4*)(V + (size_t)(t) * 64 * 64 + vkey * 64 + vc8 * 8); } while (0)
#define A_WRITE2(sl) do { *(LAS u32x4*)(lds + ALDS_K + (sl) * AK_BYTES + kdst0) = tk0; if (k2) *(LAS u32x4*)(lds + ALDS_K + (sl) * AK_BYTES + kdst1) = tk1; \
        *(LAS u32x4*)(lds + ALDS_V + (sl) * AV_BYTES + vdst) = tv; } while (0)
    f32x16 o[2]; o[0] = f32x16{}; o[1] = f32x16{};
    float mref = 0.f, lsum = 0.f; f32x16 negm = f32x16{};
    LAS const unsigned char* kb_rd = lds + ALDS_K + r32 * AK_PITCH + hi * 16;
    LAS const unsigned char* vb_rd = lds + ALDS_V + ((lane >> 4) & 1) * 32 + (lane & 3) * 8 + (4 * hi + ((lane & 15) >> 2)) * 64;
#define PIN(x) asm volatile("" : "+v"(x))
#define A_QKT(C0, C1, sl) do { LAS const unsigned char* kt_ = kb_rd + (sl) * AK_BYTES; C0 = negm; C1 = negm; \
        _Pragma("unroll") for (int s = 0; s < 6; ++s) { const bf16x8 a0 = *(LAS const bf16x8*)(kt_ + s * 32); const bf16x8 a1 = *(LAS const bf16x8*)(kt_ + 32 * AK_PITCH + s * 32); \
            C0 = __builtin_amdgcn_mfma_f32_32x32x16_bf16(a0, qr[s], C0, 0, 0, 0); C1 = __builtin_amdgcn_mfma_f32_32x32x16_bf16(a1, qr[s], C1, 0, 0, 0); } } while (0)
#define A_MAX(C0, C1, al) do { const float rm_ = rowmax32(C0, C1); al = 1.f; \
        if (__builtin_expect(__any(rm_ > 8.f), 0)) { const float dl_ = fmaxf(rm_, 0.f); mref += dl_; al = __builtin_amdgcn_exp2f(-dl_); \
            _Pragma("unroll") for (int r = 0; r < 16; ++r) { C0[r] -= dl_; C1[r] -= dl_; negm[r] = -mref; } } } while (0)
#define A_RESC(al) do { if (__any((al) < 1.f)) { if (hi == 0) wsf[r32] = (al); LDS_WAIT(); \
        _Pragma("unroll") for (int r = 0; r < 16; ++r) { const float f_ = wsf[crow(r, hi)]; o[0][r] *= f_; o[1][r] *= f_; } } } while (0)
#define A_STEP(C0, C1, P0, P1, sk_, sv_, alP, alC) do { \
        LAS const unsigned char* kt_ = kb_rd + (sk_) * AK_BYTES; LAS const unsigned char* vt_ = vb_rd + (sv_) * AV_BYTES; \
        bf16x8 ka_[2], kb_[2]; u32x4 pw_[4]; float ps0_ = 0.f, ps1_ = 0.f; \
        ka_[0] = *(LAS const bf16x8*)(kt_); kb_[0] = *(LAS const bf16x8*)(kt_ + 32 * AK_PITCH); SBAR(); \
        _Pragma("unroll") for (int s = 0; s < 6; ++s) { const int c_ = s & 1, n_ = c_ ^ 1; \
            if (s + 1 < 6) { ka_[n_] = *(LAS const bf16x8*)(kt_ + (s + 1) * 32); kb_[n_] = *(LAS const bf16x8*)(kt_ + 32 * AK_PITCH + (s + 1) * 32); } \
            if (s == 0) C0 = __builtin_amdgcn_mfma_f32_32x32x16_bf16(ka_[c_], qr[s], negm, 0, 0, 0); else C0 = __builtin_amdgcn_mfma_f32_32x32x16_bf16(ka_[c_], qr[s], C0, 0, 0, 0); \
            if (s < 4) { ps0_ += P0[4 * s] + P0[4 * s + 1]; ps1_ += P0[4 * s + 2] + P0[4 * s + 3]; PIN(ps0_); PIN(ps1_); } \
            else { pw_[2 * (s - 4)][0] = cvtpk(P0[8 * (s - 4)], P0[8 * (s - 4) + 1]); pw_[2 * (s - 4)][1] = cvtpk(P0[8 * (s - 4) + 2], P0[8 * (s - 4) + 3]); pw_[2 * (s - 4)][2] = cvtpk(P0[8 * (s - 4) + 4], P0[8 * (s - 4) + 5]); pw_[2 * (s - 4)][3] = cvtpk(P0[8 * (s - 4) + 6], P0[8 * (s - 4) + 7]); PIN(pw_[2 * (s - 4)]); } \
            SBAR(); \
            if (s == 0) C1 = __builtin_amdgcn_mfma_f32_32x32x16_bf16(kb_[c_], qr[s], negm, 0, 0, 0); else C1 = __builtin_amdgcn_mfma_f32_32x32x16_bf16(kb_[c_], qr[s], C1, 0, 0, 0); \
            if (s < 4) { ps0_ += P1[4 * s] + P1[4 * s + 1]; ps1_ += P1[4 * s + 2] + P1[4 * s + 3]; PIN(ps0_); PIN(ps1_); } \
            else { pw_[2 * (s - 4) + 1][0] = cvtpk(P1[8 * (s - 4)], P1[8 * (s - 4) + 1]); pw_[2 * (s - 4) + 1][1] = cvtpk(P1[8 * (s - 4) + 2], P1[8 * (s - 4) + 3]); pw_[2 * (s - 4) + 1][2] = cvtpk(P1[8 * (s - 4) + 4], P1[8 * (s - 4) + 5]); pw_[2 * (s - 4) + 1][3] = cvtpk(P1[8 * (s - 4) + 6], P1[8 * (s - 4) + 7]); PIN(pw_[2 * (s - 4) + 1]); } \
            SBAR(); } \
        lsum = lsum * (alP) + (ps0_ + ps1_); \
        A_MAX(C0, C1, alC); SBAR(); \
          \
        s16x4 vl_[2], vh_[2]; vl_[0] = vtr(vt_); vh_[0] = vtr(vt_ + 512); SBAR(); \
        _Pragma("unroll") for (int m_ = 0; m_ < 8; ++m_) { const int dt_ = m_ >> 2, s_ = m_ & 3, c_ = m_ & 1, n_ = c_ ^ 1; \
            if (m_ + 1 < 8) { vl_[n_] = vtr(vt_ + ((m_ + 1) >> 2) * 4096 + ((m_ + 1) & 3) * 1024); vh_[n_] = vtr(vt_ + ((m_ + 1) >> 2) * 4096 + ((m_ + 1) & 3) * 1024 + 512); } \
            const bf16x8 vf_ = {vl_[c_][0], vl_[c_][1], vl_[c_][2], vl_[c_][3], vh_[c_][0], vh_[c_][1], vh_[c_][2], vh_[c_][3]}; \
            const int pi_ = (s_ == 0) ? 0 : (s_ == 1) ? 2 : (s_ == 2) ? 1 : 3; \
            o[dt_] = __builtin_amdgcn_mfma_f32_32x32x16_bf16(__builtin_bit_cast(bf16x8, pw_[pi_]), vf_, o[dt_], 0, 0, 0); \
            if (m_ < 4) { C0[4 * m_] = __builtin_amdgcn_exp2f(C0[4 * m_]); C0[4 * m_ + 1] = __builtin_amdgcn_exp2f(C0[4 * m_ + 1]); C0[4 * m_ + 2] = __builtin_amdgcn_exp2f(C0[4 * m_ + 2]); C0[4 * m_ + 3] = __builtin_amdgcn_exp2f(C0[4 * m_ + 3]); PIN(C0); } \
            else { C1[4 * (m_ - 4)] = __builtin_amdgcn_exp2f(C1[4 * (m_ - 4)]); C1[4 * (m_ - 4) + 1] = __builtin_amdgcn_exp2f(C1[4 * (m_ - 4) + 1]); C1[4 * (m_ - 4) + 2] = __builtin_amdgcn_exp2f(C1[4 * (m_ - 4) + 2]); C1[4 * (m_ - 4) + 3] = __builtin_amdgcn_exp2f(C1[4 * (m_ - 4) + 3]); PIN(C1); } \
            SBAR(); } \
    } while (0)
    f32x16 pA0, pA1, pB0, pB1; float alA = 1.f, alB = 1.f;
    A_LOAD(0); A_WRITE(0); A_LOAD(1); A_WRITE(1); A_LOAD(2); A_LOAD2(3); __syncthreads();
    A_QKT(pA0, pA1, 0); A_MAX(pA0, pA1, alA);
#pragma unroll
    for (int r = 0; r < 16; ++r) { pA0[r] = __builtin_amdgcn_exp2f(pA0[r]); pA1[r] = __builtin_amdgcn_exp2f(pA1[r]); }
    A_WRITE(2); A_WRITE2(3);
    if (nt > 4) { A_LOAD(4); A_LOAD2(5); A_WRITE(4); A_WRITE2(5); }
    __syncthreads();
    alA = 1.f;
    int sk = 1, sv_ = 0, sw = 0;
#define A_NEXT(x) ((x) == ANSLOT - 1 ? 0 : (x) + 1)
    for (int t = 1; t + 1 < nt; t += 2) {
        const bool st = t + 6 < nt;
        if (st) { A_LOAD(t + 5); A_LOAD2(t + 6); }
        A_STEP(pB0, pB1, pA0, pA1, sk, sv_, alA, alB);
        A_RESC(alB);
        sv_ = sk; sk = A_NEXT(sk);
        A_STEP(pA0, pA1, pB0, pB1, sk, sv_, alB, alA);
        __syncthreads(); if (st) { A_WRITE(sw); A_WRITE2(A_NEXT(sw)); } A_RESC(alA);
        sv_ = sk; sk = A_NEXT(sk); sw = A_NEXT(A_NEXT(sw));
    }
    A_STEP(pB0, pB1, pA0, pA1, sk, sv_, alA, alB);
    A_RESC(alB);
    { float ps = 0.f;
#pragma unroll
      for (int r = 0; r < 16; ++r) ps += pB0[r] + pB1[r];
      lsum = lsum * alB + ps;
      bf16x8 pa[4]; pack_p(pB0, pB1, pa);
      LAS const unsigned char* vt_ = vb_rd + sk * AV_BYTES;
#pragma unroll
      for (int dt = 0; dt < 2; ++dt)
#pragma unroll
          for (int s = 0; s < 4; ++s) { const s16x4 lo_ = vtr(vt_ + dt * 4096 + s * 1024), hh_ = vtr(vt_ + dt * 4096 + s * 1024 + 512);
              const bf16x8 vf = {lo_[0], lo_[1], lo_[2], lo_[3], hh_[0], hh_[1], hh_[2], hh_[3]};
              o[dt] = __builtin_amdgcn_mfma_f32_32x32x16_bf16(pa[s], vf, o[dt], 0, 0, 0); } }
    lsum = halfsum(lsum);
    if (hi == 0) wsf[r32] = lsum; LDS_WAIT();
#pragma unroll
    for (int r = 0; r < 16; ++r) { const float inv = 1.f / wsf[crow(r, hi)]; const int row = q0 + wid * 32 + crow(r, hi);
        bf16_t* op = YA + (size_t)row * 512 + h * 64 + r32;
        op[0] = (bf16_t)(cvtpk(o[0][r] * inv, 0.f) & 0xffffu); op[32] = (bf16_t)(cvtpk(o[1][r] * inv, 0.f) & 0xffffu); }
    __syncthreads();
#undef A_LOAD
#undef A_WRITE
#undef A_LOAD2
#undef A_WRITE2
#undef A_NEXT
#undef A_QKT
#undef A_MAX
#undef A_RESC
#undef A_STEP
#undef PIN
}

constexpr int NLDS_V = 0, NLDS_RPB = 8 * 16384, NRPB_SLOT = 1152, NRPB_PAD = 48, NLDS_WS = NLDS_RPB + 8 * NRPB_SLOT, NLDS_END = NLDS_WS + 8 * 256;
static_assert(NLDS_END <= 146432, "NA LDS");
__device__ __forceinline__ void na_table(const Frame& F, const float* rpb_l) {
    const int lane = F.lane, h = F.wave;
    LAS _Float16* rpbs = (LAS _Float16*)(F.lds + NLDS_RPB + h * NRPB_SLOT) + NRPB_PAD;
    float v[9];
#pragma unroll
    for (int j = 0; j < 9; ++j) { const int i = lane - NRPB_PAD + 64 * j; v[j] = (i >= 0 && i < 15 * 31) ? rpb_l[h * 465 + i] * LOG2E : 0.f; }
#pragma unroll
    for (int j = 0; j < 9; ++j) rpbs[lane - NRPB_PAD + 64 * j] = (_Float16)v[j];
    LDS_WAIT();
}
__device__ __forceinline__ void na_unit(const Frame& F, int unit, bool ctxq, int qt) {
    const bf16_t* ZN = (const bf16_t*)(F.ws + WS_ZN); bf16_t* YB = (bf16_t*)(F.ws + WS_YB);
    LAS unsigned char* lds = F.lds;
    const int lane = F.lane, h = F.wave, r32 = lane & 31, hi = lane >> 5;
    LAS unsigned char* vlds = lds + NLDS_V + h * 16384; LAS _Float16* rpbs = (LAS _Float16*)(lds + NLDS_RPB + h * NRPB_SLOT) + NRPB_PAD; LAS float* wsf = (LAS float*)(lds + NLDS_WS) + h * 64;
    const int qrow0 = ctxq ? L + unit * 64 : unit * 64;
    const int rs = ctxq ? 0 : min(max(unit - 4, 0), 256 - 8);
    bf16x8 qr[4];
#pragma unroll
    for (int s = 0; s < 4; ++s) qr[s] = *(const bf16x8*)(ZN + (size_t)(qrow0 + qt * 32 + r32) * ZN_LD + h * 64 + s * 16 + hi * 8);
    f32x16 o[2]; o[0] = f32x16{}; o[1] = f32x16{};
    float mref = -1e30f, lsum = 0.f;
    const unsigned vb_rd = (unsigned)(uintptr_t)vlds + ((lane >> 4) & 1) * 32 + (lane & 3) * 8 + (4 * hi + ((lane & 15) >> 2)) * 64;
    const int ntl = ctxq ? 0 : 8, nt = ntl + 4;
    LDS_WAIT();
    const int qc = qt * 32 + r32, cs = min(max(qc - 8, 0), 48), dbase = 4 * hi - qc + 15;
    f32x16 mk0, mk1;
#pragma unroll
    for (int r = 0; r < 16; ++r) { const int kc0 = crow(r, hi), kc1 = kc0 + 32; mk0[r] = ((kc0 >= cs) && (kc0 < cs + 16)) ? 0.f : -1e30f; mk1[r] = ((kc1 >= cs) && (kc1 < cs + 16)) ? 0.f : -1e30f; }
    bf16x8 kf[2][4];
    const int vkey = lane >> 2, vc16 = lane & 3;
#define NA_REQ(t_) do { const int t__ = (t_); const int kr0_ = t__ < ntl ? (rs + t__) * 64 : L + (t__ - ntl) * 64; \
        LAS unsigned char* img_ = vlds + (t__ & 1) * 8192; \
        _Pragma("unroll") for (int j = 0; j < 8; ++j) __builtin_amdgcn_global_load_lds((const unsigned*)(ZN + (size_t)(kr0_ + (j & 3) * 16 + vkey) * ZN_LD + 1024 + h * 64 + (j >> 2) * 32 + vc16 * 8), (LAS unsigned*)(img_ + j * 1024), 16, 0, 0); \
        _Pragma("unroll") for (int hf = 0; hf < 2; ++hf) _Pragma("unroll") for (int s = 0; s < 4; ++s) kf[hf][s] = *(const bf16x8*)(ZN + (size_t)(kr0_ + hf * 32 + r32) * ZN_LD + 512 + h * 64 + s * 16 + hi * 8); } while (0)
    NA_REQ(0);
    for (int t = 0; t < nt; ++t) {
        const bool local = t < ntl;
        f32x16 p0, p1;
        asm volatile("s_waitcnt vmcnt(0)" ::: "memory");
        if (local) { p0 = __builtin_amdgcn_mfma_f32_32x32x16_bf16(kf[0][0], qr[0], mk0, 0, 0, 0); p1 = __builtin_amdgcn_mfma_f32_32x32x16_bf16(kf[1][0], qr[0], mk1, 0, 0, 0); }
        else { p0 = __builtin_amdgcn_mfma_f32_32x32x16_bf16(kf[0][0], qr[0], f32x16{}, 0, 0, 0); p1 = __builtin_amdgcn_mfma_f32_32x32x16_bf16(kf[1][0], qr[0], f32x16{}, 0, 0, 0); }
#pragma unroll
        for (int s = 1; s < 4; ++s) { p0 = __builtin_amdgcn_mfma_f32_32x32x16_bf16(kf[0][s], qr[s], p0, 0, 0, 0); p1 = __builtin_amdgcn_mfma_f32_32x32x16_bf16(kf[1][s], qr[s], p1, 0, 0, 0); }
        SBAR();
        if (t + 1 < nt) NA_REQ(t + 1);
        SBAR();
        const unsigned vb_t = vb_rd + (t & 1) * 8192;
        const int dr = rs + t - unit + 7;
        {
            if (local) {
                const LAS _Float16* tb = rpbs + dr * 31 + dbase;
#pragma unroll
                for (int r = 0; r < 16; ++r) { const int cr_ = (r & 3) + 8 * (r >> 2); p0[r] += (float)tb[cr_]; p1[r] += (float)tb[cr_ + 32]; }
            }
            const float rm = rowmax32(p0, p1);
            if (__any(rm > mref + 8.f)) {
                const float mn = fmaxf(mref, rm); const float al = __builtin_amdgcn_exp2f(mref - mn); mref = mn; lsum *= al;
                if (hi == 0) wsf[r32] = al; LDS_WAIT();
#pragma unroll
                for (int r = 0; r < 16; ++r) { const float f = wsf[crow(r, hi)]; o[0][r] *= f; o[1][r] *= f; }
                LDS_WAIT();
            }
            float ps = 0.f;
#pragma unroll
            for (int r = 0; r < 16; ++r) { p0[r] = __builtin_amdgcn_exp2f(p0[r] - mref); p1[r] = __builtin_amdgcn_exp2f(p1[r] - mref); ps += p0[r] + p1[r]; }
            lsum += ps;
            bf16x8 pa[4]; pack_p(p0, p1, pa);
#pragma unroll
            for (int dt = 0; dt < 2; ++dt) {
                s16x4 lo[4], hh[4];
#pragma unroll
                for (int s = 0; s < 4; ++s) { lo[s] = tr_read_at(vb_t + dt * 4096 + s * 1024); hh[s] = tr_read_at(vb_t + dt * 4096 + s * 1024 + 512); }
                LDS_WAIT(); SBAR();
#pragma unroll
                for (int s = 0; s < 4; ++s) { const bf16x8 vf = {lo[s][0], lo[s][1], lo[s][2], lo[s][3], hh[s][0], hh[s][1], hh[s][2], hh[s][3]};
                    o[dt] = __builtin_amdgcn_mfma_f32_32x32x16_bf16(pa[s], vf, o[dt], 0, 0, 0); }
            }
        }
        LDS_WAIT(); SBAR();
    }
#undef NA_REQ
    {
        const float ls = halfsum(lsum);
        if (hi == 0) wsf[r32] = ls; LDS_WAIT();
#pragma unroll
        for (int r = 0; r < 16; ++r) { const float inv = 1.f / wsf[crow(r, hi)]; const int row = qrow0 + qt * 32 + crow(r, hi);
            bf16_t* op = YB + (size_t)row * 512 + h * 64 + r32;
            op[0] = (bf16_t)(cvtpk(o[0][r] * inv, 0.f) & 0xffffu); op[32] = (bf16_t)(cvtpk(o[1][r] * inv, 0.f) & 0xffffu); }
        LDS_WAIT();
    }
}

__device__ __forceinline__ int rw_row2(int d, int seq, int t) {
    if (seq == 0) return d == 0 ? L + t : L + (CT - 1) - t;
    return d == 0 ? t : (L - 1) - t;
}
constexpr int P2_D = 4, P2_NS = 5, P2_SLOT = 24576, P2_STEPS = NCH - 2;
static_assert(P2_NS * P2_SLOT <= 131072, "pass-2 ring");
__device__ __forceinline__ void rwkv_pass2(const Frame& F, int dh) {
    const int lane = F.lane, wave = F.wave, r32 = lane & 31, hi = lane >> 5;
    float* Qb = (float*)(F.ws + WS_QST) + (size_t)dh * NCH * 4096;
    const bf16_t* PTb = (const bf16_t*)(F.ws + WS_PST) + (size_t)dh * NCH * 4096;
    LAS unsigned char* lds = F.lds;
    const bool ldP = wave < 4;
    const int lrow = ldP ? (lane >> 3) : (lane >> 4), lc = ldP ? (lane & 7) : (lane & 15);
#define P2_ISSUE(k_) do { const int k__ = (k_); const int ci_ = k__ + 1; LAS unsigned char* sb_ = lds + (k__ % P2_NS) * P2_SLOT; \
        if (ldP) { _Pragma("unroll") for (int q = 0; q < 4; ++q) { const int j = 4 * (wave - 2) + q, row = 8 * j + lrow; \
            __builtin_amdgcn_global_load_lds((const unsigned*)(PTb + (size_t)ci_ * 4096 + row * 64 + ((lc ^ (row & 7)) * 8)), (LAS unsigned*)(sb_ + j * 1024), 16, 0, 0); } } \
        else { _Pragma("unroll") for (int q = 0; q < 4; ++q) { const int j = 4 * (wave - 4) + q, row = 4 * j + lrow; \
            __builtin_amdgcn_global_load_lds((const unsigned*)(Qb + (size_t)ci_ * 4096 + row * 64 + ((lc ^ (row & 15)) * 4)), (LAS unsigned*)(sb_ + 8192 + j * 1024), 16, 0, 0); } } } while (0)
    f32x16 X[2];
    if (wave < 2) {
#pragma unroll
        for (int jt = 0; jt < 2; ++jt)
#pragma unroll
            for (int g = 0; g < 4; ++g) { const f32x4 q4 = *(const f32x4*)(Qb + (size_t)(32 * wave + r32) * 64 + 32 * jt + 8 * g + 4 * hi); X[jt][4 * g] = q4[0]; X[jt][4 * g + 1] = q4[1]; X[jt][4 * g + 2] = q4[2]; X[jt][4 * g + 3] = q4[3]; }
    } else {
#pragma unroll
        for (int k = 0; k < P2_D; ++k) P2_ISSUE(k);
    }
    for (int k = 0; k < P2_STEPS; ++k) {
        if (wave >= 2) {
            const int rem = P2_STEPS - 1 - k;
            if (rem >= 3) asm volatile("s_waitcnt vmcnt(12)" ::: "memory"); else if (rem == 2) asm volatile("s_waitcnt vmcnt(8)" ::: "memory");
            else if (rem == 1) asm volatile("s_waitcnt vmcnt(4)" ::: "memory"); else asm volatile("s_waitcnt vmcnt(0)" ::: "memory");
        } else asm volatile("s_waitcnt lgkmcnt(0)" ::: "memory");
        __builtin_amdgcn_s_barrier();
        if (wave >= 2) { if (k + P2_D < P2_STEPS) P2_ISSUE(k + P2_D); }
        else {
            LAS const unsigned char* sb = lds + (k % P2_NS) * P2_SLOT;
            float* Qc = Qb + (size_t)(k + 1) * 4096;
            bf16x8 pa[2][2][2]; f32x16 N[2];
#pragma unroll
            for (int jn = 0; jn < 2; ++jn)
#pragma unroll
                for (int jt = 0; jt < 2; ++jt)
#pragma unroll
                    for (int s_ = 0; s_ < 2; ++s_) pa[jn][jt][s_] = *(LAS const bf16x8*)(sb + (32 * jn + r32) * 128 + (((4 * jt + 2 * s_ + hi) ^ (r32 & 7)) * 16));
#pragma unroll
            for (int jt = 0; jt < 2; ++jt)
#pragma unroll
                for (int g = 0; g < 4; ++g) { const f32x4 q4 = *(LAS const f32x4*)(sb + 8192 + (32 * wave + r32) * 256 + (((8 * jt + 2 * g + hi) ^ (r32 & 15)) * 16));
                    N[jt][4 * g] = q4[0]; N[jt][4 * g + 1] = q4[1]; N[jt][4 * g + 2] = q4[2]; N[jt][4 * g + 3] = q4[3]; }
            bf16x8 bh[2][2], bl[2][2];
#pragma unroll
            for (int jt = 0; jt < 2; ++jt)
#pragma unroll
                for (int s_ = 0; s_ < 2; ++s_) {
                    unsigned wh[4], wl[4];
#pragma unroll
                    for (int e2 = 0; e2 < 4; ++e2) { const float x0 = X[jt][8 * s_ + 2 * e2], x1 = X[jt][8 * s_ + 2 * e2 + 1]; const unsigned h = cvtpk(x0, x1); wh[e2] = h; wl[e2] = cvtpk(x0 - lo_bf(h), x1 - hi_bf(h)); }
                    u32x4 a = {wh[0], wh[1], wh[2], wh[3]}, b = {wl[0], wl[1], wl[2], wl[3]}; bh[jt][s_] = __builtin_bit_cast(bf16x8, a); bl[jt][s_] = __builtin_bit_cast(bf16x8, b);
                }
#pragma unroll
            for (int jt = 0; jt < 2; ++jt)
#pragma unroll
                for (int s_ = 0; s_ < 2; ++s_)
#pragma unroll
                    for (int jn = 0; jn < 2; ++jn) { N[jn] = __builtin_amdgcn_mfma_f32_32x32x16_bf16(pa[jn][jt][s_], bh[jt][s_], N[jn], 0, 0, 0); N[jn] = __builtin_amdgcn_mfma_f32_32x32x16_bf16(pa[jn][jt][s_], bl[jt][s_], N[jn], 0, 0, 0); }
            X[0] = N[0]; X[1] = N[1];
#pragma unroll
            for (int jt = 0; jt < 2; ++jt)
#pragma unroll
                for (int g = 0; g < 4; ++g) *(f32x4*)(Qc + (size_t)(32 * wave + r32) * 64 + 32 * jt + 8 * g + 4 * hi) = (f32x4){X[jt][4 * g], X[jt][4 * g + 1], X[jt][4 * g + 2], X[jt][4 * g + 3]};
        }
    }
#undef P2_ISSUE
    asm volatile("s_waitcnt vmcnt(0) lgkmcnt(0)" ::: "memory");
    __builtin_amdgcn_s_barrier();
}


namespace rwmm {
#define RW_BAR() asm volatile("s_waitcnt lgkmcnt(0)\n\ts_barrier" ::: "memory")
constexpr int PITCH = 144, MB = 64 * PITCH;
enum { B_PR = 0, B_PT, B_QR, B_QT, B_KR, B_KT, B_VR, B_RT, B_W0, B_W1, B_W2, B_W3, B_W4, B_W5, B_SB, B_NBUF };
constexpr int OFF_GC = B_NBUF * MB, OFF_TOT = OFF_GC + 256, LDS_END = OFF_TOT + 8 * 64 * 4;
static_assert(LDS_END <= 146432, "rwmm LDS");
__device__ __forceinline__ LAS unsigned char* buf(LAS unsigned char* lds, int b) { return lds + b * MB; }
__device__ __forceinline__ f32x16 mm_acc(LAS const unsigned char* A, LAS const unsigned char* B, int mt, int nt, int r32, int hi, f32x16 acc) {
    LAS const unsigned char* ap = A + (32 * mt + r32) * PITCH + hi * 16; LAS const unsigned char* bp = B + (32 * nt + r32) * PITCH + hi * 16;
#pragma unroll
    for (int ks = 0; ks < 4; ++ks) acc = __builtin_amdgcn_mfma_f32_32x32x16_bf16(*(LAS const bf16x8*)(ap + ks * 32), *(LAS const bf16x8*)(bp + ks * 32), acc, 0, 0, 0);
    return acc;
}
__device__ __forceinline__ void store_T(const f32x16& c, LAS unsigned char* b, int mt, int nt, int r32, int hi) {
#pragma unroll
    for (int g = 0; g < 4; ++g) { u32x2 w = {cvtpk(c[4 * g], c[4 * g + 1]), cvtpk(c[4 * g + 2], c[4 * g + 3])}; *(LAS u32x2*)(b + (32 * nt + r32) * PITCH + (32 * mt + 8 * g + 4 * hi) * 2) = w; }
}
__device__ __forceinline__ void store_N(const f32x16& c, LAS unsigned char* b, int mt, int nt, int r32, int hi) {
#pragma unroll
    for (int r = 0; r < 16; ++r) *(LAS bf16_t*)(b + (32 * mt + crow(r, hi)) * PITCH + (32 * nt + r32) * 2) = (bf16_t)(cvtpk(c[r], 0.f) & 0xffffu);
}
__device__ __forceinline__ f32x16 load_T(LAS const unsigned char* b, int mt, int nt, int r32, int hi) {
    f32x16 c;
#pragma unroll
    for (int g = 0; g < 4; ++g) { const u32x2 w = *(LAS const u32x2*)(b + (32 * nt + r32) * PITCH + (32 * mt + 8 * g + 4 * hi) * 2); c[4 * g] = lo_bf(w.x); c[4 * g + 1] = hi_bf(w.x); c[4 * g + 2] = lo_bf(w.y); c[4 * g + 3] = hi_bf(w.y); }
    return c;
}
template <bool STRICT> __device__ __forceinline__ void mask_upper(f32x16& c, int mt, int nt, int r32, int hi) {
#pragma unroll
    for (int r = 0; r < 16; ++r) { const int s = 32 * mt + crow(r, hi), t = 32 * nt + r32; const bool keep = STRICT ? (s < t) : (s <= t); c[r] = keep ? c[r] : 0.f; }
}

struct Raw { unsigned ka[8], lr[8], vv[4]; float kn[8]; };
__device__ __forceinline__ void prep_load(const Frame& F, int d, int h, int seq, int t0, Raw& R_) {
    const bf16_t* RKV = (const bf16_t*)(F.ws + WS_RKV); const bf16_t* LO = (const bf16_t*)(F.ws + WS_LO); const float* KN = (const float*)(F.ws + WS_KN);
    const int c = h * 64 + F.lane;
    const unsigned cu = (unsigned)c;
#pragma unroll
    for (int e = 0; e < 8; ++e) { const int row = __builtin_amdgcn_readfirstlane(rw_row2(d, seq, t0 + 8 * F.wave + e));
        const bf16_t* rb = RKV + (size_t)row * RKV_LD; const bf16_t* lb = LO + (size_t)row * LO_LD + d * 512;
        R_.ka[e] = (unsigned)rb[512u + cu] | ((unsigned)lb[1024u + cu] << 16);
        R_.lr[e] = (unsigned)lb[cu] | ((unsigned)rb[cu] << 16);
        const unsigned v = rb[1024u + cu]; if (e & 1) R_.vv[e >> 1] |= v << 16; else R_.vv[e >> 1] = v;
        R_.kn[e] = KN[row * 8 + h]; }
}
template <bool PASS3> __device__ __forceinline__ void prep(const Frame& F, const Args& a, int l, int h, const Raw& R_) {
    LAS unsigned char* lds = F.lds; const int lane = F.lane, w = F.wave, c = h * 64 + lane;
    const float kkp = a.in[I_KK][l * 512 + c], kap = a.in[I_KA][l * 512 + c];
    float G[8]; float run = 0.f;
#pragma unroll
    for (int e = 0; e < 8; ++e) { run += lo_bf(R_.lr[e]); G[e] = run; }
    LAS float* tot = (LAS float*)(lds + OFF_TOT);
    tot[w * 64 + lane] = run;
    RW_BAR();
    float off = 0.f;
#pragma unroll
    for (int ww = 0; ww < 7; ++ww) off += (ww < w) ? tot[ww * 64 + lane] : 0.f;
    unsigned pr[4], qr_[4], kr_[4];
#pragma unroll
    for (int e2 = 0; e2 < 4; ++e2) {
        float Pv[2], Qv[2], Kv[2];
#pragma unroll
        for (int u = 0; u < 2; ++u) { const int e = 2 * e2 + u, t = 8 * w + e;
            const float k = lo_bf(R_.ka[e]), av = hi_bf(R_.ka[e]), lw = lo_bf(R_.lr[e]), rr = hi_bf(R_.lr[e]);
            const float kx = k * kkp * R_.kn[e], kd = k * (1.f + (av - 1.f) * kap);
            const float g = G[e] + off; const float gam = __expf(g), inv = __expf(-g), gprev = __expf(g - lw);
            Pv[u] = -kx * gprev; Qv[u] = kx * av * inv; Kv[u] = kd * inv; const float Rv = rr * gam;
            *(LAS bf16_t*)(buf(lds, B_PT) + t * PITCH + lane * 2) = (bf16_t)(cvtpk(Pv[u], 0.f) & 0xffffu);
            *(LAS bf16_t*)(buf(lds, B_QT) + t * PITCH + lane * 2) = (bf16_t)(cvtpk(Qv[u], 0.f) & 0xffffu);
            *(LAS bf16_t*)(buf(lds, B_KT) + t * PITCH + lane * 2) = (bf16_t)(cvtpk(Kv[u], 0.f) & 0xffffu);
            if (PASS3) *(LAS bf16_t*)(buf(lds, B_RT) + t * PITCH + lane * 2) = (bf16_t)(cvtpk(Rv, 0.f) & 0xffffu);
            if (t == 63) ((LAS float*)(lds + OFF_GC))[lane] = gam; }
        pr[e2] = cvtpk(Pv[0], Pv[1]); qr_[e2] = cvtpk(Qv[0], Qv[1]); kr_[e2] = cvtpk(Kv[0], Kv[1]);
    }
    *(LAS u32x4*)(buf(lds, B_PR) + lane * PITCH + w * 16) = (u32x4){pr[0], pr[1], pr[2], pr[3]};
    *(LAS u32x4*)(buf(lds, B_QR) + lane * PITCH + w * 16) = (u32x4){qr_[0], qr_[1], qr_[2], qr_[3]};
    *(LAS u32x4*)(buf(lds, B_KR) + lane * PITCH + w * 16) = (u32x4){kr_[0], kr_[1], kr_[2], kr_[3]};
    *(LAS u32x4*)(buf(lds, B_VR) + lane * PITCH + w * 16) = (u32x4){R_.vv[0], R_.vv[1], R_.vv[2], R_.vv[3]};
    RW_BAR();
}

__device__ __forceinline__ f32x16 mm_accT(LAS const unsigned char* At, LAS const unsigned char* B, int mt, int nt, int lane, f32x16 acc) {
    const int r32 = lane & 31, hi = lane >> 5;
    LAS const unsigned char* ap = At + (8 * hi + ((lane & 15) >> 2)) * PITCH + (32 * mt + 16 * ((lane >> 4) & 1) + 4 * (lane & 3)) * 2;
    LAS const unsigned char* bp = B + (32 * nt + r32) * PITCH + hi * 16;
#pragma unroll
    for (int ks = 0; ks < 4; ++ks) { const s16x4 lo = vtr(ap + ks * 16 * PITCH), hh = vtr(ap + ks * 16 * PITCH + 4 * PITCH);
        const bf16x8 af = {lo[0], lo[1], lo[2], lo[3], hh[0], hh[1], hh[2], hh[3]};
        acc = __builtin_amdgcn_mfma_f32_32x32x16_bf16(af, *(LAS const bf16x8*)(bp + ks * 32), acc, 0, 0, 0); }
    return acc;
}
template <bool PASS3> __device__ __forceinline__ void core(const Frame& F, bool sT  , f32x16& vk, f32x16& ye) {
    LAS unsigned char* lds = F.lds; const int lane = F.lane, r32 = lane & 31, hi = lane >> 5, q = F.wave & 3, mt = q >> 1, nt = q & 1; const bool g0 = F.wave < 4;
    const f32x16 Z16 = f32x16{};
    f32x16 Tacc = Z16, a1 = Z16;
    if (g0) { f32x16 n = mm_acc(buf(lds, B_QT), buf(lds, B_PT), mt, nt, r32, hi, Z16); mask_upper<true>(n, mt, nt, r32, hi); store_T(n, buf(lds, B_W0), mt, nt, r32, hi);
        Tacc = n;
#pragma unroll
        for (int r = 0; r < 16; ++r) Tacc[r] += (mt == nt && crow(r, hi) == r32) ? 1.f : 0.f;
        store_T(Tacc, buf(lds, B_W2), mt, nt, r32, hi);
    } else { f32x16 m = mm_acc(buf(lds, B_KT), buf(lds, B_PT), mt, nt, r32, hi, Z16); mask_upper<true>(m, mt, nt, r32, hi); store_T(m, buf(lds, B_W3), mt, nt, r32, hi); }
    RW_BAR();
    if (!g0) { const f32x16 n2 = mm_accT(buf(lds, B_W0), buf(lds, B_W0), mt, nt, lane, Z16); store_T(n2, buf(lds, B_W1), mt, nt, r32, hi); }
    else if (PASS3) { f32x16 g3 = mm_acc(buf(lds, B_QT), buf(lds, B_RT), mt, nt, r32, hi, Z16); mask_upper<false>(g3, mt, nt, r32, hi); store_T(g3, buf(lds, B_W4), mt, nt, r32, hi); }
    else { const f32x16 vm = mm_acc(buf(lds, B_VR), buf(lds, B_W3), mt, nt, r32, hi, Z16); store_T(vm, buf(lds, B_W4), mt, nt, r32, hi); }
    RW_BAR();
#pragma unroll
    for (int k = 0; k < 4; ++k) {
        const int cP = (k & 1) ? B_W0 : B_W1, nP = (k & 1) ? B_W1 : B_W0, tIn = (k & 1) ? B_W5 : B_W2, tOut = (k & 1) ? B_W2 : B_W5;
        if (!g0) { const f32x16 p2 = mm_accT(buf(lds, cP), buf(lds, cP), mt, nt, lane, Z16); store_T(p2, buf(lds, nP), mt, nt, r32, hi);
            if (PASS3) {
                if (k == 0) { f32x16 g4 = mm_acc(buf(lds, B_KT), buf(lds, B_RT), mt, nt, r32, hi, Z16); mask_upper<false>(g4, mt, nt, r32, hi); store_T(g4, buf(lds, B_QT), mt, nt, r32, hi); }
                if (k == 1) ye = sT ? mm_accT(buf(lds, B_SB), buf(lds, B_RT), mt, nt, lane, Z16) : mm_acc(buf(lds, B_SB), buf(lds, B_RT), mt, nt, r32, hi, Z16);
                if (k == 2) ye = mm_acc(buf(lds, B_VR), buf(lds, B_QT), mt, nt, r32, hi, ye);
            }
        } else { Tacc = mm_accT(buf(lds, tIn), buf(lds, cP), mt, nt, lane, Tacc); store_T(Tacc, buf(lds, tOut), mt, nt, r32, hi);
            if (PASS3) {
                if (k == 0) a1 = sT ? mm_accT(buf(lds, B_SB), buf(lds, B_PT), mt, nt, lane, Z16) : mm_acc(buf(lds, B_SB), buf(lds, B_PT), mt, nt, r32, hi, Z16);
                if (k == 1) { a1 = mm_acc(buf(lds, B_VR), buf(lds, B_W3), mt, nt, r32, hi, a1); store_T(a1, buf(lds, B_KT), mt, nt, r32, hi); }
                if (k == 2) vk = mm_acc(buf(lds, B_VR), buf(lds, B_KR), mt, nt, r32, hi, Z16);
            }
        }
        RW_BAR();
    }
    if (g0) { Tacc = mm_accT(buf(lds, B_W2), buf(lds, B_W1), mt, nt, lane, Tacc); store_T(Tacc, buf(lds, B_W5), mt, nt, r32, hi); }
    else if (!PASS3) vk = mm_acc(buf(lds, B_VR), buf(lds, B_KR), mt, nt, r32, hi, Z16);
    RW_BAR();
    if (g0) { const f32x16 e = mm_accT(buf(lds, B_W5), buf(lds, B_QR), mt, nt, lane, Z16); store_T(e, buf(lds, B_W0), mt, nt, r32, hi); }
    else if (PASS3) { const f32x16 f = mm_accT(buf(lds, B_W5), buf(lds, B_W4), mt, nt, lane, Z16); store_T(f, buf(lds, B_W1), mt, nt, r32, hi); }
    RW_BAR();
}

__device__ __forceinline__ void pass1_item(const Frame& F, const Args& a, int l, int d, int h, int ci) {
    LAS unsigned char* lds = F.lds; const int lane = F.lane, r32 = lane & 31, hi = lane >> 5, q = F.wave & 3, mt = q >> 1, nt = q & 1; const bool g0 = F.wave < 4;
    const bool ctx = ci == 0; const int nsub = ctx ? 4 : 2, seq = ctx ? 0 : 1, tb = ctx ? 0 : (ci - 1) * TCH;
    float* Qs = (float*)(F.ws + WS_QST) + (size_t)(d * 8 + h) * NCH * 4096; bf16_t* PTg = (bf16_t*)(F.ws + WS_PST) + ((size_t)(d * 8 + h) * NCH + ci) * 4096;
    const f32x16 Z16 = f32x16{};
    for (int sb = 0; sb < nsub; ++sb) {
        { Raw raw; prep_load(F, d, h, seq, tb + 64 * sb, raw); prep<false>(F, a, l, h, raw); }
        f32x16 vk = Z16, ye = Z16;
        core<false>(F, false, vk, ye);
        const float gc = ((LAS const float*)(lds + OFF_GC))[32 * nt + r32];
        f32x16 pq = Z16;
        if (g0) { if (!ctx) { pq = mm_acc(buf(lds, B_PR), buf(lds, B_W0), mt, nt, r32, hi, Z16);
#pragma unroll
                for (int r = 0; r < 16; ++r) pq[r] = (pq[r] + ((mt == nt && crow(r, hi) == r32) ? 1.f : 0.f)) * gc;
                store_T(pq, buf(lds, B_W2), mt, nt, r32, hi); if (sb == 0) store_T(pq, buf(lds, B_SB), mt, nt, r32, hi); }
            else if (sb > 0) { pq = mm_acc(buf(lds, B_PR), buf(lds, B_W0), mt, nt, r32, hi, Z16);
#pragma unroll
                for (int r = 0; r < 16; ++r) pq[r] = (pq[r] + ((mt == nt && crow(r, hi) == r32) ? 1.f : 0.f)) * gc;
                store_T(pq, buf(lds, B_W2), mt, nt, r32, hi); }
        } else { pq = mm_accT(buf(lds, B_W4), buf(lds, B_W0), mt, nt, lane, vk);
#pragma unroll
            for (int r = 0; r < 16; ++r) pq[r] *= gc;
            if (sb == 0) store_T(pq, buf(lds, B_RT), mt, nt, r32, hi); }
        RW_BAR();
        if (sb > 0) {
            if (g0) { if (!ctx) pq = mm_accT(buf(lds, B_SB), buf(lds, B_W2), mt, nt, lane, Z16); }
            else pq = mm_accT(buf(lds, B_RT), buf(lds, B_W2), mt, nt, lane, pq);
            RW_BAR();
            const bool last = sb == nsub - 1;
            if (!g0) {
                if (!last) store_T(pq, buf(lds, B_RT), mt, nt, r32, hi);
                if (last || (ctx && sb == 1)) {
                    float* o = Qs + (size_t)((ctx && sb == 1) ? NCH - 1 : ci) * 4096;
#pragma unroll
                    for (int r = 0; r < 16; ++r) o[(32 * mt + crow(r, hi)) * 64 + 32 * nt + r32] = pq[r];
                }
            } else if (!ctx) {
                if (!last) store_T(pq, buf(lds, B_SB), mt, nt, r32, hi);
                else {
#pragma unroll
                    for (int g = 0; g < 4; ++g) { const int pos = (mt << 5) | ((g >> 1) << 4) | (hi << 3) | ((g & 1) << 2);
                        u32x2 wv = {cvtpk(pq[4 * g], pq[4 * g + 1]), cvtpk(pq[4 * g + 2], pq[4 * g + 3])}; *(u32x2*)(PTg + (32 * nt + r32) * 64 + pos) = wv; }
                }
            }
            RW_BAR();
        }
    }
}
__device__ __forceinline__ void pass3_item(const Frame& F, const Args& a, int l, int d, int h, int pc) {
    LAS unsigned char* lds = F.lds; const int lane = F.lane, r32 = lane & 31, hi = lane >> 5, q = F.wave & 3, mt = q >> 1, nt = q & 1; const bool g0 = F.wave < 4;
    const int seq = pc < 2 ? 0 : 1, tb = pc < 2 ? pc * TCH : (pc - 2) * TCH, slot = pc == 1 ? NCH - 1 : pc - 2;
    bf16_t* Y = (bf16_t*)(F.ws + (d == 0 ? WS_YF : WS_YBK));
    const float* S0g = (const float*)(F.ws + WS_QST) + ((size_t)(d * 8 + h) * NCH + slot) * 4096;
    { const int i = F.tid >> 3, c8 = (F.tid & 7) * 8; u32x4 wv = {0u, 0u, 0u, 0u};
      if (pc != 0) { const float* S0 = S0g + i * 64 + c8; const f32x4 x0 = *(const f32x4*)S0, x1 = *(const f32x4*)(S0 + 4);
          wv = (u32x4){cvtpk(x0[0], x0[1]), cvtpk(x0[2], x0[3]), cvtpk(x1[0], x1[1]), cvtpk(x1[2], x1[3])}; }
      *(LAS u32x4*)(buf(lds, B_SB) + i * PITCH + c8 * 2) = wv; }
    const f32x16 Z16 = f32x16{};
    for (int sb = 0; sb < 2; ++sb) {
        { Raw raw; prep_load(F, d, h, seq, tb + 64 * sb, raw); prep<true>(F, a, l, h, raw); }
        f32x16 vk = Z16, ye = Z16;
        core<true>(F, sb == 1, vk, ye);
        f32x16 s1 = Z16;
        if (!g0) {
            const f32x16 y = mm_accT(buf(lds, B_KT), buf(lds, B_W1), mt, nt, lane, ye);
            const size_t row = (size_t)rw_row2(d, seq, tb + 64 * sb + 32 * nt + r32);
#pragma unroll
            for (int g = 0; g < 4; ++g) { u32x2 wv = {cvtpk(y[4 * g], y[4 * g + 1]), cvtpk(y[4 * g + 2], y[4 * g + 3])}; *(u32x2*)(Y + row * 512 + h * 64 + 32 * mt + 8 * g + 4 * hi) = wv; }
        } else if (sb == 0) {
            const float gc = ((LAS const float*)(lds + OFF_GC))[32 * nt + r32];
            s1 = vk;
            if (pc != 0) {
#pragma unroll
                for (int r = 0; r < 16; ++r) s1[r] += S0g[(32 * mt + crow(r, hi)) * 64 + 32 * nt + r32]; }
            s1 = mm_accT(buf(lds, B_KT), buf(lds, B_W0), mt, nt, lane, s1);
#pragma unroll
            for (int r = 0; r < 16; ++r) s1[r] *= gc;
        }
        RW_BAR();
        if (g0 && sb == 0) store_T(s1, buf(lds, B_SB), mt, nt, r32, hi);
        RW_BAR();
    }
}
#undef RW_BAR
}

__device__ __forceinline__ void norm2_route_rows(const Frame& F, const Args& a, int l, const float* src, const float* g, const float* sh, const float* sc) {
    bf16_t* H = (bf16_t*)(F.ws + WS_H);
    int* ridx = (int*)(F.ws + WS_RT_IDX); int* rpos = (int*)(F.ws + WS_RT_POS); float* rgate = (float*)(F.ws + WS_RT_GATE);
    unsigned* cnt = (unsigned*)(F.ws + WS_CTL) + CW_MOECNT;
    const float* rw = a.in[I_ROUTER];
    f32x4 ca[4], cb[4];
#pragma unroll
    for (int j = 0; j < 4; ++j) { const int d = F.lane * 4 + 256 * j; const f32x4 gg = *(const f32x4*)(g + d), s1 = *(const f32x4*)(sc + d); ca[j] = gg * (s1 + 1.0f); cb[j] = *(const f32x4*)(sh + d); }
    const int gw = F.vcu * NWAVES + F.wave, NGW = F.G * NWAVES;
    for (int m = gw; m < L; m += NGW) {
        const f32x4* xr = (const f32x4*)(src + (size_t)m * DM) + F.lane;
        f32x4 v[4]; float s = 0.f;
#pragma unroll
        for (int j = 0; j < 4; ++j) { v[j] = xr[64 * j]; s += (v[j].x * v[j].x + v[j].y * v[j].y) + (v[j].z * v[j].z + v[j].w * v[j].w); }
        const float rstd = rsqrtf(wave_sum(s) * (1.f / DM) + NORM_EPS);
        u32x2* o8 = (u32x2*)(H + (size_t)m * DM) + F.lane;
        float lg[8] = {0.f, 0.f, 0.f, 0.f, 0.f, 0.f, 0.f, 0.f};
#pragma unroll
        for (int j = 0; j < 4; ++j) { const f32x4 y = v[j] * rstd * ca[j] + cb[j]; u32x2 w; w.x = cvtpk(y.x, y.y); w.y = cvtpk(y.z, y.w); o8[64 * j] = w;
            const float* rp = rw + (size_t)(F.lane * 4 + 256 * j) * 8;
#pragma unroll
            for (int e4 = 0; e4 < 4; ++e4) { const f32x4 w0 = *(const f32x4*)(rp + e4 * 8), w1 = *(const f32x4*)(rp + e4 * 8 + 4);
                const float yy = y[e4];
                lg[0] += yy * w0[0]; lg[1] += yy * w0[1]; lg[2] += yy * w0[2]; lg[3] += yy * w0[3]; lg[4] += yy * w1[0]; lg[5] += yy * w1[1]; lg[6] += yy * w1[2]; lg[7] += yy * w1[3]; } }
#pragma unroll
        for (int e = 0; e < 8; ++e) lg[e] = wave_sum(lg[e]);
        if (F.lane == 0) {
            int i1 = 0; float l1 = lg[0];
#pragma unroll
            for (int e = 1; e < 8; ++e) if (lg[e] > l1) { l1 = lg[e]; i1 = e; }
            int i2 = -1; float l2 = -3.0e38f;
#pragma unroll
            for (int e = 0; e < 8; ++e) if (e != i1 && lg[e] > l2) { l2 = lg[e]; i2 = e; }
            const float g2v = 1.f / (1.f + __expf(l1 - l2)), g1v = 1.f - g2v;
            const unsigned p1 = __hip_atomic_fetch_add(cnt + 64 * i1, 1u, __ATOMIC_RELAXED, __HIP_MEMORY_SCOPE_AGENT);
            const unsigned p2 = __hip_atomic_fetch_add(cnt + 64 * i2, 1u, __ATOMIC_RELAXED, __HIP_MEMORY_SCOPE_AGENT);
            ridx[2 * m] = i1; ridx[2 * m + 1] = i2; rpos[2 * m] = (int)p1; rpos[2 * m + 1] = (int)p2; rgate[2 * m] = g1v; rgate[2 * m + 1] = g2v;
        }
    }
}
__device__ __forceinline__ void moe_tile_bases(const Frame& F, int (&tb)[9]) {
    const unsigned* cnt = (const unsigned*)(F.ws + WS_CTL) + CW_MOECNT;
    int acc = 0;
#pragma unroll
    for (int e = 0; e < 8; ++e) { tb[e] = acc; const unsigned c = __hip_atomic_load(cnt + 64 * e, __ATOMIC_RELAXED, __HIP_MEMORY_SCOPE_AGENT); acc += (int)((c + 255u) >> 8); }
    tb[8] = acc;
}
__device__ __forceinline__ void moe_gather(const Frame& F) {
    const bf16_t* H = (const bf16_t*)(F.ws + WS_H); bf16_t* H2G = (bf16_t*)(F.ws + WS_H2G);
    const int* ridx = (const int*)(F.ws + WS_RT_IDX); const int* rpos = (const int*)(F.ws + WS_RT_POS); const float* rgate = (const float*)(F.ws + WS_RT_GATE);
    float* rowgate = (float*)(F.ws + WS_RT_ROWGATE);
    const unsigned* cnt = (const unsigned*)(F.ws + WS_CTL) + CW_MOECNT;
    int tb[9]; moe_tile_bases(F, tb);
    const int gw = F.vcu * NWAVES + F.wave, NGW = F.G * NWAVES;
    for (int m = gw; m < L; m += NGW) {
        const u32x4 r0 = *((const u32x4*)(H + (size_t)m * DM) + F.lane), r1 = *((const u32x4*)(H + (size_t)m * DM) + 64 + F.lane);
#pragma unroll
        for (int s = 0; s < 2; ++s) {
            const int e = ridx[2 * m + s]; int base = 0;
#pragma unroll
            for (int k = 0; k < 8; ++k) base = (e == k) ? tb[k] : base;
            const size_t row = (size_t)base * 256 + rpos[2 * m + s];
            *((u32x4*)(H2G + row * DM) + F.lane) = r0; *((u32x4*)(H2G + row * DM) + 64 + F.lane) = r1;
            if (F.lane == 0) rowgate[row] = rgate[2 * m + s];
        }
    }
#pragma unroll
    for (int e = 0; e < 8; ++e) {
        const int c = (int)__hip_atomic_load(cnt + 64 * e, __ATOMIC_RELAXED, __HIP_MEMORY_SCOPE_AGENT);
        const int lo = tb[e] * 256 + c, hi_ = tb[e + 1] * 256;
        for (int row = lo + gw; row < hi_; row += NGW) { *((u32x4*)(H2G + (size_t)row * DM) + F.lane) = (u32x4){0u, 0u, 0u, 0u}; *((u32x4*)(H2G + (size_t)row * DM) + 64 + F.lane) = (u32x4){0u, 0u, 0u, 0u}; if (F.lane == 0) rowgate[row] = 0.f; }
    }
}
__device__ __forceinline__ void moe_combine(const Frame& F, float* out, const float* gt2) {
    const bf16_t* YS = (const bf16_t*)(F.ws + WS_H2G);
    const int* ridx = (const int*)(F.ws + WS_RT_IDX); const int* rpos = (const int*)(F.ws + WS_RT_POS);
    const bf16_t* YSP = (const bf16_t*)(F.ws + WS_YSP);
    int tb[9]; moe_tile_bases(F, tb);
    const size_t tail0 = (size_t)(tb[8] < 128 ? tb[8] : 128) * 256;
    const int gw = F.vcu * NWAVES + F.wave, NGW = F.G * NWAVES;
    for (int m = gw; m < L; m += NGW) {
        size_t rows[2];
#pragma unroll
        for (int s = 0; s < 2; ++s) { const int e = ridx[2 * m + s]; int base = 0;
#pragma unroll
            for (int k = 0; k < 8; ++k) base = (e == k) ? tb[k] : base;
            rows[s] = (size_t)base * 256 + rpos[2 * m + s]; }
#pragma unroll
        for (int hf = 0; hf < 2; ++hf) {
            const int c0 = hf * 512 + F.lane * 8;
            const u32x4 a0 = *(const u32x4*)(YS + rows[0] * DM + c0), a1 = *(const u32x4*)(YS + rows[1] * DM + c0);
            float* op = out + (size_t)m * DM + c0;
            const f32x4 g0 = *(const f32x4*)(gt2 + c0), g1 = *(const f32x4*)(gt2 + c0 + 4);
            f32x4 x0 = *(const f32x4*)op, x1 = *(const f32x4*)(op + 4);
            f32x4 s0 = {lo_bf(a0.x) + lo_bf(a1.x), hi_bf(a0.x) + hi_bf(a1.x), lo_bf(a0.y) + lo_bf(a1.y), hi_bf(a0.y) + hi_bf(a1.y)};
            f32x4 s1 = {lo_bf(a0.z) + lo_bf(a1.z), hi_bf(a0.z) + hi_bf(a1.z), lo_bf(a0.w) + lo_bf(a1.w), hi_bf(a0.w) + hi_bf(a1.w)};
#pragma unroll
            for (int s = 0; s < 2; ++s) if (rows[s] >= tail0) {
#pragma unroll
                for (int q = 0; q < 3; ++q) { const u32x4 p = *(const u32x4*)(YSP + ((size_t)q * MOE_TAIL_ROWS + (rows[s] - tail0)) * DM + c0);
                    s0 += (f32x4){lo_bf(p.x), hi_bf(p.x), lo_bf(p.y), hi_bf(p.y)}; s1 += (f32x4){lo_bf(p.z), hi_bf(p.z), lo_bf(p.w), hi_bf(p.w)}; } }
            x0 += g0 * s0; x1 += g1 * s1;
            *(f32x4*)op = x0; *(f32x4*)(op + 4) = x1;
        }
    }
}

#ifndef PROBE_MOE
#define PROBE_MOE 1
#endif
#ifndef PROBE_LATONLY
#define PROBE_LATONLY 0
#endif
#ifndef PROBE_SKIPNA
#define PROBE_SKIPNA 0
#endif
#ifndef PROBE_NA
#define PROBE_NA 1
#endif
#ifndef PROBE_MLA
#define PROBE_MLA 1
#endif
#ifndef PROBE_GEMM
#define PROBE_GEMM 1
#endif
#ifndef PROBE_P1012
#define PROBE_P1012 1
#endif
#ifndef PROBE_P14
#define PROBE_P14 1
#endif
#ifndef PROBE_RW3
#define PROBE_RW3 1
#endif
#ifndef PROBE_RW1
#define PROBE_RW1 1
#endif
#ifndef REP_MLA
#define REP_MLA 1
#endif
#ifndef REP_NA
#define REP_NA 1
#endif
#ifndef REP_RW1
#define REP_RW1 1
#endif
#ifndef REP_RW3
#define REP_RW3 1
#endif
#ifndef REP_GEMM
#define REP_GEMM 1
#endif
#ifndef REP_ROW
#define REP_ROW 1
#endif
#ifndef PROBE_PREFIX
#define PROBE_PREFIX 0
#endif
constexpr int PH_PER_LAYER = 24;
constexpr int N_PHASES = 1 + 2 * PH_PER_LAYER;
__global__ void __launch_bounds__(NTHR, 2) mega_fwd(Args args) {
    extern __shared__ __attribute__((aligned(16))) unsigned char lds_raw[];
    Frame F;
    F.lds = (LAS unsigned char*)lds_raw; F.ws = args.ws;
    F.tid = threadIdx.x; F.lane = F.tid & 63; F.wave = __builtin_amdgcn_readfirstlane((int)threadIdx.x >> 6);
    F.G = gridDim.x; F.bid = blockIdx.x; F.vcu = (F.G % 8 == 0) ? (F.bid % 8) * (F.G / 8) + F.bid / 8 : F.bid;
    volatile LAS unsigned* MISC = (volatile LAS unsigned*)(F.lds + LDS_MISC_OFF);
    if (F.tid < 64) MISC[F.tid] = 0u;
    __syncthreads();
    const int lo = args.ph_lo, hi_full = args.ph_hi;
    const bool multi = (hi_full - lo) > 1;
    XcdBarrier bar; bar.bar = (unsigned*)(F.ws + WS_CTL) + CW_BAR; bar.x = 0; bar.st = MISC + 8;
    if (multi) bar = xcd_barrier_post((unsigned*)(F.ws + WS_CTL) + CW_BAR, MISC + 8);
#define IN(k) (lo <= (k) && (k) < hi)
    const Frame F0 = F;
#define SEAM(k) do { if (multi && (k) < hi) xcd_barrier(bar); } while (0)
    LAS unsigned char* lds = F.lds;
    float* MODV = (float*)(F.ws + WS_MODV);
    float* out = args.out;

    for (int pass_ = 0; pass_ < (PROBE_PREFIX > 0 ? 2 : 1); ++pass_) {
    const int hi = (PROBE_PREFIX > 0 && pass_ == 0) ? PROBE_PREFIX : hi_full;
    if (IN(0)) { const Frame F = launder(F0);
        if (PROBE_PREFIX > 0 && F.bid == 0 && F.tid < 8) ((unsigned*)(F.ws + WS_CTL) + CW_MOECNT)[F.tid * 64] = 0u;
        prologue_mod(F, args); prologue_weights(F, args); }
    SEAM(0);

#pragma unroll
    for (int l = 0; l < 2; ++l) {
        const int pb = 1 + l * PH_PER_LAYER;
        const bool need_ctx = (l == 0);
        unsigned char* wb = F.ws + WS_W + (size_t)l * WB_SIZE;
        const float* modL = MODV + (size_t)(l * 2) * 6144; const float* modC = modL + 6144;
        float* X1 = (float*)(F.ws + WS_X1); float* CM = (float*)(F.ws + WS_CM);
        bf16_t* H = (bf16_t*)(F.ws + WS_H);
        const int nMall = R / 256, nMlat = L / 256;

        if (IN(pb + 0)) { const Frame F = launder(F0);
            if (l == 0) { norm_rows(F, args.in[I_X], 0, 0, L, args.in[I_N1G] + l * DM, modL, modL + 1024, H);
                          norm_rows(F, args.in[I_CTX], L, L, R, args.in[I_N1G] + l * DM, modC, modC + 1024, H); }
            else { norm_rows(F, X1, 0, 0, L, args.in[I_N1G] + l * DM, modL, modL + 1024, H);
                   norm_ctx_rows_from_parts(F, CM, (const float*)(F.ws + WS_PART), MODV + 6144 + 5120, args.in[I_N1G] + l * DM, modC, modC + 1024, H); }
        }
        SEAM(pb + 0);
        for (int rq_ = 0; rq_ < PROBE_P14; ++rq_) {
        if (IN(pb + 1)) { const Frame F = launder(F0);
            pg8::Gemm g{H, DM, (const bf16_t*)(wb + WB_WINM), DM}; pg8::StaticOrder S; S.init(nMall, ZM_N / 256, F.G, F.bid, PROBE_GEMM);
            EpiZ E{(bf16_t*)(F.ws + WS_ZA), (bf16_t*)(F.ws + WS_ZN), (bf16_t*)(F.ws + WS_ZR)};
            pg8::gemm_phase(lds, F.tid, g, S, E);
        }
        SEAM(pb + 1);
        if (IN(pb + 2)) { const Frame F = launder(F0); prepare_rows(F, args, l); }
        SEAM(pb + 2);
        if (IN(pb + 3)) { const Frame F = launder(F0);
            { pg8::Gemm g{(const bf16_t*)(F.ws + WS_CQN), 384, (const bf16_t*)(wb + WB_WUQ), 384}; pg8::StaticOrder S; S.init(nMall, 3, F.G, F.bid, PROBE_GEMM);
              EpiBf E{(bf16_t*)(F.ws + WS_QRAW), 768}; pg8::gemm_phase(lds, F.tid, g, S, E); }
            { pg8::Gemm g{(const bf16_t*)(F.ws + WS_CKVN), 256, (const bf16_t*)(wb + WB_WUKV), 256}; pg8::StaticOrder S; S.init(nMall, 4, F.G, (F.bid + F.G - (nMall * 3) % F.G) % F.G, PROBE_GEMM);
              EpiBf E{(bf16_t*)(F.ws + WS_KVRAW), 1024}; pg8::gemm_phase(lds, F.tid, g, S, E); }
            { int kl = 128; asm volatile("" : "+s"(kl));
              pg8::Gemm g{(const bf16_t*)(F.ws + WS_LA), 384, (const bf16_t*)(wb + WB_WLORA), kl, 128u, 0u}; pg8::PairSegOrder S; S.S.init(nMall, 10, F.G, (F.bid + F.G - (nMall * 7) % F.G) % F.G, PROBE_GEMM);
              EpiLora E{(bf16_t*)(F.ws + WS_LO), args.in[I_W0] + (size_t)l * 1024, args.in[I_A0] + (size_t)l * 1024}; pg8::gemm_phase(lds, F.tid, g, S, E); }
        }
        SEAM(pb + 3);
        if (IN(pb + 4)) { const Frame F = launder(F0); mla_fixup(F, args, l, need_ctx); }
        SEAM(pb + 4);
        }
        if (IN(pb + 5)) { const Frame F = launder(F0);
            const int xcd = F.bid % 8, idx = F.bid / 8, per = F.G / 8;
            for (int u0 = idx; u0 < 64 * PROBE_MLA + ((need_ctx && idx == 0) ? per : 0); u0 += per) { const int u = u0 >= 64 * PROBE_MLA ? 64 : u0 % 64;
                const bool cu = u >= 64;
                mla_unit(F, xcd, cu ? L : u * 256, cu ? L : 0, cu ? CT / 64 : R / 64);
            }
        }
        SEAM(pb + 5);
        if (IN(pb + 6)) { const Frame F = launder(F0);
            for (int it = F.bid; it < PROBE_RW1 * 16 * 128; it += F.G) { const int ci = (it >> 4) & 127, dh = it & 15;
                rwmm::pass1_item(F, args, l, dh >> 3, dh & 7, ci);
            }
        }
        SEAM(pb + 6);
        if (IN(pb + 7)) { const Frame F = launder(F0);
            const int nrw = F.G > 64 ? 16 : 0;
            if (F.bid < nrw) rwkv_pass2(F, F.bid);
            else {
                if (nrw == 0 && F.bid < 16) rwkv_pass2(F, F.bid);
                __syncthreads();
                if (need_ctx && F.bid >= F.G - 32) { const int k = F.bid - (F.G - 32); rwmm::pass3_item(F, args, l, k >> 4, (k >> 1) & 7, k & 1); }
                const float* rpb_l = args.in[I_RPB] + (size_t)l * 8 * 465;
                const bool band = F.G == 256; const int x = F.bid & 7, nall = 2 * (256 + (need_ctx ? 4 : 0));
                const int k0 = band ? (F.bid >> 3) - 2 : F.bid - nrw, kstep = band ? 30 : F.G - nrw, kend = (PROBE_SKIPNA && pass_ == 0) ? 0 : band ? 64 + (need_ctx ? 1 : 0) : nall;
                na_table(F, rpb_l);
                for (int k = k0; k < kend; k += kstep) {
                    const bool cq = band ? k >= 64 : (k >> 1) >= 256;
                    const int un = band ? (cq ? x >> 1 : 32 * x + (k >> 1)) : (cq ? (k >> 1) - 256 : k >> 1), qt = band ? (cq ? x & 1 : k & 1) : k & 1;
                    na_unit(F, un, cq, qt);
                }
            }
        }
        SEAM(pb + 7);
        if (IN(pb + 8)) { const Frame F = launder(F0);
            for (int it = F.bid; it < PROBE_RW3 * 16 * 128; it += F.G) { const int dh = it & 15, pc = 2 + ((it >> 4) & 127);
                rwmm::pass3_item(F, args, l, dh >> 3, dh & 7, pc);
            }
        }
        SEAM(pb + 8);
        if (IN(pb + 10)) { const Frame F = launder(F0);
            rwkv_output_rows(F, args, l, need_ctx ? R : L);
            __syncthreads();
            pg8::Gemm g{H, DM, (const bf16_t*)(wb + WB_WING), DM}; pg8::StaticOrder S; S.init(need_ctx ? nMall : nMlat, 12, F.G, F.bid, PROBE_GEMM);
            EpiSig E{(bf16_t*)(F.ws + WS_ZG), ZG_LD}; pg8::gemm_phase(lds, F.tid, g, S, E);
        }
        SEAM(pb + 10);
        for (int rp_ = 0; rp_ < PROBE_P1012; ++rp_) {
        if (IN(pb + 11)) { const Frame F = launder(F0);
            pg8::Gemm g{(const bf16_t*)(F.ws + WS_YA), 512, (const bf16_t*)(wb + WB_WOA), 512, (unsigned)(WS_YB - WS_YA), (unsigned)(WB_WOB - WB_WOA)};
            pg8::SegOrder3 S; S.S.init(need_ctx ? nMall : nMlat, 4, F.G, F.bid);
            EpiMerge3 E{(bf16_t*)(F.ws + WS_U), (const bf16_t*)(F.ws + WS_ZG)}; pg8::gemm_phase(lds, F.tid, g, S, E);
        }
        SEAM(pb + 11);
        if (IN(pb + 12)) { const Frame F = launder(F0);
            pg8::Gemm g{(const bf16_t*)(F.ws + WS_U), DM, (const bf16_t*)(wb + WB_WOUT), DM}; pg8::StaticOrder S; S.init(need_ctx ? nMall : nMlat, 4, F.G, F.bid, PROBE_GEMM);
            EpiRes E{l == 0 ? args.in[I_X] : X1, l == 0 ? args.in[I_CTX] : X1 + (size_t)L * DM, out, CM, modL + 2048, modC + 2048};
            pg8::gemm_phase(lds, F.tid, g, S, E);
        }
        SEAM(pb + 12);
        }
        if (l == 0) {
            if (IN(pb + 13)) { const Frame F = launder(F0); norm_rows(F, out, 0, 0, L, args.in[I_N2G] + l * DM, modL + 3072, modL + 4096, H);
                               norm_rows(F, CM, L, L, R, args.in[I_N2G] + l * DM, modC + 3072, modC + 4096, H); }
            SEAM(pb + 13);
            if (IN(pb + 14)) { const Frame F = launder(F0);
                pg8::Gemm g{H, DM, (const bf16_t*)(F.ws + WS_W13), DM}; pg8::StaticOrder S; S.init(nMall, 22, F.G, F.bid, PROBE_GEMM);
                EpiSwiglu E{(bf16_t*)(F.ws + WS_G), FF, 0, 1 << 20}; pg8::gemm_phase(lds, F.tid, g, S, E);
            }
            SEAM(pb + 14);
            if (IN(pb + 15)) { const Frame F = launder(F0);
                { pg8::Gemm g{(const bf16_t*)(F.ws + WS_G), FF, (const bf16_t*)(F.ws + WS_W2), FF}; pg8::StaticOrder S; S.init(nMlat, 4, F.G, F.bid, PROBE_GEMM);
                  EpiRes E{out, CM, X1, X1 + (size_t)L * DM, modL + 5120, modC + 5120}; pg8::gemm_phase(lds, F.tid, g, S, E); }
                { int ksl = 256; asm volatile("" : "+s"(ksl));
                  pg8::Gemm g{(const bf16_t*)(F.ws + WS_G), FF, (const bf16_t*)(F.ws + WS_W2), ksl, 512u, 512u, FF}; CtxSplitOrder S{nMlat, 4, FF / 256, F.G, (F.bid + F.G / 2) % F.G};
                  EpiCtxPart E{(float*)(F.ws + WS_PART)}; pg8::gemm_phase(lds, F.tid, g, S, E); }
            }
            SEAM(pb + 15);
        } else {
            if (IN(pb + 13)) { const Frame F = launder(F0); norm2_route_rows(F, args, l, out, args.in[I_N2G] + l * DM, modL + 3072, modL + 4096); }
            SEAM(pb + 13);
            if (IN(pb + 14)) { const Frame F = launder(F0); moe_gather(F); moe_weights(F, args, 0); }
            SEAM(pb + 14);
            int tb[9]; moe_tile_bases(F, tb);
            if (IN(pb + 15)) { const Frame F = launder(F0);
                moe_weights(F, args, 1);
                __syncthreads();
                MoeOrder S{tb[0], tb[1], tb[2], tb[3], tb[4], tb[5], tb[6], tb[7], tb[8], 28, 0, F.G, F.bid, PROBE_MOE, tb[8]};
                pg8::Gemm g{(const bf16_t*)(F.ws + WS_H2G), DM, (const bf16_t*)(F.ws + WS_W13E), DM};
                EpiSwiglu E{(bf16_t*)(F.ws + WS_HID), FFE, 0, 28}; pg8::gemm_phase(lds, F.tid, g, S, E);
            }
            SEAM(pb + 15);
            if (IN(pb + 17)) { const Frame F = launder(F0);
                const int tm = tb[8] < 128 ? tb[8] : 128;
                { MoeOrder S{tb[0], tb[1], tb[2], tb[3], tb[4], tb[5], tb[6], tb[7], tb[8], 4, W2E_HI_TILE_SHIFT, F.G, F.bid, PROBE_MOE, tm};
                  pg8::Gemm g{(const bf16_t*)(F.ws + WS_HID), FFE, (const bf16_t*)(F.ws + WS_W2E_LO), FFE};
                  EpiMoe2 E{(bf16_t*)(F.ws + WS_H2G), (const float*)(F.ws + WS_RT_ROWGATE)}; pg8::gemm_phase(lds, F.tid, g, S, E); }
                { int ksl = FFE / 4; asm volatile("" : "+s"(ksl));
                  MoeTailOrder S{tb[1], tb[2], tb[3], tb[4], tb[5], tb[6], tb[7], tb[8], tm, W2E_HI_TILE_SHIFT, F.G, F.bid};
                  pg8::Gemm g{(const bf16_t*)(F.ws + WS_HID), FFE, (const bf16_t*)(F.ws + WS_W2E_LO), ksl, (unsigned)(FFE / 4 * 2), (unsigned)(FFE / 4 * 2), FFE};
                  EpiMoe2P E{(bf16_t*)(F.ws + WS_H2G), (bf16_t*)(F.ws + WS_YSP), (const float*)(F.ws + WS_RT_ROWGATE), tm * 256}; pg8::gemm_phase(lds, F.tid, g, S, E); }
            }
            SEAM(pb + 17);
            if (IN(pb + 19)) { const Frame F = launder(F0); moe_combine(F, out, modL + 5120); }
        }
    }
    }
#undef IN
#undef SEAM
}

#ifndef MK_PER_PHASE
#define MK_PER_PHASE 0
#endif
extern "C" void kernel_launch(void* const* d_in, const int* in_sizes, int n_in, void* d_out, int out_size, void* d_ws, size_t ws_size, hipStream_t stream) {
    static int grid = 0;
    if (grid == 0) {
        if (n_in != 40 || out_size != L * DM || ws_size < 560 * MiB) { fprintf(stderr, "kernel_launch: unexpected shapes (n_in %d out %d ws %zu)\n", n_in, out_size, ws_size); grid = -1; return; }
        int dev = 0, cus = 0, per_cu = 0;
        if (hipGetDevice(&dev) != hipSuccess || hipDeviceGetAttribute(&cus, hipDeviceAttributeMultiprocessorCount, dev) != hipSuccess) { grid = -1; return; }
        if (hipFuncSetAttribute((const void*)mega_fwd, hipFuncAttributeMaxDynamicSharedMemorySize, LDS_BYTES) != hipSuccess) { fprintf(stderr, "kernel_launch: hipFuncSetAttribute failed\n"); grid = -1; return; }
        if (hipOccupancyMaxActiveBlocksPerMultiprocessor(&per_cu, (const void*)mega_fwd, NTHR, LDS_BYTES) != hipSuccess || per_cu < 1) fprintf(stderr, "kernel_launch: occupancy query says %d\n", per_cu);
        (void)hipGetLastError();
        grid = cus;
    }
    if (grid < 0) return;
    (void)hipMemsetAsync((char*)d_ws + WS_CTL, 0, CTL_ZERO_BYTES, stream);
    Args a{};
    for (int i = 0; i < 40; ++i) a.in[i] = (const float*)d_in[i];
    a.out = (float*)d_out; a.ws = (unsigned char*)d_ws;
#if MK_PER_PHASE
    for (int p = 0; p < N_PHASES; ++p) { a.ph_lo = p; a.ph_hi = p + 1; hipLaunchKernelGGL(mega_fwd, dim3(grid), dim3(NTHR), LDS_BYTES, stream, a); }
#else
    a.ph_lo = 0; a.ph_hi = N_PHASES;
    hipLaunchKernelGGL(mega_fwd, dim3(grid), dim3(NTHR), LDS_BYTES, stream, a);
#endif
    const hipError_t le = hipPeekAtLastError();
    if (le != hipSuccess) fprintf(stderr, "kernel_launch: launch failed: %s\n", hipGetErrorName(le));
}
```
